# Optimizing an MI355X kernel written in HIP

```python
import math
import jax, jax.numpy as jnp
from jax import lax
import numpy as np

D_MODEL = 1024
BATCH = 32
SEQ = 2048
DEPTH = 4

N_META = 16
GRID_W = 64
NA_HEADS = 16
NA_HEAD_DIM = 64
NA_KH_MAX = 8
NA_KW = 16
NA_Q_COLS = 16
NA_K_COLS = 32
SWA_Q_HEADS = 16
SWA_KV_HEADS = 4
SWA_GROUP = SWA_Q_HEADS // SWA_KV_HEADS
SWA_HEAD_DIM = 64
SWA_WINDOW = 128
SWA_BLOCK = 128
T5_BUCKETS = 32
T5_MAX_DIST = 128
FFN_DIM = 3584
N_EXPERTS = 8
TOP_K = 2
MOE_BLOCK = 512
EPS = 1e-6
NEG_INF = -1e30

kernel_name = 'hybrid_na_swa_moe_encoder'


def rmsnorm(x, g):
    xf = x.astype(jnp.float32)
    y = xf * lax.rsqrt(jnp.mean(xf * xf, axis=-1, keepdims=True) + EPS)
    return (y * g.astype(jnp.float32)).astype(x.dtype)


def t5_bucket(rel):
    nb = T5_BUCKETS // 2
    max_exact = nb // 2
    ret = jnp.where(rel > 0, nb, 0)
    n = jnp.abs(rel)
    nf = jnp.maximum(n, max_exact).astype(jnp.float32)
    large = max_exact + (jnp.log(nf / max_exact) / math.log(T5_MAX_DIST / max_exact) * (nb - max_exact)).astype(jnp.int32)
    large = jnp.minimum(large, nb - 1)
    return ret + jnp.where(n < max_exact, n, large)


def sink_probs(logits, sink):
    s = sink[:, :, None, None]
    m = jnp.maximum(jnp.max(logits, axis=-1, keepdims=True), s)
    e = jnp.exp(logits - m)
    return e / (jnp.sum(e, axis=-1, keepdims=True) + jnp.exp(s - m))


def swiglu(h, w_gate, w_up, w_down):
    return (jax.nn.silu(h @ w_gate) * (h @ w_up)) @ w_down


def na_mixer(h, w_qkv, q_g, k_g, rpb, w_o):
    B, L, _ = h.shape
    S = L - N_META
    rows = S // GRID_W
    kh = min(NA_KH_MAX, rows)
    n_cb = GRID_W // NA_Q_COLS
    hd = NA_HEADS * NA_HEAD_DIM
    qkv = h @ w_qkv
    q = qkv[..., :hd].reshape(B, L, NA_HEADS, NA_HEAD_DIM)
    k = qkv[..., hd:2 * hd].reshape(B, L, NA_HEADS, NA_HEAD_DIM)
    v = qkv[..., 2 * hd:].reshape(B, L, NA_HEADS, NA_HEAD_DIM)
    q = rmsnorm(q, q_g) * (NA_HEAD_DIM ** -0.5)
    k = rmsnorm(k, k_g)
    qm, km, vm = q[:, :N_META], k[:, :N_META], v[:, :N_META]
    lm = jnp.einsum('bqhd,bkhd->bhqk', qm, km, preferred_element_type=jnp.float32)
    om = jnp.einsum('bhqk,bkhd->bqhd', jax.nn.softmax(lm, axis=-1).astype(v.dtype), vm)
    qg = q[:, N_META:].reshape(B, rows, GRID_W, NA_HEADS, NA_HEAD_DIM)
    kg = k[:, N_META:].reshape(B, rows, GRID_W, NA_HEADS, NA_HEAD_DIM)
    vg = v[:, N_META:].reshape(B, rows, GRID_W, NA_HEADS, NA_HEAD_DIM)
    q_col = np.arange(GRID_W).reshape(n_cb, NA_Q_COLS)
    k_start = np.clip(np.arange(n_cb) * NA_Q_COLS - NA_KW // 2, 0, GRID_W - NA_K_COLS)
    k_col = k_start[:, None] + np.arange(NA_K_COLS)
    w_start = np.clip(q_col - NA_KW // 2, 0, GRID_W - NA_KW)
    col_ok = (k_col[:, None, :] >= w_start[:, :, None]) & (k_col[:, None, :] < w_start[:, :, None] + NA_KW)
    nk = kh * NA_K_COLS
    mask = np.broadcast_to(col_ok[:, :, None, :], (n_cb, NA_Q_COLS, kh, NA_K_COLS)).reshape(n_cb, NA_Q_COLS, nk)
    dc = np.clip(k_col[:, None, :] - q_col[:, :, None] + NA_KW - 1, 0, 2 * NA_KW - 2)

    def row_block(r):
        rs = jnp.clip(r - kh // 2, 0, rows - kh)
        kb = lax.dynamic_slice_in_dim(kg, rs, kh, axis=1)[:, :, k_col]
        vb = lax.dynamic_slice_in_dim(vg, rs, kh, axis=1)[:, :, k_col]
        kb = kb.transpose(0, 2, 1, 3, 4, 5).reshape(B, n_cb, nk, NA_HEADS, NA_HEAD_DIM)
        vb = vb.transpose(0, 2, 1, 3, 4, 5).reshape(B, n_cb, nk, NA_HEADS, NA_HEAD_DIM)
        qr = lax.dynamic_index_in_dim(qg, r, axis=1, keepdims=False).reshape(B, n_cb, NA_Q_COLS, NA_HEADS, NA_HEAD_DIM)
        dr = rs - r + jnp.arange(kh) + NA_KH_MAX - 1
        bias = rpb[:, dr][:, :, dc].transpose(0, 2, 3, 1, 4).reshape(NA_HEADS, n_cb, NA_Q_COLS, nk)
        lw = jnp.einsum('bcqhd,bckhd->bhcqk', qr, kb, preferred_element_type=jnp.float32)
        lw = jnp.where(mask, lw + bias.astype(jnp.float32), NEG_INF)
        lmk = jnp.einsum('bcqhd,bmhd->bhcqm', qr, km, preferred_element_type=jnp.float32)
        p = jax.nn.softmax(jnp.concatenate([lmk, lw], axis=-1), axis=-1).astype(v.dtype)
        o = (jnp.einsum('bhcqm,bmhd->bcqhd', p[..., :N_META], vm)
             + jnp.einsum('bhcqk,bckhd->bcqhd', p[..., N_META:], vb))
        return o.reshape(B, GRID_W, NA_HEADS, NA_HEAD_DIM)

    og = lax.map(row_block, jnp.arange(rows))
    og = jnp.moveaxis(og, 0, 1).reshape(B, S, hd)
    o = jnp.concatenate([om.reshape(B, N_META, hd), og], axis=1)
    return o @ w_o


def swa_mixer(h, w_qkv, q_g, k_g, sink, t5_bias, w_o):
    B, L, _ = h.shape
    S = L - N_META
    nb = S // SWA_BLOCK
    nq = SWA_Q_HEADS * SWA_HEAD_DIM
    nkv = SWA_KV_HEADS * SWA_HEAD_DIM
    qkv = h @ w_qkv
    q = qkv[..., :nq].reshape(B, L, SWA_KV_HEADS, SWA_GROUP, SWA_HEAD_DIM)
    k = qkv[..., nq:nq + nkv].reshape(B, L, SWA_KV_HEADS, SWA_HEAD_DIM)
    v = qkv[..., nq + nkv:].reshape(B, L, SWA_KV_HEADS, SWA_HEAD_DIM)
    q = rmsnorm(q, q_g) * (SWA_HEAD_DIM ** -0.5)
    k = rmsnorm(k, k_g)
    s = sink.astype(jnp.float32).reshape(SWA_KV_HEADS, SWA_GROUP)

    def head_bias(rel):
        b = t5_bias[t5_bucket(rel)].astype(jnp.float32)
        return jnp.moveaxis(b, -1, 0).reshape(SWA_KV_HEADS, SWA_GROUP, rel.shape[0], rel.shape[1])

    qm, km, vm = q[:, :N_META], k[:, :N_META], v[:, :N_META]
    pos_m = jnp.arange(N_META)
    lm = jnp.einsum('bqngd,bknd->bngqk', qm, km, preferred_element_type=jnp.float32)
    lm = lm + head_bias(pos_m[None, :] - pos_m[:, None])
    om = jnp.einsum('bngqk,bknd->bqngd', sink_probs(lm, s).astype(v.dtype), vm)
    qr = q[:, N_META:]
    pad = ((0, 0), (SWA_BLOCK, SWA_BLOCK), (0, 0), (0, 0))
    kp = jnp.pad(k[:, N_META:], pad)
    vp = jnp.pad(v[:, N_META:], pad)
    j = jnp.arange(3 * SWA_BLOCK)
    qi = jnp.arange(SWA_BLOCK)
    rel_w = j[None, :] - SWA_BLOCK - qi[:, None]
    bias_w = head_bias(rel_w)
    band = jnp.abs(rel_w) <= SWA_WINDOW

    def block(i):
        qb = lax.dynamic_slice_in_dim(qr, i * SWA_BLOCK, SWA_BLOCK, axis=1)
        kb = lax.dynamic_slice_in_dim(kp, i * SWA_BLOCK, 3 * SWA_BLOCK, axis=1)
        vb = lax.dynamic_slice_in_dim(vp, i * SWA_BLOCK, 3 * SWA_BLOCK, axis=1)
        kidx = i * SWA_BLOCK - SWA_BLOCK + j
        ok = band & ((kidx >= 0) & (kidx < S))[None, :]
        lw = jnp.einsum('bqngd,bknd->bngqk', qb, kb, preferred_element_type=jnp.float32)
        lw = jnp.where(ok, lw + bias_w, NEG_INF)
        qpos = N_META + i * SWA_BLOCK + qi
        lmk = jnp.einsum('bqngd,bmnd->bngqm', qb, km, preferred_element_type=jnp.float32)
        lmk = lmk + head_bias(pos_m[None, :] - qpos[:, None])
        p = sink_probs(jnp.concatenate([lmk, lw], axis=-1), s).astype(v.dtype)
        o = (jnp.einsum('bngqm,bmnd->bqngd', p[..., :N_META], vm)
             + jnp.einsum('bngqk,bknd->bqngd', p[..., N_META:], vb))
        return o.reshape(B, SWA_BLOCK, nq)

    ob = lax.map(block, jnp.arange(nb))
    o_real = jnp.moveaxis(ob, 0, 1).reshape(B, S, nq)
    o = jnp.concatenate([om.reshape(B, N_META, nq), o_real], axis=1)
    return o @ w_o


def moe_ffn(h, w_router, w_gate, w_up, w_down):
    B, L, D = h.shape
    xf = h.reshape(-1, D)
    N = xf.shape[0]
    logits = jnp.matmul(xf, w_router, preferred_element_type=jnp.float32)
    top_val, top_idx = lax.top_k(logits, TOP_K)
    gates = jax.nn.softmax(top_val, axis=-1)
    A = N * TOP_K
    e_flat = top_idx.reshape(-1).astype(jnp.int32)
    tok_flat = jnp.repeat(jnp.arange(N, dtype=jnp.int32), TOP_K)
    g_flat = gates.reshape(-1)
    order = jnp.argsort(e_flat)
    e_s, tok_s, g_s = e_flat[order], tok_flat[order], g_flat[order]
    counts = jnp.zeros((N_EXPERTS,), jnp.int32).at[e_flat].add(1)
    padded = (counts + MOE_BLOCK - 1) // MOE_BLOCK * MOE_BLOCK
    start = jnp.cumsum(counts) - counts
    pend = jnp.cumsum(padded)
    pstart = pend - padded
    dest = pstart[e_s] + (jnp.arange(A, dtype=jnp.int32) - start[e_s])
    n_blk = -(-(A + N_EXPERTS * (MOE_BLOCK - 1)) // MOE_BLOCK)
    P = n_blk * MOE_BLOCK
    row_tok = jnp.zeros((P,), jnp.int32).at[dest].set(tok_s)
    row_gate = jnp.zeros((P,), jnp.float32).at[dest].set(g_s)
    blk_exp = jnp.minimum(jnp.searchsorted(pend, jnp.arange(n_blk, dtype=jnp.int32) * MOE_BLOCK, side='right'), N_EXPERTS - 1)

    def expert_block(args):
        toks, e, g = args
        xb = xf[toks]
        hb = jax.nn.silu(xb @ w_gate[e]) * (xb @ w_up[e])
        return (hb @ w_down[e]) * g[:, None].astype(xf.dtype)

    yb = lax.map(expert_block, (row_tok.reshape(n_blk, MOE_BLOCK), blk_exp, row_gate.reshape(n_blk, MOE_BLOCK)))
    y = jnp.zeros_like(xf).at[row_tok].add(yb.reshape(P, D).astype(xf.dtype))
    return y.reshape(B, L, D)


def setup_inputs(seed: int = 0) -> dict:
    key = jax.random.key(seed)
    ks = iter(jax.random.split(key, 64))
    D = D_MODEL

    def nrm(shape, scale):
        return jax.random.normal(next(ks), shape, jnp.float32) * scale

    def gain(n):
        return 1.0 + 0.05 * jax.random.normal(next(ks), (n,), jnp.float32)

    inp = {}
    inp['x'] = nrm((BATCH, SEQ, D), 1.0)
    inp['meta_tokens'] = nrm((N_META, D), 1.0)
    inp['t5_bias'] = nrm((T5_BUCKETS, SWA_Q_HEADS), 0.1)
    for i in range(DEPTH):
        p = 'l%d_' % i
        inp[p + 'norm_mix'] = gain(D)
        if i % 2 == 0:
            hd = NA_HEADS * NA_HEAD_DIM
            inp[p + 'w_qkv'] = nrm((D, 3 * hd), D ** -0.5)
            inp[p + 'q_norm'] = gain(NA_HEAD_DIM)
            inp[p + 'k_norm'] = gain(NA_HEAD_DIM)
            inp[p + 'rpb'] = nrm((NA_HEADS, 2 * NA_KH_MAX - 1, 2 * NA_KW - 1), 0.1)
            inp[p + 'w_o'] = nrm((hd, D), hd ** -0.5)
        else:
            nq = SWA_Q_HEADS * SWA_HEAD_DIM
            nqkv = (SWA_Q_HEADS + 2 * SWA_KV_HEADS) * SWA_HEAD_DIM
            inp[p + 'w_qkv'] = nrm((D, nqkv), D ** -0.5)
            inp[p + 'q_norm'] = gain(SWA_HEAD_DIM)
            inp[p + 'k_norm'] = gain(SWA_HEAD_DIM)
            inp[p + 'sink'] = nrm((SWA_Q_HEADS,), 0.5)
            inp[p + 'w_o'] = nrm((nq, D), nq ** -0.5)
        inp[p + 'norm_ffn'] = gain(D)
        if i % 2 == 0:
            inp[p + 'w_gate'] = nrm((D, FFN_DIM), D ** -0.5)
            inp[p + 'w_up'] = nrm((D, FFN_DIM), D ** -0.5)
            inp[p + 'w_down'] = nrm((FFN_DIM, D), FFN_DIM ** -0.5)
        else:
            inp[p + 'w_router'] = nrm((D, N_EXPERTS), D ** -0.5)
            inp[p + 'w_gate'] = nrm((N_EXPERTS, D, FFN_DIM), D ** -0.5)
            inp[p + 'w_up'] = nrm((N_EXPERTS, D, FFN_DIM), D ** -0.5)
            inp[p + 'w_down'] = nrm((N_EXPERTS, FFN_DIM, D), FFN_DIM ** -0.5)
    return inp


def reference(x, meta_tokens, t5_bias,
              l0_norm_mix, l0_w_qkv, l0_q_norm, l0_k_norm, l0_rpb, l0_w_o, l0_norm_ffn, l0_w_gate, l0_w_up, l0_w_down,
              l1_norm_mix, l1_w_qkv, l1_q_norm, l1_k_norm, l1_sink, l1_w_o, l1_norm_ffn, l1_w_router, l1_w_gate, l1_w_up, l1_w_down,
              l2_norm_mix, l2_w_qkv, l2_q_norm, l2_k_norm, l2_rpb, l2_w_o, l2_norm_ffn, l2_w_gate, l2_w_up, l2_w_down,
              l3_norm_mix, l3_w_qkv, l3_q_norm, l3_k_norm, l3_sink, l3_w_o, l3_norm_ffn, l3_w_router, l3_w_gate, l3_w_up, l3_w_down):
    layers = [
        dict(norm_mix=l0_norm_mix, w_qkv=l0_w_qkv, q_norm=l0_q_norm, k_norm=l0_k_norm, rpb=l0_rpb, w_o=l0_w_o,
             norm_ffn=l0_norm_ffn, w_gate=l0_w_gate, w_up=l0_w_up, w_down=l0_w_down),
        dict(norm_mix=l1_norm_mix, w_qkv=l1_w_qkv, q_norm=l1_q_norm, k_norm=l1_k_norm, sink=l1_sink, w_o=l1_w_o,
             norm_ffn=l1_norm_ffn, w_router=l1_w_router, w_gate=l1_w_gate, w_up=l1_w_up, w_down=l1_w_down),
        dict(norm_mix=l2_norm_mix, w_qkv=l2_w_qkv, q_norm=l2_q_norm, k_norm=l2_k_norm, rpb=l2_rpb, w_o=l2_w_o,
             norm_ffn=l2_norm_ffn, w_gate=l2_w_gate, w_up=l2_w_up, w_down=l2_w_down),
        dict(norm_mix=l3_norm_mix, w_qkv=l3_w_qkv, q_norm=l3_q_norm, k_norm=l3_k_norm, sink=l3_sink, w_o=l3_w_o,
             norm_ffn=l3_norm_ffn, w_router=l3_w_router, w_gate=l3_w_gate, w_up=l3_w_up, w_down=l3_w_down),
    ]
    B = x.shape[0]
    meta = jnp.broadcast_to(meta_tokens[None].astype(x.dtype), (B, N_META, x.shape[-1]))
    h = jnp.concatenate([meta, x], axis=1)
    for i in range(DEPTH):
        p = layers[i]
        y = rmsnorm(h, p['norm_mix'])
        if i % 2 == 0:
            h = h + na_mixer(y, p['w_qkv'], p['q_norm'], p['k_norm'], p['rpb'], p['w_o'])
        else:
            h = h + swa_mixer(y, p['w_qkv'], p['q_norm'], p['k_norm'], p['sink'], t5_bias, p['w_o'])
        y = rmsnorm(h, p['norm_ffn'])
        if i % 2 == 0:
            h = h + swiglu(y, p['w_gate'], p['w_up'], p['w_down'])
        else:
            h = h + moe_ffn(y, p['w_router'], p['w_gate'], p['w_up'], p['w_down'])
    return h[:, N_META:]
```

```cpp
#include <hip/hip_runtime.h>
#include <cstdio>
#include <cstdint>

#ifndef MK_MULTI
#define MK_MULTI 0
#endif

#ifndef MK_STOP
#define MK_STOP 1000
#endif
#define LAS __attribute__((address_space(3)))
#define GAS __attribute__((address_space(1)))
typedef unsigned short bf16_t;
typedef short bf16x8 __attribute__((ext_vector_type(8)));
typedef short s16x4 __attribute__((ext_vector_type(4)));
typedef float f32x4 __attribute__((ext_vector_type(4)));
typedef float f32x2 __attribute__((ext_vector_type(2)));
typedef unsigned u32x4 __attribute__((ext_vector_type(4)));
typedef unsigned u32x2 __attribute__((ext_vector_type(2)));
#define RLX_AGENT __ATOMIC_RELAXED, __HIP_MEMORY_SCOPE_AGENT

constexpr int D = 1024, NREG = 65536, NMETA_ROWS = 512, M = NREG + NMETA_ROWS, NPANEL = M / 256;
constexpr int SEQ = 2048, BATCH = 32, FF = 3584, NE = 8;
constexpr float EPS = 1e-6f;
constexpr float LOG2E = 1.4426950408889634f;
constexpr float NEGBIG = -1e30f;

constexpr size_t WS_CTL = 0, CTL_BYTES = 8u << 20;
constexpr int CW_TMO = 0, CW_BAR = 4096, CW_CNT = 8192;
constexpr size_t CTL_SSQ = 65536;
constexpr size_t SSQ_BYTES = (size_t)M * 8;
constexpr float SSQ_SCALE = 16777216.0f, SSQ_INV = 1.0f / 16777216.0f;
typedef unsigned long long u64;
static_assert(CTL_SSQ + 8 * SSQ_BYTES <= CTL_BYTES, "ctl");
constexpr size_t W_QKV_NA = (size_t)3072 * 1024 * 2, W_O = (size_t)1024 * 1024 * 2, W_GU = (size_t)7168 * 1024 * 2, W_D = (size_t)1024 * 3584 * 2, W_QKV_SWA = (size_t)1536 * 1024 * 2;
constexpr size_t WNA_QKV = 0, WNA_O = WNA_QKV + W_QKV_NA, WNA_GU = WNA_O + W_O, WNA_D = WNA_GU + W_GU, WNA_END = WNA_D + W_D;
constexpr size_t WSW_QKV = WNA_END, WSW_O = WSW_QKV + W_QKV_SWA, WSW_GU = WSW_O + W_O, WSW_D = WSW_GU + NE * W_GU, WPAIR = WSW_D + NE * W_D;
constexpr size_t WS_W = CTL_BYTES;
constexpr size_t WS_HB = WS_W + 2 * WPAIR;
constexpr size_t HB_BYTES = (size_t)M * D * 2;
constexpr size_t WS_HMETA = WS_HB + HB_BYTES;
constexpr size_t WS_TAB = WS_HMETA + (size_t)NMETA_ROWS * D * 4;
constexpr size_t TAB_BYTES = (size_t)NE * M * 4;
constexpr size_t WS_R = WS_TAB + 4 * TAB_BYTES;
constexpr size_t R_Q = 0, R_K = HB_BYTES, R_VT_NA = 2 * HB_BYTES, R_VT_SWA = HB_BYTES + (size_t)M * 256 * 2;
constexpr int MOE_CH = 128;
constexpr size_t R_YS = (size_t)MOE_CH * 256 * FF * 2;
constexpr size_t R_DENSE = (size_t)M * FF * 2, R_MOE = R_YS + (size_t)2 * M * D * 2;
constexpr size_t R_BYTES = R_DENSE > R_MOE ? R_DENSE : R_MOE;
static_assert(3 * HB_BYTES <= R_BYTES, "R");
constexpr size_t WS_END = WS_R + R_BYTES;
static_assert(WS_END <= 1115912448ull, "d_ws budget");

constexpr int TAB_OFF = 131072;
constexpr int GAIN_OFF = TAB_OFF + 10240;
constexpr int MISC_OFF = GAIN_OFF + 512;
constexpr int LDS_BYTES = 147456;
static_assert(MISC_OFF + 256 <= LDS_BYTES, "lds");

__device__ __forceinline__ unsigned cvt_pk_bf16(float lo, float hi) { unsigned r; asm volatile("v_cvt_pk_bf16_f32 %0, %1, %2" : "=v"(r) : "v"(lo), "v"(hi)); return r; }
__device__ __forceinline__ float wave_sum(float v) {
#pragma unroll
    for (int o = 1; o < 64; o <<= 1) v += __shfl_xor(v, o);
    return v;
}
__device__ __forceinline__ float fast_rsqrt(float x) { return __builtin_amdgcn_rsqf(x); }
__device__ __forceinline__ float fast_exp2(float x) { return __builtin_amdgcn_exp2f(x); }
__device__ __forceinline__ float fast_rcp(float x) { return __builtin_amdgcn_rcpf(x); }
__device__ __forceinline__ float silu_f(float x) { return x * fast_rcp(1.0f + fast_exp2(-x * LOG2E)); }

#define XB_TMO      128
#define XB_XCNT(j)  (256  + 64 * (j))
#define XB_XSUB(j)  (1280 + 64 * (j))
#define XB_XGEN(j)  (2304 + 64 * (j))
#define XB_TOP      3328
#define XB_TOPGEN   3392
#define XCD_BAR_WORDS 3456
#define XB_SPIN_CAP (1u << 18)
template <class T> __device__ __forceinline__ unsigned xb_ld(T* p)              { return __hip_atomic_load(p, __ATOMIC_RELAXED, __HIP_MEMORY_SCOPE_AGENT); }
template <class T> __device__ __forceinline__ unsigned xb_add(T* p, unsigned v) { return __hip_atomic_fetch_add(p, v, __ATOMIC_RELAXED, __HIP_MEMORY_SCOPE_AGENT); }
__device__ __forceinline__ unsigned xb_xcc_id() { return (unsigned)__builtin_amdgcn_s_getreg((3 << 11) | 20) & 0xFu; }
#define XB_SPIN(cond, bar) do { unsigned _sp = 0; while (cond) { __builtin_amdgcn_s_sleep(1); \
    if ((++_sp & 255u) == 0u) { if (xb_ld(&(bar)[XB_TMO])) break; if (_sp > XB_SPIN_CAP) { xb_add(&(bar)[XB_TMO], 1u); break; } } } } while (0)
struct XcdBarrier { unsigned* bar; unsigned x; volatile LAS unsigned* st; };
__device__ __forceinline__ XcdBarrier xcd_barrier_post(unsigned* bar, volatile LAS unsigned* st) {
    XcdBarrier b; b.bar = bar; b.x = xb_xcc_id(); b.st = st;
    if (threadIdx.x == 0) (void)xb_add(&bar[XB_XCNT(b.x)], 1u);
    return b;
}
__device__ __forceinline__ void xcd_barrier_complete(GAS unsigned* bar, unsigned x, unsigned& nloc, unsigned& nx) {
    const unsigned G = gridDim.x * gridDim.y * gridDim.z;
    unsigned sum, cnt, mine, sp = 0u;
    for (;;) {
        sum = 0u; cnt = 0u; mine = 0u;
#pragma unroll
        for (unsigned j = 0; j < 16; ++j) { const unsigned c = xb_ld(&bar[XB_XCNT(j)]); sum += c; cnt += (c > 0u) ? 1u : 0u; mine = (j == x) ? c : mine; }
        if (sum == G) break;
        __builtin_amdgcn_s_sleep(1);
        if ((++sp & 255u) == 0u) { if (xb_ld(&bar[XB_TMO])) break; if (sp > XB_SPIN_CAP) { xb_add(&bar[XB_TMO], 1u); break; } }
    }
    nloc = mine > 0u ? mine : 1u; nx = cnt > 0u ? cnt : 1u;
}
__device__ __noinline__ void xcd_barrier_leader(GAS unsigned* bar, unsigned x, volatile LAS unsigned* st) {
    __builtin_amdgcn_s_waitcnt(0);
    unsigned nloc = st[0], nx = st[1];
    if (nloc == 0u) { xcd_barrier_complete(bar, x, nloc, nx); st[0] = nloc; st[1] = nx; }
    const unsigned old = xb_add(&bar[XB_XSUB(x)], 1u);
    const unsigned gen = old / nloc;
    if (old + 1u == (gen + 1u) * nloc) {
        __builtin_amdgcn_fence(__ATOMIC_RELEASE, "agent");
        asm volatile("s_waitcnt vmcnt(0)" ::: "memory");
        const unsigned og = xb_add(&bar[XB_TOP], 1u);
        const unsigned tg = og / nx;
        if (og + 1u == (tg + 1u) * nx) xb_add(&bar[XB_TOPGEN], 1u);
        else XB_SPIN(xb_ld(&bar[XB_TOPGEN]) == tg, bar);
        __builtin_amdgcn_fence(__ATOMIC_ACQUIRE, "agent");
        xb_add(&bar[XB_XGEN(x)], 1u);
        asm volatile("s_waitcnt vmcnt(0)" ::: "memory");
    } else {
        XB_SPIN(xb_ld(&bar[XB_XGEN(x)]) == gen, bar);
        __builtin_amdgcn_fence(__ATOMIC_ACQUIRE, "agent");
        asm volatile("s_waitcnt vmcnt(0)" ::: "memory");
    }
}
__device__ __forceinline__ void xcd_barrier(const XcdBarrier& b) {
    asm volatile("s_waitcnt vmcnt(0)" ::: "memory");
    __syncthreads();
    if (threadIdx.x == 0) xcd_barrier_leader((GAS unsigned*)b.bar, b.x, b.st);
    __syncthreads();
}

namespace pg8 {
constexpr int BM = 256, BK = 64, HALF = 128, HTB = HALF * BK * 2, NXCD = 8, WGM = 8;
__host__ __device__ __forceinline__ int lds_byte(int r, int c) { const int st = (r >> 4) * 2 + (c >> 5), rr = r & 15, cc = c & 31, ob = rr * 64 + cc * 2; return st * 1024 + (ob ^ (((ob >> 9) & 1) << 5)); }
__host__ __device__ __forceinline__ void stage_rc(int b, int& R, int& C) { const int st = b / 1024, sb = b % 1024, swz = sb ^ (((sb >> 9) & 1) << 5); R = (st >> 1) * 16 + swz / 64; C = (st & 1) * 32 + (swz % 64) / 2; }
struct Unit { const char* A; const char* B; int pm, pn, kind, aux, aux2; };
__device__ __forceinline__ void tile_of(int L, int nM, int nN, int& pm, int& pn) {
    const int nwg = nM * nN; int wgid = L; { const int q = nwg / NXCD, r = nwg % NXCD, xcd = wgid % NXCD, off = wgid / NXCD; wgid = (xcd < r ? xcd * (q + 1) : r * (q + 1) + (xcd - r) * q) + off; }
    const int nig = WGM * nN, gid = wgid / nig, fm = gid * WGM, gsz = (nM - fm) < WGM ? (nM - fm) : WGM;
    pm = fm + ((wgid % nig) % gsz); pn = (wgid % nig) / gsz;
}
__device__ __forceinline__ void dma4(const void* g, LAS void* l) { __builtin_amdgcn_global_load_lds((const unsigned*)g, (LAS unsigned*)l, 4, 0, 0); }

template <class P>
__device__ __forceinline__ void gemm_phase(LAS unsigned char* lds, LAS unsigned char* tab, const P& S) {
    int tid_l = threadIdx.x; asm volatile("" : "+v"(tid_l));
    const int tid = tid_l, wid = __builtin_amdgcn_readfirstlane(tid >> 6), lane = tid & 63, wr = wid >> 2, wc = wid & 3, fr = lane & 15, fq = lane >> 4;
    const int nt = S.nt;
    int Rr[2], Cc[2];
#pragma unroll
    for (int i = 0; i < 2; ++i) stage_rc(tid * 16 + i * 8192, Rr[i], Cc[i]);
    unsigned voffB[2], voffA[2][2];
#pragma unroll
    for (int i = 0; i < 2; ++i) { voffB[i] = (unsigned)Rr[i] * S.pitchB + (unsigned)Cc[i] * 2u;
#pragma unroll
        for (int h = 0; h < 2; ++h) voffA[h][i] = (unsigned)(HALF * h + Rr[i]) * S.pitchA + (unsigned)Cc[i] * 2u; }
    const size_t kstep = (size_t)(BK * 2);
    const size_t hstepB = (size_t)HALF * S.pitchB;
    const unsigned ldsw = (unsigned)wid * 1024u;
    const int aoff = lds_byte(wr * 64 + fr, fq * 8), boff = lds_byte(wc * 32 + fr, fq * 8);
    LAS unsigned* idtab = (LAS unsigned*)tab;
#define PG8_SA(b, h) (((b) * 2 + (h)) * HTB)
#define PG8_SB(b, h) ((4 + (b) * 2 + (h)) * HTB)
#define PG8_STAGE(bufoff, gbase, voff) do { _Pragma("unroll") for (int _i = 0; _i < 2; ++_i) \
        __builtin_amdgcn_global_load_lds((const unsigned*)((const char*)(gbase) + (voff)[_i]), (LAS unsigned*)(lds + (bufoff) + ldsw + _i * 8192), 16, 0, 0); } while (0)
#define PG8_LDA(dst, b, h) do { _Pragma("unroll") for (int m = 0; m < 4; ++m) _Pragma("unroll") for (int k = 0; k < 2; ++k) dst[m][k] = *(const LAS bf16x8*)(lds + PG8_SA(b, h) + aoff + m * 2048 + k * 1024); } while (0)
#define PG8_LDB(dst, b, h) do { _Pragma("unroll") for (int n = 0; n < 2; ++n) _Pragma("unroll") for (int k = 0; k < 2; ++k) dst[n][k] = *(const LAS bf16x8*)(lds + PG8_SB(b, h) + boff + n * 2048 + k * 1024); } while (0)
#define PG8_MMA(ai, bj, At, Bt) do { __builtin_amdgcn_s_setprio(1); _Pragma("unroll") for (int m = 0; m < 4; ++m) _Pragma("unroll") for (int n = 0; n < 2; ++n) _Pragma("unroll") for (int k = 0; k < 2; ++k) \
        acc[ai][bj][m][n] = __builtin_amdgcn_mfma_f32_16x16x32_bf16(Bt[n][k], At[m][k], acc[ai][bj][m][n], 0, 0, 0); __builtin_amdgcn_s_setprio(0); } while (0)
#define PG8_WAIT_V(n) asm volatile("s_waitcnt vmcnt(" #n ")" ::: "memory")
#define PG8_WAIT_L(n) asm volatile("s_waitcnt lgkmcnt(" #n ")" ::: "memory")
#define PG8_BAR __builtin_amdgcn_s_barrier()
#define PG8_SCHED __builtin_amdgcn_sched_barrier(0)
    Unit cur, nxt; int ui = 0;
    if (!S.next(0, cur)) return;
    f32x4 acc[2][2][4][2];
#pragma unroll
    for (int a = 0; a < 2; ++a)
#pragma unroll
        for (int b = 0; b < 2; ++b)
#pragma unroll
            for (int m = 0; m < 4; ++m)
#pragma unroll
                for (int n = 0; n < 2; ++n) acc[a][b][m][n] = (f32x4){0.f, 0.f, 0.f, 0.f};
    bf16x8 At[4][2], B0[2][2], B1[2][2];
    const char* cA = cur.A; const char* cB = cur.B;
    if constexpr (P::GATHER) {
        if (wid < 4) dma4(S.id_src(cur, wid * 64 + lane), idtab + wid * 64);
        PG8_WAIT_V(0); PG8_BAR; asm volatile("" ::: "memory");
#pragma unroll
        for (int h = 0; h < 2; ++h)
#pragma unroll
            for (int i = 0; i < 2; ++i) voffA[h][i] = idtab[HALF * h + Rr[i]] * S.pitchA + (unsigned)Cc[i] * 2u;
        PG8_WAIT_L(0); asm volatile("" ::: "memory");
    }
    PG8_STAGE(PG8_SB(0, 0), cB, voffB); PG8_STAGE(PG8_SB(0, 1), cB + hstepB, voffB); PG8_STAGE(PG8_SA(0, 0), cA, voffA[0]); PG8_STAGE(PG8_SA(0, 1), cA, voffA[1]);
    if (wr == 1) PG8_BAR;
    PG8_WAIT_V(2); PG8_BAR;
    PG8_STAGE(PG8_SB(1, 0), cB + kstep, voffB); PG8_STAGE(PG8_SA(1, 0), cA + kstep, voffA[0]); PG8_STAGE(PG8_SB(1, 1), cB + hstepB + kstep, voffB);
    PG8_WAIT_V(6); PG8_BAR;
    for (;;) {
        const bool has_next = S.next(ui + 1, nxt);
        const int slot = ui & 1;
        S.dma_tables(cur, tab, slot, wid, lane);
        if constexpr (P::GATHER) { if (has_next && wid < 4) dma4(S.id_src(nxt, wid * 64 + lane), idtab + (slot ^ 1) * 256 + wid * 64); }
        const char* nA = has_next ? nxt.A : cA; const char* nB = has_next ? nxt.B : cB;
        for (int t = 0; t < nt; t += 2) {
            const bool last = (t == nt - 2);
            const char* a1 = cA + (size_t)(t + 1) * kstep;
            const char* a2 = last ? nA : cA + (size_t)(t + 2) * kstep; const char* b2 = last ? nB : cB + (size_t)(t + 2) * kstep;
            const char* a3 = a2 + kstep; const char* b3 = b2 + kstep;
            PG8_LDB(B0, 0, 0); PG8_LDB(B1, 0, 1); PG8_SCHED; PG8_LDA(At, 0, 0); PG8_STAGE(PG8_SA(1, 1), a1, voffA[1]);
            if constexpr (P::GATHER) {
                if (last && has_next) {
                    int t2 = tid; asm volatile("" : "+v"(t2));
#pragma unroll
                    for (int i = 0; i < 2; ++i) { int R2, C2; stage_rc(t2 * 16 + i * 8192, R2, C2);
#pragma unroll
                        for (int h = 0; h < 2; ++h) voffA[h][i] = idtab[(slot ^ 1) * 256 + HALF * h + R2] * S.pitchA + (unsigned)C2 * 2u; }
                }
            }
            PG8_WAIT_V(8); PG8_WAIT_L(0); PG8_BAR; PG8_MMA(0, 0, At, B0); PG8_MMA(0, 1, At, B1); PG8_BAR; PG8_SCHED;
            PG8_LDA(At, 0, 1); PG8_STAGE(PG8_SB(0, 0), b2, voffB); PG8_STAGE(PG8_SB(0, 1), b2 + hstepB, voffB); PG8_STAGE(PG8_SA(0, 0), a2, voffA[0]);
            PG8_WAIT_V(8); PG8_WAIT_L(0); PG8_BAR; PG8_MMA(1, 0, At, B0); PG8_MMA(1, 1, At, B1); PG8_BAR; PG8_SCHED;
            PG8_LDB(B0, 1, 0); PG8_LDB(B1, 1, 1); PG8_SCHED; PG8_LDA(At, 1, 0); PG8_STAGE(PG8_SA(0, 1), a2, voffA[1]);
            PG8_WAIT_V(8); PG8_WAIT_L(0); PG8_BAR; PG8_MMA(0, 0, At, B0); PG8_MMA(0, 1, At, B1); PG8_BAR; PG8_SCHED;
            PG8_LDA(At, 1, 1); PG8_STAGE(PG8_SB(1, 0), b3, voffB); PG8_STAGE(PG8_SB(1, 1), b3 + hstepB, voffB); PG8_STAGE(PG8_SA(1, 0), a3, voffA[0]);
            PG8_WAIT_V(8); PG8_WAIT_L(0); PG8_BAR; PG8_MMA(1, 0, At, B0); PG8_MMA(1, 1, At, B1); PG8_BAR; PG8_SCHED;
        }
        if (wr == 0) PG8_BAR;
        S.epi(acc, cur, tab, slot, wr, wc, fr, fq);
        if (!has_next) break;
#pragma unroll
        for (int a = 0; a < 2; ++a)
#pragma unroll
            for (int b = 0; b < 2; ++b)
#pragma unroll
                for (int m = 0; m < 4; ++m)
#pragma unroll
                    for (int n = 0; n < 2; ++n) acc[a][b][m][n] = (f32x4){0.f, 0.f, 0.f, 0.f};
        cur = nxt; cA = nA; cB = nB; ++ui;
        if (wr == 1) PG8_BAR;
    }
    PG8_WAIT_V(0);
    PG8_BAR;
#undef PG8_SA
#undef PG8_SB
#undef PG8_STAGE
#undef PG8_LDA
#undef PG8_LDB
#undef PG8_MMA
#undef PG8_WAIT_V
#undef PG8_WAIT_L
#undef PG8_BAR
#undef PG8_SCHED
}
}
using pg8::Unit;
typedef f32x4 Acc[2][2][4][2];

struct Args { const float* in[45]; float* out; unsigned char* ws; int ph_lo, ph_hi; };
enum { I_X = 0, I_META = 1, I_T5 = 2, I_L0 = 3, I_L1 = 13, I_L2 = 24, I_L3 = 34 };

struct Frame {
    LAS unsigned char* lds; LAS unsigned char* tab;
    int tid, lane, wave, G, bx;
    unsigned char* ws; float* out; float* hmeta; bf16_t* hb; unsigned* ctl;
};
__device__ __forceinline__ u64* ssq_buf(const Frame& F, int i) { return (u64*)(F.ws + WS_CTL + CTL_SSQ + (size_t)i * SSQ_BYTES); }
__device__ __forceinline__ u64 ssq_fix(float s) { return (u64)(s * SSQ_SCALE); }
__device__ __forceinline__ float ssq_val(u64 v) { return (float)v * SSQ_INV; }
__device__ __forceinline__ float* hrow(const Frame& F, int m) { return m < NREG ? F.out + (size_t)m * D : F.hmeta + (size_t)(m - NREG) * D; }

struct QkvPolicy {
    static constexpr bool GATHER = false;
    int nt; unsigned pitchA, pitchB;
    int G, c, nN, QT;
    const char* hb; const char* W;
    const u64* ssq;
    bf16_t* Q; bf16_t* K; bf16_t* VT; int kpitch, nQ;
    const LAS float* gains;
    __device__ __forceinline__ bool next(int i, Unit& u) const {
        const long L = (long)i * G + c; if (L >= (long)NPANEL * nN) return false;
        int pm, pn; pg8::tile_of((int)L, NPANEL, nN, pm, pn);
        u.pm = pm; u.pn = pn; u.kind = pn < QT ? 0 : 1; u.aux = 0; u.aux2 = 0;
        const char* a = hb + (size_t)pm * 256 * 2048; const char* w = W + (size_t)pn * 256 * 2048;
        u.A = u.kind ? w : a; u.B = u.kind ? a : w; return true;
    }
    __device__ __forceinline__ void dma_tables(const Unit& u, LAS unsigned char* tab, int slot, int wid, int lane) const {
        pg8::dma4((const unsigned*)(ssq + u.pm * 256) + wid * 64 + lane, (LAS unsigned*)(tab + 2048) + slot * 512 + wid * 64);
    }
    __device__ __forceinline__ void epi(const Acc& acc, const Unit& u, LAS unsigned char* tab, int slot, int wr, int wc, int fr, int fq) const {
        const LAS u64* et = (const LAS u64*)(tab + 2048) + slot * 256;
        if (u.kind == 0) {
            const bool isq = u.pn < nQ;
            const LAS float* gp = gains + (isq ? 0 : 64) + 8 * fq;
            const f32x4 g00 = *(const LAS f32x4*)(gp), g01 = *(const LAS f32x4*)(gp + 4), g10 = *(const LAS f32x4*)(gp + 32), g11 = *(const LAS f32x4*)(gp + 36);
            bf16_t* dst = isq ? Q + (size_t)(u.pn * 4 + wc) * 64 : K + (size_t)((u.pn - nQ) * 4 + wc) * 64;
            const int pitch = isq ? 1024 : kpitch;
#pragma unroll
            for (int ai = 0; ai < 2; ++ai)
#pragma unroll
                for (int m = 0; m < 4; ++m) {
                    const int row = ai * 128 + wr * 64 + m * 16 + fr;
                    const float rstd = fast_rsqrt(ssq_val(et[row]) * (1.0f / 1024.0f) + EPS);
                    f32x4 v00 = acc[ai][0][m][0] * rstd, v01 = acc[ai][0][m][1] * rstd, v10 = acc[ai][1][m][0] * rstd, v11 = acc[ai][1][m][1] * rstd;
                    float ss = 0.f;
#pragma unroll
                    for (int j = 0; j < 4; ++j) ss += v00[j] * v00[j] + v01[j] * v01[j] + v10[j] * v10[j] + v11[j] * v11[j];
                    ss += __shfl_xor(ss, 16); ss += __shfl_xor(ss, 32);
                    const float hn = fast_rsqrt(ss * (1.0f / 64.0f) + EPS);
                    v00 = v00 * g00 * hn; v01 = v01 * g01 * hn; v10 = v10 * g10 * hn; v11 = v11 * g11 * hn;
                    bf16_t* rp = dst + (size_t)(u.pm * 256 + row) * pitch + 8 * fq;
                    u32x4 w0; w0.x = cvt_pk_bf16(v00[0], v00[1]); w0.y = cvt_pk_bf16(v00[2], v00[3]); w0.z = cvt_pk_bf16(v01[0], v01[1]); w0.w = cvt_pk_bf16(v01[2], v01[3]);
                    u32x4 w1; w1.x = cvt_pk_bf16(v10[0], v10[1]); w1.y = cvt_pk_bf16(v10[2], v10[3]); w1.z = cvt_pk_bf16(v11[0], v11[1]); w1.w = cvt_pk_bf16(v11[2], v11[3]);
                    *(u32x4*)(rp) = w0; *(u32x4*)(rp + 32) = w1;
                }
        } else {
            f32x4 rs[2][2];
#pragma unroll
            for (int bj = 0; bj < 2; ++bj)
#pragma unroll
                for (int n = 0; n < 2; ++n) {
#pragma unroll
                    for (int j = 0; j < 4; ++j) rs[bj][n][j] = fast_rsqrt(ssq_val(et[bj * 128 + wc * 32 + n * 16 + 4 * fq + j]) * (1.0f / 1024.0f) + EPS); }
#pragma unroll
            for (int ai = 0; ai < 2; ++ai)
#pragma unroll
                for (int m = 0; m < 4; ++m) {
                    const int hd = (u.pn - QT) * 256 + ai * 128 + wr * 64 + m * 16 + fr;
                    bf16_t* rp = VT + (size_t)hd * M + (size_t)u.pm * 256 + wc * 32 + 4 * fq;
#pragma unroll
                    for (int bj = 0; bj < 2; ++bj)
#pragma unroll
                        for (int n = 0; n < 2; ++n) { const f32x4 v = acc[ai][bj][m][n] * rs[bj][n]; u32x2 w; w.x = cvt_pk_bf16(v[0], v[1]); w.y = cvt_pk_bf16(v[2], v[3]); *(u32x2*)(rp + bj * 128 + n * 16) = w; }
                }
        }
    }
};

struct ResPolicy {
    static constexpr bool GATHER = false;
    int nt; unsigned pitchA, pitchB;
    int G, c;
    const char* A; const char* W;
    const float* base_reg; float* out_reg; float* hmeta; bf16_t* hb; u64* ssq_out;
    __device__ __forceinline__ bool next(int i, Unit& u) const {
        const long L = (long)i * G + c; if (L >= (long)NPANEL * 4) return false;
        int pm, pn; pg8::tile_of((int)L, NPANEL, 4, pm, pn);
        u.pm = pm; u.pn = pn; u.kind = 0; u.aux = 0; u.aux2 = 0;
        u.A = A + (size_t)pm * 256 * pitchA; u.B = W + (size_t)pn * 256 * pitchB; return true;
    }
    __device__ __forceinline__ void dma_tables(const Unit&, LAS unsigned char*, int, int, int) const {}
    __device__ __forceinline__ void epi(const Acc& acc, const Unit& u, LAS unsigned char*, int, int wr, int wc, int fr, int fq) const {
#pragma unroll
        for (int ai = 0; ai < 2; ++ai)
#pragma unroll
            for (int m = 0; m < 4; ++m) {
                const int row = u.pm * 256 + ai * 128 + wr * 64 + m * 16 + fr;
                const int col = u.pn * 256 + wc * 32 + 4 * fq;
                const float* bp = (row < NREG ? base_reg + (size_t)row * D : hmeta + (size_t)(row - NREG) * D) + col;
                float* op = (row < NREG ? out_reg + (size_t)row * D : hmeta + (size_t)(row - NREG) * D) + col;
                bf16_t* hp = hb + (size_t)row * D + col;
                float ss = 0.f;
#pragma unroll
                for (int bj = 0; bj < 2; ++bj)
#pragma unroll
                    for (int n = 0; n < 2; ++n) {
                        const f32x4 o = *(const f32x4*)(bp + bj * 128 + n * 16) + acc[ai][bj][m][n];
                        *(f32x4*)(op + bj * 128 + n * 16) = o;
                        u32x2 w; w.x = cvt_pk_bf16(o[0], o[1]); w.y = cvt_pk_bf16(o[2], o[3]); *(u32x2*)(hp + bj * 128 + n * 16) = w;
                        ss += o[0] * o[0] + o[1] * o[1] + o[2] * o[2] + o[3] * o[3];
                    }
                ss += __shfl_xor(ss, 16); ss += __shfl_xor(ss, 32);
                if (fq == 0) __hip_atomic_fetch_add(ssq_out + row, ssq_fix(ss), RLX_AGENT);
            }
    }
};

template <bool MOE>
struct GuPolicy {
    static constexpr bool GATHER = MOE;
    int nt; unsigned pitchA, pitchB;
    int G, c;
    const char* hb; const char* W;
    const void* ssq;
    bf16_t* hid;
    const unsigned* rowtok; int p0, p1;
    const LAS int* ptab;
    __device__ __forceinline__ bool next(int i, Unit& u) const {
        const long L = (long)i * G + c;
        if constexpr (!MOE) {
            if (L >= (long)NPANEL * 28) return false;
            int pm, pn; pg8::tile_of((int)L, NPANEL, 28, pm, pn);
            u.pm = pm; u.pn = pn; u.kind = 0; u.aux = 0; u.aux2 = 0;
            u.A = hb + (size_t)pm * 256 * 2048; u.B = W + (size_t)pn * 256 * 2048; return true;
        } else {
            const int nM = p1 - p0; if (L >= (long)nM * 28) return false;
            int pm, pn; pg8::tile_of((int)L, nM, 28, pm, pn);
            const int p = p0 + pm; int e = 0;
#pragma unroll
            for (int j = 1; j < NE; ++j) e += (p >= ptab[j]) ? 1 : 0;
            const int pbe = ptab[e], ce = ptab[9 + e];
            u.pm = pm; u.pn = pn; u.kind = e; u.aux = (p - pbe) * 256; u.aux2 = ce;
            u.A = hb; u.B = W + (size_t)e * W_GU + (size_t)pn * 256 * 2048; return true;
        }
    }
    __device__ __forceinline__ const unsigned* id_src(const Unit& u, int i) const { int r = u.aux + i; r = r < u.aux2 ? r : u.aux2 - 1; return rowtok + (size_t)u.kind * M + r; }
    __device__ __forceinline__ void dma_tables(const Unit& u, LAS unsigned char* tab, int slot, int wid, int lane) const {
        if constexpr (!MOE) pg8::dma4((const unsigned*)((const u64*)ssq + u.pm * 256) + wid * 64 + lane, (LAS unsigned*)(tab + 2048) + slot * 512 + wid * 64);
        else if (wid >= 4) { int r = u.aux + (wid - 4) * 64 + lane; r = r < u.aux2 ? r : u.aux2 - 1; pg8::dma4((const float*)ssq + (size_t)u.kind * M + r, (LAS float*)(tab + 2048) + slot * 256 + (wid - 4) * 64); }
    }
    __device__ __forceinline__ void epi(const Acc& acc, const Unit& u, LAS unsigned char* tab, int slot, int wr, int wc, int fr, int fq) const {
#pragma unroll
        for (int ai = 0; ai < 2; ++ai)
#pragma unroll
            for (int m = 0; m < 4; ++m) {
                const int row = ai * 128 + wr * 64 + m * 16 + fr;
                float sq;
                if constexpr (MOE) sq = ((const LAS float*)(tab + 2048) + slot * 256)[row]; else sq = ssq_val(((const LAS u64*)(tab + 2048) + slot * 256)[row]);
                const float rstd = fast_rsqrt(sq * (1.0f / 1024.0f) + EPS);
                float o[8];
#pragma unroll
                for (int n = 0; n < 2; ++n)
#pragma unroll
                    for (int j = 0; j < 4; ++j) { const float g = acc[ai][0][m][n][j] * rstd, up = acc[ai][1][m][n][j] * rstd; o[n * 4 + j] = silu_f(g) * up; }
                u32x4 w; w.x = cvt_pk_bf16(o[0], o[1]); w.y = cvt_pk_bf16(o[2], o[3]); w.z = cvt_pk_bf16(o[4], o[5]); w.w = cvt_pk_bf16(o[6], o[7]);
                *(u32x4*)(hid + (size_t)(u.pm * 256 + row) * FF + u.pn * 128 + wc * 32 + 8 * fq) = w;
            }
    }
};

struct MoeDownPolicy {
    static constexpr bool GATHER = false;
    int nt; unsigned pitchA, pitchB;
    int G, c;
    const char* hid; const char* W;
    const unsigned* rowslot; const float* rowgate; bf16_t* ys;
    int p0, p1; const LAS int* ptab;
    __device__ __forceinline__ bool next(int i, Unit& u) const {
        const long L = (long)i * G + c; const int nM = p1 - p0; if (L >= (long)nM * 4) return false;
        int pm, pn; pg8::tile_of((int)L, nM, 4, pm, pn);
        const int p = p0 + pm; int e = 0;
#pragma unroll
        for (int j = 1; j < NE; ++j) e += (p >= ptab[j]) ? 1 : 0;
        const int pbe = ptab[e], ce = ptab[9 + e];
        u.pm = pm; u.pn = pn; u.kind = e; u.aux = (p - pbe) * 256; u.aux2 = ce;
        u.A = hid + (size_t)pm * 256 * pitchA; u.B = W + (size_t)e * W_D + (size_t)pn * 256 * pitchB; return true;
    }
    __device__ __forceinline__ void dma_tables(const Unit& u, LAS unsigned char* tab, int slot, int wid, int lane) const {
        int r = u.aux + (wid & 3) * 64 + lane; r = r < u.aux2 ? r : u.aux2 - 1;
        if (wid < 4) pg8::dma4(rowslot + (size_t)u.kind * M + r, (LAS unsigned*)(tab + 6144) + slot * 256 + wid * 64);
        else pg8::dma4(rowgate + (size_t)u.kind * M + r, (LAS float*)(tab + 8192) + slot * 256 + (wid - 4) * 64);
    }
    __device__ __forceinline__ void epi(const Acc& acc, const Unit& u, LAS unsigned char* tab, int slot, int wr, int wc, int fr, int fq) const {
        const LAS unsigned* es = (const LAS unsigned*)(tab + 6144) + slot * 256;
        const LAS float* eg = (const LAS float*)(tab + 8192) + slot * 256;
#pragma unroll
        for (int ai = 0; ai < 2; ++ai)
#pragma unroll
            for (int m = 0; m < 4; ++m) {
                const int row = ai * 128 + wr * 64 + m * 16 + fr;
                if (u.aux + row < u.aux2) {
                    const unsigned sl = es[row]; const float g = eg[row];
                    bf16_t* rp = ys + (size_t)sl * D + u.pn * 256 + wc * 32 + 4 * fq;
#pragma unroll
                    for (int bj = 0; bj < 2; ++bj)
#pragma unroll
                        for (int n = 0; n < 2; ++n) { const f32x4 v = acc[ai][bj][m][n] * g; u32x2 w; w.x = cvt_pk_bf16(v[0], v[1]); w.y = cvt_pk_bf16(v[2], v[3]); *(u32x2*)(rp + bj * 128 + n * 16) = w; }
                }
            }
    }
};

struct WDesc { const float* src; const float* gain; bf16_t* dst; int K, N, map, ibase; };
__device__ __forceinline__ int qk_perm(int s) { return 128 * ((s >> 5) & 1) + 32 * (s >> 6) + 16 * ((s >> 2) & 1) + 4 * ((s >> 3) & 3) + (s & 3); }
__device__ __forceinline__ int dst_row(int map, int c) {
    if (map == 1) return c < 2048 ? (c & ~255) + qk_perm(c & 255) : c;
    if (map == 2) return c < 1280 ? (c & ~255) + qk_perm(c & 255) : c;
    if (map == 3 || map == 4) { const int t = c >> 7, w = c & 127; return 256 * t + (map == 4 ? 128 : 0) + 32 * (w >> 5) + 16 * ((w >> 2) & 1) + 4 * ((w >> 3) & 3) + (w & 3); }
    return c;
}
__device__ __forceinline__ void transpose_item(const GAS float* src, const GAS float* gain, GAS bf16_t* dst, int K, int N, int map, LAS float* scr, int item, int lane) {
    const int nblk = N / 32, kb = item / nblk, nb = item % nblk, k0 = 64 * kb, n0 = 32 * nb;
#pragma unroll 8
    for (int i = 0; i < 32; ++i) { const int kk = 2 * i + (lane >> 5); float v = src[(size_t)(k0 + kk) * N + n0 + (lane & 31)]; if (gain) v *= gain[k0 + kk]; scr[kk * 33 + (lane & 31)] = v; }
    asm volatile("s_waitcnt lgkmcnt(0)" ::: "memory");
    const int c = lane & 7;
#pragma unroll
    for (int j = 0; j < 4; ++j) { const int n = (lane >> 3) + 8 * j; const LAS float* s = scr + (8 * c) * 33 + n;
        u32x4 o; o.x = cvt_pk_bf16(s[0 * 33], s[1 * 33]); o.y = cvt_pk_bf16(s[2 * 33], s[3 * 33]); o.z = cvt_pk_bf16(s[4 * 33], s[5 * 33]); o.w = cvt_pk_bf16(s[6 * 33], s[7 * 33]);
        *(GAS u32x4*)(dst + (size_t)dst_row(map, n0 + n) * K + k0 + 8 * c) = o; }
    asm volatile("s_waitcnt lgkmcnt(0)" ::: "memory");
}
constexpr int N_WDESC = 62;
__device__ __forceinline__ void prologue(Frame& F, const __attribute__((address_space(4))) Args* a) {
    LAS WDesc* wd = (LAS WDesc*)(F.lds + 8 * 16384);
    LAS int* wtot = (LAS int*)(F.lds + 8 * 16384 + N_WDESC * sizeof(WDesc));
    if (F.tid == 0) {
        int n = 0, ib = 0;
#define ADDW(src_, gain_, dst_, K_, N_, map_) do { wd[n].src = (src_); wd[n].gain = (gain_); wd[n].dst = (bf16_t*)(dst_); wd[n].K = (K_); wd[n].N = (N_); wd[n].map = (map_); wd[n].ibase = ib; ++n; ib += ((K_) / 64) * ((N_) / 32); } while (0)
        for (int p = 0; p < 2; ++p) {
            const int na0 = p ? I_L2 : I_L0, sw0 = p ? I_L3 : I_L1;
#define NA_(i) (a->in[na0 + (i)])
#define SW_(i) (a->in[sw0 + (i)])
            unsigned char* wb = F.ws + WS_W + (size_t)p * WPAIR;
            ADDW(NA_(1), NA_(0), wb + WNA_QKV, 1024, 3072, 1);
            ADDW(NA_(5), (const float*)nullptr, wb + WNA_O, 1024, 1024, 0);
            ADDW(NA_(7), NA_(6), wb + WNA_GU, 1024, FF, 3);
            ADDW(NA_(8), NA_(6), wb + WNA_GU, 1024, FF, 4);
            ADDW(NA_(9), (const float*)nullptr, wb + WNA_D, FF, 1024, 0);
            ADDW(SW_(1), SW_(0), wb + WSW_QKV, 1024, 1536, 2);
            ADDW(SW_(5), (const float*)nullptr, wb + WSW_O, 1024, 1024, 0);
            for (int e = 0; e < NE; ++e) {
                ADDW(SW_(8) + (size_t)e * 1024 * FF, SW_(6), wb + WSW_GU + (size_t)e * W_GU, 1024, FF, 3);
                ADDW(SW_(9) + (size_t)e * 1024 * FF, SW_(6), wb + WSW_GU + (size_t)e * W_GU, 1024, FF, 4);
                ADDW(SW_(10) + (size_t)e * FF * 1024, (const float*)nullptr, wb + WSW_D + (size_t)e * W_D, FF, 1024, 0);
            }
        }
#undef ADDW
        *wtot = ib;
    }
    __syncthreads();
    LAS float* scr = (LAS float*)(F.lds + F.wave * 16384);
    const int gw = F.bx * 8 + F.wave, NGW = F.G * 8;
    const int total = *wtot;
    for (int it = gw; it < total; it += NGW) {
        int k = 0;
        for (int j = 1; j < N_WDESC; ++j) k += (it >= wd[j].ibase) ? 1 : 0;
        transpose_item((const GAS float*)wd[k].src, (const GAS float*)wd[k].gain, (GAS bf16_t*)wd[k].dst, wd[k].K, wd[k].N, wd[k].map, scr, it - wd[k].ibase, F.lane);
    }
    u64* ssq0 = ssq_buf(F, 0);
    for (int m = gw; m < M; m += NGW) {
        const float* src = m < NREG ? a->in[I_X] + (size_t)m * D : a->in[I_META] + (size_t)((m - NREG) & 15) * D;
        const f32x4* xr = (const f32x4*)src + F.lane;
        f32x4 v[4]; float s = 0.f;
#pragma unroll
        for (int j = 0; j < 4; ++j) { v[j] = xr[64 * j]; s += (v[j].x * v[j].x + v[j].y * v[j].y) + (v[j].z * v[j].z + v[j].w * v[j].w); }
        s = wave_sum(s);
        u32x2* o8 = (u32x2*)(F.hb + (size_t)m * D) + F.lane;
#pragma unroll
        for (int j = 0; j < 4; ++j) { u32x2 w; w.x = cvt_pk_bf16(v[j].x, v[j].y); w.y = cvt_pk_bf16(v[j].z, v[j].w); o8[64 * j] = w; }
        if (m >= NREG) { f32x4* hm = (f32x4*)(F.hmeta + (size_t)(m - NREG) * D) + F.lane;
#pragma unroll
            for (int j = 0; j < 4; ++j) hm[64 * j] = v[j]; }
        if (F.lane == 0) ssq0[m] = ssq_fix(s);
    }
}

struct AttnCtx {
    const bf16_t* Q; const bf16_t* K; const bf16_t* VT; bf16_t* O; int kpitch;
    const LAS float* tbl;
};
constexpr int NTILE = 18;
__device__ __forceinline__ int t5_bucket_abs(int n) {
    return n < 8 ? n : (n < 12 ? 8 : (n < 16 ? 9 : (n < 23 ? 10 : (n < 32 ? 11 : (n < 46 ? 12 : (n < 64 ? 13 : (n < 91 ? 14 : 15)))))));
}
template <int TYPE>
__device__ __forceinline__ void attn_unit(const AttnCtx& X, int b, int hq, int u0, int u1, bool metaq, int lane) {
    const int q = lane & 15, kg = lane >> 4;
    const int hk = TYPE == 0 ? hq : (hq >> 2);
    int qtok0, rs = 0, ks = 0, r = 0, qc = 0, wsq = 0, q0 = 0;
    if (metaq) qtok0 = NREG + b * 16;
    else if (TYPE == 0) { r = u0; const int cb = u1; qtok0 = b * SEQ + r * 64 + 16 * cb; rs = r - 4; rs = rs < 0 ? 0 : (rs > 24 ? 24 : rs); ks = 16 * cb - 8; ks = ks < 0 ? 0 : (ks > 32 ? 32 : ks);
        qc = 16 * cb + q; wsq = qc - 8; wsq = wsq < 0 ? 0 : (wsq > 48 ? 48 : wsq); }
    else { q0 = 16 * u0; qtok0 = b * SEQ + q0; }
    constexpr int NWIN = TYPE == 0 ? 16 : 17, TMETA = NWIN;
    int tb[NTILE];
#pragma unroll
    for (int t = 0; t < NTILE; ++t) {
        if (t < NWIN) {
            if (metaq) tb[t] = -1;
            else if (TYPE == 0) tb[t] = b * SEQ + (rs + (t >> 1)) * 64 + ks + 16 * (t & 1);
            else { const int j0 = q0 - 128 + 16 * t; tb[t] = (j0 >= 0 && j0 < SEQ) ? b * SEQ + j0 : -1; }
        } else tb[t] = (t == TMETA) ? NREG + b * 16 : -1;
    }
    bf16x8 Qf[2];
    { const bf16_t* qp = X.Q + (size_t)(qtok0 + q) * 1024 + hq * 64 + 8 * kg; Qf[0] = *(const bf16x8*)qp; Qf[1] = *(const bf16x8*)(qp + 32); }
    f32x4 S[NTILE];
    const bf16_t* kbase = X.K + (size_t)q * X.kpitch + hk * 64 + 8 * kg;
#pragma unroll
    for (int t0 = 0; t0 < NTILE; t0 += 6) {
        bf16x8 Kf[6][2];
#pragma unroll
        for (int t = 0; t < 6; ++t) if (tb[t0 + t] >= 0) { const bf16_t* kp = kbase + (size_t)tb[t0 + t] * X.kpitch; Kf[t][0] = *(const bf16x8*)kp; Kf[t][1] = *(const bf16x8*)(kp + 32); }
#pragma unroll
        for (int t = 0; t < 6; ++t) {
            if (tb[t0 + t] >= 0) { f32x4 s = {0.f, 0.f, 0.f, 0.f}; s = __builtin_amdgcn_mfma_f32_16x16x32_bf16(Kf[t][0], Qf[0], s, 0, 0, 0); s = __builtin_amdgcn_mfma_f32_16x16x32_bf16(Kf[t][1], Qf[1], s, 0, 0, 0); S[t0 + t] = s; }
            else S[t0 + t] = (f32x4){NEGBIG, NEGBIG, NEGBIG, NEGBIG};
        }
    }
    float mx = NEGBIG;
#pragma unroll
    for (int t = 0; t < NTILE; ++t) {
        if (tb[t] < 0) continue;
#pragma unroll
        for (int j = 0; j < 4; ++j) {
            float s = S[t][j];
            if (t < NWIN) {
                if (TYPE == 0) {
                    const int kc = ks + 16 * (t & 1) + 4 * kg + j; const bool ok = (kc >= wsq) && (kc < wsq + 16);
                    const int dc = kc - qc + 15, dr = rs + (t >> 1) - r + 7;
                    const float bias = X.tbl[ok ? (hq * 465 + dr * 31 + dc) : 0];
                    s = ok ? s + bias : NEGBIG;
                } else {
                    const int rel = 16 * t - 128 + 4 * kg + j - q; const bool ok = (rel >= -128) && (rel <= 128);
                    const float bias = X.tbl[ok ? (hq * 257 + rel + 128) : 0];
                    s = ok ? s + bias : NEGBIG;
                }
            } else if (TYPE == 1) {
                const int mk = 4 * kg + j; int bucket;
                if (metaq) { const int rel = mk - q; bucket = (rel > 0 ? 16 : 0) + t5_bucket_abs(rel < 0 ? -rel : rel); }
                else bucket = t5_bucket_abs(16 + q0 + q - mk);
                s += X.tbl[16 * 257 + bucket * 16 + hq];
            }
            S[t][j] = s; mx = fmaxf(mx, s);
        }
    }
    mx = fmaxf(mx, __shfl_xor(mx, 16)); mx = fmaxf(mx, __shfl_xor(mx, 32));
    float sk = 0.f;
    if (TYPE == 1) { sk = X.tbl[16 * 257 + 512 + hq]; mx = fmaxf(mx, sk); }
    float l = 0.f;
#pragma unroll
    for (int t = 0; t < NTILE; ++t) {
        if (tb[t] < 0) { S[t] = (f32x4){0.f, 0.f, 0.f, 0.f}; continue; }
#pragma unroll
        for (int j = 0; j < 4; ++j) { const float p = fast_exp2(S[t][j] - mx); S[t][j] = p; l += p; }
    }
    l += __shfl_xor(l, 16); l += __shfl_xor(l, 32);
    if (TYPE == 1) l += fast_exp2(sk - mx);
    const float inv = 1.0f / l;
    f32x4 O[4];
#pragma unroll
    for (int dt = 0; dt < 4; ++dt) O[dt] = (f32x4){0.f, 0.f, 0.f, 0.f};
    const bf16_t* vbase = X.VT + (size_t)(hk * 64 + q) * M + 4 * kg;
#pragma unroll
    for (int s0 = 0; s0 < NTILE / 2; s0 += 3) {
        s16x4 Vl[3][4], Vh[3][4];
#pragma unroll
        for (int s = 0; s < 3; ++s) {
            const int ta = tb[2 * (s0 + s)], tbb = tb[2 * (s0 + s) + 1];
#pragma unroll
            for (int dt = 0; dt < 4; ++dt) {
                Vl[s][dt] = ta >= 0 ? *(const s16x4*)(vbase + (size_t)dt * 16 * M + ta) : (s16x4){0, 0, 0, 0};
                Vh[s][dt] = tbb >= 0 ? *(const s16x4*)(vbase + (size_t)dt * 16 * M + tbb) : (s16x4){0, 0, 0, 0};
            }
        }
#pragma unroll
        for (int s = 0; s < 3; ++s) {
            const int ta = tb[2 * (s0 + s)], tbb = tb[2 * (s0 + s) + 1];
            if (ta < 0 && tbb < 0) continue;
            const f32x4 pa = S[2 * (s0 + s)], pb = S[2 * (s0 + s) + 1];
            u32x4 pw; pw.x = cvt_pk_bf16(pa[0], pa[1]); pw.y = cvt_pk_bf16(pa[2], pa[3]); pw.z = cvt_pk_bf16(pb[0], pb[1]); pw.w = cvt_pk_bf16(pb[2], pb[3]);
            const bf16x8 Pf = __builtin_bit_cast(bf16x8, pw);
#pragma unroll
            for (int dt = 0; dt < 4; ++dt) {
                const bf16x8 Vf = __builtin_shufflevector(Vl[s][dt], Vh[s][dt], 0, 1, 2, 3, 4, 5, 6, 7);
                O[dt] = __builtin_amdgcn_mfma_f32_16x16x32_bf16(Vf, Pf, O[dt], 0, 0, 0);
            }
        }
    }
    bf16_t* op = X.O + (size_t)(qtok0 + q) * 1024 + hq * 64 + 4 * kg;
#pragma unroll
    for (int dt = 0; dt < 4; ++dt) { u32x2 w; w.x = cvt_pk_bf16(O[dt][0] * inv, O[dt][1] * inv); w.y = cvt_pk_bf16(O[dt][2] * inv, O[dt][3] * inv); *(u32x2*)(op + 16 * dt) = w; }
}

template <int TYPE>
__device__ __forceinline__ void attn_phase(Frame& F, const AttnCtx& X) {
    int lane_l = F.lane; asm volatile("" : "+v"(lane_l));
    const int UPC = (NREG + F.G - 1) / F.G;
    const int ubeg = F.bx * UPC, uend = (ubeg + UPC) < NREG ? (ubeg + UPC) : NREG;
    for (int u = ubeg + F.wave; u < uend; u += 8) {
        if (TYPE == 0) { const int cb = u & 3, r = (u >> 2) & 31, h = (u >> 7) & 15, b = u >> 11; attn_unit<0>(X, b, h, r, cb, false, lane_l); }
        else { const int g = u & 3, qb = (u >> 2) & 127, n = (u >> 9) & 3, b = u >> 11; attn_unit<1>(X, b, n * 4 + g, qb, 0, false, lane_l); }
    }
    for (int u = F.bx * 8 + F.wave; u < 512; u += F.G * 8) attn_unit<TYPE>(X, u >> 4, u & 15, 0, 0, true, lane_l);
}

__device__ __forceinline__ void router_phase(Frame& F, const float* wr, const float* gain, int moe_idx) {
    float W[4][4][8];
#pragma unroll
    for (int j = 0; j < 4; ++j)
#pragma unroll
        for (int c = 0; c < 4; ++c) { const int k = 4 * F.lane + 256 * j + c; const float g = gain[k]; const f32x4 a = *(const f32x4*)(wr + (size_t)k * 8), bq = *(const f32x4*)(wr + (size_t)k * 8 + 4);
            W[j][c][0] = a.x * g; W[j][c][1] = a.y * g; W[j][c][2] = a.z * g; W[j][c][3] = a.w * g; W[j][c][4] = bq.x * g; W[j][c][5] = bq.y * g; W[j][c][6] = bq.z * g; W[j][c][7] = bq.w * g; }
    unsigned* cnt = F.ctl + CW_CNT + moe_idx * 8 * 64;
    unsigned* rowtok = (unsigned*)(F.ws + WS_TAB); float* rowssq = (float*)(F.ws + WS_TAB + TAB_BYTES);
    unsigned* rowslot = (unsigned*)(F.ws + WS_TAB + 2 * TAB_BYTES); float* rowgate = (float*)(F.ws + WS_TAB + 3 * TAB_BYTES);
    const int gw = F.bx * 8 + F.wave, NGW = F.G * 8;
    for (int task = gw; task < M / 32; task += NGW) {
        int me1 = 0, me2 = 0; float mg1 = 0.f, mg2 = 0.f, mss = 0.f;
        for (int t = 0; t < 32; ++t) {
            const int m = task * 32 + t;
            const f32x4* xr = (const f32x4*)hrow(F, m) + F.lane;
            float lg[8]; float ss = 0.f;
#pragma unroll
            for (int e = 0; e < 8; ++e) lg[e] = 0.f;
#pragma unroll
            for (int j = 0; j < 4; ++j) { const f32x4 v = xr[64 * j]; ss += (v.x * v.x + v.y * v.y) + (v.z * v.z + v.w * v.w);
#pragma unroll
                for (int e = 0; e < 8; ++e) lg[e] += v.x * W[j][0][e] + v.y * W[j][1][e] + v.z * W[j][2][e] + v.w * W[j][3][e]; }
            ss = wave_sum(ss);
#pragma unroll
            for (int e = 0; e < 8; ++e) lg[e] = wave_sum(lg[e]);
            const float rstd = 1.0f / sqrtf(ss * (1.0f / 1024.0f) + EPS);
            int e1 = 0; float v1 = lg[0];
#pragma unroll
            for (int e = 1; e < 8; ++e) if (lg[e] > v1) { v1 = lg[e]; e1 = e; }
            int e2 = -1; float v2 = -3.0e38f;
#pragma unroll
            for (int e = 0; e < 8; ++e) if (e != e1 && lg[e] > v2) { v2 = lg[e]; e2 = e; }
            const float ex = __expf((v2 - v1) * rstd); const float g1 = 1.0f / (1.0f + ex), g2 = ex * g1;
            if (F.lane == t) { me1 = e1; me2 = e2; mg1 = g1; mg2 = g2; mss = ss; }
        }
        const bool act = F.lane < 32;
        int rank1 = 0, rank2 = 0, mycnt = 0, n1e2 = 0;
        const unsigned long long lt = (1ull << F.lane) - 1ull;
#pragma unroll
        for (int e = 0; e < 8; ++e) {
            const unsigned long long m1 = __ballot(act && me1 == e), m2 = __ballot(act && me2 == e);
            const int c1 = __popcll(m1), c2 = __popcll(m2);
            if (me1 == e) rank1 = __popcll(m1 & lt);
            if (me2 == e) { rank2 = __popcll(m2 & lt); n1e2 = c1; }
            if (F.lane == e) mycnt = c1 + c2;
        }
        unsigned basev = 0;
        if (F.lane < 8 && mycnt > 0) basev = __hip_atomic_fetch_add(cnt + F.lane * 64, (unsigned)mycnt, RLX_AGENT);
        const unsigned b1 = __shfl(basev, me1), b2 = __shfl(basev, me2);
        if (act) {
            const int m = task * 32 + F.lane;
            const size_t p1 = (size_t)me1 * M + b1 + rank1, p2 = (size_t)me2 * M + b2 + n1e2 + rank2;
            rowtok[p1] = m; rowssq[p1] = mss; rowslot[p1] = 2 * m; rowgate[p1] = mg1;
            rowtok[p2] = m; rowssq[p2] = mss; rowslot[p2] = 2 * m + 1; rowgate[p2] = mg2;
        }
    }
}
__device__ __forceinline__ void combine_phase(Frame& F, const bf16_t* ys, u64* ssq_next, bool last) {
    const int gw = F.bx * 8 + F.wave, NGW = F.G * 8;
    for (int m = gw; m < (last ? NREG : M); m += NGW) {
        f32x4* hr = (f32x4*)hrow(F, m) + F.lane;
        const u32x2* y0 = (const u32x2*)(ys + (size_t)(2 * m) * D) + F.lane; const u32x2* y1 = (const u32x2*)(ys + (size_t)(2 * m + 1) * D) + F.lane;
        f32x4 v[4]; float s = 0.f;
#pragma unroll
        for (int j = 0; j < 4; ++j) { v[j] = hr[64 * j]; const u32x2 a = y0[64 * j], c = y1[64 * j];
            v[j].x += __uint_as_float(a.x << 16) + __uint_as_float(c.x << 16); v[j].y += __uint_as_float(a.x & 0xffff0000u) + __uint_as_float(c.x & 0xffff0000u);
            v[j].z += __uint_as_float(a.y << 16) + __uint_as_float(c.y << 16); v[j].w += __uint_as_float(a.y & 0xffff0000u) + __uint_as_float(c.y & 0xffff0000u);
            s += (v[j].x * v[j].x + v[j].y * v[j].y) + (v[j].z * v[j].z + v[j].w * v[j].w); hr[64 * j] = v[j]; }
        if (!last) {
            s = wave_sum(s);
            u32x2* o8 = (u32x2*)(F.hb + (size_t)m * D) + F.lane;
#pragma unroll
            for (int j = 0; j < 4; ++j) { u32x2 w; w.x = cvt_pk_bf16(v[j].x, v[j].y); w.y = cvt_pk_bf16(v[j].z, v[j].w); o8[64 * j] = w; }
            if (F.lane == 0) ssq_next[m] = ssq_fix(s);
        }
    }
}

constexpr int PH_PER_PAIR = 20, N_PHASES = 1 + 2 * PH_PER_PAIR;
typedef const __attribute__((address_space(4))) Args* KArgs;
__device__ __forceinline__ KArgs kargs() { KArgs p = (KArgs)__builtin_amdgcn_kernarg_segment_ptr(); asm volatile("" : "+s"(p)); return p; }
__device__ __forceinline__ void make_frame(Frame& F, KArgs ap) {
    extern __shared__ __attribute__((aligned(16))) unsigned char lds_raw[];
    F.lds = (LAS unsigned char*)lds_raw; F.tab = F.lds + TAB_OFF;
    int t = threadIdx.x; asm volatile("" : "+v"(t));
    F.tid = t; F.lane = t & 63; F.wave = __builtin_amdgcn_readfirstlane(t >> 6); F.G = gridDim.x; F.bx = blockIdx.x;
    unsigned char* ws = ap->ws;
    F.ws = ws; F.out = ap->out; F.hmeta = (float*)(ws + WS_HMETA); F.hb = (bf16_t*)(ws + WS_HB); F.ctl = (unsigned*)(ws + WS_CTL);
}
__device__ __forceinline__ void grid_seam() {
    KArgs ap = kargs();
    extern __shared__ __attribute__((aligned(16))) unsigned char lds_raw[];
    XcdBarrier b; b.bar = (unsigned*)(ap->ws + WS_CTL) + CW_BAR; b.x = xb_xcc_id(); b.st = (volatile LAS unsigned*)((LAS unsigned char*)lds_raw + MISC_OFF) + 8;
    xcd_barrier(b);
}
#ifndef SITE_MASK
#define SITE_MASK 0xFFFF
#endif
#define SITE(b) ((SITE_MASK >> (b)) & 1)

__device__ __forceinline__ void site_na_qkv(int pr) {
    KArgs ap = kargs(); Frame F; make_frame(F, ap);
    const int lb = pr ? I_L2 : I_L0; const unsigned char* wb = F.ws + WS_W + (size_t)pr * WPAIR; unsigned char* R = F.ws + WS_R;
    LAS float* gainsL = (LAS float*)(F.lds + GAIN_OFF);
    if (F.tid < 64) { gainsL[F.tid] = ap->in[lb + 2][F.tid] * (0.125f * LOG2E); gainsL[64 + F.tid] = ap->in[lb + 3][F.tid]; }
    __syncthreads();
    QkvPolicy P; P.nt = 16; P.pitchA = 2048; P.pitchB = 2048; P.G = F.G; P.c = F.bx; P.nN = 12; P.QT = 8; P.hb = (const char*)F.hb; P.W = (const char*)(wb + WNA_QKV);
    P.ssq = ssq_buf(F, 4 * pr + 0); P.Q = (bf16_t*)(R + R_Q); P.K = (bf16_t*)(R + R_K); P.VT = (bf16_t*)(R + R_VT_NA); P.kpitch = 1024; P.nQ = 4; P.gains = gainsL;
    pg8::gemm_phase(F.lds, F.tab, P);
}
__device__ __forceinline__ void site_na_attn(int pr) {
    KArgs ap = kargs(); Frame F; make_frame(F, ap);
    const int lb = pr ? I_L2 : I_L0; unsigned char* R = F.ws + WS_R;
    LAS float* tbl = (LAS float*)F.lds; const float* rpb = ap->in[lb + 4];
    for (int i = F.tid; i < 16 * 465; i += 512) tbl[i] = rpb[i] * LOG2E;
    __syncthreads();
    AttnCtx X; X.Q = (const bf16_t*)(R + R_Q); X.K = (const bf16_t*)(R + R_K); X.VT = (const bf16_t*)(R + R_VT_NA); X.O = (bf16_t*)(R + R_Q); X.kpitch = 1024; X.tbl = tbl;
    attn_phase<0>(F, X);
    __syncthreads();
}
__device__ __forceinline__ void site_wo(int pr, int swa) {
    KArgs ap = kargs(); Frame F; make_frame(F, ap);
    const unsigned char* wb = F.ws + WS_W + (size_t)pr * WPAIR; unsigned char* R = F.ws + WS_R;
    ResPolicy P; P.nt = 16; P.pitchA = 2048; P.pitchB = 2048; P.G = F.G; P.c = F.bx; P.A = (const char*)(R + R_Q); P.W = (const char*)(wb + (swa ? WSW_O : WNA_O));
    P.base_reg = (pr == 0 && swa == 0) ? ap->in[I_X] : F.out; P.out_reg = F.out; P.hmeta = F.hmeta; P.hb = F.hb; P.ssq_out = ssq_buf(F, 4 * pr + (swa ? 3 : 1));
    pg8::gemm_phase(F.lds, F.tab, P);
}
__device__ __forceinline__ void site_dense_gu(int pr) {
    KArgs ap = kargs(); Frame F; make_frame(F, ap);
    const unsigned char* wb = F.ws + WS_W + (size_t)pr * WPAIR; unsigned char* R = F.ws + WS_R;
    GuPolicy<false> P; P.nt = 16; P.pitchA = 2048; P.pitchB = 2048; P.G = F.G; P.c = F.bx; P.hb = (const char*)F.hb; P.W = (const char*)(wb + WNA_GU); P.ssq = ssq_buf(F, 4 * pr + 1); P.hid = (bf16_t*)R;
    P.rowtok = nullptr; P.p0 = 0; P.p1 = 0; P.ptab = nullptr;
    pg8::gemm_phase(F.lds, F.tab, P);
}
__device__ __forceinline__ void site_dense_down(int pr) {
    KArgs ap = kargs(); Frame F; make_frame(F, ap);
    const unsigned char* wb = F.ws + WS_W + (size_t)pr * WPAIR; unsigned char* R = F.ws + WS_R;
    ResPolicy P; P.nt = 56; P.pitchA = 7168; P.pitchB = 7168; P.G = F.G; P.c = F.bx; P.A = (const char*)R; P.W = (const char*)(wb + WNA_D);
    P.base_reg = F.out; P.out_reg = F.out; P.hmeta = F.hmeta; P.hb = F.hb; P.ssq_out = ssq_buf(F, 4 * pr + 2);
    pg8::gemm_phase(F.lds, F.tab, P);
}
__device__ __forceinline__ void site_swa_qkv(int pr) {
    KArgs ap = kargs(); Frame F; make_frame(F, ap);
    const int lb = pr ? I_L3 : I_L1; const unsigned char* wb = F.ws + WS_W + (size_t)pr * WPAIR; unsigned char* R = F.ws + WS_R;
    LAS float* gainsL = (LAS float*)(F.lds + GAIN_OFF);
    if (F.tid < 64) { gainsL[F.tid] = ap->in[lb + 2][F.tid] * (0.125f * LOG2E); gainsL[64 + F.tid] = ap->in[lb + 3][F.tid]; }
    __syncthreads();
    QkvPolicy P; P.nt = 16; P.pitchA = 2048; P.pitchB = 2048; P.G = F.G; P.c = F.bx; P.nN = 6; P.QT = 5; P.hb = (const char*)F.hb; P.W = (const char*)(wb + WSW_QKV);
    P.ssq = ssq_buf(F, 4 * pr + 2); P.Q = (bf16_t*)(R + R_Q); P.K = (bf16_t*)(R + R_K); P.VT = (bf16_t*)(R + R_VT_SWA); P.kpitch = 256; P.nQ = 4; P.gains = gainsL;
    pg8::gemm_phase(F.lds, F.tab, P);
}
__device__ __forceinline__ void site_swa_attn(int pr) {
    KArgs ap = kargs(); Frame F; make_frame(F, ap);
    const int lb = pr ? I_L3 : I_L1; unsigned char* R = F.ws + WS_R;
    LAS float* tbl = (LAS float*)F.lds;
    const float* t5 = ap->in[I_T5]; const float* sink = ap->in[lb + 4];
    for (int i = F.tid; i < 16 * 257; i += 512) { const int h = i / 257, rel = i % 257 - 128; const int bkt = (rel > 0 ? 16 : 0) + t5_bucket_abs(rel < 0 ? -rel : rel); tbl[i] = t5[bkt * 16 + h] * LOG2E; }
    tbl[16 * 257 + F.tid] = t5[F.tid] * LOG2E;
    if (F.tid < 16) tbl[16 * 257 + 512 + F.tid] = sink[F.tid] * LOG2E;
    __syncthreads();
    AttnCtx X; X.Q = (const bf16_t*)(R + R_Q); X.K = (const bf16_t*)(R + R_K); X.VT = (const bf16_t*)(R + R_VT_SWA); X.O = (bf16_t*)(R + R_Q); X.kpitch = 256; X.tbl = tbl;
    attn_phase<1>(F, X);
    __syncthreads();
}
__device__ __forceinline__ void site_router(int pr) {
    KArgs ap = kargs(); Frame F; make_frame(F, ap);
    const int lb = pr ? I_L3 : I_L1;
    router_phase(F, ap->in[lb + 7], ap->in[lb + 6], pr);
}
__device__ __forceinline__ int moe_tables(Frame& F, int pr) {
    volatile LAS int* pt = (volatile LAS int*)(F.lds + MISC_OFF + 128);
    if (F.tid == 0) { int acc = 0; pt[0] = 0;
        for (int e = 0; e < NE; ++e) { const int c = (int)__hip_atomic_load(F.ctl + CW_CNT + pr * 8 * 64 + e * 64, RLX_AGENT); pt[9 + e] = c; acc += (c + 255) / 256; pt[e + 1] = acc; } }
    __syncthreads();
    return pt[NE];
}
__device__ __forceinline__ void site_moe_gu(int pr, int ch) {
    KArgs ap = kargs(); Frame F; make_frame(F, ap);
    const int PT = moe_tables(F, pr); const int P0 = ch * MOE_CH, P1 = (P0 + MOE_CH) < PT ? (P0 + MOE_CH) : PT;
    if (P0 < P1) {
        const unsigned char* wb = F.ws + WS_W + (size_t)pr * WPAIR; unsigned char* R = F.ws + WS_R;
        GuPolicy<true> P; P.nt = 16; P.pitchA = 2048; P.pitchB = 2048; P.G = F.G; P.c = F.bx; P.hb = (const char*)F.hb; P.W = (const char*)(wb + WSW_GU); P.ssq = (const void*)(F.ws + WS_TAB + TAB_BYTES); P.hid = (bf16_t*)R;
        P.rowtok = (const unsigned*)(F.ws + WS_TAB); P.p0 = P0; P.p1 = P1; P.ptab = (const LAS int*)(F.lds + MISC_OFF + 128);
        pg8::gemm_phase(F.lds, F.tab, P);
    }
    __syncthreads();
}
__device__ __forceinline__ void site_moe_down(int pr, int ch) {
    KArgs ap = kargs(); Frame F; make_frame(F, ap);
    const int PT = moe_tables(F, pr); const int P0 = ch * MOE_CH, P1 = (P0 + MOE_CH) < PT ? (P0 + MOE_CH) : PT;
    if (P0 < P1) {
        const unsigned char* wb = F.ws + WS_W + (size_t)pr * WPAIR; unsigned char* R = F.ws + WS_R;
        MoeDownPolicy P; P.nt = 56; P.pitchA = 7168; P.pitchB = 7168; P.G = F.G; P.c = F.bx; P.hid = (const char*)R; P.W = (const char*)(wb + WSW_D);
        P.rowslot = (const unsigned*)(F.ws + WS_TAB + 2 * TAB_BYTES); P.rowgate = (const float*)(F.ws + WS_TAB + 3 * TAB_BYTES); P.ys = (bf16_t*)(R + R_YS); P.p0 = P0; P.p1 = P1; P.ptab = (const LAS int*)(F.lds + MISC_OFF + 128);
        pg8::gemm_phase(F.lds, F.tab, P);
    }
    __syncthreads();
}
__device__ __forceinline__ void site_combine(int pr) {
    KArgs ap = kargs(); Frame F; make_frame(F, ap);
    combine_phase(F, (const bf16_t*)(F.ws + WS_R + R_YS), ssq_buf(F, pr ? 0 : 4), pr == 1);
}

__global__ void __launch_bounds__(512, 2) fwd_kernel(Args args) {
    extern __shared__ __attribute__((aligned(16))) unsigned char lds_raw[];
    {
        volatile LAS unsigned* MISC = (volatile LAS unsigned*)((LAS unsigned char*)lds_raw + MISC_OFF);
        if (threadIdx.x < 64) MISC[threadIdx.x] = 0u;
        __syncthreads();
    }
    const int lo = args.ph_lo, hi = args.ph_hi;
    if (hi - lo > 1) { KArgs ap = kargs(); (void)xcd_barrier_post((unsigned*)(ap->ws + WS_CTL) + CW_BAR, (volatile LAS unsigned*)((LAS unsigned char*)lds_raw + MISC_OFF) + 8); }
#define IN(k) (lo <= (k) && (k) < hi)
#define SEAM(k) do { if (IN(k) && IN((k) + 1)) grid_seam(); } while (0)
    if (SITE(0) && IN(0)) { KArgs ap = kargs(); Frame F; make_frame(F, ap); prologue(F, ap); }
    SEAM(0);
    for (int pr = 0; pr < 2; ++pr) {
        const int pb = 1 + pr * PH_PER_PAIR;
        if (SITE(1) && IN(pb + 0)) site_na_qkv(pr);
        SEAM(pb + 0);
        if (SITE(2) && IN(pb + 1)) site_na_attn(pr);
        SEAM(pb + 1);
        if (SITE(3) && IN(pb + 2)) site_wo(pr, 0);
        SEAM(pb + 2);
        if (SITE(4) && IN(pb + 3)) site_dense_gu(pr);
        SEAM(pb + 3);
        if (SITE(5) && IN(pb + 4)) site_dense_down(pr);
        SEAM(pb + 4);
        if (SITE(6) && IN(pb + 5)) site_swa_qkv(pr);
        SEAM(pb + 5);
        if (SITE(7) && IN(pb + 6)) site_swa_attn(pr);
        SEAM(pb + 6);
        if (SITE(8) && IN(pb + 7)) site_wo(pr, 1);
        SEAM(pb + 7);
        if (SITE(9) && IN(pb + 8)) site_router(pr);
        SEAM(pb + 8);
        for (int ch = 0; ch < 5; ++ch) {
            if (SITE(10) && IN(pb + 9 + 2 * ch)) site_moe_gu(pr, ch);
            SEAM(pb + 9 + 2 * ch);
            if (SITE(11) && IN(pb + 10 + 2 * ch)) site_moe_down(pr, ch);
            SEAM(pb + 10 + 2 * ch);
        }
        if (SITE(12) && IN(pb + 19)) site_combine(pr);
        SEAM(pb + 19);
    }
#undef IN
#undef SEAM
}

extern "C" void kernel_launch(void* const* d_in, const int* in_sizes, int n_in, void* d_out, int out_size, void* d_ws, size_t ws_size, hipStream_t stream) {
    static int grid = 0;
    if (grid == 0) {
        if (n_in != 45 || out_size != NREG * D || ws_size < WS_END) { fprintf(stderr, "kernel_launch: unexpected shapes (n_in %d out %d ws %zu need %zu)\n", n_in, out_size, ws_size, (size_t)WS_END); grid = -1; return; }
        int dev = 0, cus = 0, per_cu = 0;
        if (hipGetDevice(&dev) != hipSuccess || hipDeviceGetAttribute(&cus, hipDeviceAttributeMultiprocessorCount, dev) != hipSuccess) { grid = -1; return; }
        if (hipFuncSetAttribute((const void*)fwd_kernel, hipFuncAttributeMaxDynamicSharedMemorySize, LDS_BYTES) != hipSuccess) { fprintf(stderr, "kernel_launch: hipFuncSetAttribute failed\n"); grid = -1; return; }
        if (hipOccupancyMaxActiveBlocksPerMultiprocessor(&per_cu, (const void*)fwd_kernel, 512, LDS_BYTES) != hipSuccess || per_cu < 1) fprintf(stderr, "kernel_launch: occupancy query says %d\n", per_cu);
        (void)hipGetLastError();
        grid = cus;
    }
    if (grid < 0) return;
    (void)hipMemsetAsync((char*)d_ws + WS_CTL, 0, CTL_BYTES, stream);
    Args a{};
    for (int i = 0; i < 45; ++i) a.in[i] = (const float*)d_in[i];
    a.out = (float*)d_out; a.ws = (unsigned char*)d_ws;
#if MK_MULTI
    for (int p = 0; p < N_PHASES && p <= MK_STOP; ++p) { a.ph_lo = p; a.ph_hi = p + 1; hipLaunchKernelGGL(fwd_kernel, dim3(grid), dim3(512), LDS_BYTES, stream, a); }
#else
    a.ph_lo = 0; a.ph_hi = N_PHASES;
    hipLaunchKernelGGL(fwd_kernel, dim3(grid), dim3(512), LDS_BYTES, stream, a);
#endif
}
```

```cpp
#include <hip/hip_runtime.h>
#include <cstdio>
#include <cstdint>

#ifndef MK_MULTI
#define MK_MULTI 0
#endif

#ifndef PROBE_A
#define PROBE_A 0ull
#define PROBE_B 0ull
#endif
#ifndef DENSE8_FROM
#define DENSE8_FROM 1
#endif
#ifndef REP_MASK
#define REP_MASK 0
#endif
#ifndef DUP_PHASE
#define DUP_PHASE -1
#endif
#ifndef MK_STOP
#define MK_STOP 1000
#endif
#define LAS __attribute__((address_space(3)))
#define GAS __attribute__((address_space(1)))
typedef unsigned short bf16_t;
typedef short bf16x8 __attribute__((ext_vector_type(8)));
typedef short s16x4 __attribute__((ext_vector_type(4)));
typedef float f32x4 __attribute__((ext_vector_type(4)));
typedef float f32x2 __attribute__((ext_vector_type(2)));
typedef unsigned u32x4 __attribute__((ext_vector_type(4)));
typedef unsigned u32x2 __attribute__((ext_vector_type(2)));
#define RLX_AGENT __ATOMIC_RELAXED, __HIP_MEMORY_SCOPE_AGENT

constexpr int D = 1024, NREG = 65536, NMETA_ROWS = 16, M = NREG + NMETA_ROWS, NPANEL = NREG / 256;
constexpr int SEQ = 2048, BATCH = 32, FF = 3584, NE = 8;
constexpr float EPS = 1e-6f;
constexpr float LOG2E = 1.4426950408889634f;
constexpr float NEGBIG = -1e30f;
constexpr float SM_SHIFT = 16.0f;

constexpr size_t WS_CTL = 0, CTL_BYTES = 8u << 20;
constexpr int CW_TMO = 0, CW_BAR = 4096, CW_CNT = 8192;
constexpr size_t CTL_SSQ = 65536;
constexpr size_t SSQ_BYTES = (size_t)M * 8;
constexpr float SSQ_SCALE = 16777216.0f, SSQ_INV = 1.0f / 16777216.0f;
typedef unsigned long long u64;
static_assert(CTL_SSQ + 9 * SSQ_BYTES <= CTL_BYTES, "ctl");
constexpr size_t W_QKV_NA = (size_t)3072 * 1024 * 2, W_O = (size_t)1024 * 1024 * 2, W_GU = (size_t)7168 * 1024 * 2, W_D = (size_t)1024 * 3584 * 2, W_QKV_SWA = (size_t)1536 * 1024 * 2;
constexpr size_t WNA_QKV = 0, WNA_O = WNA_QKV + W_QKV_NA, WNA_GU = WNA_O + W_O, WNA_D = WNA_GU + W_GU, WNA_END = WNA_D + W_D;
constexpr size_t W_GU8 = (size_t)7168 * 1024;
constexpr size_t W_D8 = (size_t)1024 * 3584;
constexpr float W8_SCALE = 64.0f, W8_INV = 1.0f / 64.0f;
constexpr float YS8_SCALE = 16.0f, YS8_INV = 0.0625f;
constexpr float HID8_SCALE = 4.0f, HID8_INV = 0.25f;
constexpr size_t WSW_QKV = WNA_END, WSW_O = WSW_QKV + W_QKV_SWA, WSW_GU = WSW_O + W_O, WSW_D = WSW_GU + NE * W_GU8, WPAIR = WSW_D + NE * W_D8;
constexpr size_t WS_W = CTL_BYTES;
constexpr size_t WS_HB = WS_W + 2 * WPAIR;
constexpr size_t HB_BYTES = (size_t)M * D * 2;
constexpr size_t WS_HB8 = WS_HB + HB_BYTES;
constexpr size_t WS_TAB = WS_HB8 + (size_t)M * D;
constexpr size_t TAB_BYTES = (size_t)NE * M * 4;
constexpr size_t WS_R = WS_TAB + 4 * TAB_BYTES;
constexpr size_t R_Q = 0, R_K = HB_BYTES, R_VT_NA = 2 * HB_BYTES, R_VT_SWA = HB_BYTES + (size_t)M * 256 * 2;
constexpr int MOE_CH = 256, MOE_NCH = 2, MOE_CH_MAX = 264;
constexpr size_t R_YS = (size_t)MOE_CH_MAX * 256 * FF;
constexpr size_t R_DENSE = (size_t)M * FF * 2, R_MOE = R_YS + (size_t)2 * M * D * 2;
constexpr size_t R_BYTES = R_DENSE > R_MOE ? R_DENSE : R_MOE;
static_assert(3 * HB_BYTES <= R_BYTES, "R");
constexpr size_t WS_END = WS_R + R_BYTES;
static_assert(WS_END + (24u << 20) <= 1115912448ull, "d_ws budget (incl. the 24 MiB scratch window of timing experiments)");

constexpr int TAB_OFF = 131072;
constexpr int GAIN_OFF = TAB_OFF + 10240;
constexpr int MISC_OFF = 163840 - 512;
constexpr int ATT_X_OFF = 147456;
constexpr int LDS_BYTES = 163840;
static_assert(MISC_OFF + 256 <= LDS_BYTES, "lds");

__device__ __forceinline__ unsigned cvt_pk_bf16(float lo, float hi) { unsigned r; asm volatile("v_cvt_pk_bf16_f32 %0, %1, %2" : "=v"(r) : "v"(lo), "v"(hi)); return r; }
__device__ __forceinline__ float wave_sum(float v) {
#pragma unroll
    for (int o = 1; o < 64; o <<= 1) v += __shfl_xor(v, o);
    return v;
}
__device__ __forceinline__ float fast_rsqrt(float x) { return __builtin_amdgcn_rsqf(x); }
__device__ __forceinline__ float fast_exp2(float x) { return __builtin_amdgcn_exp2f(x); }
__device__ __forceinline__ float fast_rcp(float x) { return __builtin_amdgcn_rcpf(x); }
__device__ __forceinline__ float silu_f(float x) { return x * fast_rcp(1.0f + fast_exp2(-x * LOG2E)); }

#define XB_TMO      128
#define XB_XCNT(j)  (256  + 64 * (j))
#define XB_XSUB(j)  (1280 + 64 * (j))
#define XB_XGEN(j)  (2304 + 64 * (j))
#define XB_TOP      3328
#define XB_TOPGEN   3392
#define XCD_BAR_WORDS 3456
#define XB_SPIN_CAP (1u << 18)
template <class T> __device__ __forceinline__ unsigned xb_ld(T* p)              { return __hip_atomic_load(p, __ATOMIC_RELAXED, __HIP_MEMORY_SCOPE_AGENT); }
template <class T> __device__ __forceinline__ unsigned xb_add(T* p, unsigned v) { return __hip_atomic_fetch_add(p, v, __ATOMIC_RELAXED, __HIP_MEMORY_SCOPE_AGENT); }
__device__ __forceinline__ unsigned xb_xcc_id() { return (unsigned)__builtin_amdgcn_s_getreg((3 << 11) | 20) & 0xFu; }
#define XB_SPIN(cond, bar) do { unsigned _sp = 0; while (cond) { __builtin_amdgcn_s_sleep(1); \
    if ((++_sp & 255u) == 0u) { if (xb_ld(&(bar)[XB_TMO])) break; if (_sp > XB_SPIN_CAP) { xb_add(&(bar)[XB_TMO], 1u); break; } } } } while (0)
struct XcdBarrier { unsigned* bar; unsigned x; volatile LAS unsigned* st; };
__device__ __forceinline__ XcdBarrier xcd_barrier_post(unsigned* bar, volatile LAS unsigned* st) {
    XcdBarrier b; b.bar = bar; b.x = xb_xcc_id(); b.st = st;
    if (threadIdx.x == 0) (void)xb_add(&bar[XB_XCNT(b.x)], 1u);
    return b;
}
__device__ __forceinline__ void xcd_barrier_complete(GAS unsigned* bar, unsigned x, unsigned& nloc, unsigned& nx) {
    const unsigned G = gridDim.x * gridDim.y * gridDim.z;
    unsigned sum, cnt, mine, sp = 0u;
    for (;;) {
        sum = 0u; cnt = 0u; mine = 0u;
#pragma unroll
        for (unsigned j = 0; j < 16; ++j) { const unsigned c = xb_ld(&bar[XB_XCNT(j)]); sum += c; cnt += (c > 0u) ? 1u : 0u; mine = (j == x) ? c : mine; }
        if (sum == G) break;
        __builtin_amdgcn_s_sleep(1);
        if ((++sp & 255u) == 0u) { if (xb_ld(&bar[XB_TMO])) break; if (sp > XB_SPIN_CAP) { xb_add(&bar[XB_TMO], 1u); break; } }
    }
    nloc = mine > 0u ? mine : 1u; nx = cnt > 0u ? cnt : 1u;
}
__device__ __noinline__ void xcd_barrier_leader(GAS unsigned* bar, unsigned x, volatile LAS unsigned* st) {
    __builtin_amdgcn_s_waitcnt(0);
    unsigned nloc = st[0], nx = st[1];
    if (nloc == 0u) { xcd_barrier_complete(bar, x, nloc, nx); st[0] = nloc; st[1] = nx; }
    const unsigned old = xb_add(&bar[XB_XSUB(x)], 1u);
    const unsigned gen = old / nloc;
    if (old + 1u == (gen + 1u) * nloc) {
        __builtin_amdgcn_fence(__ATOMIC_RELEASE, "agent");
        asm volatile("s_waitcnt vmcnt(0)" ::: "memory");
        const unsigned og = xb_add(&bar[XB_TOP], 1u);
        const unsigned tg = og / nx;
        if (og + 1u == (tg + 1u) * nx) xb_add(&bar[XB_TOPGEN], 1u);
        else XB_SPIN(xb_ld(&bar[XB_TOPGEN]) == tg, bar);
        __builtin_amdgcn_fence(__ATOMIC_ACQUIRE, "agent");
        xb_add(&bar[XB_XGEN(x)], 1u);
        asm volatile("s_waitcnt vmcnt(0)" ::: "memory");
    } else {
        XB_SPIN(xb_ld(&bar[XB_XGEN(x)]) == gen, bar);
        __builtin_amdgcn_fence(__ATOMIC_ACQUIRE, "agent");
        asm volatile("s_waitcnt vmcnt(0)" ::: "memory");
    }
}
__device__ __forceinline__ void xcd_barrier(const XcdBarrier& b) {
    asm volatile("s_waitcnt vmcnt(0)" ::: "memory");
    __syncthreads();
    if (threadIdx.x == 0) xcd_barrier_leader((GAS unsigned*)b.bar, b.x, b.st);
    __syncthreads();
}

namespace pg8 {
constexpr int BM = 256, BK = 64, HALF = 128, HTB = HALF * BK * 2, NXCD = 8, WGM = 8;
__host__ __device__ __forceinline__ int lds_byte(int r, int c) { const int st = (r >> 4) * 2 + (c >> 5), rr = r & 15, cc = c & 31, ob = rr * 64 + cc * 2; return st * 1024 + (ob ^ (((ob >> 9) & 1) << 5)); }
__host__ __device__ __forceinline__ void stage_rc(int b, int& R, int& C) { const int st = b / 1024, sb = b % 1024, swz = sb ^ (((sb >> 9) & 1) << 5); R = (st >> 1) * 16 + swz / 64; C = (st & 1) * 32 + (swz % 64) / 2; }
struct Unit { const char* A; const char* B; int pm, pn, kind, aux, aux2; };
__device__ __forceinline__ void tile_of(int L, int nM, int nN, int& pm, int& pn) {
    const int nwg = nM * nN; int wgid = L; { const int q = nwg / NXCD, r = nwg % NXCD, xcd = wgid % NXCD, off = wgid / NXCD; wgid = (xcd < r ? xcd * (q + 1) : r * (q + 1) + (xcd - r) * q) + off; }
    const int nig = WGM * nN, gid = wgid / nig, fm = gid * WGM, gsz = (nM - fm) < WGM ? (nM - fm) : WGM;
    pm = fm + ((wgid % nig) % gsz); pn = (wgid % nig) / gsz;
}
__device__ __forceinline__ void dma4(const void* g, LAS void* l) { __builtin_amdgcn_global_load_lds((const unsigned*)g, (LAS unsigned*)l, 4, 0, 0); }
typedef int v8i __attribute__((ext_vector_type(8)));
typedef int v4i __attribute__((ext_vector_type(4)));
__device__ __forceinline__ v8i cat8(bf16x8 lo, bf16x8 hi) { const v4i a = __builtin_bit_cast(v4i, lo), b = __builtin_bit_cast(v4i, hi); return __builtin_shufflevector(a, b, 0, 1, 2, 3, 4, 5, 6, 7); }

template <class P>
__device__ __forceinline__ void gemm_phase(LAS unsigned char* lds, LAS unsigned char* tab, const P& S) {
    int tid_l = threadIdx.x; asm volatile("" : "+v"(tid_l));
    const int tid = tid_l, wid = __builtin_amdgcn_readfirstlane(tid >> 6), lane = tid & 63, wr = wid >> 2, wc = wid & 3, fr = lane & 15, fq = lane >> 4;
    const int nt = S.nt;
    int Rr[2], Cc[2];
#pragma unroll
    for (int i = 0; i < 2; ++i) stage_rc(tid * 16 + i * 8192, Rr[i], Cc[i]);
    unsigned voffB[2], voffA[2][2];
#pragma unroll
    for (int i = 0; i < 2; ++i) { voffB[i] = (unsigned)Rr[i] * S.pitchB + (unsigned)Cc[i] * 2u;
#pragma unroll
        for (int h = 0; h < 2; ++h) voffA[h][i] = (unsigned)(HALF * h + Rr[i]) * S.pitchA + (unsigned)Cc[i] * 2u; }
    const size_t kstep = (size_t)(BK * 2);
    const size_t hstepB = (size_t)HALF * S.pitchB;
    const unsigned ldsw = (unsigned)wid * 1024u;
    constexpr int FSTEP = 8, KOFF = 1024;
    const int aoff = lds_byte(wr * 64 + fr, fq * FSTEP), boff = lds_byte(wc * 32 + fr, fq * FSTEP);
    LAS unsigned* idtab = (LAS unsigned*)tab;
#define PG8_SA(b, h) (((b) * 2 + (h)) * HTB)
#define PG8_SB(b, h) ((4 + (b) * 2 + (h)) * HTB)
#define PG8_STAGE(bufoff, gbase, voff) do { _Pragma("unroll") for (int _i = 0; _i < 2; ++_i) { unsigned _vo = (voff)[_i]; asm volatile("" : "+v"(_vo)); \
        __builtin_amdgcn_global_load_lds((const unsigned*)((const char*)(gbase) + _vo), (LAS unsigned*)(lds + (bufoff) + ldsw + _i * 8192), 16, 0, 0); } } while (0)
#define PG8_LDA(dst, b, h) do { _Pragma("unroll") for (int m = 0; m < 4; ++m) _Pragma("unroll") for (int k = 0; k < 2; ++k) dst[m][k] = *(const LAS bf16x8*)(lds + PG8_SA(b, h) + aoff + m * 2048 + k * KOFF); } while (0)
#define PG8_LDB(dst, b, h) do { _Pragma("unroll") for (int n = 0; n < 2; ++n) _Pragma("unroll") for (int k = 0; k < 2; ++k) dst[n][k] = *(const LAS bf16x8*)(lds + PG8_SB(b, h) + boff + n * 2048 + k * KOFF); } while (0)
#define PG8_MMA(ai, bj, At, Bt) do { __builtin_amdgcn_s_setprio(1); _Pragma("unroll") for (int m = 0; m < 4; ++m) _Pragma("unroll") for (int n = 0; n < 2; ++n) { \
        if constexpr (P::FP8) acc[ai][bj][m][n] = __builtin_amdgcn_mfma_scale_f32_16x16x128_f8f6f4(pg8::cat8(Bt[n][0], Bt[n][1]), pg8::cat8(At[m][0], At[m][1]), acc[ai][bj][m][n], 0, 0, 0, 0, 0, 0); \
        else { _Pragma("unroll") for (int k = 0; k < 2; ++k) acc[ai][bj][m][n] = __builtin_amdgcn_mfma_f32_16x16x32_bf16(Bt[n][k], At[m][k], acc[ai][bj][m][n], 0, 0, 0); } } \
        __builtin_amdgcn_s_setprio(0); } while (0)
#define PG8_WAIT_V(n) asm volatile("s_waitcnt vmcnt(" #n ")" ::: "memory")
#define PG8_WAIT_L(n) asm volatile("s_waitcnt lgkmcnt(" #n ")" ::: "memory")
#define PG8_BAR __builtin_amdgcn_s_barrier()
#define PG8_SCHED __builtin_amdgcn_sched_barrier(0)
    Unit cur, nxt; int ui = 0;
    if (!S.next(0, cur)) return;
    f32x4 acc[2][2][4][2];
#pragma unroll
    for (int a = 0; a < 2; ++a)
#pragma unroll
        for (int b = 0; b < 2; ++b)
#pragma unroll
            for (int m = 0; m < 4; ++m)
#pragma unroll
                for (int n = 0; n < 2; ++n) acc[a][b][m][n] = (f32x4){0.f, 0.f, 0.f, 0.f};
    bf16x8 At[4][2], B0[2][2], B1[2][2];
    const char* cA = cur.A; const char* cB = cur.B;
    if constexpr (P::GATHER) {
        if (wid < 4) dma4(S.id_src(cur, wid * 64 + lane), idtab + wid * 64);
        PG8_WAIT_V(0); PG8_BAR; asm volatile("" ::: "memory");
#pragma unroll
        for (int h = 0; h < 2; ++h)
#pragma unroll
            for (int i = 0; i < 2; ++i) voffA[h][i] = idtab[HALF * h + Rr[i]] * S.pitchA + (unsigned)Cc[i] * 2u;
        PG8_WAIT_L(0); asm volatile("" ::: "memory");
    }
    PG8_STAGE(PG8_SB(0, 0), cB, voffB); PG8_STAGE(PG8_SB(0, 1), cB + hstepB, voffB); PG8_STAGE(PG8_SA(0, 0), cA, voffA[0]); PG8_STAGE(PG8_SA(0, 1), cA, voffA[1]);
    if (wr == 1) PG8_BAR;
    PG8_WAIT_V(2); PG8_BAR;
    PG8_STAGE(PG8_SB(1, 0), cB + kstep, voffB); PG8_STAGE(PG8_SA(1, 0), cA + kstep, voffA[0]); PG8_STAGE(PG8_SB(1, 1), cB + hstepB + kstep, voffB);
    PG8_WAIT_V(6); PG8_BAR;
    for (;;) {
        const bool has_next = S.next(ui + 1, nxt);
        const int slot = ui & 1;
        S.dma_tables(cur, tab, slot, wid, lane);
        if constexpr (P::GATHER) { if (has_next && wid < 4) dma4(S.id_src(nxt, wid * 64 + lane), idtab + (slot ^ 1) * 256 + wid * 64); }
        const char* nA = has_next ? nxt.A : cA; const char* nB = has_next ? nxt.B : cB;
        for (int t = 0; t < nt; t += 2) {
            const bool last = (t == nt - 2);
            const char* a1 = cA + (size_t)(t + 1) * kstep;
            const char* a2 = last ? nA : cA + (size_t)(t + 2) * kstep; const char* b2 = last ? nB : cB + (size_t)(t + 2) * kstep;
            const char* a3 = a2 + kstep; const char* b3 = b2 + kstep;
            PG8_LDB(B0, 0, 0); PG8_LDB(B1, 0, 1); PG8_SCHED; PG8_LDA(At, 0, 0); PG8_STAGE(PG8_SA(1, 1), a1, voffA[1]);
            if constexpr (!P::GATHER && P::FP8) { if (last && has_next) asm volatile("s_nop 0"); }
            if constexpr (P::GATHER) {
                if (last && has_next) {
                    int t2 = tid; asm volatile("" : "+v"(t2));
#pragma unroll
                    for (int i = 0; i < 2; ++i) { int R2, C2; stage_rc(t2 * 16 + i * 8192, R2, C2);
#pragma unroll
                        for (int h = 0; h < 2; ++h) voffA[h][i] = idtab[(slot ^ 1) * 256 + HALF * h + R2] * S.pitchA + (unsigned)C2 * 2u; }
                }
            }
            PG8_WAIT_V(8); PG8_WAIT_L(0); PG8_BAR; PG8_MMA(0, 0, At, B0); PG8_MMA(0, 1, At, B1); PG8_BAR; PG8_SCHED;
            PG8_LDA(At, 0, 1); PG8_STAGE(PG8_SB(0, 0), b2, voffB); PG8_STAGE(PG8_SB(0, 1), b2 + hstepB, voffB); PG8_STAGE(PG8_SA(0, 0), a2, voffA[0]);
            PG8_WAIT_V(8); PG8_WAIT_L(0); PG8_BAR; PG8_MMA(1, 0, At, B0); PG8_MMA(1, 1, At, B1); PG8_BAR; PG8_SCHED;
            PG8_LDB(B0, 1, 0); PG8_LDB(B1, 1, 1); PG8_SCHED; PG8_LDA(At, 1, 0); PG8_STAGE(PG8_SA(0, 1), a2, voffA[1]);
            PG8_WAIT_V(8); PG8_WAIT_L(0); PG8_BAR; PG8_MMA(0, 0, At, B0); PG8_MMA(0, 1, At, B1); PG8_BAR; PG8_SCHED;
            PG8_LDA(At, 1, 1); PG8_STAGE(PG8_SB(1, 0), b3, voffB); PG8_STAGE(PG8_SB(1, 1), b3 + hstepB, voffB); PG8_STAGE(PG8_SA(1, 0), a3, voffA[0]);
            PG8_WAIT_V(8); PG8_WAIT_L(0); PG8_BAR; PG8_MMA(1, 0, At, B0); PG8_MMA(1, 1, At, B1); PG8_BAR; PG8_SCHED;
        }
        if constexpr (P::ALIGN) { if (wr == 0) PG8_BAR; }
        S.epi(acc, cur, tab, slot, wr, wc, fr, fq);
        if (!has_next) break;
#pragma unroll
        for (int a = 0; a < 2; ++a)
#pragma unroll
            for (int b = 0; b < 2; ++b)
#pragma unroll
                for (int m = 0; m < 4; ++m)
#pragma unroll
                    for (int n = 0; n < 2; ++n) acc[a][b][m][n] = (f32x4){0.f, 0.f, 0.f, 0.f};
        cur = nxt; cA = nA; cB = nB; ++ui;
        if constexpr (P::ALIGN) { if (wr == 1) PG8_BAR; }
    }
    PG8_WAIT_V(0);
    if constexpr (!P::ALIGN) { if (wr == 0) PG8_BAR; }
    PG8_BAR;
#undef PG8_SA
#undef PG8_SB
#undef PG8_STAGE
#undef PG8_LDA
#undef PG8_LDB
#undef PG8_MMA
#undef PG8_WAIT_V
#undef PG8_WAIT_L
#undef PG8_BAR
#undef PG8_SCHED
}
}
#ifndef ALIGN_LIGHT
#define ALIGN_LIGHT true
#endif
using pg8::Unit;
typedef f32x4 Acc[2][2][4][2];

struct Args { const float* in[45]; float* out; unsigned char* ws; int ph_lo, ph_hi, dummy, pad; };
enum { I_X = 0, I_META = 1, I_T5 = 2, I_L0 = 3, I_L1 = 13, I_L2 = 24, I_L3 = 34 };

struct Frame {
    LAS unsigned char* lds; LAS unsigned char* tab;
    int tid, lane, wave, G, bx;
    unsigned char* ws; float* out; bf16_t* hb; unsigned* ctl;
};
__device__ __forceinline__ u64* ssq_buf(const Frame& F, int i) { return (u64*)(F.ws + WS_CTL + CTL_SSQ + (size_t)i * SSQ_BYTES); }
__device__ __forceinline__ u64 ssq_fix(float s) { return (u64)(s * SSQ_SCALE); }
__device__ __forceinline__ float ssq_val(u64 v) { return (float)v * SSQ_INV; }

struct QkvPolicy {
    static constexpr bool GATHER = false, ALIGN = ALIGN_LIGHT, FP8 = false;
    int nt; unsigned pitchA, pitchB;
    int G, c, nN, QT;
    const char* hb; const char* W;
    const u64* ssq;
    bf16_t* Q; bf16_t* K; bf16_t* VT; int kpitch, nQ;
    const LAS float* gains;
    __device__ __forceinline__ bool next(int i, Unit& u) const {
        const long L = (long)i * G + c; if (L >= (long)NPANEL * nN) return false;
        int pm, pn; pg8::tile_of((int)L, NPANEL, nN, pm, pn);
        u.pm = pm; u.pn = pn; u.kind = pn < QT ? 0 : 1; u.aux = 0; u.aux2 = 0;
        const char* a = hb + (size_t)pm * 256 * 2048; const char* w = W + (size_t)pn * 256 * 2048;
        u.A = u.kind ? w : a; u.B = u.kind ? a : w; return true;
    }
    __device__ __forceinline__ void dma_tables(const Unit& u, LAS unsigned char* tab, int slot, int wid, int lane) const {
        pg8::dma4((const unsigned*)(ssq + u.pm * 256) + wid * 64 + lane, (LAS unsigned*)(tab + 2048) + slot * 512 + wid * 64);
    }
    __device__ __forceinline__ void epi(const Acc& acc, const Unit& u, LAS unsigned char* tab, int slot, int wr, int wc, int fr, int fq) const {
        const LAS u64* et = (const LAS u64*)(tab + 2048) + slot * 256;
        if (u.kind == 0) {
            const bool isq = u.pn < nQ;
            const LAS float* gp = gains + (isq ? 0 : 64) + 8 * fq;
            const f32x4 g00 = *(const LAS f32x4*)(gp), g01 = *(const LAS f32x4*)(gp + 4), g10 = *(const LAS f32x4*)(gp + 32), g11 = *(const LAS f32x4*)(gp + 36);
            const int hk = (u.pn - nQ) * 4 + wc, nhk = kpitch >> 6;
#pragma unroll
            for (int ai = 0; ai < 2; ++ai)
#pragma unroll
                for (int m = 0; m < 4; ++m) {
                    const int row = ai * 128 + wr * 64 + m * 16 + fr;
                    const float rstd = fast_rsqrt(ssq_val(et[row]) * (1.0f / 1024.0f) + EPS);
                    f32x4 v00 = acc[ai][0][m][0] * rstd, v01 = acc[ai][0][m][1] * rstd, v10 = acc[ai][1][m][0] * rstd, v11 = acc[ai][1][m][1] * rstd;
                    const f32x4 sq4 = v00 * v00 + v01 * v01 + v10 * v10 + v11 * v11;
                    float ss = (sq4[0] + sq4[1]) + (sq4[2] + sq4[3]);
                    ss += __shfl_xor(ss, 16); ss += __shfl_xor(ss, 32);
                    const float hn = fast_rsqrt(ss * (1.0f / 64.0f) + EPS);
                    v00 = v00 * g00 * hn; v01 = v01 * g01 * hn; v10 = v10 * g10 * hn; v11 = v11 * g11 * hn;
                    const int tok = u.pm * 256 + row;
                    bf16_t* rp = isq ? Q + (size_t)tok * 1024 + (u.pn * 4 + wc) * 64 + 8 * fq
                                     : K + ((((size_t)(tok >> 3) * nhk + hk) * 2) * 4 + fq) * 64 + (tok & 7) * 8;
                    const int o1 = isq ? 32 : 256;
                    u32x4 w0; w0.x = cvt_pk_bf16(v00[0], v00[1]); w0.y = cvt_pk_bf16(v00[2], v00[3]); w0.z = cvt_pk_bf16(v01[0], v01[1]); w0.w = cvt_pk_bf16(v01[2], v01[3]);
                    u32x4 w1; w1.x = cvt_pk_bf16(v10[0], v10[1]); w1.y = cvt_pk_bf16(v10[2], v10[3]); w1.z = cvt_pk_bf16(v11[0], v11[1]); w1.w = cvt_pk_bf16(v11[2], v11[3]);
                    *(u32x4*)(rp) = w0; *(u32x4*)(rp + o1) = w1;
                }
        } else {
            f32x4 rs[2][2];
#pragma unroll
            for (int bj = 0; bj < 2; ++bj)
#pragma unroll
                for (int n = 0; n < 2; ++n) {
#pragma unroll
                    for (int j = 0; j < 4; ++j) rs[bj][n][j] = fast_rsqrt(ssq_val(et[bj * 128 + wc * 32 + n * 16 + 4 * fq + j]) * (1.0f / 1024.0f) + EPS); }
#pragma unroll
            for (int ai = 0; ai < 2; ++ai)
#pragma unroll
                for (int m = 0; m < 4; ++m) {
                    const int hd = (u.pn - QT) * 256 + ai * 128 + wr * 64 + m * 16 + fr, hk = hd >> 6, d = hd & 63, nhk = kpitch >> 6;
#pragma unroll
                    for (int bj = 0; bj < 2; ++bj)
#pragma unroll
                        for (int n = 0; n < 2; ++n) { const f32x4 v = acc[ai][bj][m][n] * rs[bj][n]; u32x2 w; w.x = cvt_pk_bf16(v[0], v[1]); w.y = cvt_pk_bf16(v[2], v[3]);
                            const int c0 = u.pm * 256 + bj * 128 + wc * 32 + n * 16 + 4 * fq;
                            *(u32x2*)(VT + ((size_t)(c0 >> 3) * nhk + hk) * 512 + (((d >> 4) * 2 + ((c0 >> 2) & 1)) * 16 + (d & 15)) * 4) = w; }
                }
        }
    }
};

template <bool F8 = false>
struct ResPolicy {
    static constexpr bool GATHER = false, ALIGN = true, FP8 = F8;
    int nt; unsigned pitchA, pitchB;
    int G, c;
    const char* A; const char* W;
    bf16_t* hb; u64* ssq_out; bf16_t* dmy;
    unsigned char* hb8;
    __device__ __forceinline__ bool next(int i, Unit& u) const {
        const long L = (long)i * G + c; if (L >= (long)NPANEL * 4) return false;
        int pm, pn; pg8::tile_of((int)L, NPANEL, 4, pm, pn);
        u.pm = pm; u.pn = pn; u.kind = 0; u.aux = 0; u.aux2 = 0;
        u.A = A + (size_t)pm * 256 * pitchA; u.B = W + (size_t)pn * 256 * pitchB; return true;
    }
    __device__ __forceinline__ void dma_tables(const Unit&, LAS unsigned char*, int, int, int) const {}
    __device__ __forceinline__ void epi(const Acc& acc, const Unit& u, LAS unsigned char*, int, int wr, int wc, int fr, int fq) const {
        const int col = u.pn * 256 + wc * 32 + 8 * fq;
#pragma unroll
        for (int ai = 0; ai < 2; ++ai) {
            u32x4 bv[4][2];
#pragma unroll
            for (int m = 0; m < 4; ++m) { const bf16_t* bp = hb + (size_t)(u.pm * 256 + ai * 128 + wr * 64 + m * 16 + fr) * D + col;
#pragma unroll
                for (int bj = 0; bj < 2; ++bj) bv[m][bj] = *(const u32x4*)(bp + bj * 128); }
            __builtin_amdgcn_sched_barrier(0);
#pragma unroll
            for (int m = 0; m < 4; ++m) {
                const int row = u.pm * 256 + ai * 128 + wr * 64 + m * 16 + fr;
                bf16_t* hp = (dmy ? dmy + (size_t)(row & 0xFFF) * D : hb + (size_t)row * D) + col;
                f32x2 ss2 = {0.f, 0.f};
#pragma unroll
                for (int bj = 0; bj < 2; ++bj) {
                    const u32x4 b = bv[m][bj]; const f32x4 a0 = acc[ai][bj][m][0], a1 = acc[ai][bj][m][1];
                    const unsigned bw[4] = {b.x, b.y, b.z, b.w}; const f32x2 av[4] = {{a0[0], a0[1]}, {a0[2], a0[3]}, {a1[0], a1[1]}, {a1[2], a1[3]}};
                    f32x2 o[4]; u32x4 w; unsigned* wp = (unsigned*)&w;
#pragma unroll
                    for (int i = 0; i < 4; ++i) { const f32x2 hv = {__uint_as_float(bw[i] << 16), __uint_as_float(bw[i] & 0xffff0000u)}; if constexpr (F8) o[i] = hv + av[i] * (W8_INV * HID8_INV); else o[i] = hv + av[i]; ss2 = ss2 + o[i] * o[i]; wp[i] = cvt_pk_bf16(o[i].x, o[i].y); }
                    *(u32x4*)(hp + bj * 128) = w;
                    if (hb8) { int p0 = 0, p1 = 0; p0 = __builtin_amdgcn_cvt_pk_fp8_f32(o[0].x, o[0].y, p0, false); p0 = __builtin_amdgcn_cvt_pk_fp8_f32(o[1].x, o[1].y, p0, true); p1 = __builtin_amdgcn_cvt_pk_fp8_f32(o[2].x, o[2].y, p1, false); p1 = __builtin_amdgcn_cvt_pk_fp8_f32(o[3].x, o[3].y, p1, true);
                        u32x2 w8; w8.x = (unsigned)p0; w8.y = (unsigned)p1; *(u32x2*)(hb8 + (size_t)row * D + col + bj * 128) = w8; }
                }
                float ss = ss2.x + ss2.y;
                ss += __shfl_xor(ss, 16); ss += __shfl_xor(ss, 32);
                if (fq == 0) __hip_atomic_fetch_add(ssq_out + row, ssq_fix(ss), RLX_AGENT);
            }
            __builtin_amdgcn_sched_barrier(0);
        }
    }
};

template <bool MOE, bool F8 = MOE>
struct GuPolicy {
    static constexpr bool GATHER = MOE, ALIGN = ALIGN_LIGHT, FP8 = F8;
    int nt; unsigned pitchA, pitchB;
    int G, c;
    const char* hb; const char* W;
    const void* ssq;
    bf16_t* hid;
    const unsigned* rowtok; int p0, p1;
    const LAS int* ptab;
    __device__ __forceinline__ bool next(int i, Unit& u) const {
        const long L = (long)i * G + c;
        if constexpr (!MOE) {
            if (L >= (long)NPANEL * 28) return false;
            int pm, pn; pg8::tile_of((int)L, NPANEL, 28, pm, pn);
            u.pm = pm; u.pn = pn; u.kind = 0; u.aux = 0; u.aux2 = 0;
            u.A = hb + (size_t)pm * 256 * pitchA; u.B = W + (size_t)pn * 256 * pitchB; return true;
        } else {
            const int nM = p1 - p0; if (L >= (long)nM * 28) return false;
            int pm, pn; pg8::tile_of((int)L, nM, 28, pm, pn);
            const int p = p0 + pm; const int lane_ = (int)(threadIdx.x & 31u); const int tv = ptab[lane_];
            const int e = __popcll(__ballot(lane_ >= 1 && lane_ <= 7 && p >= tv) & 0xFFFFFFFFull);
            const int pbe = __builtin_amdgcn_readlane(tv, e), ce = __builtin_amdgcn_readlane(tv, 9 + e);
            u.pm = pm; u.pn = pn; u.kind = e; u.aux = (p - pbe) * 256; u.aux2 = ce;
            u.A = hb; u.B = W + (size_t)e * W_GU8 + (size_t)pn * 256 * 1024; return true;
        }
    }
    __device__ __forceinline__ const unsigned* id_src(const Unit& u, int i) const { int r = u.aux + i; r = r < u.aux2 ? r : u.aux2 - 1; return rowtok + (size_t)u.kind * M + r; }
    __device__ __forceinline__ void dma_tables(const Unit& u, LAS unsigned char* tab, int slot, int wid, int lane) const {
        if constexpr (!MOE) pg8::dma4((const unsigned*)((const u64*)ssq + u.pm * 256) + wid * 64 + lane, (LAS unsigned*)(tab + 2048) + slot * 512 + wid * 64);
        else if (wid >= 4) { int r = u.aux + (wid - 4) * 64 + lane; r = r < u.aux2 ? r : u.aux2 - 1; pg8::dma4((const float*)ssq + (size_t)u.kind * M + r, (LAS float*)(tab + 2048) + slot * 256 + (wid - 4) * 64); }
    }
    __device__ __forceinline__ void epi(const Acc& acc, const Unit& u, LAS unsigned char* tab, int slot, int wr, int wc, int fr, int fq) const {
#pragma unroll
        for (int ai = 0; ai < 2; ++ai)
#pragma unroll
            for (int m = 0; m < 4; ++m) {
                const int row = ai * 128 + wr * 64 + m * 16 + fr;
                float sq;
                if constexpr (MOE) sq = ((const LAS float*)(tab + 2048) + slot * 256)[row]; else sq = ssq_val(((const LAS u64*)(tab + 2048) + slot * 256)[row]);
                const float rstd = fast_rsqrt(sq * (1.0f / 1024.0f) + EPS);
                const float rs_ = F8 ? rstd * W8_INV : rstd;
                const float c1 = -rs_ * LOG2E;
                const float kk = (sq * (1.0f / 1024.0f) + EPS) * (F8 ? W8_SCALE * W8_SCALE * HID8_INV : 1.0f);
                float o[8];
#pragma unroll
                for (int n = 0; n < 2; ++n)
#pragma unroll
                    for (int j = 0; j < 4; j += 2) {
                        const f32x2 g = {acc[ai][0][m][n][j], acc[ai][0][m][n][j + 1]}, up = {acc[ai][1][m][n][j], acc[ai][1][m][n][j + 1]};
                        const f32x2 t = g * c1; f32x2 e; e.x = fast_exp2(t.x); e.y = fast_exp2(t.y);
                        const f32x2 kk2 = {kk, kk}; const f32x2 d = e * kk2 + kk2; f32x2 r; r.x = fast_rcp(d.x); r.y = fast_rcp(d.y);
                        const f32x2 v = (g * up) * r;
                        o[n * 4 + j] = v.x; o[n * 4 + j + 1] = v.y; }
                if constexpr (F8) {
                    int q0 = 0, q1 = 0; q0 = __builtin_amdgcn_cvt_pk_fp8_f32(o[0], o[1], q0, false); q0 = __builtin_amdgcn_cvt_pk_fp8_f32(o[2], o[3], q0, true); q1 = __builtin_amdgcn_cvt_pk_fp8_f32(o[4], o[5], q1, false); q1 = __builtin_amdgcn_cvt_pk_fp8_f32(o[6], o[7], q1, true);
                    u32x2 w8; w8.x = (unsigned)q0; w8.y = (unsigned)q1;
                    *(u32x2*)((unsigned char*)hid + (size_t)(u.pm * 256 + row) * FF + u.pn * 128 + wc * 32 + 8 * fq) = w8;
                } else {
                u32x4 w; w.x = cvt_pk_bf16(o[0], o[1]); w.y = cvt_pk_bf16(o[2], o[3]); w.z = cvt_pk_bf16(o[4], o[5]); w.w = cvt_pk_bf16(o[6], o[7]);
                *(u32x4*)(hid + (size_t)(u.pm * 256 + row) * FF + u.pn * 128 + wc * 32 + 8 * fq) = w; }
            }
    }
};

struct MoeDownPolicy {
    static constexpr bool GATHER = false, ALIGN = ALIGN_LIGHT, FP8 = true;
    int nt; unsigned pitchA, pitchB;
    int G, c;
    const char* hid; const char* W;
    const unsigned* rowslot; const float* rowgate; bf16_t* ys;
    int p0, p1; const LAS int* ptab;
    __device__ __forceinline__ bool next(int i, Unit& u) const {
        const long L = (long)i * G + c; const int nM = p1 - p0; if (L >= (long)nM * 4) return false;
        int pm, pn; pg8::tile_of((int)L, nM, 4, pm, pn);
        const int p = p0 + pm; const int lane_ = (int)(threadIdx.x & 31u); const int tv = ptab[lane_];
        const int e = __popcll(__ballot(lane_ >= 1 && lane_ <= 7 && p >= tv) & 0xFFFFFFFFull);
        const int pbe = __builtin_amdgcn_readlane(tv, e), ce = __builtin_amdgcn_readlane(tv, 9 + e);
        u.pm = pm; u.pn = pn; u.kind = e; u.aux = (p - pbe) * 256; u.aux2 = ce;
        u.A = hid + (size_t)pm * 256 * pitchA; u.B = W + (size_t)e * W_D8 + (size_t)pn * 256 * pitchB; return true;
    }
    __device__ __forceinline__ void dma_tables(const Unit& u, LAS unsigned char* tab, int slot, int wid, int lane) const {
        int r = u.aux + (wid & 3) * 64 + lane; r = r < u.aux2 ? r : u.aux2 - 1;
        if (wid < 4) pg8::dma4(rowslot + (size_t)u.kind * M + r, (LAS unsigned*)(tab + 6144) + slot * 256 + wid * 64);
        else pg8::dma4(rowgate + (size_t)u.kind * M + r, (LAS float*)(tab + 8192) + slot * 256 + (wid - 4) * 64);
    }
    __device__ __forceinline__ void epi(const Acc& acc, const Unit& u, LAS unsigned char* tab, int slot, int wr, int wc, int fr, int fq) const {
        const LAS unsigned* es = (const LAS unsigned*)(tab + 6144) + slot * 256;
        const LAS float* eg = (const LAS float*)(tab + 8192) + slot * 256;
#pragma unroll
        for (int ai = 0; ai < 2; ++ai)
#pragma unroll
            for (int m = 0; m < 4; ++m) {
                const int row = ai * 128 + wr * 64 + m * 16 + fr;
                if (u.aux + row < u.aux2) {
                    const unsigned sl = es[row]; const float g = eg[row] * (W8_INV * HID8_INV * YS8_SCALE);
                    unsigned char* rp = (unsigned char*)ys + (size_t)sl * D + u.pn * 256 + wc * 32 + 8 * fq;
#pragma unroll
                    for (int bj = 0; bj < 2; ++bj) { const f32x4 v0 = acc[ai][bj][m][0] * g, v1 = acc[ai][bj][m][1] * g;
                        int q0 = 0, q1 = 0; q0 = __builtin_amdgcn_cvt_pk_fp8_f32(v0[0], v0[1], q0, false); q0 = __builtin_amdgcn_cvt_pk_fp8_f32(v0[2], v0[3], q0, true); q1 = __builtin_amdgcn_cvt_pk_fp8_f32(v1[0], v1[1], q1, false); q1 = __builtin_amdgcn_cvt_pk_fp8_f32(v1[2], v1[3], q1, true);
                        u32x2 w; w.x = (unsigned)q0; w.y = (unsigned)q1; *(u32x2*)(rp + bj * 128) = w; }
                }
            }
    }
};

struct WDesc { const float* src; const float* gain; bf16_t* dst; int K, N, map, ibase; };
__device__ __forceinline__ int qk_perm(int s) { return 128 * ((s >> 5) & 1) + 32 * (s >> 6) + 16 * ((s >> 2) & 1) + 4 * ((s >> 3) & 3) + (s & 3); }
__device__ __forceinline__ int dst_row(int map, int c) {
    if (map == 1) return c < 2048 ? (c & ~255) + qk_perm(c & 255) : c;
    if (map == 2) return c < 1280 ? (c & ~255) + qk_perm(c & 255) : c;
    if (map == 3 || map == 4) { const int t = c >> 7, w = c & 127; return 256 * t + (map == 4 ? 128 : 0) + 32 * (w >> 5) + 16 * ((w >> 2) & 1) + 4 * ((w >> 3) & 3) + (w & 3); }
    if (map == 5) return (c & ~31) + 16 * ((c >> 2) & 1) + 4 * ((c >> 3) & 3) + (c & 3);
    return c;
}
__device__ __forceinline__ void transpose_item(const GAS float* src, const GAS float* gain, GAS bf16_t* dst, int K, int N, int map, LAS float* scr, int item, int lane) {
    const int nblk = N / 64, kb = item / nblk, nb = item % nblk, k0 = 64 * kb, n0 = 64 * nb;
    const int c = lane & 15, r = lane >> 4;
    f32x4 v[16];
#pragma unroll
    for (int i = 0; i < 16; ++i) v[i] = *(const GAS f32x4*)(src + (size_t)(k0 + 4 * i + r) * N + n0 + 4 * c);
#pragma unroll
    for (int i = 0; i < 16; ++i) { const int kk = 4 * i + r; const float g = gain ? gain[k0 + kk] : 1.0f; LAS float* p = scr + kk * 65 + 4 * c; p[0] = v[i].x * g; p[1] = v[i].y * g; p[2] = v[i].z * g; p[3] = v[i].w * g; }
    asm volatile("s_waitcnt lgkmcnt(0)" ::: "memory");
    const int c8 = lane & 7;
#pragma unroll
    for (int j = 0; j < 8; ++j) { const int n = (lane >> 3) + 8 * j; const LAS float* p = scr + (8 * c8) * 65 + n;
        if (map >= 16) { int q0 = 0, q1 = 0;
            q0 = __builtin_amdgcn_cvt_pk_fp8_f32(p[0 * 65] * W8_SCALE, p[1 * 65] * W8_SCALE, q0, false); q0 = __builtin_amdgcn_cvt_pk_fp8_f32(p[2 * 65] * W8_SCALE, p[3 * 65] * W8_SCALE, q0, true);
            q1 = __builtin_amdgcn_cvt_pk_fp8_f32(p[4 * 65] * W8_SCALE, p[5 * 65] * W8_SCALE, q1, false); q1 = __builtin_amdgcn_cvt_pk_fp8_f32(p[6 * 65] * W8_SCALE, p[7 * 65] * W8_SCALE, q1, true);
            u32x2 o8; o8.x = (unsigned)q0; o8.y = (unsigned)q1; *(GAS u32x2*)((GAS unsigned char*)dst + (size_t)dst_row(map - 16, n0 + n) * K + k0 + 8 * c8) = o8; }
        else {
        u32x4 o; o.x = cvt_pk_bf16(p[0 * 65], p[1 * 65]); o.y = cvt_pk_bf16(p[2 * 65], p[3 * 65]); o.z = cvt_pk_bf16(p[4 * 65], p[5 * 65]); o.w = cvt_pk_bf16(p[6 * 65], p[7 * 65]);
        *(GAS u32x4*)(dst + (size_t)dst_row(map, n0 + n) * K + k0 + 8 * c8) = o; } }
    asm volatile("s_waitcnt lgkmcnt(0)" ::: "memory");
}
constexpr int N_WDESC = 62;
__device__ __forceinline__ void prologue(Frame& F, const __attribute__((address_space(4))) Args* a) {
    LAS WDesc* wd = (LAS WDesc*)(F.lds + 8 * 16640);
    LAS int* wtot = (LAS int*)(F.lds + 8 * 16640 + N_WDESC * sizeof(WDesc));
    static_assert(8 * 16640 + N_WDESC * sizeof(WDesc) + 16 <= (size_t)GAIN_OFF, "prologue LDS");
    if (F.tid == 0) {
        int n = 0, ib = 0;
#define ADDW(src_, gain_, dst_, K_, N_, map_) do { wd[n].src = (src_); wd[n].gain = (gain_); wd[n].dst = (bf16_t*)(dst_); wd[n].K = (K_); wd[n].N = (N_); wd[n].map = (map_); wd[n].ibase = ib; ++n; ib += ((K_) / 64) * ((N_) / 64); } while (0)
        for (int p = 0; p < 2; ++p) {
            const int na0 = p ? I_L2 : I_L0, sw0 = p ? I_L3 : I_L1;
#define NA_(i) (a->in[na0 + (i)])
#define SW_(i) (a->in[sw0 + (i)])
            unsigned char* wb = F.ws + WS_W + (size_t)p * WPAIR;
            ADDW(NA_(1), NA_(0), wb + WNA_QKV, 1024, 3072, 1);
            ADDW(NA_(5), (const float*)nullptr, wb + WNA_O, 1024, 1024, 5);
            ADDW(NA_(7), NA_(6), wb + WNA_GU, 1024, FF, (p >= DENSE8_FROM ? 16 : 0) + 3);
            ADDW(NA_(8), NA_(6), wb + WNA_GU, 1024, FF, (p >= DENSE8_FROM ? 16 : 0) + 4);
            ADDW(NA_(9), (const float*)nullptr, wb + WNA_D, FF, 1024, (p >= DENSE8_FROM ? 16 : 0) + 5);
            ADDW(SW_(1), SW_(0), wb + WSW_QKV, 1024, 1536, 2);
            ADDW(SW_(5), (const float*)nullptr, wb + WSW_O, 1024, 1024, 5);
            for (int e = 0; e < NE; ++e) {
                ADDW(SW_(8) + (size_t)e * 1024 * FF, SW_(6), wb + WSW_GU + (size_t)e * W_GU8, 1024, FF, 16 + 3);
                ADDW(SW_(9) + (size_t)e * 1024 * FF, SW_(6), wb + WSW_GU + (size_t)e * W_GU8, 1024, FF, 16 + 4);
                ADDW(SW_(10) + (size_t)e * FF * 1024, (const float*)nullptr, wb + WSW_D + (size_t)e * W_D8, FF, 1024, 16 + 5);
            }
        }
#undef ADDW
        *wtot = ib;
    }
    __syncthreads();
    LAS float* scr = (LAS float*)(F.lds + F.wave * 16640);
    const int gw = F.bx * 8 + F.wave, NGW = F.G * 8;
    const int total = *wtot;
    for (int it = gw; it < total; it += NGW) {
        int k = 0;
        for (int j = 1; j < N_WDESC; ++j) k += (it >= wd[j].ibase) ? 1 : 0;
        transpose_item((const GAS float*)wd[k].src, (const GAS float*)wd[k].gain, (GAS bf16_t*)wd[k].dst, wd[k].K, wd[k].N, wd[k].map, scr, it - wd[k].ibase, F.lane);
    }
    u64* ssq0 = ssq_buf(F, 0);
    for (int m = gw; m < M; m += NGW) {
        const float* src = m < NREG ? a->in[I_X] + (size_t)m * D : a->in[I_META] + (size_t)(m - NREG) * D;
        const f32x4* xr = (const f32x4*)src + F.lane;
        f32x4 v[4]; float s = 0.f;
#pragma unroll
        for (int j = 0; j < 4; ++j) { v[j] = xr[64 * j]; s += (v[j].x * v[j].x + v[j].y * v[j].y) + (v[j].z * v[j].z + v[j].w * v[j].w); }
        s = wave_sum(s);
        u32x2* o8 = (u32x2*)(F.hb + (size_t)m * D) + F.lane;
#pragma unroll
        for (int j = 0; j < 4; ++j) { u32x2 w; w.x = cvt_pk_bf16(v[j].x, v[j].y); w.y = cvt_pk_bf16(v[j].z, v[j].w); o8[64 * j] = w; }
        if (F.lane == 0) ssq0[m] = ssq_fix(s);
    }
}

struct AttnCtx {
    const bf16_t* Q; const bf16_t* K; const bf16_t* VT; bf16_t* O; int kpitch; unsigned omask;
    const LAS float* tbl;
};
constexpr int NTILE = 18;
__device__ __forceinline__ int t5_bucket_abs(int n) {
    const int big = 8 + (n >= 12) + (n >= 16) + (n >= 23) + (n >= 32) + (n >= 46) + (n >= 64) + (n >= 91);
    return n < 8 ? n : big;
}
constexpr int NA_TBL_ROW = 64, NA_TBL_HEAD = 15 * 64, SWA_TBL_HEAD = 576, SWA_T5_OFF = 16 * 576, SWA_SINK_OFF = SWA_T5_OFF + 512;
template <int TYPE>
__device__ __forceinline__ void attn_unit(const AttnCtx& X, int b, int hq, int u0, int u1, bool metaq, int lane) {
    const int q = lane & 15, kg = lane >> 4;
    const int hk = TYPE == 0 ? hq : (hq >> 2);
    constexpr int NWIN = TYPE == 0 ? 16 : 17, TMETA = NWIN, NREAL = NWIN + 1;
    int qtok0, wtok0, bidx;
    int colbase = 0, relbase = 0, wsq = 0;
    if (TYPE == 0) {
        const int r = metaq ? 0 : u0, cb = metaq ? 0 : u1;
        int rs = r - 4; rs = rs < 0 ? 0 : (rs > 24 ? 24 : rs); int ks = 16 * cb - 8; ks = ks < 0 ? 0 : (ks > 32 ? 32 : ks);
        qtok0 = metaq ? NREG : b * SEQ + r * 64 + 16 * cb; wtok0 = b * SEQ + rs * 64 + ks;
        const int qc = 16 * cb + q; wsq = qc - 8; wsq = wsq < 0 ? 0 : (wsq > 48 ? 48 : wsq);
        colbase = ks + 4 * kg;
        bidx = hq * NA_TBL_HEAD + (rs - r + 7) * NA_TBL_ROW + (colbase - qc + 15 + 16);
    } else {
        const int q0 = metaq ? 0 : 16 * u0;
        int jb = q0 - 128; jb = jb < 0 ? 0 : (jb > SEQ - 272 ? SEQ - 272 : jb);
        qtok0 = metaq ? NREG : b * SEQ + q0; wtok0 = b * SEQ + jb;
        relbase = jb + 4 * kg - q0 - q;
        bidx = hq * SWA_TBL_HEAD + relbase + 288;
        colbase = q0 + q;
    }
    const int mtok0 = NREG;
    const int nhk = X.kpitch >> 6;
    constexpr int TSTEP = 2;
    const size_t blk = (size_t)nhk * 512;
    const bf16_t* kwin = X.K + (size_t)(wtok0 >> 3) * blk + ((((size_t)(q >> 3) * nhk + hk) * 2) * 4 + kg) * 64 + (q & 7) * 8;
    const bf16_t* kmet = X.K + (size_t)(mtok0 >> 3) * blk + ((((size_t)(q >> 3) * nhk + hk) * 2) * 4 + kg) * 64 + (q & 7) * 8;
    const bf16_t* vwin = X.VT + (size_t)(wtok0 >> 3) * blk + ((size_t)(kg >> 1) * nhk + hk) * 512 + ((kg & 1) * 16 + q) * 4;
    const bf16_t* vmet = X.VT + (size_t)(mtok0 >> 3) * blk + ((size_t)(kg >> 1) * nhk + hk) * 512 + ((kg & 1) * 16 + q) * 4;
#define ATT_TOFF(t) ((size_t)(TYPE == 0 ? (8 * ((t) >> 1) + 2 * ((t) & 1)) : TSTEP * (t)) * blk)
    bf16x8 Qf[2];
    { const bf16_t* qp = X.Q + (size_t)(qtok0 + q) * 1024 + hq * 64 + 8 * kg; Qf[0] = *(const bf16x8*)qp; Qf[1] = *(const bf16x8*)(qp + 32); }
    f32x4 S[NTILE];
    f32x4 O[4];
#define ATT_LOADK(buf, t0) do { _Pragma("unroll") for (int t = 0; t < 6; ++t) if ((t0) + t < NREAL) { const bf16_t* kp = ((t0) + t == TMETA) ? kmet : kwin + ATT_TOFF((t0) + t); buf[t][0] = *(const bf16x8*)kp; buf[t][1] = *(const bf16x8*)(kp + 256); } } while (0)
#define ATT_MMAK(buf, t0) do { _Pragma("unroll") for (int t = 0; t < 6; ++t) if ((t0) + t < NREAL) { \
        f32x4 s_ = __builtin_amdgcn_mfma_f32_16x16x32_bf16(buf[t][0], Qf[0], S[(t0) + t], 0, 0, 0); S[(t0) + t] = __builtin_amdgcn_mfma_f32_16x16x32_bf16(buf[t][1], Qf[1], s_, 0, 0, 0); } } while (0)
#define ATT_VPTR(t) (((t) == TMETA) ? vmet : vwin + ATT_TOFF(t))
#define ATT_LOADV(bl, bh, s0) do { _Pragma("unroll") for (int s = 0; s < 3; ++s) { \
        _Pragma("unroll") for (int dt = 0; dt < 4; ++dt) { \
            bl[s][dt] = *(const s16x4*)(ATT_VPTR(2 * ((s0) + s)) + dt * 128); \
            if (2 * ((s0) + s) + 1 < NREAL) bh[s][dt] = *(const s16x4*)(ATT_VPTR(2 * ((s0) + s) + 1) + dt * 128); else bh[s][dt] = (s16x4){0, 0, 0, 0}; } } } while (0)
#define ATT_PV(bl, bh, s0) do { _Pragma("unroll") for (int s = 0; s < 3; ++s) { \
        const f32x4 pa = S[2 * ((s0) + s)]; f32x4 pb = {0.f, 0.f, 0.f, 0.f}; if (2 * ((s0) + s) + 1 < NREAL) pb = S[2 * ((s0) + s) + 1]; \
        u32x4 pw; pw.x = cvt_pk_bf16(pa[0], pa[1]); pw.y = cvt_pk_bf16(pa[2], pa[3]); pw.z = cvt_pk_bf16(pb[0], pb[1]); pw.w = cvt_pk_bf16(pb[2], pb[3]); \
        const bf16x8 Pf = __builtin_bit_cast(bf16x8, pw); \
        _Pragma("unroll") for (int dt = 0; dt < 4; ++dt) { const bf16x8 Vf = __builtin_shufflevector(bl[s][dt], bh[s][dt], 0, 1, 2, 3, 4, 5, 6, 7); \
            O[dt] = __builtin_amdgcn_mfma_f32_16x16x32_bf16(Vf, Pf, O[dt], 0, 0, 0); } } } while (0)
    bf16x8 KA[6][2], KB[6][2];
    s16x4 VAl[3][4], VAh[3][4], VBl[3][4], VBh[3][4];
    ATT_LOADK(KA, 0); ATT_LOADK(KB, 6);
    {
        const LAS float* bt = X.tbl + bidx;
#pragma unroll
        for (int t = 0; t < NWIN; ++t)
#pragma unroll
            for (int j = 0; j < 4; ++j) S[t][j] = TYPE == 0 ? bt[(t >> 1) * NA_TBL_ROW + 16 * (t & 1) + j] : bt[16 * t + j];
#pragma unroll
        for (int j = 0; j < 4; ++j) {
            if (TYPE == 1) { const int mk = 4 * kg + j; int bucket;
                if (metaq) { const int rel = mk - q; bucket = (rel > 0 ? 16 : 0) + t5_bucket_abs(rel < 0 ? -rel : rel); } else bucket = t5_bucket_abs(16 + colbase - mk);
                S[TMETA][j] = X.tbl[SWA_T5_OFF + bucket * 16 + hq];
            } else S[TMETA][j] = -SM_SHIFT;
        }
        if (TYPE == 0) {
            bool okm[2][4];
#pragma unroll
            for (int hf = 0; hf < 2; ++hf)
#pragma unroll
                for (int j = 0; j < 4; ++j) okm[hf][j] = !metaq && (unsigned)(colbase + 16 * hf + j - wsq) < 16u;
#pragma unroll
            for (int t = 0; t < NWIN; ++t)
#pragma unroll
                for (int j = 0; j < 4; ++j) S[t][j] = okm[t & 1][j] ? S[t][j] : NEGBIG;
        } else {
#pragma unroll
            for (int t = 0; t < NWIN; ++t)
#pragma unroll
                for (int j = 0; j < 4; ++j) S[t][j] = (!metaq && (unsigned)(relbase + 16 * t + j + 128) <= 256u) ? S[t][j] : NEGBIG;
        }
    }
    ATT_MMAK(KA, 0);
    ATT_LOADK(KA, 12);
    ATT_MMAK(KB, 6);
    if (TYPE == 0) ATT_LOADV(VAl, VAh, 0);
    ATT_MMAK(KA, 12);
    if (TYPE == 1) ATT_LOADV(VAl, VAh, 0);
#pragma unroll
    for (int dt = 0; dt < 4; ++dt) O[dt] = (f32x4){0.f, 0.f, 0.f, 0.f};
    __builtin_amdgcn_sched_barrier(0);
    float sk = 0.f;
    if (TYPE == 1) sk = X.tbl[SWA_SINK_OFF + hq];
    ATT_LOADV(VBl, VBh, 3);
    float l = 0.f;
#pragma unroll
    for (int t = 0; t < NREAL; ++t) {
#pragma unroll
        for (int j = 0; j < 4; ++j) { const float p = fast_exp2(S[t][j]); S[t][j] = p; l += p; }
    }
    l += __shfl_xor(l, 16); l += __shfl_xor(l, 32);
    if (TYPE == 1) l += fast_exp2(sk);
    __builtin_amdgcn_sched_barrier(0);
    const float inv = 1.0f / l;
    ATT_PV(VAl, VAh, 0);
    ATT_LOADV(VAl, VAh, 6);
    ATT_PV(VBl, VBh, 3);
    ATT_PV(VAl, VAh, 6);
#undef ATT_LOADK
#undef ATT_MMAK
#undef ATT_LOADV
#undef ATT_PV
#undef ATT_VPTR
#undef ATT_TOFF
    bf16_t* op = X.O + (size_t)((unsigned)(qtok0 + q) & X.omask) * 1024 + hq * 64 + 4 * kg;
#pragma unroll
    for (int dt = 0; dt < 4; ++dt) { u32x2 w; w.x = cvt_pk_bf16(O[dt][0] * inv, O[dt][1] * inv); w.y = cvt_pk_bf16(O[dt][2] * inv, O[dt][3] * inv); *(u32x2*)(op + 16 * dt) = w; }
}

template <int TYPE>
__device__ __forceinline__ void metaq_unit(const AttnCtx& X, const LAS float* t5s, const LAS float* sinks, int b, int hq, int lane) {
    const int q = lane & 15, kg = lane >> 4, hk = TYPE == 0 ? hq : (hq >> 2), nhk = X.kpitch >> 6, mtok0 = NREG;
    const size_t blk = (size_t)nhk * 512;
    const bf16_t* qp = X.Q + (size_t)(mtok0 + q) * 1024 + hq * 64 + 8 * kg;
    const bf16_t* kp = X.K + (size_t)(mtok0 >> 3) * blk + ((((size_t)(q >> 3) * nhk + hk) * 2) * 4 + kg) * 64 + (q & 7) * 8;
    const bf16_t* vp = X.VT + (size_t)(mtok0 >> 3) * blk + ((size_t)(kg >> 1) * nhk + hk) * 512 + ((kg & 1) * 16 + q) * 4;
    const bf16x8 q0 = *(const bf16x8*)qp, q1 = *(const bf16x8*)(qp + 32), k0 = *(const bf16x8*)kp, k1 = *(const bf16x8*)(kp + 256);
    s16x4 vl[4];
#pragma unroll
    for (int dt = 0; dt < 4; ++dt) vl[dt] = *(const s16x4*)(vp + dt * 128);
    f32x4 S;
#pragma unroll
    for (int j = 0; j < 4; ++j) {
        if (TYPE == 1) { const int rel = 4 * kg + j - q; S[j] = t5s[((rel > 0 ? 16 : 0) + t5_bucket_abs(rel < 0 ? -rel : rel)) * 16 + hq]; } else S[j] = -SM_SHIFT;
    }
    S = __builtin_amdgcn_mfma_f32_16x16x32_bf16(k0, q0, S, 0, 0, 0); S = __builtin_amdgcn_mfma_f32_16x16x32_bf16(k1, q1, S, 0, 0, 0);
    float l = 0.f;
#pragma unroll
    for (int j = 0; j < 4; ++j) { S[j] = fast_exp2(S[j]); l += S[j]; }
    l += __shfl_xor(l, 16); l += __shfl_xor(l, 32);
    if (TYPE == 1) l += fast_exp2(sinks[hq]);
    const float inv = 1.0f / l;
    u32x4 pw; pw.x = cvt_pk_bf16(S[0], S[1]); pw.y = cvt_pk_bf16(S[2], S[3]); pw.z = 0u; pw.w = 0u;
    const bf16x8 Pf = __builtin_bit_cast(bf16x8, pw);
    bf16_t* op = X.O + (size_t)((unsigned)(mtok0 + q) & X.omask) * 1024 + hq * 64 + 4 * kg;
#pragma unroll
    for (int dt = 0; dt < 4; ++dt) {
        const bf16x8 Vf = __builtin_shufflevector(vl[dt], (s16x4){0, 0, 0, 0}, 0, 1, 2, 3, 4, 5, 6, 7);
        const f32x4 o = __builtin_amdgcn_mfma_f32_16x16x32_bf16(Vf, Pf, (f32x4){0.f, 0.f, 0.f, 0.f}, 0, 0, 0);
        u32x2 w; w.x = cvt_pk_bf16(o[0] * inv, o[1] * inv); w.y = cvt_pk_bf16(o[2] * inv, o[3] * inv); *(u32x2*)(op + 16 * dt) = w;
    }
}

template <int TYPE>
__device__ __forceinline__ void attn_phase(Frame& F, const AttnCtx& X) {
    int lane_l = F.lane; asm volatile("" : "+v"(lane_l));
    if (F.G == 256) {
        const int xcd = F.bx & 7, cu = F.bx >> 3, w = F.wave;
        if (TYPE == 0) {
            for (int it = 0; it < 32; ++it) { const int p = xcd * 64 + 2 * it + (w >> 2); attn_unit<0>(X, p >> 4, p & 15, cu, w & 3, false, lane_l); }
        } else {
            for (int it = 0; it < 32; ++it) { const int bn = xcd * 16 + (it >> 1), qb = 4 * cu + 2 * (it & 1) + (w >> 2); attn_unit<1>(X, bn >> 2, (bn & 3) * 4 + (w & 3), qb, 0, false, lane_l); }
        }
    } else {
        const int UPC = (NREG + F.G - 1) / F.G;
        const int ubeg = F.bx * UPC, uend = (ubeg + UPC) < NREG ? (ubeg + UPC) : NREG;
        for (int u = ubeg + F.wave; u < uend; u += 8) {
            if (TYPE == 0) { const int cb = u & 3, r = (u >> 2) & 31, h = (u >> 7) & 15, b = u >> 11; attn_unit<0>(X, b, h, r, cb, false, lane_l); }
            else { const int g = u & 3, qb = (u >> 2) & 127, n = (u >> 9) & 3, b = u >> 11; attn_unit<1>(X, b, n * 4 + g, qb, 0, false, lane_l); }
        }
    }
    for (int u = F.bx * 8 + F.wave; u < 16; u += F.G * 8) metaq_unit<TYPE>(X, X.tbl, X.tbl, 0, u, lane_l);
}

__device__ __forceinline__ void dma16(const void* g, LAS void* l) { __builtin_amdgcn_global_load_lds((const unsigned*)g, (LAS unsigned*)l, 16, 0, 0); }
constexpr int NA_RING_ROWS = 12, NA_TBL_OFF = NA_RING_ROWS * 8192;
__device__ __forceinline__ void na_ring_item(Frame& F, const AttnCtx& X, int pair) {
    int lane = F.lane; asm volatile("" : "+v"(lane));
    const int w = F.wave, q = lane & 15, kg = lane >> 4, cb = w & 3, rsel = w >> 2, b = pair >> 4, hq = pair & 15;
    LAS unsigned char* lds = F.lds;
    const LAS float* tbl = (const LAS float*)(lds + NA_TBL_OFF);
    constexpr int nhk = 16; const size_t blk = (size_t)nhk * 512;
    const bf16_t* vglob = X.VT + ((size_t)(b * 256) * nhk + hq) * 512 + lane * 8;
    const int mtok0 = NREG;
    const bf16_t* kmet = X.K + (size_t)(mtok0 >> 3) * blk + ((((size_t)(q >> 3) * nhk + hq) * 2) * 4 + kg) * 64 + (q & 7) * 8;
    const bf16_t* vmet = X.VT + (size_t)(mtok0 >> 3) * blk + ((size_t)(kg >> 1) * nhk + hq) * 512 + ((kg & 1) * 16 + q) * 4;
#pragma unroll
    for (int r = 0; r < 8; ++r) dma16(vglob + (size_t)(8 * r + w) * blk, lds + r * 8192 + w * 1024);
    int loaded_hi = 8;
    const int ks = (16 * cb - 8) < 0 ? 0 : ((16 * cb - 8) > 32 ? 32 : (16 * cb - 8));
    const int qc = 16 * cb + q; int wsq = qc - 8; wsq = wsq < 0 ? 0 : (wsq > 48 ? 48 : wsq);
    const int colbase = ks + 4 * kg;
    bool okm[2][4];
#pragma unroll
    for (int hf = 0; hf < 2; ++hf)
#pragma unroll
        for (int j = 0; j < 4; ++j) okm[hf][j] = (unsigned)(colbase + 16 * hf + j - wsq) < 16u;
    const int kfl = ((((q >> 3) * nhk + hq) * 2) * 4 + kg) * 64 + (q & 7) * 8;
    const int vfl = ((ks >> 3) + (kg >> 1)) * 1024 + ((kg & 1) * 16 + q) * 8;
    bf16x8 Qn[2];
    { const bf16_t* qp = X.Q + (size_t)(b * SEQ + rsel * 64 + 16 * cb + q) * 1024 + hq * 64 + 8 * kg; Qn[0] = *(const bf16x8*)qp; Qn[1] = *(const bf16x8*)(qp + 32); }
    __builtin_amdgcn_s_waitcnt(0x0F70); asm volatile("" ::: "memory"); __builtin_amdgcn_s_barrier(); asm volatile("" ::: "memory");
    for (int s = 0; s < 16; ++s) {
        const int r = 2 * s + rsel;
        bf16x8 Qf[2]; Qf[0] = Qn[0]; Qf[1] = Qn[1];
        if (s + 1 < 16) {
            int nh = 2 * s + 3 - 4; nh = nh < 0 ? 0 : (nh > 24 ? 24 : nh); nh += 8;
#pragma unroll
            for (int k = 0; k < 2; ++k) { const int rr = loaded_hi + k; if (rr < nh) { const int slot = rr >= 24 ? rr - 24 : (rr >= 12 ? rr - 12 : rr); dma16(vglob + (size_t)(8 * rr + w) * blk, lds + slot * 8192 + w * 1024); } }
            loaded_hi = nh > loaded_hi ? nh : loaded_hi;
            const bf16_t* qp = X.Q + (size_t)(b * SEQ + (r + 2) * 64 + 16 * cb + q) * 1024 + hq * 64 + 8 * kg; Qn[0] = *(const bf16x8*)qp; Qn[1] = *(const bf16x8*)(qp + 32);
        }
        int rs = r - 4; rs = rs < 0 ? 0 : (rs > 24 ? 24 : rs);
        const int wtok0 = b * SEQ + rs * 64 + ks;
        const bf16_t* kwin = X.K + (size_t)(wtok0 >> 3) * blk + kfl;
        const LAS float* bt = tbl + hq * NA_TBL_HEAD + (rs - r + 7) * NA_TBL_ROW + (colbase - qc + 15 + 16);
        f32x4 S[17];
        bf16x8 KA[6][2], KB[6][2];
#define NR_LOADK(buf, t0) do { _Pragma("unroll") for (int t = 0; t < 6; ++t) if ((t0) + t < 17) { const bf16_t* kp = ((t0) + t == 16) ? kmet : kwin + (size_t)(8 * (((t0) + t) >> 1) + 2 * (((t0) + t) & 1)) * blk; buf[t][0] = *(const bf16x8*)kp; buf[t][1] = *(const bf16x8*)(kp + 256); } } while (0)
#define NR_MMAK(buf, t0) do { _Pragma("unroll") for (int t = 0; t < 6; ++t) if ((t0) + t < 17) { \
        f32x4 s_ = __builtin_amdgcn_mfma_f32_16x16x32_bf16(buf[t][0], Qf[0], S[(t0) + t], 0, 0, 0); S[(t0) + t] = __builtin_amdgcn_mfma_f32_16x16x32_bf16(buf[t][1], Qf[1], s_, 0, 0, 0); } } while (0)
        NR_LOADK(KA, 0); NR_LOADK(KB, 6);
        s16x4 vm[4];
#pragma unroll
        for (int dt = 0; dt < 4; ++dt) vm[dt] = *(const s16x4*)(vmet + dt * 128);
#pragma unroll
        for (int t = 0; t < 16; ++t)
#pragma unroll
            for (int j = 0; j < 4; ++j) S[t][j] = bt[(t >> 1) * NA_TBL_ROW + 16 * (t & 1) + j];
#pragma unroll
        for (int t = 0; t < 16; ++t)
#pragma unroll
            for (int j = 0; j < 4; ++j) S[t][j] = okm[t & 1][j] ? S[t][j] : NEGBIG;
        S[16] = (f32x4){-SM_SHIFT, -SM_SHIFT, -SM_SHIFT, -SM_SHIFT};
        NR_MMAK(KA, 0);
        NR_LOADK(KA, 12);
        NR_MMAK(KB, 6);
        NR_MMAK(KA, 12);
#undef NR_LOADK
#undef NR_MMAK
        __builtin_amdgcn_sched_barrier(0);
        float l = 0.f;
#pragma unroll
        for (int t = 0; t < 17; ++t)
#pragma unroll
            for (int j = 0; j < 4; ++j) { const float p = fast_exp2(S[t][j]); S[t][j] = p; l += p; }
        l += __shfl_xor(l, 16); l += __shfl_xor(l, 32);
        const float inv = 1.0f / l;
        __builtin_amdgcn_sched_barrier(0);
        f32x4 O[4];
#pragma unroll
        for (int dt = 0; dt < 4; ++dt) O[dt] = (f32x4){0.f, 0.f, 0.f, 0.f};
#pragma unroll
        for (int st = 0; st < 9; ++st) {
            const f32x4 pa = S[2 * st]; f32x4 pb = {0.f, 0.f, 0.f, 0.f}; if (st < 8) pb = S[2 * st + 1];
            u32x4 pw; pw.x = cvt_pk_bf16(pa[0], pa[1]); pw.y = cvt_pk_bf16(pa[2], pa[3]); pw.z = cvt_pk_bf16(pb[0], pb[1]); pw.w = cvt_pk_bf16(pb[2], pb[3]);
            const bf16x8 Pf = __builtin_bit_cast(bf16x8, pw);
            int rr = rs + st; const int slot = rr >= 24 ? rr - 24 : (rr >= 12 ? rr - 12 : rr);
            const LAS unsigned char* vp = lds + slot * 8192 + vfl;
#pragma unroll
            for (int dt = 0; dt < 4; ++dt) {
                s16x4 vl, vh;
                if (st < 8) { vl = *(const LAS s16x4*)(vp + 256 * dt); vh = *(const LAS s16x4*)(vp + 2048 + 256 * dt); } else { vl = vm[dt]; vh = (s16x4){0, 0, 0, 0}; }
                const bf16x8 Vf = __builtin_shufflevector(vl, vh, 0, 1, 2, 3, 4, 5, 6, 7);
                O[dt] = __builtin_amdgcn_mfma_f32_16x16x32_bf16(Vf, Pf, O[dt], 0, 0, 0);
            }
        }
        bf16_t* op = X.O + (size_t)((unsigned)(b * SEQ + r * 64 + 16 * cb + q) & X.omask) * 1024 + hq * 64 + 4 * kg;
#pragma unroll
        for (int dt = 0; dt < 4; ++dt) { u32x2 wv; wv.x = cvt_pk_bf16(O[dt][0] * inv, O[dt][1] * inv); wv.y = cvt_pk_bf16(O[dt][2] * inv, O[dt][3] * inv); *(u32x2*)(op + 16 * dt) = wv; }
        __builtin_amdgcn_s_waitcnt(0x0F74); asm volatile("" ::: "memory"); __builtin_amdgcn_s_barrier(); asm volatile("" ::: "memory");
    }
    __builtin_amdgcn_s_waitcnt(0x0F70); asm volatile("" ::: "memory");
}

constexpr int SX_T5 = 0, SX_SINK = 2048, SX_TBL = 2176, SX_MK = 11392, SX_MV = 13440, SWA_VRING = 65536;
__device__ __forceinline__ void swa_ring_item(Frame& F, const AttnCtx& X, int item) {
    int lane = F.lane; asm volatile("" : "+v"(lane));
    const int w = F.wave, q = lane & 15, kg = lane >> 4;
    const int bn = item >> 1, hf = item & 1, b = bn >> 2, n = bn & 3, g = w & 3, qsel = w >> 2, hq = n * 4 + g;
    LAS unsigned char* lds = F.lds;
    const LAS float* xt5 = (const LAS float*)(lds + ATT_X_OFF + SX_T5);
    const LAS float* xtb = (const LAS float*)(lds + ATT_X_OFF + SX_TBL) + g * SWA_TBL_HEAD;
    const float sk = ((const LAS float*)(lds + ATT_X_OFF + SX_SINK))[hq];
    const bf16_t* kglob = X.K + ((size_t)(b * 256) * 4 + n) * 512 + lane * 8;
    const bf16_t* vglob = X.VT + ((size_t)(b * 256) * 4 + n) * 512 + lane * 8;
    if (w < 4) { const size_t mb = ((size_t)(NREG >> 3) + (w & 1)) * 4 + n; dma16((w < 2 ? X.K : X.VT) + mb * 512 + lane * 8, lds + ATT_X_OFF + (w < 2 ? SX_MK : SX_MV) + (w & 1) * 1024); }
    const int qbase = 64 * hf;
    int q0f = 16 * qbase; int lo = q0f - 128; lo = lo < 0 ? 0 : (lo > SEQ - 272 ? SEQ - 272 : lo);
    int hi0 = q0f + 16 - 128; hi0 = hi0 < 0 ? 0 : (hi0 > SEQ - 272 ? SEQ - 272 : hi0); hi0 += 272;
    for (int B = (lo >> 3) + w; B < (hi0 >> 3); B += 8) { dma16(kglob + (size_t)B * 2048, lds + (B & 63) * 1024); dma16(vglob + (size_t)B * 2048, lds + SWA_VRING + (B & 63) * 1024); }
    int loaded_hi = hi0;
    bf16x8 Qn[2];
    { const bf16_t* qp = X.Q + (size_t)(b * SEQ + 16 * (qbase + qsel) + q) * 1024 + hq * 64 + 8 * kg; Qn[0] = *(const bf16x8*)qp; Qn[1] = *(const bf16x8*)(qp + 32); }
    const int kfrag = (q >> 3) * 1024 + kg * 128 + (q & 7) * 16;
    const int vfrag = (kg >> 1) * 1024 + ((kg & 1) * 16 + q) * 8;
    __builtin_amdgcn_s_waitcnt(0x0F70); asm volatile("" ::: "memory"); __builtin_amdgcn_s_barrier(); asm volatile("" ::: "memory");
    for (int s = 0; s < 32; ++s) {
        const int qblk = qbase + 2 * s + qsel, q0 = 16 * qblk;
        bf16x8 Qf[2]; Qf[0] = Qn[0]; Qf[1] = Qn[1];
        if (s + 1 < 32) {
            int nh = 16 * (qbase + 2 * s + 3) - 128; nh = nh < 0 ? 0 : (nh > SEQ - 272 ? SEQ - 272 : nh); nh += 272;
            const int B = (loaded_hi >> 3) + (w & 3);
            if (B < (nh >> 3)) { if (w < 4) dma16(kglob + (size_t)B * 2048, lds + (B & 63) * 1024); else dma16(vglob + (size_t)B * 2048, lds + SWA_VRING + (B & 63) * 1024); }
            loaded_hi = nh > loaded_hi ? nh : loaded_hi;
            const bf16_t* qp = X.Q + (size_t)(b * SEQ + q0 + 32 + q) * 1024 + hq * 64 + 8 * kg; Qn[0] = *(const bf16x8*)qp; Qn[1] = *(const bf16x8*)(qp + 32);
        }
        int jb = q0 - 128; jb = jb < 0 ? 0 : (jb > SEQ - 272 ? SEQ - 272 : jb);
        const int relbase = jb + 4 * kg - q0 - q;
        const int jblk = jb >> 3;
        f32x4 S[18];
        {
            const LAS float* bt = xtb + relbase + 288;
#pragma unroll
            for (int t = 0; t < 17; ++t)
#pragma unroll
                for (int j = 0; j < 4; ++j) S[t][j] = bt[16 * t + j];
#pragma unroll
            for (int j = 0; j < 4; ++j) S[17][j] = xt5[t5_bucket_abs(16 + q0 + q - (4 * kg + j)) * 16 + hq];
            if (jb == q0 - 128) {
#pragma unroll
                for (int j = 0; j < 4; ++j) { S[0][j] = (relbase + j >= -128) ? S[0][j] : NEGBIG; S[16][j] = (relbase + 256 + j <= 128) ? S[16][j] : NEGBIG; }
            } else {
                int r0 = relbase + 128; asm volatile("" : "+v"(r0));
#pragma unroll
                for (int t = 0; t < 17; ++t)
#pragma unroll
                    for (int j = 0; j < 4; ++j) S[t][j] = ((unsigned)(r0 + (16 * t + j)) <= 256u) ? S[t][j] : NEGBIG;
            }
        }
#pragma unroll
        for (int t0 = 0; t0 < 18; t0 += 6) {
            bf16x8 Kf[6][2];
#pragma unroll
            for (int t = 0; t < 6; ++t) {
                const LAS unsigned char* kp = (t0 + t == 17) ? lds + ATT_X_OFF + SX_MK + kfrag : lds + (((jblk + 2 * (t0 + t) + (q >> 3)) & 63) * 1024) + (kfrag & 1023);
                Kf[t][0] = *(const LAS bf16x8*)kp; Kf[t][1] = *(const LAS bf16x8*)(kp + 512);
            }
#pragma unroll
            for (int t = 0; t < 6; ++t) { f32x4 s_ = __builtin_amdgcn_mfma_f32_16x16x32_bf16(Kf[t][0], Qf[0], S[t0 + t], 0, 0, 0); S[t0 + t] = __builtin_amdgcn_mfma_f32_16x16x32_bf16(Kf[t][1], Qf[1], s_, 0, 0, 0); }
        }
        __builtin_amdgcn_sched_barrier(0);
        float l = 0.f;
#pragma unroll
        for (int t = 0; t < 18; ++t)
#pragma unroll
            for (int j = 0; j < 4; ++j) { const float p = fast_exp2(S[t][j]); S[t][j] = p; l += p; }
        l += __shfl_xor(l, 16); l += __shfl_xor(l, 32);
        l += fast_exp2(sk);
        __builtin_amdgcn_sched_barrier(0);
        const float inv = 1.0f / l;
        f32x4 O[4];
#pragma unroll
        for (int dt = 0; dt < 4; ++dt) O[dt] = (f32x4){0.f, 0.f, 0.f, 0.f};
#pragma unroll
        for (int st = 0; st < 9; ++st) {
            const LAS unsigned char* va = lds + SWA_VRING + (((jblk + 4 * st + (kg >> 1)) & 63) * 1024) + (vfrag & 1023);
            const LAS unsigned char* vb = (st == 8) ? lds + ATT_X_OFF + SX_MV + vfrag : lds + SWA_VRING + (((jblk + 4 * st + 2 + (kg >> 1)) & 63) * 1024) + (vfrag & 1023);
            const f32x4 pa = S[2 * st], pb = S[2 * st + 1];
            u32x4 pw; pw.x = cvt_pk_bf16(pa[0], pa[1]); pw.y = cvt_pk_bf16(pa[2], pa[3]); pw.z = cvt_pk_bf16(pb[0], pb[1]); pw.w = cvt_pk_bf16(pb[2], pb[3]);
            const bf16x8 Pf = __builtin_bit_cast(bf16x8, pw);
#pragma unroll
            for (int dt = 0; dt < 4; ++dt) {
                const s16x4 vl = *(const LAS s16x4*)(va + 256 * dt), vh = *(const LAS s16x4*)(vb + 256 * dt);
                const bf16x8 Vf = __builtin_shufflevector(vl, vh, 0, 1, 2, 3, 4, 5, 6, 7);
                O[dt] = __builtin_amdgcn_mfma_f32_16x16x32_bf16(Vf, Pf, O[dt], 0, 0, 0);
            }
        }
        bf16_t* op = X.O + (size_t)((unsigned)(b * SEQ + q0 + q) & X.omask) * 1024 + hq * 64 + 4 * kg;
#pragma unroll
        for (int dt = 0; dt < 4; ++dt) { u32x2 wv; wv.x = cvt_pk_bf16(O[dt][0] * inv, O[dt][1] * inv); wv.y = cvt_pk_bf16(O[dt][2] * inv, O[dt][3] * inv); *(u32x2*)(op + 16 * dt) = wv; }
        __builtin_amdgcn_s_waitcnt(0x0F74); asm volatile("" ::: "memory"); __builtin_amdgcn_s_barrier(); asm volatile("" ::: "memory");
    }
    asm volatile("s_waitcnt vmcnt(0)" ::: "memory");
}

__device__ __forceinline__ void router_phase(Frame& F, const float* wr, const float* gain, const u64* ssq, int moe_idx, bool dummy) {
    LAS u32x4* Wl = (LAS u32x4*)F.lds;
    for (int idx = F.tid; idx < 32 * 64; idx += 512) {
        const int st = idx >> 6, ln = idx & 63, n = ln & 15, kg = ln >> 4, e = 2 * (n >> 2) + (n & 1), part = (n >> 1) & 1;
        float v[8];
#pragma unroll
        for (int c = 0; c < 8; ++c) { const int k = 64 * (st >> 1) + 16 * kg + 8 * (st & 1) + c; const float w = wr[(size_t)k * 8 + e] * gain[k];
            const float hi = __uint_as_float(cvt_pk_bf16(w, 0.f) << 16); v[c] = part ? w - hi : hi; }
        u32x4 o; o.x = cvt_pk_bf16(v[0], v[1]); o.y = cvt_pk_bf16(v[2], v[3]); o.z = cvt_pk_bf16(v[4], v[5]); o.w = cvt_pk_bf16(v[6], v[7]);
        Wl[idx] = o;
    }
    __syncthreads();
    unsigned* cnt = F.ctl + CW_CNT + (dummy ? 2 : moe_idx) * 8 * 64;
    unsigned char* tb_ = dummy ? F.ws + WS_R : F.ws + WS_TAB;
    unsigned* rowtok = (unsigned*)(tb_); float* rowssq = (float*)(tb_ + TAB_BYTES);
    unsigned* rowslot = (unsigned*)(tb_ + 2 * TAB_BYTES); float* rowgate = (float*)(tb_ + 3 * TAB_BYTES);
    const int gw = F.bx * 8 + F.wave, NGW = F.G * 8;
    constexpr int RT = 48;
    int lane_ = F.lane; asm volatile("" : "+v"(lane_));
    const int tok = lane_ & 15, q = lane_ >> 4;
    constexpr int NT = (M + RT - 1) / RT;
    LAS unsigned* wcnt = (LAS unsigned*)(F.lds + 32768);
    (void)gw;
    for (int t0 = 0; t0 < NT; t0 += NGW) {
        const int task = t0 + F.wave * F.G + F.bx; const bool has = task < NT;
        int me1 = 0, me2 = 0; float mg1 = 0.f, mg2 = 0.f, mss = 0.f;
        if (has) for (int j = 0; j < 3; ++j) {
            int mm = task * RT + 16 * j + tok; mm = mm < M ? mm : M - 1;
            const bf16_t* xr = F.hb + (size_t)mm * D + 16 * q;
            bf16x8 xa[16][2];
#pragma unroll
            for (int i = 0; i < 16; ++i) { xa[i][0] = *(const bf16x8*)(xr + 64 * i); xa[i][1] = *(const bf16x8*)(xr + 64 * i + 8); }
            const float ssv = ssq_val(ssq[mm]);
            f32x4 acc0 = {0.f, 0.f, 0.f, 0.f}, acc1 = {0.f, 0.f, 0.f, 0.f};
#pragma unroll
            for (int i = 0; i < 16; ++i) {
                const bf16x8 w0 = __builtin_bit_cast(bf16x8, Wl[(2 * i) * 64 + lane_]), w1 = __builtin_bit_cast(bf16x8, Wl[(2 * i + 1) * 64 + lane_]);
                acc0 = __builtin_amdgcn_mfma_f32_16x16x32_bf16(w0, xa[i][0], acc0, 0, 0, 0);
                acc1 = __builtin_amdgcn_mfma_f32_16x16x32_bf16(w1, xa[i][1], acc1, 0, 0, 0); }
            const f32x4 acc = acc0 + acc1;
            const float l0 = acc[0] + acc[2], l1 = acc[1] + acc[3];
            float cv[8]; int ce[8];
            cv[0] = l0; cv[1] = l1; ce[0] = 2 * q; ce[1] = 2 * q + 1;
#pragma unroll
            for (int d = 1; d < 4; ++d) { cv[2 * d] = __shfl_xor(l0, 16 * d); cv[2 * d + 1] = __shfl_xor(l1, 16 * d); ce[2 * d] = 2 * (q ^ d); ce[2 * d + 1] = 2 * (q ^ d) + 1; }
            int e1 = ce[0]; float v1 = cv[0];
#pragma unroll
            for (int c = 1; c < 8; ++c) if (cv[c] > v1 || (cv[c] == v1 && ce[c] < e1)) { v1 = cv[c]; e1 = ce[c]; }
            int e2 = -1; float v2 = -3.0e38f;
#pragma unroll
            for (int c = 0; c < 8; ++c) if (ce[c] != e1 && (cv[c] > v2 || (cv[c] == v2 && ce[c] < e2))) { v2 = cv[c]; e2 = ce[c]; }
            if (e2 < 0) e2 = e1 ^ 1;
            const float rstd = 1.0f / sqrtf(ssv * (1.0f / 1024.0f) + EPS);
            const float ex = __expf((v2 - v1) * rstd); const float g1 = 1.0f / (1.0f + ex), g2 = ex * g1;
            if (q == j) { me1 = e1; me2 = e2; mg1 = g1; mg2 = g2; mss = ssv; }
        }
        const bool act = has && F.lane < RT && task * RT + F.lane < M;
        int rank1 = 0, rank2 = 0, mycnt = 0, n1e2 = 0;
        const unsigned long long lt = (1ull << F.lane) - 1ull;
#pragma unroll
        for (int e = 0; e < 8; ++e) {
            const unsigned long long m1 = __ballot(act && me1 == e), m2 = __ballot(act && me2 == e);
            const int c1 = __popcll(m1), c2 = __popcll(m2);
            if (me1 == e) rank1 = __popcll(m1 & lt);
            if (me2 == e) { rank2 = __popcll(m2 & lt); n1e2 = c1; }
            if (F.lane == e) mycnt = c1 + c2;
        }
        unsigned basev = 0;
        if (F.lane < 8) wcnt[F.wave * 8 + F.lane] = (unsigned)mycnt;
        __syncthreads();
        if (F.wave == 0 && F.lane < 8) { unsigned tot = 0;
#pragma unroll
            for (int w = 0; w < 8; ++w) tot += wcnt[w * 8 + F.lane];
            wcnt[64 + F.lane] = tot ? __hip_atomic_fetch_add(cnt + F.lane * 64, tot, RLX_AGENT) : 0u; }
        __syncthreads();
        if (F.lane < 8) { basev = wcnt[64 + F.lane]; for (int w = 0; w < F.wave; ++w) basev += wcnt[w * 8 + F.lane]; }
        __syncthreads();
        const unsigned b1 = __shfl(basev, me1), b2 = __shfl(basev, me2);
        if (act) {
            const int m = task * RT + F.lane;
            const size_t p1 = (size_t)me1 * M + b1 + rank1, p2 = (size_t)me2 * M + b2 + n1e2 + rank2;
            rowtok[p1] = m; rowssq[p1] = mss; rowslot[p1] = 2 * m; rowgate[p1] = mg1;
            rowtok[p2] = m; rowssq[p2] = mss; rowslot[p2] = 2 * m + 1; rowgate[p2] = mg2;
        }
    }
}
__device__ __forceinline__ void combine_phase(Frame& F, const unsigned char* ys, u64* ssq_next, bool last, bool dummy) {
    const int gw = F.bx * 8 + F.wave, NGW = F.G * 8, mend = last ? NREG : M;
    u32x4 nh[2]; u32x2 na[2], nc[2];
    if (gw < mend) { const u32x4* hr = (const u32x4*)(F.hb + (size_t)gw * D) + F.lane; const u32x2* y0 = (const u32x2*)(ys + (size_t)(2 * gw) * D) + F.lane; const u32x2* y1 = (const u32x2*)(ys + (size_t)(2 * gw + 1) * D) + F.lane;
#pragma unroll
        for (int j = 0; j < 2; ++j) { nh[j] = hr[64 * j]; na[j] = y0[64 * j]; nc[j] = y1[64 * j]; } }
    for (int m = gw; m < mend; m += NGW) {
        u32x4 ch[2]; u32x2 ca[2], cc2[2];
#pragma unroll
        for (int j = 0; j < 2; ++j) { ch[j] = nh[j]; ca[j] = na[j]; cc2[j] = nc[j]; }
        const int mn = m + NGW;
        if (mn < mend) { const u32x4* hr = (const u32x4*)(F.hb + (size_t)mn * D) + F.lane; const u32x2* y0 = (const u32x2*)(ys + (size_t)(2 * mn) * D) + F.lane; const u32x2* y1 = (const u32x2*)(ys + (size_t)(2 * mn + 1) * D) + F.lane;
#pragma unroll
            for (int j = 0; j < 2; ++j) { nh[j] = hr[64 * j]; na[j] = y0[64 * j]; nc[j] = y1[64 * j]; } }
        float v[2][8]; float s = 0.f;
#pragma unroll
        for (int j = 0; j < 2; ++j) { const u32x4 h4 = ch[j]; const u32x2 a = ca[j], c = cc2[j];
            const unsigned hh[4] = {h4.x, h4.y, h4.z, h4.w}; const int aa[2] = {(int)a.x, (int)a.y}, cc[2] = {(int)c.x, (int)c.y};
#pragma unroll
            for (int i2 = 0; i2 < 2; ++i2) {
                const f32x2 ya0 = __builtin_amdgcn_cvt_pk_f32_fp8(aa[i2], false), ya1 = __builtin_amdgcn_cvt_pk_f32_fp8(aa[i2], true), yc0 = __builtin_amdgcn_cvt_pk_f32_fp8(cc[i2], false), yc1 = __builtin_amdgcn_cvt_pk_f32_fp8(cc[i2], true);
                v[j][4 * i2 + 0] = __uint_as_float(hh[2 * i2] << 16) + (ya0.x + yc0.x) * YS8_INV;
                v[j][4 * i2 + 1] = __uint_as_float(hh[2 * i2] & 0xffff0000u) + (ya0.y + yc0.y) * YS8_INV;
                v[j][4 * i2 + 2] = __uint_as_float(hh[2 * i2 + 1] << 16) + (ya1.x + yc1.x) * YS8_INV;
                v[j][4 * i2 + 3] = __uint_as_float(hh[2 * i2 + 1] & 0xffff0000u) + (ya1.y + yc1.y) * YS8_INV; }
#pragma unroll
            for (int i = 0; i < 8; ++i) s += v[j][i] * v[j][i]; }
        if (last) {
            f32x4* o = (f32x4*)((dummy ? (float*)(F.ws + WS_R) + (size_t)(m & 0x7FFF) * D : F.out + (size_t)m * D)) + 2 * F.lane;
#pragma unroll
            for (int j = 0; j < 2; ++j) { o[128 * j] = (f32x4){v[j][0], v[j][1], v[j][2], v[j][3]}; o[128 * j + 1] = (f32x4){v[j][4], v[j][5], v[j][6], v[j][7]}; }
        } else {
            s = wave_sum(s);
            u32x4* o8 = (u32x4*)(dummy ? (bf16_t*)(F.ws + WS_R) + (size_t)(m & 0x7FFF) * D : F.hb + (size_t)m * D) + F.lane;
#pragma unroll
            for (int j = 0; j < 2; ++j) { u32x4 w; w.x = cvt_pk_bf16(v[j][0], v[j][1]); w.y = cvt_pk_bf16(v[j][2], v[j][3]); w.z = cvt_pk_bf16(v[j][4], v[j][5]); w.w = cvt_pk_bf16(v[j][6], v[j][7]); o8[64 * j] = w; }
            if (F.lane == 0) ssq_next[m] = ssq_fix(s);
        }
    }
}

__device__ __forceinline__ bool thin_gemm(Frame& F, f32x4 (&acc)[4], const bf16_t* ap, const bf16_t* const (&bp)[4], int K, int lane) {
#pragma unroll
    for (int t = 0; t < 4; ++t) acc[t] = (f32x4){0.f, 0.f, 0.f, 0.f};
    const int ksl = K / 8, kb = F.wave * ksl;
#pragma unroll 2
    for (int k0 = kb; k0 < kb + ksl; k0 += 64) {
        bf16x8 af[2], bf[2][4];
#pragma unroll
        for (int st = 0; st < 2; ++st) { af[st] = *(const bf16x8*)(ap + k0 + 32 * st);
#pragma unroll
            for (int t = 0; t < 4; ++t) bf[st][t] = *(const bf16x8*)(bp[t] + k0 + 32 * st); }
#pragma unroll
        for (int st = 0; st < 2; ++st)
#pragma unroll
            for (int t = 0; t < 4; ++t) acc[t] = __builtin_amdgcn_mfma_f32_16x16x32_bf16(bf[st][t], af[st], acc[t], 0, 0, 0);
    }
    LAS f32x4* part = (LAS f32x4*)F.lds;
#pragma unroll
    for (int t = 0; t < 4; ++t) part[(F.wave * 4 + t) * 64 + lane] = acc[t];
    __syncthreads();
    if (F.wave == 0) {
#pragma unroll
        for (int w = 1; w < 8; ++w)
#pragma unroll
            for (int t = 0; t < 4; ++t) acc[t] = acc[t] + part[(w * 4 + t) * 64 + lane];
    }
    return F.wave == 0;
}
__device__ __forceinline__ void thin_qkv(Frame& F, const bf16_t* W, const u64* ssq, const float* gq, const float* gk, bf16_t* Q, bf16_t* Kb, bf16_t* Vb, int nhk, int QT) {
    for (int task = F.bx; task < 16 + 2 * nhk; task += F.G) {
    int lane = F.lane; asm volatile("" : "+v"(lane));
    const int tk = lane & 15, kg = lane >> 4, tok = NREG + tk;
    const int kind = task < 16 ? 0 : (task < 16 + nhk ? 1 : 2), hh = kind == 0 ? task : (kind == 1 ? task - 16 : task - 16 - nhk);
    const bf16_t* bp[4];
#pragma unroll
    for (int t = 0; t < 4; ++t) { const int d = 16 * t + tk;
        const int row = kind == 0 ? (hh >> 2) * 256 + qk_perm(64 * (hh & 3) + d) : (kind == 1 ? (4 + (hh >> 2)) * 256 + qk_perm(64 * (hh & 3) + d) : QT * 256 + hh * 64 + d);
        bp[t] = W + (size_t)row * 1024 + 8 * kg; }
    f32x4 acc[4];
    if (thin_gemm(F, acc, F.hb + (size_t)tok * D + 8 * kg, bp, 1024, lane)) {
        const float rstd = fast_rsqrt(ssq_val(ssq[tok]) * (1.0f / 1024.0f) + EPS);
        if (kind < 2) {
            float ss = 0.f;
#pragma unroll
            for (int t = 0; t < 4; ++t) { acc[t] = acc[t] * rstd; ss += acc[t][0] * acc[t][0] + acc[t][1] * acc[t][1] + acc[t][2] * acc[t][2] + acc[t][3] * acc[t][3]; }
            ss += __shfl_xor(ss, 16); ss += __shfl_xor(ss, 32);
            const float hn = fast_rsqrt(ss * (1.0f / 64.0f) + EPS) * (kind == 0 ? 0.125f * LOG2E : 1.0f);
            const float* gp = kind == 0 ? gq : gk;
#pragma unroll
            for (int t = 0; t < 4; ++t) { const int d0 = 16 * t + 4 * kg; const f32x4 g = *(const f32x4*)(gp + d0); const f32x4 v = acc[t] * g * hn;
                u32x2 w; w.x = cvt_pk_bf16(v[0], v[1]); w.y = cvt_pk_bf16(v[2], v[3]);
                if (kind == 0) *(u32x2*)(Q + (size_t)tok * 1024 + hh * 64 + d0) = w;
                else *(u32x2*)(Kb + (((((size_t)(tok >> 3) * nhk + hh) * 2 + (d0 >> 5)) * 4 + ((d0 >> 3) & 3)) * 64) + (tok & 7) * 8 + (d0 & 7)) = w; }
        } else {
#pragma unroll
            for (int t = 0; t < 4; ++t)
#pragma unroll
                for (int r = 0; r < 4; ++r) { const int d = 16 * t + 4 * kg + r; const unsigned pk = cvt_pk_bf16(acc[t][r] * rstd, 0.f);
                    Vb[((size_t)(tok >> 3) * nhk + hh) * 512 + (((d >> 4) * 2 + ((tok >> 2) & 1)) * 16 + (d & 15)) * 4 + (tok & 3)] = (bf16_t)(pk & 0xffffu); }
        }
    }
    __syncthreads();
    }
}
__device__ __forceinline__ void thin_res(Frame& F, const bf16_t* A, int pitchA, int K, const bf16_t* W, u64* ssq_out, unsigned char* hb8) {
    for (int task = F.bx; task < 16; task += F.G) {
    int lane = F.lane; asm volatile("" : "+v"(lane));
    const int tk = lane & 15, kg = lane >> 4, tok = NREG + tk, c0 = 64 * task;
    const bf16_t* bp[4];
#pragma unroll
    for (int t = 0; t < 4; ++t) bp[t] = W + (size_t)dst_row(5, c0 + 16 * t + tk) * K + 8 * kg;
    f32x4 acc[4];
    if (thin_gemm(F, acc, A + (size_t)tk * pitchA + 8 * kg, bp, K, lane)) {
        float ss = 0.f;
#pragma unroll
        for (int t = 0; t < 4; ++t) { bf16_t* hp = F.hb + (size_t)tok * D + c0 + 16 * t + 4 * kg; const u32x2 b = *(const u32x2*)hp;
            const float o0 = __uint_as_float(b.x << 16) + acc[t][0], o1 = __uint_as_float(b.x & 0xffff0000u) + acc[t][1], o2 = __uint_as_float(b.y << 16) + acc[t][2], o3 = __uint_as_float(b.y & 0xffff0000u) + acc[t][3];
            u32x2 w; w.x = cvt_pk_bf16(o0, o1); w.y = cvt_pk_bf16(o2, o3); *(u32x2*)hp = w; ss += o0 * o0 + o1 * o1 + o2 * o2 + o3 * o3;
            if (hb8) { int p0 = 0; p0 = __builtin_amdgcn_cvt_pk_fp8_f32(o0, o1, p0, false); p0 = __builtin_amdgcn_cvt_pk_fp8_f32(o2, o3, p0, true); *(unsigned*)(hb8 + (size_t)tok * D + c0 + 16 * t + 4 * kg) = (unsigned)p0; } }
        ss += __shfl_xor(ss, 16); ss += __shfl_xor(ss, 32);
        if (kg == 0) __hip_atomic_fetch_add(ssq_out + tok, ssq_fix(ss), RLX_AGENT);
    }
    __syncthreads();
    }
}
__device__ __forceinline__ void thin_gu(Frame& F, const bf16_t* W, const u64* ssq, bf16_t* hid) {
    for (int task = F.bx; task < FF / 32; task += F.G) {
    int lane = F.lane; asm volatile("" : "+v"(lane));
    const int tk = lane & 15, kg = lane >> 4, tok = NREG + tk, j0 = 32 * task;
    const bf16_t* bp[4];
#pragma unroll
    for (int t = 0; t < 4; ++t) bp[t] = W + (size_t)dst_row(t < 2 ? 3 : 4, j0 + 16 * (t & 1) + tk) * 1024 + 8 * kg;
    f32x4 acc[4];
    if (thin_gemm(F, acc, F.hb + (size_t)tok * D + 8 * kg, bp, 1024, lane)) {
        const float rstd = fast_rsqrt(ssq_val(ssq[tok]) * (1.0f / 1024.0f) + EPS);
#pragma unroll
        for (int t = 0; t < 2; ++t) { float o[4];
#pragma unroll
            for (int r = 0; r < 4; ++r) o[r] = silu_f(acc[t][r] * rstd) * (acc[t + 2][r] * rstd);
            u32x2 w; w.x = cvt_pk_bf16(o[0], o[1]); w.y = cvt_pk_bf16(o[2], o[3]); *(u32x2*)(hid + (size_t)tok * FF + j0 + 16 * t + 4 * kg) = w; }
    }
    __syncthreads();
    }
}

__device__ __forceinline__ void thin_gu8(Frame& F, const unsigned char* W, const u64* ssq, bf16_t* hid) {
    for (int task = F.bx; task < FF / 32; task += F.G) {
    int lane = F.lane; asm volatile("" : "+v"(lane));
    const int tk = lane & 15, kg = lane >> 4, tok = NREG + tk, j0 = 32 * task;
    const unsigned char* ap = F.ws + WS_HB8 + (size_t)tok * D + F.wave * 128 + 32 * kg;
    const bf16x8 a0 = *(const bf16x8*)ap, a1 = *(const bf16x8*)(ap + 16);
    f32x4 acc[4];
#pragma unroll
    for (int t = 0; t < 4; ++t) { const unsigned char* bp = W + (size_t)dst_row(t < 2 ? 3 : 4, j0 + 16 * (t & 1) + tk) * 1024 + F.wave * 128 + 32 * kg;
        const bf16x8 b0 = *(const bf16x8*)bp, b1 = *(const bf16x8*)(bp + 16);
        acc[t] = __builtin_amdgcn_mfma_scale_f32_16x16x128_f8f6f4(pg8::cat8(b0, b1), pg8::cat8(a0, a1), (f32x4){0.f, 0.f, 0.f, 0.f}, 0, 0, 0, 0, 0, 0); }
    LAS f32x4* part = (LAS f32x4*)F.lds;
#pragma unroll
    for (int t = 0; t < 4; ++t) part[(F.wave * 4 + t) * 64 + lane] = acc[t];
    __syncthreads();
    if (F.wave == 0) {
#pragma unroll
        for (int w = 1; w < 8; ++w)
#pragma unroll
            for (int t = 0; t < 4; ++t) acc[t] = acc[t] + part[(w * 4 + t) * 64 + lane];
        const float rstd = fast_rsqrt(ssq_val(ssq[tok]) * (1.0f / 1024.0f) + EPS) * W8_INV;
#pragma unroll
        for (int t = 0; t < 2; ++t) { float o[4];
#pragma unroll
            for (int r = 0; r < 4; ++r) o[r] = silu_f(acc[t][r] * rstd) * (acc[t + 2][r] * rstd) * HID8_SCALE;
            int q = 0; q = __builtin_amdgcn_cvt_pk_fp8_f32(o[0], o[1], q, false); q = __builtin_amdgcn_cvt_pk_fp8_f32(o[2], o[3], q, true);
            *(unsigned*)((unsigned char*)hid + (size_t)tok * FF + j0 + 16 * t + 4 * kg) = (unsigned)q; }
    }
    __syncthreads();
    }
}
__device__ __forceinline__ void thin_res8(Frame& F, const unsigned char* A, const unsigned char* W, u64* ssq_out) {
    for (int task = F.bx; task < 16; task += F.G) {
    int lane = F.lane; asm volatile("" : "+v"(lane));
    const int tk = lane & 15, kg = lane >> 4, tok = NREG + tk, c0 = 64 * task;
    f32x4 acc[4];
#pragma unroll
    for (int t = 0; t < 4; ++t) acc[t] = (f32x4){0.f, 0.f, 0.f, 0.f};
    if (F.wave < 7) {
        const unsigned char* ap = A + (size_t)tk * FF + F.wave * 512 + 32 * kg;
#pragma unroll
        for (int i = 0; i < 4; ++i) {
            const bf16x8 a0 = *(const bf16x8*)(ap + 128 * i), a1 = *(const bf16x8*)(ap + 128 * i + 16);
#pragma unroll
            for (int t = 0; t < 4; ++t) { const unsigned char* bp = W + (size_t)dst_row(5, c0 + 16 * t + tk) * FF + F.wave * 512 + 128 * i + 32 * kg;
                const bf16x8 b0 = *(const bf16x8*)bp, b1 = *(const bf16x8*)(bp + 16);
                acc[t] = __builtin_amdgcn_mfma_scale_f32_16x16x128_f8f6f4(pg8::cat8(b0, b1), pg8::cat8(a0, a1), acc[t], 0, 0, 0, 0, 0, 0); }
        }
    }
    LAS f32x4* part = (LAS f32x4*)F.lds;
#pragma unroll
    for (int t = 0; t < 4; ++t) part[(F.wave * 4 + t) * 64 + lane] = acc[t];
    __syncthreads();
    if (F.wave == 0) {
#pragma unroll
        for (int w = 1; w < 8; ++w)
#pragma unroll
            for (int t = 0; t < 4; ++t) acc[t] = acc[t] + part[(w * 4 + t) * 64 + lane];
        float ss = 0.f;
#pragma unroll
        for (int t = 0; t < 4; ++t) { bf16_t* hp = F.hb + (size_t)tok * D + c0 + 16 * t + 4 * kg; const u32x2 b = *(const u32x2*)hp; const f32x4 a = acc[t] * (W8_INV * HID8_INV);
            const float o0 = __uint_as_float(b.x << 16) + a[0], o1 = __uint_as_float(b.x & 0xffff0000u) + a[1], o2 = __uint_as_float(b.y << 16) + a[2], o3 = __uint_as_float(b.y & 0xffff0000u) + a[3];
            u32x2 w; w.x = cvt_pk_bf16(o0, o1); w.y = cvt_pk_bf16(o2, o3); *(u32x2*)hp = w; ss += o0 * o0 + o1 * o1 + o2 * o2 + o3 * o3; }
        ss += __shfl_xor(ss, 16); ss += __shfl_xor(ss, 32);
        if (kg == 0) __hip_atomic_fetch_add(ssq_out + tok, ssq_fix(ss), RLX_AGENT);
    }
    __syncthreads();
    }
}

constexpr int PH_PER_PAIR = 10 + 2 * MOE_NCH, N_PHASES = 1 + 2 * PH_PER_PAIR;
typedef const __attribute__((address_space(4))) Args* KArgs;
__device__ __forceinline__ KArgs kargs() { KArgs p = (KArgs)__builtin_amdgcn_kernarg_segment_ptr(); asm volatile("" : "+s"(p)); return p; }
__device__ __forceinline__ void make_frame(Frame& F, KArgs ap) {
    extern __shared__ __attribute__((aligned(16))) unsigned char lds_raw[];
    { LAS unsigned char* lp = (LAS unsigned char*)lds_raw; asm volatile("" : "+s"(lp)); F.lds = lp; }
    F.tab = F.lds + TAB_OFF;
    int t = threadIdx.x; asm volatile("" : "+v"(t));
    F.tid = t; F.lane = t & 63; F.wave = __builtin_amdgcn_readfirstlane(t >> 6);
    { int g_ = gridDim.x, b_ = blockIdx.x; asm volatile("" : "+s"(g_), "+s"(b_)); F.G = g_; F.bx = b_; }
    unsigned char* ws = ap->ws;
    F.ws = ws; F.out = ap->out; F.hb = (bf16_t*)(ws + WS_HB); F.ctl = (unsigned*)(ws + WS_CTL);
}
__device__ __forceinline__ void grid_seam() {
    KArgs ap = kargs();
    extern __shared__ __attribute__((aligned(16))) unsigned char lds_raw[];
    XcdBarrier b; b.bar = (unsigned*)(ap->ws + WS_CTL) + CW_BAR; b.x = xb_xcc_id(); b.st = (volatile LAS unsigned*)((LAS unsigned char*)lds_raw + MISC_OFF) + 8;
    xcd_barrier(b);
}
#ifndef SITE_MASK
#define SITE_MASK 0xFFFF
#endif
#define SITE(b) ((SITE_MASK >> (b)) & 1)

__device__ __forceinline__ void site_na_qkv(int pr) {
    KArgs ap = kargs(); Frame F; make_frame(F, ap);
    const int lb = pr ? I_L2 : I_L0; const unsigned char* wb = F.ws + WS_W + (size_t)pr * WPAIR; unsigned char* R = F.ws + WS_R;
    LAS float* gainsL = (LAS float*)(F.lds + GAIN_OFF);
    if (F.tid < 64) { gainsL[F.tid] = ap->in[lb + 2][F.tid] * (0.125f * LOG2E); gainsL[64 + F.tid] = ap->in[lb + 3][F.tid]; }
    __syncthreads();
    QkvPolicy P; P.nt = 16; P.pitchA = 2048; P.pitchB = 2048; P.G = F.G; P.c = F.bx; P.nN = 12; P.QT = 8; P.hb = (const char*)F.hb; P.W = (const char*)(wb + WNA_QKV);
    P.ssq = ssq_buf(F, 4 * pr + 0); P.Q = (bf16_t*)(R + R_Q); P.K = (bf16_t*)(R + R_K); P.VT = (bf16_t*)(R + R_VT_NA); P.kpitch = 1024; P.nQ = 4; P.gains = gainsL;
    thin_qkv(F, (const bf16_t*)(wb + WNA_QKV), ssq_buf(F, 4 * pr + 0), ap->in[lb + 2], ap->in[lb + 3], P.Q, P.K, P.VT, 16, 8);
    pg8::gemm_phase(F.lds, F.tab, P);
}
__device__ __forceinline__ void site_na_attn(int pr, bool dummy) {
    KArgs ap = kargs(); Frame F; make_frame(F, ap);
    const int lb = pr ? I_L2 : I_L0; unsigned char* R = F.ws + WS_R;
    LAS float* tbl = (LAS float*)(F.lds + NA_TBL_OFF); const float* rpb = ap->in[lb + 4];
    for (int i = F.tid; i < 16 * NA_TBL_HEAD; i += 512) { const int c = (i & 63) - 16, hd = i >> 6; tbl[i] = (c >= 0 && c < 31) ? rpb[hd * 31 + c] * LOG2E - SM_SHIFT : 0.f; }
    __syncthreads();
    AttnCtx X; X.Q = (const bf16_t*)(R + R_Q); X.K = (const bf16_t*)(R + R_K); X.VT = (const bf16_t*)(R + R_VT_NA); X.O = dummy ? (bf16_t*)(R + 3 * HB_BYTES) : (bf16_t*)(R + R_Q); X.omask = dummy ? 0x7FFFu : 0xFFFFFFFFu; X.kpitch = 1024; X.tbl = tbl;
    { int lane_l = F.lane; asm volatile("" : "+v"(lane_l));
      for (int u = F.bx * 8 + F.wave; u < 16; u += F.G * 8) metaq_unit<0>(X, tbl, tbl, 0, u, lane_l); }
    for (int pair = F.bx; pair < 512; pair += F.G) na_ring_item(F, X, pair);
    __syncthreads();
}
__device__ __forceinline__ void site_wo(int pr, int swa) {
    KArgs ap = kargs(); Frame F; make_frame(F, ap);
    const unsigned char* wb = F.ws + WS_W + (size_t)pr * WPAIR; unsigned char* R = F.ws + WS_R;
    ResPolicy<> P; P.nt = 16; P.pitchA = 2048; P.pitchB = 2048; P.G = F.G; P.c = F.bx; P.A = (const char*)(R + R_Q); P.W = (const char*)(wb + (swa ? WSW_O : WNA_O));
    const bool dummy = ap->dummy != 0;
    P.hb = F.hb; P.ssq_out = ssq_buf(F, dummy ? 8 : 4 * pr + (swa ? 3 : 1)); P.dmy = dummy ? (bf16_t*)(F.ws + WS_END) : nullptr;
    P.hb8 = ((swa || pr >= DENSE8_FROM) && !dummy) ? F.ws + WS_HB8 : nullptr;
    if (!dummy) thin_res(F, (const bf16_t*)(R + R_Q) + (size_t)NREG * 1024, 1024, 1024, (const bf16_t*)P.W, P.ssq_out, P.hb8);
    pg8::gemm_phase(F.lds, F.tab, P);
}
__device__ __forceinline__ void site_dense_gu(int pr) {
    KArgs ap = kargs(); Frame F; make_frame(F, ap);
    const unsigned char* wb = F.ws + WS_W + (size_t)pr * WPAIR; unsigned char* R = F.ws + WS_R;
    if (pr >= DENSE8_FROM) {
        GuPolicy<false, true> P; P.nt = 8; P.pitchA = 1024; P.pitchB = 1024; P.G = F.G; P.c = F.bx; P.hb = (const char*)(F.ws + WS_HB8); P.W = (const char*)(wb + WNA_GU); P.ssq = ssq_buf(F, 4 * pr + 1); P.hid = (bf16_t*)R;
        P.rowtok = nullptr; P.p0 = 0; P.p1 = 0; P.ptab = nullptr;
        thin_gu8(F, wb + WNA_GU, ssq_buf(F, 4 * pr + 1), (bf16_t*)R);
        pg8::gemm_phase(F.lds, F.tab, P);
    } else {
    GuPolicy<false> P; P.nt = 16; P.pitchA = 2048; P.pitchB = 2048; P.G = F.G; P.c = F.bx; P.hb = (const char*)F.hb; P.W = (const char*)(wb + WNA_GU); P.ssq = ssq_buf(F, 4 * pr + 1); P.hid = (bf16_t*)R;
    P.rowtok = nullptr; P.p0 = 0; P.p1 = 0; P.ptab = nullptr;
    thin_gu(F, (const bf16_t*)(wb + WNA_GU), ssq_buf(F, 4 * pr + 1), (bf16_t*)R);
    pg8::gemm_phase(F.lds, F.tab, P);
    }
}
__device__ __forceinline__ void site_dense_down(int pr) {
    KArgs ap = kargs(); Frame F; make_frame(F, ap);
    const unsigned char* wb = F.ws + WS_W + (size_t)pr * WPAIR; unsigned char* R = F.ws + WS_R;
    const bool dummy = ap->dummy != 0;
    if (pr >= DENSE8_FROM) {
        ResPolicy<true> P; P.nt = 28; P.pitchA = 3584; P.pitchB = 3584; P.G = F.G; P.c = F.bx; P.A = (const char*)R; P.W = (const char*)(wb + WNA_D);
        P.hb = F.hb; P.ssq_out = ssq_buf(F, dummy ? 8 : 4 * pr + 2); P.dmy = dummy ? (bf16_t*)(F.ws + WS_END) : nullptr;
        P.hb8 = nullptr;
        if (!dummy) thin_res8(F, (const unsigned char*)R + (size_t)NREG * FF, (const unsigned char*)P.W, P.ssq_out);
        pg8::gemm_phase(F.lds, F.tab, P);
    } else {
    ResPolicy<> P; P.nt = 56; P.pitchA = 7168; P.pitchB = 7168; P.G = F.G; P.c = F.bx; P.A = (const char*)R; P.W = (const char*)(wb + WNA_D);
    P.hb = F.hb; P.ssq_out = ssq_buf(F, dummy ? 8 : 4 * pr + 2); P.dmy = dummy ? (bf16_t*)(F.ws + WS_END) : nullptr;
    P.hb8 = nullptr;
    if (!dummy) thin_res(F, (const bf16_t*)R + (size_t)NREG * FF, FF, FF, (const bf16_t*)P.W, P.ssq_out, nullptr);
    pg8::gemm_phase(F.lds, F.tab, P);
    }
}
__device__ __forceinline__ void site_swa_qkv(int pr) {
    KArgs ap = kargs(); Frame F; make_frame(F, ap);
    const int lb = pr ? I_L3 : I_L1; const unsigned char* wb = F.ws + WS_W + (size_t)pr * WPAIR; unsigned char* R = F.ws + WS_R;
    LAS float* gainsL = (LAS float*)(F.lds + GAIN_OFF);
    if (F.tid < 64) { gainsL[F.tid] = ap->in[lb + 2][F.tid] * (0.125f * LOG2E); gainsL[64 + F.tid] = ap->in[lb + 3][F.tid]; }
    __syncthreads();
    QkvPolicy P; P.nt = 16; P.pitchA = 2048; P.pitchB = 2048; P.G = F.G; P.c = F.bx; P.nN = 6; P.QT = 5; P.hb = (const char*)F.hb; P.W = (const char*)(wb + WSW_QKV);
    P.ssq = ssq_buf(F, 4 * pr + 2); P.Q = (bf16_t*)(R + R_Q); P.K = (bf16_t*)(R + R_K); P.VT = (bf16_t*)(R + R_VT_SWA); P.kpitch = 256; P.nQ = 4; P.gains = gainsL;
    thin_qkv(F, (const bf16_t*)(wb + WSW_QKV), ssq_buf(F, 4 * pr + 2), ap->in[lb + 2], ap->in[lb + 3], P.Q, P.K, P.VT, 4, 5);
    pg8::gemm_phase(F.lds, F.tab, P);
}
__device__ __forceinline__ void site_swa_attn(int pr, bool dummy) {
    KArgs ap = kargs(); Frame F; make_frame(F, ap);
    const int lb = pr ? I_L3 : I_L1; unsigned char* R = F.ws + WS_R;
    const float* t5 = ap->in[I_T5]; const float* sink = ap->in[lb + 4];
    AttnCtx X; X.Q = (const bf16_t*)(R + R_Q); X.K = (const bf16_t*)(R + R_K); X.VT = (const bf16_t*)(R + R_VT_SWA); X.O = dummy ? (bf16_t*)(R + 3 * HB_BYTES) : (bf16_t*)(R + R_Q); X.omask = dummy ? 0x7FFFu : 0xFFFFFFFFu; X.kpitch = 256;
    {
        LAS float* xt = (LAS float*)(F.lds + ATT_X_OFF);
        xt[SX_T5 / 4 + F.tid] = t5[F.tid] * LOG2E - SM_SHIFT;
        if (F.tid < 16) xt[SX_SINK / 4 + F.tid] = sink[F.tid] * LOG2E - SM_SHIFT;
        __syncthreads();
        X.tbl = (const LAS float*)(F.lds + ATT_X_OFF) - SWA_T5_OFF;
        { int lane_l = F.lane; asm volatile("" : "+v"(lane_l));
          for (int u = F.bx * 8 + F.wave; u < 16; u += F.G * 8) attn_unit<1>(X, 0, u, 0, 0, true, lane_l); }
        for (int item = F.bx; item < 256; item += F.G) {
            const int n = (item >> 1) & 3;
            __syncthreads();
            for (int i = F.tid; i < 4 * SWA_TBL_HEAD; i += 512) { const int gg = i / SWA_TBL_HEAD, rel = i % SWA_TBL_HEAD - 288; const int bkt = (rel > 0 ? 16 : 0) + t5_bucket_abs(rel < 0 ? -rel : rel); xt[SX_TBL / 4 + i] = t5[bkt * 16 + n * 4 + gg] * LOG2E - SM_SHIFT; }
            __syncthreads();
            swa_ring_item(F, X, item);
        }
    }
    __syncthreads();
}
__device__ __forceinline__ void site_router(int pr) {
    KArgs ap = kargs(); Frame F; make_frame(F, ap);
    const int lb = pr ? I_L3 : I_L1;
    router_phase(F, ap->in[lb + 7], ap->in[lb + 6], ssq_buf(F, 4 * pr + 3), pr, ap->dummy != 0);
}
__device__ __forceinline__ int moe_tables(Frame& F, int pr) {
    volatile LAS int* pt = (volatile LAS int*)(F.lds + MISC_OFF + 128);
    if (F.tid == 0) { int acc = 0; pt[0] = 0;
        for (int e = 0; e < NE; ++e) { const int c = (int)__hip_atomic_load(F.ctl + CW_CNT + pr * 8 * 64 + e * 64, RLX_AGENT); pt[9 + e] = c; acc += (c + 255) / 256; pt[e + 1] = acc; } }
    __syncthreads();
    return pt[NE];
}
__device__ __forceinline__ void site_moe_gu(int pr, int ch) {
    KArgs ap = kargs(); Frame F; make_frame(F, ap);
    const int PT = moe_tables(F, pr); const int P0 = ch * MOE_CH, P1 = (ch == MOE_NCH - 1 || (P0 + MOE_CH) >= PT) ? PT : (P0 + MOE_CH);
    if (P0 < P1) {
        const unsigned char* wb = F.ws + WS_W + (size_t)pr * WPAIR; unsigned char* R = F.ws + WS_R;
        GuPolicy<true> P; P.nt = 8; P.pitchA = 1024; P.pitchB = 1024; P.G = F.G; P.c = F.bx; P.hb = (const char*)(F.ws + WS_HB8); P.W = (const char*)(wb + WSW_GU); P.ssq = (const void*)(F.ws + WS_TAB + TAB_BYTES); P.hid = (bf16_t*)R;
        P.rowtok = (const unsigned*)(F.ws + WS_TAB); P.p0 = P0; P.p1 = P1; P.ptab = (const LAS int*)(F.lds + MISC_OFF + 128);
        pg8::gemm_phase(F.lds, F.tab, P);
    }
    __syncthreads();
}
__device__ __forceinline__ void site_moe_down(int pr, int ch) {
    KArgs ap = kargs(); Frame F; make_frame(F, ap);
    const int PT = moe_tables(F, pr); const int P0 = ch * MOE_CH, P1 = (ch == MOE_NCH - 1 || (P0 + MOE_CH) >= PT) ? PT : (P0 + MOE_CH);
    if (P0 < P1) {
        const unsigned char* wb = F.ws + WS_W + (size_t)pr * WPAIR; unsigned char* R = F.ws + WS_R;
        MoeDownPolicy P; P.nt = 28; P.pitchA = 3584; P.pitchB = 3584; P.G = F.G; P.c = F.bx; P.hid = (const char*)R; P.W = (const char*)(wb + WSW_D);
        P.rowslot = (const unsigned*)(F.ws + WS_TAB + 2 * TAB_BYTES); P.rowgate = (const float*)(F.ws + WS_TAB + 3 * TAB_BYTES); P.ys = (bf16_t*)(R + R_YS); P.p0 = P0; P.p1 = P1; P.ptab = (const LAS int*)(F.lds + MISC_OFF + 128);
        pg8::gemm_phase(F.lds, F.tab, P);
    }
    __syncthreads();
}
__device__ __forceinline__ void site_combine(int pr) {
    KArgs ap = kargs(); Frame F; make_frame(F, ap);
    const bool dummy = ap->dummy != 0;
    combine_phase(F, (const unsigned char*)(F.ws + WS_R + R_YS), ssq_buf(F, dummy ? 3 : (pr ? 0 : 4)), pr == 1, dummy);
}

__global__ void __launch_bounds__(512, 2) fwd_kernel(Args args) {
    extern __shared__ __attribute__((aligned(16))) unsigned char lds_raw[];
    {
        volatile LAS unsigned* MISC = (volatile LAS unsigned*)((LAS unsigned char*)lds_raw + MISC_OFF);
        if (threadIdx.x < 64) MISC[threadIdx.x] = 0u;
        __syncthreads();
    }
    const int lo = args.ph_lo, hi = args.ph_hi;
    if (hi - lo > 1) { KArgs ap = kargs(); (void)xcd_barrier_post((unsigned*)(ap->ws + WS_CTL) + CW_BAR, (volatile LAS unsigned*)((LAS unsigned char*)lds_raw + MISC_OFF) + 8); }
#define IN(k) (lo <= (k) && (k) < hi)
#if PROBE_A || PROBE_B
#define STAMP(k) do { if (blockIdx.x == 0 && threadIdx.x == 0) { KArgs ap_ = kargs(); ((u64*)(ap_->ws + WS_CTL + 49152))[(k)] = __builtin_amdgcn_s_memrealtime(); } } while (0)
#else
#define STAMP(k) do { } while (0)
#endif
#define SEAM(k) do { if (IN(k) && IN((k) + 1)) grid_seam(); STAMP((k) + 1); } while (0)
    STAMP(0);
    if ((REP_MASK & 1) && IN(0)) { KArgs ap = kargs(); Frame F; make_frame(F, ap); prologue(F, ap); grid_seam(); }
    if (SITE(0) && IN(0)) { KArgs ap = kargs(); Frame F; make_frame(F, ap); prologue(F, ap); }
    SEAM(0);
    for (int pr = 0; pr < 2; ++pr) {
        const int pb = 1 + pr * PH_PER_PAIR;
        if (((REP_MASK >> 1) & 1) && IN(pb + 0)) { site_na_qkv(pr); grid_seam(); }
        if (SITE(1) && IN(pb + 0)) site_na_qkv(pr);
        SEAM(pb + 0);
        if (((REP_MASK >> 2) & 1) && IN(pb + 1)) { site_na_attn(pr, true); grid_seam(); }
        if (SITE(2) && IN(pb + 1)) site_na_attn(pr, kargs()->dummy != 0);
        SEAM(pb + 1);
        if (SITE(3) && IN(pb + 2)) site_wo(pr, 0);
        SEAM(pb + 2);
        if (((REP_MASK >> 4) & 1) && IN(pb + 3)) { site_dense_gu(pr); grid_seam(); }
        if (SITE(4) && IN(pb + 3)) site_dense_gu(pr);
        SEAM(pb + 3);
        if (SITE(5) && IN(pb + 4)) site_dense_down(pr);
        SEAM(pb + 4);
        if (SITE(6) && IN(pb + 5)) site_swa_qkv(pr);
        SEAM(pb + 5);
        if (((REP_MASK >> 7) & 1) && IN(pb + 6)) { site_swa_attn(pr, true); grid_seam(); }
        if (SITE(7) && IN(pb + 6)) site_swa_attn(pr, kargs()->dummy != 0);
        SEAM(pb + 6);
        if (SITE(8) && IN(pb + 7)) site_wo(pr, 1);
        SEAM(pb + 7);
        if (SITE(9) && IN(pb + 8)) site_router(pr);
        SEAM(pb + 8);
        for (int ch = 0; ch < MOE_NCH; ++ch) {
            if (SITE(10) && IN(pb + 9 + 2 * ch)) site_moe_gu(pr, ch);
            SEAM(pb + 9 + 2 * ch);
            if (SITE(11) && IN(pb + 10 + 2 * ch)) site_moe_down(pr, ch);
            SEAM(pb + 10 + 2 * ch);
        }
        if (SITE(12) && IN(pb + 9 + 2 * MOE_NCH)) site_combine(pr);
        SEAM(pb + 9 + 2 * MOE_NCH);
    }
#if PROBE_A || PROBE_B
    {
        grid_seam();
        KArgs ap = kargs(); const u64* ts = (const u64*)(ap->ws + WS_CTL + 49152);
        u64 ta = 0, tb = 0;
        for (int k = 0; k < N_PHASES; ++k) { const u64 d = __hip_atomic_load(ts + k + 1, RLX_AGENT) - __hip_atomic_load(ts + k, RLX_AGENT); if ((PROBE_A >> k) & 1ull) ta += d; if ((PROBE_B >> k) & 1ull) tb += d; }
        const float sc = 1.0f + (float)ta * 1e-5f;
        float* o = ap->out;
        for (size_t i = (size_t)blockIdx.x * 512 + threadIdx.x; i < (size_t)NREG * D; i += (size_t)gridDim.x * 512) o[i] *= sc;
        if (PROBE_B) { grid_seam(); if (blockIdx.x == 0 && threadIdx.x == 0) o[0] = (float)tb * 0.01f; }
    }
#endif
#undef IN
#undef SEAM
}

extern "C" void kernel_launch(void* const* d_in, const int* in_sizes, int n_in, void* d_out, int out_size, void* d_ws, size_t ws_size, hipStream_t stream) {
    static int grid = 0;
    if (grid == 0) {
        if (n_in != 45 || out_size != NREG * D || ws_size < WS_END) { fprintf(stderr, "kernel_launch: unexpected shapes (n_in %d out %d ws %zu need %zu)\n", n_in, out_size, ws_size, (size_t)WS_END); grid = -1; return; }
        int dev = 0, cus = 0, per_cu = 0;
        if (hipGetDevice(&dev) != hipSuccess || hipDeviceGetAttribute(&cus, hipDeviceAttributeMultiprocessorCount, dev) != hipSuccess) { grid = -1; return; }
        if (hipFuncSetAttribute((const void*)fwd_kernel, hipFuncAttributeMaxDynamicSharedMemorySize, LDS_BYTES) != hipSuccess) { fprintf(stderr, "kernel_launch: hipFuncSetAttribute failed\n"); grid = -1; return; }
        if (hipOccupancyMaxActiveBlocksPerMultiprocessor(&per_cu, (const void*)fwd_kernel, 512, LDS_BYTES) != hipSuccess || per_cu < 1) fprintf(stderr, "kernel_launch: occupancy query says %d\n", per_cu);
        (void)hipGetLastError();
        grid = cus;
    }
    if (grid < 0) return;
    (void)hipMemsetAsync((char*)d_ws + WS_CTL, 0, CTL_BYTES, stream);
    Args a{};
    for (int i = 0; i < 45; ++i) a.in[i] = (const float*)d_in[i];
    a.out = (float*)d_out; a.ws = (unsigned char*)d_ws;
#if MK_MULTI
    for (int p = 0; p < N_PHASES && p <= MK_STOP; ++p) { a.ph_lo = p; a.ph_hi = p + 1;
        if (p == DUP_PHASE) { a.dummy = 1; hipLaunchKernelGGL(fwd_kernel, dim3(grid), dim3(512), LDS_BYTES, stream, a); a.dummy = 0; }
        hipLaunchKernelGGL(fwd_kernel, dim3(grid), dim3(512), LDS_BYTES, stream, a); }
#else
    a.ph_lo = 0; a.ph_hi = N_PHASES;
    hipLaunchKernelGGL(fwd_kernel, dim3(grid), dim3(512), LDS_BYTES, stream, a);
#endif
}
```

```cpp
#include <hip/hip_runtime.h>
#include <cstdio>
#include <cstdint>

#ifndef MK_MULTI
#define MK_MULTI 0
#endif

#ifndef PROBE_A
#define PROBE_A 0ull
#define PROBE_B 0ull
#endif
#ifndef DENSE8_FROM
#define DENSE8_FROM 1
#endif
#ifndef REP_MASK
#define REP_MASK 0
#endif
#ifndef DUP_PHASE
#define DUP_PHASE -1
#endif
#ifndef MK_STOP
#define MK_STOP 1000
#endif
#define LAS __attribute__((address_space(3)))
#define GAS __attribute__((address_space(1)))
typedef unsigned short bf16_t;
typedef short bf16x8 __attribute__((ext_vector_type(8)));
typedef short s16x4 __attribute__((ext_vector_type(4)));
typedef float f32x4 __attribute__((ext_vector_type(4)));
typedef float f32x2 __attribute__((ext_vector_type(2)));
typedef unsigned u32x4 __attribute__((ext_vector_type(4)));
typedef unsigned u32x2 __attribute__((ext_vector_type(2)));
#define RLX_AGENT __ATOMIC_RELAXED, __HIP_MEMORY_SCOPE_AGENT

constexpr int D = 1024, NREG = 65536, NMETA_ROWS = 16, M = NREG + NMETA_ROWS, NPANEL = NREG / 256;
constexpr int SEQ = 2048, BATCH = 32, FF = 3584, NE = 8;
constexpr float EPS = 1e-6f;
constexpr float LOG2E = 1.4426950408889634f;
constexpr float NEGBIG = -1e30f;
constexpr float SM_SHIFT = 16.0f;

constexpr size_t WS_CTL = 0, CTL_BYTES = 8u << 20;
constexpr int CW_TMO = 0, CW_BAR = 4096, CW_CNT = 8192;
constexpr size_t CTL_SSQ = 65536;
constexpr size_t SSQ_BYTES = (size_t)M * 8;
constexpr float SSQ_SCALE = 16777216.0f, SSQ_INV = 1.0f / 16777216.0f;
typedef unsigned long long u64;
static_assert(CTL_SSQ + 9 * SSQ_BYTES <= CTL_BYTES, "ctl");
constexpr size_t W_QKV_NA = (size_t)3072 * 1024 * 2, W_O = (size_t)1024 * 1024 * 2, W_GU = (size_t)7168 * 1024 * 2, W_D = (size_t)1024 * 3584 * 2, W_QKV_SWA = (size_t)1536 * 1024 * 2;
constexpr size_t WNA_QKV = 0, WNA_O = WNA_QKV + W_QKV_NA, WNA_GU = WNA_O + W_O, WNA_D = WNA_GU + W_GU, WNA_END = WNA_D + W_D;
constexpr size_t W_GU8 = (size_t)7168 * 1024;
constexpr size_t W_D8 = (size_t)1024 * 3584;
constexpr float W8_SCALE = 64.0f, W8_INV = 1.0f / 64.0f;
constexpr float HID8_SCALE = 4.0f, HID8_INV = 0.25f;
constexpr size_t WSW_QKV = WNA_END, WSW_O = WSW_QKV + W_QKV_SWA, WSW_GU = WSW_O + W_O, WSW_D = WSW_GU + NE * W_GU8, WPAIR = WSW_D + NE * W_D8;
constexpr size_t WS_W = CTL_BYTES;
constexpr size_t WS_HB = WS_W + 2 * WPAIR;
constexpr size_t HB_BYTES = (size_t)M * D * 2;
constexpr size_t WS_HB8 = WS_HB + HB_BYTES;
constexpr size_t WS_TAB = WS_HB8 + (size_t)M * D;
constexpr size_t TAB_BYTES = (size_t)NE * M * 4;
constexpr size_t WS_R = WS_TAB + 4 * TAB_BYTES;
constexpr size_t R_Q = 0, R_K = HB_BYTES, R_VT_NA = 2 * HB_BYTES, R_VT_SWA = HB_BYTES + (size_t)M * 256 * 2;
constexpr int MOE_CH = 256, MOE_NCH = 2, MOE_CH_MAX = 264;
constexpr size_t R_YS = (size_t)MOE_CH_MAX * 256 * FF;
constexpr size_t R_DENSE = (size_t)M * FF * 2, R_MOE = R_YS + (size_t)2 * M * D * 2;
constexpr size_t R_BYTES = R_DENSE > R_MOE ? R_DENSE : R_MOE;
static_assert(3 * HB_BYTES <= R_BYTES, "R");
constexpr size_t WS_END = WS_R + R_BYTES;
static_assert(WS_END + (24u << 20) <= 1115912448ull, "d_ws budget (incl. the 24 MiB scratch window of timing experiments)");

constexpr int TAB_OFF = 131072;
constexpr int GAIN_OFF = TAB_OFF + 10240;
constexpr int MISC_OFF = 163840 - 512;
constexpr int ATT_X_OFF = 147456;
constexpr int LDS_BYTES = 163840;
static_assert(MISC_OFF + 256 <= LDS_BYTES, "lds");

__device__ __forceinline__ unsigned cvt_pk_bf16(float lo, float hi) { unsigned r; asm volatile("v_cvt_pk_bf16_f32 %0, %1, %2" : "=v"(r) : "v"(lo), "v"(hi)); return r; }
__device__ __forceinline__ float wave_sum(float v) {
#pragma unroll
    for (int o = 1; o < 64; o <<= 1) v += __shfl_xor(v, o);
    return v;
}
__device__ __forceinline__ float fast_rsqrt(float x) { return __builtin_amdgcn_rsqf(x); }
__device__ __forceinline__ float fast_exp2(float x) { return __builtin_amdgcn_exp2f(x); }
__device__ __forceinline__ float fast_rcp(float x) { return __builtin_amdgcn_rcpf(x); }
__device__ __forceinline__ float silu_f(float x) { return x * fast_rcp(1.0f + fast_exp2(-x * LOG2E)); }

#define XB_TMO      128
#define XB_XCNT(j)  (256  + 64 * (j))
#define XB_XSUB(j)  (1280 + 64 * (j))
#define XB_XGEN(j)  (2304 + 64 * (j))
#define XB_TOP      3328
#define XB_TOPGEN   3392
#define XCD_BAR_WORDS 3456
#define XB_SPIN_CAP (1u << 18)
template <class T> __device__ __forceinline__ unsigned xb_ld(T* p)              { return __hip_atomic_load(p, __ATOMIC_RELAXED, __HIP_MEMORY_SCOPE_AGENT); }
template <class T> __device__ __forceinline__ unsigned xb_add(T* p, unsigned v) { return __hip_atomic_fetch_add(p, v, __ATOMIC_RELAXED, __HIP_MEMORY_SCOPE_AGENT); }
__device__ __forceinline__ unsigned xb_xcc_id() { return (unsigned)__builtin_amdgcn_s_getreg((3 << 11) | 20) & 0xFu; }
#define XB_SPIN(cond, bar) do { unsigned _sp = 0; while (cond) { __builtin_amdgcn_s_sleep(1); \
    if ((++_sp & 255u) == 0u) { if (xb_ld(&(bar)[XB_TMO])) break; if (_sp > XB_SPIN_CAP) { xb_add(&(bar)[XB_TMO], 1u); break; } } } } while (0)
struct XcdBarrier { unsigned* bar; unsigned x; volatile LAS unsigned* st; };
__device__ __forceinline__ XcdBarrier xcd_barrier_post(unsigned* bar, volatile LAS unsigned* st) {
    XcdBarrier b; b.bar = bar; b.x = xb_xcc_id(); b.st = st;
    if (threadIdx.x == 0) (void)xb_add(&bar[XB_XCNT(b.x)], 1u);
    return b;
}
__device__ __forceinline__ void xcd_barrier_complete(GAS unsigned* bar, unsigned x, unsigned& nloc, unsigned& nx) {
    const unsigned G = gridDim.x * gridDim.y * gridDim.z;
    unsigned sum, cnt, mine, sp = 0u;
    for (;;) {
        sum = 0u; cnt = 0u; mine = 0u;
#pragma unroll
        for (unsigned j = 0; j < 16; ++j) { const unsigned c = xb_ld(&bar[XB_XCNT(j)]); sum += c; cnt += (c > 0u) ? 1u : 0u; mine = (j == x) ? c : mine; }
        if (sum == G) break;
        __builtin_amdgcn_s_sleep(1);
        if ((++sp & 255u) == 0u) { if (xb_ld(&bar[XB_TMO])) break; if (sp > XB_SPIN_CAP) { xb_add(&bar[XB_TMO], 1u); break; } }
    }
    nloc = mine > 0u ? mine : 1u; nx = cnt > 0u ? cnt : 1u;
}
__device__ __noinline__ void xcd_barrier_leader(GAS unsigned* bar, unsigned x, volatile LAS unsigned* st) {
    __builtin_amdgcn_s_waitcnt(0);
    unsigned nloc = st[0], nx = st[1];
    if (nloc == 0u) { xcd_barrier_complete(bar, x, nloc, nx); st[0] = nloc; st[1] = nx; }
    const unsigned old = xb_add(&bar[XB_XSUB(x)], 1u);
    const unsigned gen = old / nloc;
    if (old + 1u == (gen + 1u) * nloc) {
        __builtin_amdgcn_fence(__ATOMIC_RELEASE, "agent");
        asm volatile("s_waitcnt vmcnt(0)" ::: "memory");
        const unsigned og = xb_add(&bar[XB_TOP], 1u);
        const unsigned tg = og / nx;
        if (og + 1u == (tg + 1u) * nx) xb_add(&bar[XB_TOPGEN], 1u);
        else XB_SPIN(xb_ld(&bar[XB_TOPGEN]) == tg, bar);
        __builtin_amdgcn_fence(__ATOMIC_ACQUIRE, "agent");
        xb_add(&bar[XB_XGEN(x)], 1u);
        asm volatile("s_waitcnt vmcnt(0)" ::: "memory");
    } else {
        XB_SPIN(xb_ld(&bar[XB_XGEN(x)]) == gen, bar);
        __builtin_amdgcn_fence(__ATOMIC_ACQUIRE, "agent");
        asm volatile("s_waitcnt vmcnt(0)" ::: "memory");
    }
}
__device__ __forceinline__ void xcd_barrier(const XcdBarrier& b) {
    asm volatile("s_waitcnt vmcnt(0)" ::: "memory");
    __syncthreads();
    if (threadIdx.x == 0) xcd_barrier_leader((GAS unsigned*)b.bar, b.x, b.st);
    __syncthreads();
}

namespace pg8 {
constexpr int BM = 256, BK = 64, HALF = 128, HTB = HALF * BK * 2, NXCD = 8, WGM = 8;
__host__ __device__ __forceinline__ int lds_byte(int r, int c) { const int st = (r >> 4) * 2 + (c >> 5), rr = r & 15, cc = c & 31, ob = rr * 64 + cc * 2; return st * 1024 + (ob ^ (((ob >> 9) & 1) << 5)); }
__host__ __device__ __forceinline__ void stage_rc(int b, int& R, int& C) { const int st = b / 1024, sb = b % 1024, swz = sb ^ (((sb >> 9) & 1) << 5); R = (st >> 1) * 16 + swz / 64; C = (st & 1) * 32 + (swz % 64) / 2; }
struct Unit { const char* A; const char* B; int pm, pn, kind, aux, aux2; };
__device__ __forceinline__ void tile_of(int L, int nM, int nN, int& pm, int& pn) {
    const int nwg = nM * nN; int wgid = L; { const int q = nwg / NXCD, r = nwg % NXCD, xcd = wgid % NXCD, off = wgid / NXCD; wgid = (xcd < r ? xcd * (q + 1) : r * (q + 1) + (xcd - r) * q) + off; }
    const int nig = WGM * nN, gid = wgid / nig, fm = gid * WGM, gsz = (nM - fm) < WGM ? (nM - fm) : WGM;
    pm = fm + ((wgid % nig) % gsz); pn = (wgid % nig) / gsz;
}
__device__ __forceinline__ void dma4(const void* g, LAS void* l) { __builtin_amdgcn_global_load_lds((const unsigned*)g, (LAS unsigned*)l, 4, 0, 0); }
typedef int v8i __attribute__((ext_vector_type(8)));
typedef int v4i __attribute__((ext_vector_type(4)));
__device__ __forceinline__ v8i cat8(bf16x8 lo, bf16x8 hi) { const v4i a = __builtin_bit_cast(v4i, lo), b = __builtin_bit_cast(v4i, hi); return __builtin_shufflevector(a, b, 0, 1, 2, 3, 4, 5, 6, 7); }

template <class P>
__device__ __forceinline__ void gemm_phase(LAS unsigned char* lds, LAS unsigned char* tab, const P& S) {
    int tid_l = threadIdx.x; asm volatile("" : "+v"(tid_l));
    const int tid = tid_l, wid = __builtin_amdgcn_readfirstlane(tid >> 6), lane = tid & 63, wr = wid >> 2, wc = wid & 3, fr = lane & 15, fq = lane >> 4;
    const int nt = S.nt;
    int Rr[2], Cc[2];
#pragma unroll
    for (int i = 0; i < 2; ++i) stage_rc(tid * 16 + i * 8192, Rr[i], Cc[i]);
    unsigned voffB[2], voffA[2][2];
#pragma unroll
    for (int i = 0; i < 2; ++i) { voffB[i] = (unsigned)Rr[i] * S.pitchB + (unsigned)Cc[i] * 2u;
#pragma unroll
        for (int h = 0; h < 2; ++h) voffA[h][i] = (unsigned)(HALF * h + Rr[i]) * S.pitchA + (unsigned)Cc[i] * 2u; }
    const size_t kstep = (size_t)(BK * 2);
    const size_t hstepB = (size_t)HALF * S.pitchB;
    const unsigned ldsw = (unsigned)wid * 1024u;
    constexpr int FSTEP = 8, KOFF = 1024;
    const int aoff = lds_byte(wr * 64 + fr, fq * FSTEP), boff = lds_byte(wc * 32 + fr, fq * FSTEP);
    LAS unsigned* idtab = (LAS unsigned*)tab;
#define PG8_SA(b, h) (((b) * 2 + (h)) * HTB)
#define PG8_SB(b, h) ((4 + (b) * 2 + (h)) * HTB)
#define PG8_STAGE(bufoff, gbase, voff) do { _Pragma("unroll") for (int _i = 0; _i < 2; ++_i) { unsigned _vo = (voff)[_i]; asm volatile("" : "+v"(_vo)); \
        __builtin_amdgcn_global_load_lds((const unsigned*)((const char*)(gbase) + _vo), (LAS unsigned*)(lds + (bufoff) + ldsw + _i * 8192), 16, 0, 0); } } while (0)
#define PG8_LDA(dst, b, h) do { _Pragma("unroll") for (int m = 0; m < 4; ++m) _Pragma("unroll") for (int k = 0; k < 2; ++k) dst[m][k] = *(const LAS bf16x8*)(lds + PG8_SA(b, h) + aoff + m * 2048 + k * KOFF); } while (0)
#define PG8_LDB(dst, b, h) do { _Pragma("unroll") for (int n = 0; n < 2; ++n) _Pragma("unroll") for (int k = 0; k < 2; ++k) dst[n][k] = *(const LAS bf16x8*)(lds + PG8_SB(b, h) + boff + n * 2048 + k * KOFF); } while (0)
#define PG8_MMA(ai, bj, At, Bt) do { __builtin_amdgcn_s_setprio(1); _Pragma("unroll") for (int m = 0; m < 4; ++m) _Pragma("unroll") for (int n = 0; n < 2; ++n) { \
        if constexpr (P::FP8) acc[ai][bj][m][n] = __builtin_amdgcn_mfma_scale_f32_16x16x128_f8f6f4(pg8::cat8(Bt[n][0], Bt[n][1]), pg8::cat8(At[m][0], At[m][1]), acc[ai][bj][m][n], 0, 0, 0, 0, 0, 0); \
        else { _Pragma("unroll") for (int k = 0; k < 2; ++k) acc[ai][bj][m][n] = __builtin_amdgcn_mfma_f32_16x16x32_bf16(Bt[n][k], At[m][k], acc[ai][bj][m][n], 0, 0, 0); } } \
        __builtin_amdgcn_s_setprio(0); } while (0)
#define PG8_WAIT_V(n) asm volatile("s_waitcnt vmcnt(" #n ")" ::: "memory")
#define PG8_WAIT_L(n) asm volatile("s_waitcnt lgkmcnt(" #n ")" ::: "memory")
#define PG8_BAR __builtin_amdgcn_s_barrier()
#define PG8_SCHED __builtin_amdgcn_sched_barrier(0)
    LAS unsigned* ulist = (LAS unsigned*)(tab + 12288);
    if (tid < 32) { Unit t_; t_.A = nullptr; t_.B = nullptr; t_.pm = t_.pn = t_.kind = t_.aux = t_.aux2 = 0; const bool ok_ = S.next(tid, t_);
        LAS unsigned* e_ = ulist + tid * 12; const u64 a_ = (u64)(size_t)t_.A, b_ = (u64)(size_t)t_.B;
        e_[0] = ok_ ? 1u : 0u; e_[1] = (unsigned)t_.pm; e_[2] = (unsigned)t_.pn; e_[3] = (unsigned)t_.kind; e_[4] = (unsigned)t_.aux; e_[5] = (unsigned)t_.aux2;
        e_[6] = (unsigned)a_; e_[7] = (unsigned)(a_ >> 32); e_[8] = (unsigned)b_; e_[9] = (unsigned)(b_ >> 32); }
    asm volatile("s_waitcnt lgkmcnt(0)" ::: "memory"); __builtin_amdgcn_s_barrier(); asm volatile("" ::: "memory");
#define PG8_FETCH(i_, u_, ok_) do { const LAS u32x4* e4_ = (const LAS u32x4*)(ulist + (i_) * 12); const u32x4 x0_ = e4_[0], x1_ = e4_[1], x2_ = e4_[2]; \
        (ok_) = __builtin_amdgcn_readfirstlane(x0_.x) != 0; (u_).pm = __builtin_amdgcn_readfirstlane(x0_.y); (u_).pn = __builtin_amdgcn_readfirstlane(x0_.z); (u_).kind = __builtin_amdgcn_readfirstlane(x0_.w); \
        (u_).aux = __builtin_amdgcn_readfirstlane(x1_.x); (u_).aux2 = __builtin_amdgcn_readfirstlane(x1_.y); \
        (u_).A = (const char*)(size_t)(((u64)(unsigned)__builtin_amdgcn_readfirstlane(x1_.w) << 32) | (unsigned)__builtin_amdgcn_readfirstlane(x1_.z)); \
        (u_).B = (const char*)(size_t)(((u64)(unsigned)__builtin_amdgcn_readfirstlane(x2_.y) << 32) | (unsigned)__builtin_amdgcn_readfirstlane(x2_.x)); } while (0)
    Unit cur, nxt; int ui = 0;
    { bool ok0; PG8_FETCH(0, cur, ok0); if (!ok0) return; }
    f32x4 acc[2][2][4][2];
#pragma unroll
    for (int a = 0; a < 2; ++a)
#pragma unroll
        for (int b = 0; b < 2; ++b)
#pragma unroll
            for (int m = 0; m < 4; ++m)
#pragma unroll
                for (int n = 0; n < 2; ++n) acc[a][b][m][n] = (f32x4){0.f, 0.f, 0.f, 0.f};
    bf16x8 At[4][2], B0[2][2], B1[2][2];
    const char* cA = cur.A; const char* cB = cur.B;
    if constexpr (P::GATHER) {
        if (wid < 4) dma4(S.id_src(cur, wid * 64 + lane), idtab + wid * 64);
        PG8_WAIT_V(0); PG8_BAR; asm volatile("" ::: "memory");
#pragma unroll
        for (int h = 0; h < 2; ++h)
#pragma unroll
            for (int i = 0; i < 2; ++i) voffA[h][i] = idtab[HALF * h + Rr[i]] * S.pitchA + (unsigned)Cc[i] * 2u;
        PG8_WAIT_L(0); asm volatile("" ::: "memory");
    }
    PG8_STAGE(PG8_SB(0, 0), cB, voffB); PG8_STAGE(PG8_SB(0, 1), cB + hstepB, voffB); PG8_STAGE(PG8_SA(0, 0), cA, voffA[0]); PG8_STAGE(PG8_SA(0, 1), cA, voffA[1]);
    if (wr == 1) PG8_BAR;
    PG8_WAIT_V(2); PG8_BAR;
    PG8_STAGE(PG8_SB(1, 0), cB + kstep, voffB); PG8_STAGE(PG8_SA(1, 0), cA + kstep, voffA[0]); PG8_STAGE(PG8_SB(1, 1), cB + hstepB + kstep, voffB);
    PG8_WAIT_V(6); PG8_BAR;
    for (;;) {
        bool has_next; PG8_FETCH(ui + 1, nxt, has_next);
        const int slot = ui & 1;
        S.dma_tables(cur, tab, slot, wid, lane);
        if constexpr (P::GATHER) { if (has_next && wid < 4) dma4(S.id_src(nxt, wid * 64 + lane), idtab + (slot ^ 1) * 256 + wid * 64); }
        const char* nA = has_next ? nxt.A : cA; const char* nB = has_next ? nxt.B : cB;
        for (int t = 0; t < nt; t += 2) {
            const bool last = (t == nt - 2);
            const char* a1 = cA + (size_t)(t + 1) * kstep;
            const char* a2 = last ? nA : cA + (size_t)(t + 2) * kstep; const char* b2 = last ? nB : cB + (size_t)(t + 2) * kstep;
            const char* a3 = a2 + kstep; const char* b3 = b2 + kstep;
            PG8_LDB(B0, 0, 0); PG8_LDB(B1, 0, 1); PG8_SCHED; PG8_LDA(At, 0, 0); PG8_STAGE(PG8_SA(1, 1), a1, voffA[1]);
            if constexpr (!P::GATHER && P::FP8) { if (last && has_next) asm volatile("s_nop 0"); }
            if constexpr (P::GATHER) {
                if (last && has_next) {
                    int t2 = tid; asm volatile("" : "+v"(t2));
#pragma unroll
                    for (int i = 0; i < 2; ++i) { int R2, C2; stage_rc(t2 * 16 + i * 8192, R2, C2);
#pragma unroll
                        for (int h = 0; h < 2; ++h) voffA[h][i] = idtab[(slot ^ 1) * 256 + HALF * h + R2] * S.pitchA + (unsigned)C2 * 2u; }
                }
            }
            PG8_WAIT_V(8); PG8_WAIT_L(0); PG8_BAR; PG8_MMA(0, 0, At, B0); PG8_MMA(0, 1, At, B1); PG8_BAR; PG8_SCHED;
            PG8_LDA(At, 0, 1); PG8_STAGE(PG8_SB(0, 0), b2, voffB); PG8_STAGE(PG8_SB(0, 1), b2 + hstepB, voffB); PG8_STAGE(PG8_SA(0, 0), a2, voffA[0]);
            PG8_WAIT_V(8); PG8_WAIT_L(0); PG8_BAR; PG8_MMA(1, 0, At, B0); PG8_MMA(1, 1, At, B1); PG8_BAR; PG8_SCHED;
            PG8_LDB(B0, 1, 0); PG8_LDB(B1, 1, 1); PG8_SCHED; PG8_LDA(At, 1, 0); PG8_STAGE(PG8_SA(0, 1), a2, voffA[1]);
            PG8_WAIT_V(8); PG8_WAIT_L(0); PG8_BAR; PG8_MMA(0, 0, At, B0); PG8_MMA(0, 1, At, B1); PG8_BAR; PG8_SCHED;
            PG8_LDA(At, 1, 1); PG8_STAGE(PG8_SB(1, 0), b3, voffB); PG8_STAGE(PG8_SB(1, 1), b3 + hstepB, voffB); PG8_STAGE(PG8_SA(1, 0), a3, voffA[0]);
            PG8_WAIT_V(8); PG8_WAIT_L(0); PG8_BAR; PG8_MMA(1, 0, At, B0); PG8_MMA(1, 1, At, B1); PG8_BAR; PG8_SCHED;
        }
        if constexpr (P::ALIGN) { if (wr == 0) PG8_BAR; }
        S.epi(acc, cur, tab, slot, wr, wc, fr, fq);
        if (!has_next) break;
#pragma unroll
        for (int a = 0; a < 2; ++a)
#pragma unroll
            for (int b = 0; b < 2; ++b)
#pragma unroll
                for (int m = 0; m < 4; ++m)
#pragma unroll
                    for (int n = 0; n < 2; ++n) acc[a][b][m][n] = (f32x4){0.f, 0.f, 0.f, 0.f};
        cur = nxt; cA = nA; cB = nB; ++ui;
        if constexpr (P::ALIGN) { if (wr == 1) PG8_BAR; }
    }
    PG8_WAIT_V(0);
    if constexpr (!P::ALIGN) { if (wr == 0) PG8_BAR; }
    PG8_BAR;
#undef PG8_FETCH
#undef PG8_SA
#undef PG8_SB
#undef PG8_STAGE
#undef PG8_LDA
#undef PG8_LDB
#undef PG8_MMA
#undef PG8_WAIT_V
#undef PG8_WAIT_L
#undef PG8_BAR
#undef PG8_SCHED
}
}
#ifndef ALIGN_LIGHT
#define ALIGN_LIGHT true
#endif
using pg8::Unit;
typedef f32x4 Acc[2][2][4][2];

struct Args { const float* in[45]; float* out; unsigned char* ws; int ph_lo, ph_hi, dummy, pad; };
enum { I_X = 0, I_META = 1, I_T5 = 2, I_L0 = 3, I_L1 = 13, I_L2 = 24, I_L3 = 34 };

struct Frame {
    LAS unsigned char* lds; LAS unsigned char* tab;
    int tid, lane, wave, G, bx;
    unsigned char* ws; float* out; bf16_t* hb; unsigned* ctl;
};
__device__ __forceinline__ u64* ssq_buf(const Frame& F, int i) { return (u64*)(F.ws + WS_CTL + CTL_SSQ + (size_t)i * SSQ_BYTES); }
__device__ __forceinline__ u64 ssq_fix(float s) { return (u64)(s * SSQ_SCALE); }
__device__ __forceinline__ float ssq_val(u64 v) { return (float)v * SSQ_INV; }

struct QkvPolicy {
    static constexpr bool GATHER = false, ALIGN = ALIGN_LIGHT, FP8 = false;
    int nt; unsigned pitchA, pitchB;
    int G, c, nN, QT;
    const char* hb; const char* W;
    const u64* ssq;
    bf16_t* Q; bf16_t* K; bf16_t* VT; int kpitch, nQ;
    const LAS float* gains;
    __device__ __forceinline__ bool next(int i, Unit& u) const {
        const long L = (long)i * G + c; if (L >= (long)NPANEL * nN) return false;
        int pm, pn; pg8::tile_of((int)L, NPANEL, nN, pm, pn);
        u.pm = pm; u.pn = pn; u.kind = pn < QT ? 0 : 1; u.aux = 0; u.aux2 = 0;
        const char* a = hb + (size_t)pm * 256 * 2048; const char* w = W + (size_t)pn * 256 * 2048;
        u.A = u.kind ? w : a; u.B = u.kind ? a : w; return true;
    }
    __device__ __forceinline__ void dma_tables(const Unit& u, LAS unsigned char* tab, int slot, int wid, int lane) const {
        pg8::dma4((const unsigned*)(ssq + u.pm * 256) + wid * 64 + lane, (LAS unsigned*)(tab + 2048) + slot * 512 + wid * 64);
    }
    __device__ __forceinline__ void epi(const Acc& acc, const Unit& u, LAS unsigned char* tab, int slot, int wr, int wc, int fr, int fq) const {
        const LAS u64* et = (const LAS u64*)(tab + 2048) + slot * 256;
        if (u.kind == 0) {
            const bool isq = u.pn < nQ;
            const LAS float* gp = gains + (isq ? 0 : 64) + 8 * fq;
            const f32x4 g00 = *(const LAS f32x4*)(gp), g01 = *(const LAS f32x4*)(gp + 4), g10 = *(const LAS f32x4*)(gp + 32), g11 = *(const LAS f32x4*)(gp + 36);
            const int hk = (u.pn - nQ) * 4 + wc, nhk = kpitch >> 6;
#pragma unroll
            for (int ai = 0; ai < 2; ++ai)
#pragma unroll
                for (int m = 0; m < 4; ++m) {
                    const int row = ai * 128 + wr * 64 + m * 16 + fr;
                    const float rstd = fast_rsqrt(ssq_val(et[row]) * (1.0f / 1024.0f) + EPS);
                    f32x4 v00 = acc[ai][0][m][0] * rstd, v01 = acc[ai][0][m][1] * rstd, v10 = acc[ai][1][m][0] * rstd, v11 = acc[ai][1][m][1] * rstd;
                    const f32x4 sq4 = v00 * v00 + v01 * v01 + v10 * v10 + v11 * v11;
                    float ss = (sq4[0] + sq4[1]) + (sq4[2] + sq4[3]);
                    ss += __shfl_xor(ss, 16); ss += __shfl_xor(ss, 32);
                    const float hn = fast_rsqrt(ss * (1.0f / 64.0f) + EPS);
                    v00 = v00 * g00 * hn; v01 = v01 * g01 * hn; v10 = v10 * g10 * hn; v11 = v11 * g11 * hn;
                    const int tok = u.pm * 256 + row;
                    bf16_t* rp = isq ? Q + (size_t)tok * 1024 + (u.pn * 4 + wc) * 64 + 8 * fq
                                     : K + ((((size_t)(tok >> 3) * nhk + hk) * 2) * 4 + fq) * 64 + (tok & 7) * 8;
                    const int o1 = isq ? 32 : 256;
                    u32x4 w0; w0.x = cvt_pk_bf16(v00[0], v00[1]); w0.y = cvt_pk_bf16(v00[2], v00[3]); w0.z = cvt_pk_bf16(v01[0], v01[1]); w0.w = cvt_pk_bf16(v01[2], v01[3]);
                    u32x4 w1; w1.x = cvt_pk_bf16(v10[0], v10[1]); w1.y = cvt_pk_bf16(v10[2], v10[3]); w1.z = cvt_pk_bf16(v11[0], v11[1]); w1.w = cvt_pk_bf16(v11[2], v11[3]);
                    *(u32x4*)(rp) = w0; *(u32x4*)(rp + o1) = w1;
                }
        } else {
            f32x4 rs[2][2];
#pragma unroll
            for (int bj = 0; bj < 2; ++bj)
#pragma unroll
                for (int n = 0; n < 2; ++n) {
#pragma unroll
                    for (int j = 0; j < 4; ++j) rs[bj][n][j] = fast_rsqrt(ssq_val(et[bj * 128 + wc * 32 + n * 16 + 4 * fq + j]) * (1.0f / 1024.0f) + EPS); }
#pragma unroll
            for (int ai = 0; ai < 2; ++ai)
#pragma unroll
                for (int m = 0; m < 4; ++m) {
                    const int hd = (u.pn - QT) * 256 + ai * 128 + wr * 64 + m * 16 + fr, hk = hd >> 6, d = hd & 63, nhk = kpitch >> 6;
#pragma unroll
                    for (int bj = 0; bj < 2; ++bj)
#pragma unroll
                        for (int n = 0; n < 2; ++n) { const f32x4 v = acc[ai][bj][m][n] * rs[bj][n]; u32x2 w; w.x = cvt_pk_bf16(v[0], v[1]); w.y = cvt_pk_bf16(v[2], v[3]);
                            const int c0 = u.pm * 256 + bj * 128 + wc * 32 + n * 16 + 4 * fq;
                            *(u32x2*)(VT + ((size_t)(c0 >> 3) * nhk + hk) * 512 + (((d >> 4) * 2 + ((c0 >> 2) & 1)) * 16 + (d & 15)) * 4) = w; }
                }
        }
    }
};

template <bool F8 = false>
struct ResPolicy {
    static constexpr bool GATHER = false, ALIGN = true, FP8 = F8;
    int nt; unsigned pitchA, pitchB;
    int G, c;
    const char* A; const char* W;
    bf16_t* hb; u64* ssq_out; bf16_t* dmy;
    unsigned char* hb8;
    __device__ __forceinline__ bool next(int i, Unit& u) const {
        const long L = (long)i * G + c; if (L >= (long)NPANEL * 4) return false;
        int pm, pn; pg8::tile_of((int)L, NPANEL, 4, pm, pn);
        u.pm = pm; u.pn = pn; u.kind = 0; u.aux = 0; u.aux2 = 0;
        u.A = A + (size_t)pm * 256 * pitchA; u.B = W + (size_t)pn * 256 * pitchB; return true;
    }
    __device__ __forceinline__ void dma_tables(const Unit&, LAS unsigned char*, int, int, int) const {}
    __device__ __forceinline__ void epi(const Acc& acc, const Unit& u, LAS unsigned char*, int, int wr, int wc, int fr, int fq) const {
        const int col = u.pn * 256 + wc * 32 + 8 * fq;
#pragma unroll
        for (int ai = 0; ai < 2; ++ai) {
            u32x4 bv[4][2];
#pragma unroll
            for (int m = 0; m < 4; ++m) { const bf16_t* bp = hb + (size_t)(u.pm * 256 + ai * 128 + wr * 64 + m * 16 + fr) * D + col;
#pragma unroll
                for (int bj = 0; bj < 2; ++bj) bv[m][bj] = *(const u32x4*)(bp + bj * 128); }
            __builtin_amdgcn_sched_barrier(0);
#pragma unroll
            for (int m = 0; m < 4; ++m) {
                const int row = u.pm * 256 + ai * 128 + wr * 64 + m * 16 + fr;
                bf16_t* hp = (dmy ? dmy + (size_t)(row & 0xFFF) * D : hb + (size_t)row * D) + col;
                f32x2 ss2 = {0.f, 0.f};
#pragma unroll
                for (int bj = 0; bj < 2; ++bj) {
                    const u32x4 b = bv[m][bj]; const f32x4 a0 = acc[ai][bj][m][0], a1 = acc[ai][bj][m][1];
                    const unsigned bw[4] = {b.x, b.y, b.z, b.w}; const f32x2 av[4] = {{a0[0], a0[1]}, {a0[2], a0[3]}, {a1[0], a1[1]}, {a1[2], a1[3]}};
                    f32x2 o[4]; u32x4 w; unsigned* wp = (unsigned*)&w;
#pragma unroll
                    for (int i = 0; i < 4; ++i) { const f32x2 hv = {__uint_as_float(bw[i] << 16), __uint_as_float(bw[i] & 0xffff0000u)}; if constexpr (F8) o[i] = hv + av[i] * (W8_INV * HID8_INV); else o[i] = hv + av[i]; ss2 = ss2 + o[i] * o[i]; wp[i] = cvt_pk_bf16(o[i].x, o[i].y); }
                    *(u32x4*)(hp + bj * 128) = w;
                    if (hb8) { int p0 = 0, p1 = 0; p0 = __builtin_amdgcn_cvt_pk_fp8_f32(o[0].x, o[0].y, p0, false); p0 = __builtin_amdgcn_cvt_pk_fp8_f32(o[1].x, o[1].y, p0, true); p1 = __builtin_amdgcn_cvt_pk_fp8_f32(o[2].x, o[2].y, p1, false); p1 = __builtin_amdgcn_cvt_pk_fp8_f32(o[3].x, o[3].y, p1, true);
                        u32x2 w8; w8.x = (unsigned)p0; w8.y = (unsigned)p1; *(u32x2*)(hb8 + (size_t)row * D + col + bj * 128) = w8; }
                }
                float ss = ss2.x + ss2.y;
                ss += __shfl_xor(ss, 16); ss += __shfl_xor(ss, 32);
                if (fq == 0) __hip_atomic_fetch_add(ssq_out + row, ssq_fix(ss), RLX_AGENT);
            }
            __builtin_amdgcn_sched_barrier(0);
        }
    }
};

template <bool MOE, bool F8 = MOE>
struct GuPolicy {
    static constexpr bool GATHER = MOE, ALIGN = ALIGN_LIGHT, FP8 = F8;
    int nt; unsigned pitchA, pitchB;
    int G, c;
    const char* hb; const char* W;
    const void* ssq;
    bf16_t* hid;
    const unsigned* rowtok; int p0, p1;
    const LAS int* ptab;
    __device__ __forceinline__ bool next(int i, Unit& u) const {
        const long L = (long)i * G + c;
        if constexpr (!MOE) {
            if (L >= (long)NPANEL * 28) return false;
            int pm, pn; pg8::tile_of((int)L, NPANEL, 28, pm, pn);
            u.pm = pm; u.pn = pn; u.kind = 0; u.aux = 0; u.aux2 = 0;
            u.A = hb + (size_t)pm * 256 * pitchA; u.B = W + (size_t)pn * 256 * pitchB; return true;
        } else {
            const int nM = p1 - p0; if (L >= (long)nM * 28) return false;
            int pm, pn; pg8::tile_of((int)L, nM, 28, pm, pn);
            const int p = p0 + pm; int e = 0;
#pragma unroll
            for (int k = 1; k <= 7; ++k) e += (p >= ptab[k]) ? 1 : 0;
            const int pbe = ptab[e], ce = ptab[9 + e];
            u.pm = pm; u.pn = pn; u.kind = e; u.aux = (p - pbe) * 256; u.aux2 = ce;
            u.A = hb; u.B = W + (size_t)e * W_GU8 + (size_t)pn * 256 * 1024; return true;
        }
    }
    __device__ __forceinline__ const unsigned* id_src(const Unit& u, int i) const { int r = u.aux + i; r = r < u.aux2 ? r : u.aux2 - 1; return rowtok + (size_t)u.kind * M + r; }
    __device__ __forceinline__ void dma_tables(const Unit& u, LAS unsigned char* tab, int slot, int wid, int lane) const {
        if constexpr (!MOE) pg8::dma4((const unsigned*)((const u64*)ssq + u.pm * 256) + wid * 64 + lane, (LAS unsigned*)(tab + 2048) + slot * 512 + wid * 64);
        else if (wid >= 4) { int r = u.aux + (wid - 4) * 64 + lane; r = r < u.aux2 ? r : u.aux2 - 1; pg8::dma4((const float*)ssq + (size_t)u.kind * M + r, (LAS float*)(tab + 2048) + slot * 256 + (wid - 4) * 64); }
    }
    __device__ __forceinline__ void epi(const Acc& acc, const Unit& u, LAS unsigned char* tab, int slot, int wr, int wc, int fr, int fq) const {
#pragma unroll
        for (int ai = 0; ai < 2; ++ai)
#pragma unroll
            for (int m = 0; m < 4; ++m) {
                const int row = ai * 128 + wr * 64 + m * 16 + fr;
                float sq;
                if constexpr (MOE) sq = ((const LAS float*)(tab + 2048) + slot * 256)[row]; else sq = ssq_val(((const LAS u64*)(tab + 2048) + slot * 256)[row]);
                const float rstd = fast_rsqrt(sq * (1.0f / 1024.0f) + EPS);
                const float rs_ = F8 ? rstd * W8_INV : rstd;
                const float c1 = -rs_ * LOG2E;
                const float kk = (sq * (1.0f / 1024.0f) + EPS) * (F8 ? W8_SCALE * W8_SCALE * HID8_INV : 1.0f);
                float o[8];
#pragma unroll
                for (int n = 0; n < 2; ++n)
#pragma unroll
                    for (int j = 0; j < 4; j += 2) {
                        const f32x2 g = {acc[ai][0][m][n][j], acc[ai][0][m][n][j + 1]}, up = {acc[ai][1][m][n][j], acc[ai][1][m][n][j + 1]};
                        const f32x2 t = g * c1; f32x2 e; e.x = fast_exp2(t.x); e.y = fast_exp2(t.y);
                        const f32x2 kk2 = {kk, kk}; const f32x2 d = e * kk2 + kk2; f32x2 r; r.x = fast_rcp(d.x); r.y = fast_rcp(d.y);
                        const f32x2 v = (g * up) * r;
                        o[n * 4 + j] = v.x; o[n * 4 + j + 1] = v.y; }
                if constexpr (F8) {
                    int q0 = 0, q1 = 0; q0 = __builtin_amdgcn_cvt_pk_fp8_f32(o[0], o[1], q0, false); q0 = __builtin_amdgcn_cvt_pk_fp8_f32(o[2], o[3], q0, true); q1 = __builtin_amdgcn_cvt_pk_fp8_f32(o[4], o[5], q1, false); q1 = __builtin_amdgcn_cvt_pk_fp8_f32(o[6], o[7], q1, true);
                    u32x2 w8; w8.x = (unsigned)q0; w8.y = (unsigned)q1;
                    *(u32x2*)((unsigned char*)hid + (size_t)(u.pm * 256 + row) * FF + u.pn * 128 + wc * 32 + 8 * fq) = w8;
                } else {
                u32x4 w; w.x = cvt_pk_bf16(o[0], o[1]); w.y = cvt_pk_bf16(o[2], o[3]); w.z = cvt_pk_bf16(o[4], o[5]); w.w = cvt_pk_bf16(o[6], o[7]);
                *(u32x4*)(hid + (size_t)(u.pm * 256 + row) * FF + u.pn * 128 + wc * 32 + 8 * fq) = w; }
            }
    }
};

struct MoeDownPolicy {
    static constexpr bool GATHER = false, ALIGN = ALIGN_LIGHT, FP8 = true;
    int nt; unsigned pitchA, pitchB;
    int G, c;
    const char* hid; const char* W;
    const unsigned* rowslot; const float* rowgate; bf16_t* ys;
    int p0, p1; const LAS int* ptab;
    __device__ __forceinline__ bool next(int i, Unit& u) const {
        const long L = (long)i * G + c; const int nM = p1 - p0; if (L >= (long)nM * 4) return false;
        int pm, pn; pg8::tile_of((int)L, nM, 4, pm, pn);
        const int p = p0 + pm; int e = 0;
#pragma unroll
        for (int k = 1; k <= 7; ++k) e += (p >= ptab[k]) ? 1 : 0;
        const int pbe = ptab[e], ce = ptab[9 + e];
        u.pm = pm; u.pn = pn; u.kind = e; u.aux = (p - pbe) * 256; u.aux2 = ce;
        u.A = hid + (size_t)pm * 256 * pitchA; u.B = W + (size_t)e * W_D8 + (size_t)pn * 256 * pitchB; return true;
    }
    __device__ __forceinline__ void dma_tables(const Unit& u, LAS unsigned char* tab, int slot, int wid, int lane) const {
        int r = u.aux + (wid & 3) * 64 + lane; r = r < u.aux2 ? r : u.aux2 - 1;
        if (wid < 4) pg8::dma4(rowslot + (size_t)u.kind * M + r, (LAS unsigned*)(tab + 6144) + slot * 256 + wid * 64);
        else pg8::dma4(rowgate + (size_t)u.kind * M + r, (LAS float*)(tab + 8192) + slot * 256 + (wid - 4) * 64);
    }
    __device__ __forceinline__ void epi(const Acc& acc, const Unit& u, LAS unsigned char* tab, int slot, int wr, int wc, int fr, int fq) const {
        const LAS unsigned* es = (const LAS unsigned*)(tab + 6144) + slot * 256;
        const LAS float* eg = (const LAS float*)(tab + 8192) + slot * 256;
#pragma unroll
        for (int ai = 0; ai < 2; ++ai)
#pragma unroll
            for (int m = 0; m < 4; ++m) {
                const int row = ai * 128 + wr * 64 + m * 16 + fr;
                if (u.aux + row < u.aux2) {
                    const unsigned sl = es[row]; const float g = eg[row] * (W8_INV * HID8_INV);
                    bf16_t* rp = ys + (size_t)sl * D + u.pn * 256 + wc * 32 + 8 * fq;
#pragma unroll
                    for (int bj = 0; bj < 2; ++bj) { const f32x4 v0 = acc[ai][bj][m][0] * g, v1 = acc[ai][bj][m][1] * g;
                        u32x4 w; w.x = cvt_pk_bf16(v0[0], v0[1]); w.y = cvt_pk_bf16(v0[2], v0[3]); w.z = cvt_pk_bf16(v1[0], v1[1]); w.w = cvt_pk_bf16(v1[2], v1[3]); *(u32x4*)(rp + bj * 128) = w; }
                }
            }
    }
};

struct WDesc { const float* src; const float* gain; bf16_t* dst; int K, N, map, ibase; };
__device__ __forceinline__ int qk_perm(int s) { return 128 * ((s >> 5) & 1) + 32 * (s >> 6) + 16 * ((s >> 2) & 1) + 4 * ((s >> 3) & 3) + (s & 3); }
__device__ __forceinline__ int dst_row(int map, int c) {
    if (map == 1) return c < 2048 ? (c & ~255) + qk_perm(c & 255) : c;
    if (map == 2) return c < 1280 ? (c & ~255) + qk_perm(c & 255) : c;
    if (map == 3 || map == 4) { const int t = c >> 7, w = c & 127; return 256 * t + (map == 4 ? 128 : 0) + 32 * (w >> 5) + 16 * ((w >> 2) & 1) + 4 * ((w >> 3) & 3) + (w & 3); }
    if (map == 5) return (c & ~31) + 16 * ((c >> 2) & 1) + 4 * ((c >> 3) & 3) + (c & 3);
    return c;
}
__device__ __forceinline__ void transpose_item(const GAS float* src, const GAS float* gain, GAS bf16_t* dst, int K, int N, int map, LAS float* scr, int item, int lane) {
    const int nblk = N / 64, kb = item / nblk, nb = item % nblk, k0 = 64 * kb, n0 = 64 * nb;
    const int c = lane & 15, r = lane >> 4;
    f32x4 v[16];
#pragma unroll
    for (int i = 0; i < 16; ++i) v[i] = *(const GAS f32x4*)(src + (size_t)(k0 + 4 * i + r) * N + n0 + 4 * c);
#pragma unroll
    for (int i = 0; i < 16; ++i) { const int kk = 4 * i + r; const float g = gain ? gain[k0 + kk] : 1.0f; LAS float* p = scr + kk * 65 + 4 * c; p[0] = v[i].x * g; p[1] = v[i].y * g; p[2] = v[i].z * g; p[3] = v[i].w * g; }
    asm volatile("s_waitcnt lgkmcnt(0)" ::: "memory");
    const int c8 = lane & 7;
#pragma unroll
    for (int j = 0; j < 8; ++j) { const int n = (lane >> 3) + 8 * j; const LAS float* p = scr + (8 * c8) * 65 + n;
        if (map >= 16) { int q0 = 0, q1 = 0;
            q0 = __builtin_amdgcn_cvt_pk_fp8_f32(p[0 * 65] * W8_SCALE, p[1 * 65] * W8_SCALE, q0, false); q0 = __builtin_amdgcn_cvt_pk_fp8_f32(p[2 * 65] * W8_SCALE, p[3 * 65] * W8_SCALE, q0, true);
            q1 = __builtin_amdgcn_cvt_pk_fp8_f32(p[4 * 65] * W8_SCALE, p[5 * 65] * W8_SCALE, q1, false); q1 = __builtin_amdgcn_cvt_pk_fp8_f32(p[6 * 65] * W8_SCALE, p[7 * 65] * W8_SCALE, q1, true);
            u32x2 o8; o8.x = (unsigned)q0; o8.y = (unsigned)q1; *(GAS u32x2*)((GAS unsigned char*)dst + (size_t)dst_row(map - 16, n0 + n) * K + k0 + 8 * c8) = o8; }
        else {
        u32x4 o; o.x = cvt_pk_bf16(p[0 * 65], p[1 * 65]); o.y = cvt_pk_bf16(p[2 * 65], p[3 * 65]); o.z = cvt_pk_bf16(p[4 * 65], p[5 * 65]); o.w = cvt_pk_bf16(p[6 * 65], p[7 * 65]);
        *(GAS u32x4*)(dst + (size_t)dst_row(map, n0 + n) * K + k0 + 8 * c8) = o; } }
    asm volatile("s_waitcnt lgkmcnt(0)" ::: "memory");
}
constexpr int N_WDESC = 62;
__device__ __forceinline__ void prologue(Frame& F, const __attribute__((address_space(4))) Args* a) {
    LAS WDesc* wd = (LAS WDesc*)(F.lds + 8 * 16640);
    LAS int* wtot = (LAS int*)(F.lds + 8 * 16640 + N_WDESC * sizeof(WDesc));
    static_assert(8 * 16640 + N_WDESC * sizeof(WDesc) + 16 <= (size_t)GAIN_OFF, "prologue LDS");
    if (F.tid == 0) {
        int n = 0, ib = 0;
#define ADDW(src_, gain_, dst_, K_, N_, map_) do { wd[n].src = (src_); wd[n].gain = (gain_); wd[n].dst = (bf16_t*)(dst_); wd[n].K = (K_); wd[n].N = (N_); wd[n].map = (map_); wd[n].ibase = ib; ++n; ib += ((K_) / 64) * ((N_) / 64); } while (0)
        for (int p = 0; p < 2; ++p) {
            const int na0 = p ? I_L2 : I_L0, sw0 = p ? I_L3 : I_L1;
#define NA_(i) (a->in[na0 + (i)])
#define SW_(i) (a->in[sw0 + (i)])
            unsigned char* wb = F.ws + WS_W + (size_t)p * WPAIR;
            ADDW(NA_(1), NA_(0), wb + WNA_QKV, 1024, 3072, 1);
            ADDW(NA_(5), (const float*)nullptr, wb + WNA_O, 1024, 1024, 5);
            ADDW(NA_(7), NA_(6), wb + WNA_GU, 1024, FF, (p >= DENSE8_FROM ? 16 : 0) + 3);
            ADDW(NA_(8), NA_(6), wb + WNA_GU, 1024, FF, (p >= DENSE8_FROM ? 16 : 0) + 4);
            ADDW(NA_(9), (const float*)nullptr, wb + WNA_D, FF, 1024, (p >= DENSE8_FROM ? 16 : 0) + 5);
            ADDW(SW_(1), SW_(0), wb + WSW_QKV, 1024, 1536, 2);
            ADDW(SW_(5), (const float*)nullptr, wb + WSW_O, 1024, 1024, 5);
            for (int e = 0; e < NE; ++e) {
                ADDW(SW_(8) + (size_t)e * 1024 * FF, SW_(6), wb + WSW_GU + (size_t)e * W_GU8, 1024, FF, 16 + 3);
                ADDW(SW_(9) + (size_t)e * 1024 * FF, SW_(6), wb + WSW_GU + (size_t)e * W_GU8, 1024, FF, 16 + 4);
                ADDW(SW_(10) + (size_t)e * FF * 1024, (const float*)nullptr, wb + WSW_D + (size_t)e * W_D8, FF, 1024, 16 + 5);
            }
        }
#undef ADDW
        *wtot = ib;
    }
    __syncthreads();
    LAS float* scr = (LAS float*)(F.lds + F.wave * 16640);
    const int gw = F.bx * 8 + F.wave, NGW = F.G * 8;
    const int total = *wtot;
    for (int it = gw; it < total; it += NGW) {
        int k = 0;
        for (int j = 1; j < N_WDESC; ++j) k += (it >= wd[j].ibase) ? 1 : 0;
        transpose_item((const GAS float*)wd[k].src, (const GAS float*)wd[k].gain, (GAS bf16_t*)wd[k].dst, wd[k].K, wd[k].N, wd[k].map, scr, it - wd[k].ibase, F.lane);
    }
    u64* ssq0 = ssq_buf(F, 0);
    for (int m = gw; m < M; m += NGW) {
        const float* src = m < NREG ? a->in[I_X] + (size_t)m * D : a->in[I_META] + (size_t)(m - NREG) * D;
        const f32x4* xr = (const f32x4*)src + F.lane;
        f32x4 v[4]; float s = 0.f;
#pragma unroll
        for (int j = 0; j < 4; ++j) { v[j] = xr[64 * j]; s += (v[j].x * v[j].x + v[j].y * v[j].y) + (v[j].z * v[j].z + v[j].w * v[j].w); }
        s = wave_sum(s);
        u32x2* o8 = (u32x2*)(F.hb + (size_t)m * D) + F.lane;
#pragma unroll
        for (int j = 0; j < 4; ++j) { u32x2 w; w.x = cvt_pk_bf16(v[j].x, v[j].y); w.y = cvt_pk_bf16(v[j].z, v[j].w); o8[64 * j] = w; }
        if (F.lane == 0) ssq0[m] = ssq_fix(s);
    }
}

struct AttnCtx {
    const bf16_t* Q; const bf16_t* K; const bf16_t* VT; bf16_t* O; int kpitch; unsigned omask;
    const LAS float* tbl;
};
constexpr int NTILE = 18;
__device__ __forceinline__ int t5_bucket_abs(int n) {
    const int big = 8 + (n >= 12) + (n >= 16) + (n >= 23) + (n >= 32) + (n >= 46) + (n >= 64) + (n >= 91);
    return n < 8 ? n : big;
}
constexpr int NA_TBL_ROW = 64, NA_TBL_HEAD = 15 * 64, SWA_TBL_HEAD = 576, SWA_T5_OFF = 16 * 576, SWA_SINK_OFF = SWA_T5_OFF + 512;
template <int TYPE>
__device__ __forceinline__ void attn_unit(const AttnCtx& X, int b, int hq, int u0, int u1, bool metaq, int lane) {
    const int q = lane & 15, kg = lane >> 4;
    const int hk = TYPE == 0 ? hq : (hq >> 2);
    constexpr int NWIN = TYPE == 0 ? 16 : 17, TMETA = NWIN, NREAL = NWIN + 1;
    int qtok0, wtok0, bidx;
    int colbase = 0, relbase = 0, wsq = 0;
    if (TYPE == 0) {
        const int r = metaq ? 0 : u0, cb = metaq ? 0 : u1;
        int rs = r - 4; rs = rs < 0 ? 0 : (rs > 24 ? 24 : rs); int ks = 16 * cb - 8; ks = ks < 0 ? 0 : (ks > 32 ? 32 : ks);
        qtok0 = metaq ? NREG : b * SEQ + r * 64 + 16 * cb; wtok0 = b * SEQ + rs * 64 + ks;
        const int qc = 16 * cb + q; wsq = qc - 8; wsq = wsq < 0 ? 0 : (wsq > 48 ? 48 : wsq);
        colbase = ks + 4 * kg;
        bidx = hq * NA_TBL_HEAD + (rs - r + 7) * NA_TBL_ROW + (colbase - qc + 15 + 16);
    } else {
        const int q0 = metaq ? 0 : 16 * u0;
        int jb = q0 - 128; jb = jb < 0 ? 0 : (jb > SEQ - 272 ? SEQ - 272 : jb);
        qtok0 = metaq ? NREG : b * SEQ + q0; wtok0 = b * SEQ + jb;
        relbase = jb + 4 * kg - q0 - q;
        bidx = hq * SWA_TBL_HEAD + relbase + 288;
        colbase = q0 + q;
    }
    const int mtok0 = NREG;
    const int nhk = X.kpitch >> 6;
    constexpr int TSTEP = 2;
    const size_t blk = (size_t)nhk * 512;
    const bf16_t* kwin = X.K + (size_t)(wtok0 >> 3) * blk + ((((size_t)(q >> 3) * nhk + hk) * 2) * 4 + kg) * 64 + (q & 7) * 8;
    const bf16_t* kmet = X.K + (size_t)(mtok0 >> 3) * blk + ((((size_t)(q >> 3) * nhk + hk) * 2) * 4 + kg) * 64 + (q & 7) * 8;
    const bf16_t* vwin = X.VT + (size_t)(wtok0 >> 3) * blk + ((size_t)(kg >> 1) * nhk + hk) * 512 + ((kg & 1) * 16 + q) * 4;
    const bf16_t* vmet = X.VT + (size_t)(mtok0 >> 3) * blk + ((size_t)(kg >> 1) * nhk + hk) * 512 + ((kg & 1) * 16 + q) * 4;
#define ATT_TOFF(t) ((size_t)(TYPE == 0 ? (8 * ((t) >> 1) + 2 * ((t) & 1)) : TSTEP * (t)) * blk)
    bf16x8 Qf[2];
    { const bf16_t* qp = X.Q + (size_t)(qtok0 + q) * 1024 + hq * 64 + 8 * kg; Qf[0] = *(const bf16x8*)qp; Qf[1] = *(const bf16x8*)(qp + 32); }
    f32x4 S[NTILE];
    f32x4 O[4];
#define ATT_LOADK(buf, t0) do { _Pragma("unroll") for (int t = 0; t < 6; ++t) if ((t0) + t < NREAL) { const bf16_t* kp = ((t0) + t == TMETA) ? kmet : kwin + ATT_TOFF((t0) + t); buf[t][0] = *(const bf16x8*)kp; buf[t][1] = *(const bf16x8*)(kp + 256); } } while (0)
#define ATT_MMAK(buf, t0) do { _Pragma("unroll") for (int t = 0; t < 6; ++t) if ((t0) + t < NREAL) { \
        f32x4 s_ = __builtin_amdgcn_mfma_f32_16x16x32_bf16(buf[t][0], Qf[0], S[(t0) + t], 0, 0, 0); S[(t0) + t] = __builtin_amdgcn_mfma_f32_16x16x32_bf16(buf[t][1], Qf[1], s_, 0, 0, 0); } } while (0)
#define ATT_VPTR(t) (((t) == TMETA) ? vmet : vwin + ATT_TOFF(t))
#define ATT_LOADV(bl, bh, s0) do { _Pragma("unroll") for (int s = 0; s < 3; ++s) { \
        _Pragma("unroll") for (int dt = 0; dt < 4; ++dt) { \
            bl[s][dt] = *(const s16x4*)(ATT_VPTR(2 * ((s0) + s)) + dt * 128); \
            if (2 * ((s0) + s) + 1 < NREAL) bh[s][dt] = *(const s16x4*)(ATT_VPTR(2 * ((s0) + s) + 1) + dt * 128); else bh[s][dt] = (s16x4){0, 0, 0, 0}; } } } while (0)
#define ATT_PV(bl, bh, s0) do { _Pragma("unroll") for (int s = 0; s < 3; ++s) { \
        const f32x4 pa = S[2 * ((s0) + s)]; f32x4 pb = {0.f, 0.f, 0.f, 0.f}; if (2 * ((s0) + s) + 1 < NREAL) pb = S[2 * ((s0) + s) + 1]; \
        u32x4 pw; pw.x = cvt_pk_bf16(pa[0], pa[1]); pw.y = cvt_pk_bf16(pa[2], pa[3]); pw.z = cvt_pk_bf16(pb[0], pb[1]); pw.w = cvt_pk_bf16(pb[2], pb[3]); \
        const bf16x8 Pf = __builtin_bit_cast(bf16x8, pw); \
        _Pragma("unroll") for (int dt = 0; dt < 4; ++dt) { const bf16x8 Vf = __builtin_shufflevector(bl[s][dt], bh[s][dt], 0, 1, 2, 3, 4, 5, 6, 7); \
            O[dt] = __builtin_amdgcn_mfma_f32_16x16x32_bf16(Vf, Pf, O[dt], 0, 0, 0); } } } while (0)
    bf16x8 KA[6][2], KB[6][2];
    s16x4 VAl[3][4], VAh[3][4], VBl[3][4], VBh[3][4];
    ATT_LOADK(KA, 0); ATT_LOADK(KB, 6);
    {
        const LAS float* bt = X.tbl + bidx;
#pragma unroll
        for (int t = 0; t < NWIN; ++t)
#pragma unroll
            for (int j = 0; j < 4; ++j) S[t][j] = TYPE == 0 ? bt[(t >> 1) * NA_TBL_ROW + 16 * (t & 1) + j] : bt[16 * t + j];
#pragma unroll
        for (int j = 0; j < 4; ++j) {
            if (TYPE == 1) { const int mk = 4 * kg + j; int bucket;
                if (metaq) { const int rel = mk - q; bucket = (rel > 0 ? 16 : 0) + t5_bucket_abs(rel < 0 ? -rel : rel); } else bucket = t5_bucket_abs(16 + colbase - mk);
                S[TMETA][j] = X.tbl[SWA_T5_OFF + bucket * 16 + hq];
            } else S[TMETA][j] = -SM_SHIFT;
        }
        if (TYPE == 0) {
            bool okm[2][4];
#pragma unroll
            for (int hf = 0; hf < 2; ++hf)
#pragma unroll
                for (int j = 0; j < 4; ++j) okm[hf][j] = !metaq && (unsigned)(colbase + 16 * hf + j - wsq) < 16u;
#pragma unroll
            for (int t = 0; t < NWIN; ++t)
#pragma unroll
                for (int j = 0; j < 4; ++j) S[t][j] = okm[t & 1][j] ? S[t][j] : NEGBIG;
        } else {
#pragma unroll
            for (int t = 0; t < NWIN; ++t)
#pragma unroll
                for (int j = 0; j < 4; ++j) S[t][j] = (!metaq && (unsigned)(relbase + 16 * t + j + 128) <= 256u) ? S[t][j] : NEGBIG;
        }
    }
    ATT_MMAK(KA, 0);
    ATT_LOADK(KA, 12);
    ATT_MMAK(KB, 6);
    if (TYPE == 0) ATT_LOADV(VAl, VAh, 0);
    ATT_MMAK(KA, 12);
    if (TYPE == 1) ATT_LOADV(VAl, VAh, 0);
#pragma unroll
    for (int dt = 0; dt < 4; ++dt) O[dt] = (f32x4){0.f, 0.f, 0.f, 0.f};
    __builtin_amdgcn_sched_barrier(0);
    float sk = 0.f;
    if (TYPE == 1) sk = X.tbl[SWA_SINK_OFF + hq];
    ATT_LOADV(VBl, VBh, 3);
    float l = 0.f;
#pragma unroll
    for (int t = 0; t < NREAL; ++t) {
#pragma unroll
        for (int j = 0; j < 4; ++j) { const float p = fast_exp2(S[t][j]); S[t][j] = p; l += p; }
    }
    l += __shfl_xor(l, 16); l += __shfl_xor(l, 32);
    if (TYPE == 1) l += fast_exp2(sk);
    __builtin_amdgcn_sched_barrier(0);
    const float inv = 1.0f / l;
    ATT_PV(VAl, VAh, 0);
    ATT_LOADV(VAl, VAh, 6);
    ATT_PV(VBl, VBh, 3);
    ATT_PV(VAl, VAh, 6);
#undef ATT_LOADK
#undef ATT_MMAK
#undef ATT_LOADV
#undef ATT_PV
#undef ATT_VPTR
#undef ATT_TOFF
    bf16_t* op = X.O + (size_t)((unsigned)(qtok0 + q) & X.omask) * 1024 + hq * 64 + 4 * kg;
#pragma unroll
    for (int dt = 0; dt < 4; ++dt) { u32x2 w; w.x = cvt_pk_bf16(O[dt][0] * inv, O[dt][1] * inv); w.y = cvt_pk_bf16(O[dt][2] * inv, O[dt][3] * inv); *(u32x2*)(op + 16 * dt) = w; }
}

template <int TYPE>
__device__ __forceinline__ void metaq_unit(const AttnCtx& X, const LAS float* t5s, const LAS float* sinks, int b, int hq, int lane) {
    const int q = lane & 15, kg = lane >> 4, hk = TYPE == 0 ? hq : (hq >> 2), nhk = X.kpitch >> 6, mtok0 = NREG;
    const size_t blk = (size_t)nhk * 512;
    const bf16_t* qp = X.Q + (size_t)(mtok0 + q) * 1024 + hq * 64 + 8 * kg;
    const bf16_t* kp = X.K + (size_t)(mtok0 >> 3) * blk + ((((size_t)(q >> 3) * nhk + hk) * 2) * 4 + kg) * 64 + (q & 7) * 8;
    const bf16_t* vp = X.VT + (size_t)(mtok0 >> 3) * blk + ((size_t)(kg >> 1) * nhk + hk) * 512 + ((kg & 1) * 16 + q) * 4;
    const bf16x8 q0 = *(const bf16x8*)qp, q1 = *(const bf16x8*)(qp + 32), k0 = *(const bf16x8*)kp, k1 = *(const bf16x8*)(kp + 256);
    s16x4 vl[4];
#pragma unroll
    for (int dt = 0; dt < 4; ++dt) vl[dt] = *(const s16x4*)(vp + dt * 128);
    f32x4 S;
#pragma unroll
    for (int j = 0; j < 4; ++j) {
        if (TYPE == 1) { const int rel = 4 * kg + j - q; S[j] = t5s[((rel > 0 ? 16 : 0) + t5_bucket_abs(rel < 0 ? -rel : rel)) * 16 + hq]; } else S[j] = -SM_SHIFT;
    }
    S = __builtin_amdgcn_mfma_f32_16x16x32_bf16(k0, q0, S, 0, 0, 0); S = __builtin_amdgcn_mfma_f32_16x16x32_bf16(k1, q1, S, 0, 0, 0);
    float l = 0.f;
#pragma unroll
    for (int j = 0; j < 4; ++j) { S[j] = fast_exp2(S[j]); l += S[j]; }
    l += __shfl_xor(l, 16); l += __shfl_xor(l, 32);
    if (TYPE == 1) l += fast_exp2(sinks[hq]);
    const float inv = 1.0f / l;
    u32x4 pw; pw.x = cvt_pk_bf16(S[0], S[1]); pw.y = cvt_pk_bf16(S[2], S[3]); pw.z = 0u; pw.w = 0u;
    const bf16x8 Pf = __builtin_bit_cast(bf16x8, pw);
    bf16_t* op = X.O + (size_t)((unsigned)(mtok0 + q) & X.omask) * 1024 + hq * 64 + 4 * kg;
#pragma unroll
    for (int dt = 0; dt < 4; ++dt) {
        const bf16x8 Vf = __builtin_shufflevector(vl[dt], (s16x4){0, 0, 0, 0}, 0, 1, 2, 3, 4, 5, 6, 7);
        const f32x4 o = __builtin_amdgcn_mfma_f32_16x16x32_bf16(Vf, Pf, (f32x4){0.f, 0.f, 0.f, 0.f}, 0, 0, 0);
        u32x2 w; w.x = cvt_pk_bf16(o[0] * inv, o[1] * inv); w.y = cvt_pk_bf16(o[2] * inv, o[3] * inv); *(u32x2*)(op + 16 * dt) = w;
    }
}

template <int TYPE>
__device__ __forceinline__ void attn_phase(Frame& F, const AttnCtx& X) {
    int lane_l = F.lane; asm volatile("" : "+v"(lane_l));
    if (F.G == 256) {
        const int xcd = F.bx & 7, cu = F.bx >> 3, w = F.wave;
        if (TYPE == 0) {
            for (int it = 0; it < 32; ++it) { const int p = xcd * 64 + 2 * it + (w >> 2); attn_unit<0>(X, p >> 4, p & 15, cu, w & 3, false, lane_l); }
        } else {
            for (int it = 0; it < 32; ++it) { const int bn = xcd * 16 + (it >> 1), qb = 4 * cu + 2 * (it & 1) + (w >> 2); attn_unit<1>(X, bn >> 2, (bn & 3) * 4 + (w & 3), qb, 0, false, lane_l); }
        }
    } else {
        const int UPC = (NREG + F.G - 1) / F.G;
        const int ubeg = F.bx * UPC, uend = (ubeg + UPC) < NREG ? (ubeg + UPC) : NREG;
        for (int u = ubeg + F.wave; u < uend; u += 8) {
            if (TYPE == 0) { const int cb = u & 3, r = (u >> 2) & 31, h = (u >> 7) & 15, b = u >> 11; attn_unit<0>(X, b, h, r, cb, false, lane_l); }
            else { const int g = u & 3, qb = (u >> 2) & 127, n = (u >> 9) & 3, b = u >> 11; attn_unit<1>(X, b, n * 4 + g, qb, 0, false, lane_l); }
        }
    }
    for (int u = F.bx * 8 + F.wave; u < 16; u += F.G * 8) metaq_unit<TYPE>(X, X.tbl, X.tbl, 0, u, lane_l);
}

__device__ __forceinline__ void dma16(const void* g, LAS void* l) { __builtin_amdgcn_global_load_lds((const unsigned*)g, (LAS unsigned*)l, 16, 0, 0); }
constexpr int NA_RING_ROWS = 12, NA_TBL_OFF = NA_RING_ROWS * 8192;
__device__ __forceinline__ void na_ring_item(Frame& F, const AttnCtx& X, int pair) {
    int lane = F.lane; asm volatile("" : "+v"(lane));
    const int w = F.wave, q = lane & 15, kg = lane >> 4, cb = w & 3, rsel = w >> 2, b = pair >> 4, hq = pair & 15;
    LAS unsigned char* lds = F.lds;
    const LAS float* tbl = (const LAS float*)(lds + NA_TBL_OFF);
    constexpr int nhk = 16; const size_t blk = (size_t)nhk * 512;
    const bf16_t* vglob = X.VT + ((size_t)(b * 256) * nhk + hq) * 512 + lane * 8;
    const int mtok0 = NREG;
    const bf16_t* kmet = X.K + (size_t)(mtok0 >> 3) * blk + ((((size_t)(q >> 3) * nhk + hq) * 2) * 4 + kg) * 64 + (q & 7) * 8;
    const bf16_t* vmet = X.VT + (size_t)(mtok0 >> 3) * blk + ((size_t)(kg >> 1) * nhk + hq) * 512 + ((kg & 1) * 16 + q) * 4;
#pragma unroll
    for (int r = 0; r < 8; ++r) dma16(vglob + (size_t)(8 * r + w) * blk, lds + r * 8192 + w * 1024);
    int loaded_hi = 8;
    const int ks = (16 * cb - 8) < 0 ? 0 : ((16 * cb - 8) > 32 ? 32 : (16 * cb - 8));
    const int qc = 16 * cb + q; int wsq = qc - 8; wsq = wsq < 0 ? 0 : (wsq > 48 ? 48 : wsq);
    const int colbase = ks + 4 * kg;
    bool okm[2][4];
#pragma unroll
    for (int hf = 0; hf < 2; ++hf)
#pragma unroll
        for (int j = 0; j < 4; ++j) okm[hf][j] = (unsigned)(colbase + 16 * hf + j - wsq) < 16u;
    const int kfl = ((((q >> 3) * nhk + hq) * 2) * 4 + kg) * 64 + (q & 7) * 8;
    const int vfl = ((ks >> 3) + (kg >> 1)) * 1024 + ((kg & 1) * 16 + q) * 8;
    bf16x8 Qn[2];
    { const bf16_t* qp = X.Q + (size_t)(b * SEQ + rsel * 64 + 16 * cb + q) * 1024 + hq * 64 + 8 * kg; Qn[0] = *(const bf16x8*)qp; Qn[1] = *(const bf16x8*)(qp + 32); }
    __builtin_amdgcn_s_waitcnt(0x0F70); asm volatile("" ::: "memory"); __builtin_amdgcn_s_barrier(); asm volatile("" ::: "memory");
    for (int s = 0; s < 16; ++s) {
        const int r = 2 * s + rsel;
        bf16x8 Qf[2]; Qf[0] = Qn[0]; Qf[1] = Qn[1];
        if (s + 1 < 16) {
            int nh = 2 * s + 3 - 4; nh = nh < 0 ? 0 : (nh > 24 ? 24 : nh); nh += 8;
#pragma unroll
            for (int k = 0; k < 2; ++k) { const int rr = loaded_hi + k; if (rr < nh) { const int slot = rr >= 24 ? rr - 24 : (rr >= 12 ? rr - 12 : rr); dma16(vglob + (size_t)(8 * rr + w) * blk, lds + slot * 8192 + w * 1024); } }
            loaded_hi = nh > loaded_hi ? nh : loaded_hi;
            const bf16_t* qp = X.Q + (size_t)(b * SEQ + (r + 2) * 64 + 16 * cb + q) * 1024 + hq * 64 + 8 * kg; Qn[0] = *(const bf16x8*)qp; Qn[1] = *(const bf16x8*)(qp + 32);
        }
        int rs = r - 4; rs = rs < 0 ? 0 : (rs > 24 ? 24 : rs);
        const int wtok0 = b * SEQ + rs * 64 + ks;
        const bf16_t* kwin = X.K + (size_t)(wtok0 >> 3) * blk + kfl;
        const LAS float* bt = tbl + hq * NA_TBL_HEAD + (rs - r + 7) * NA_TBL_ROW + (colbase - qc + 15 + 16);
        f32x4 S[17];
        bf16x8 KA[6][2], KB[6][2];
#define NR_LOADK(buf, t0) do { _Pragma("unroll") for (int t = 0; t < 6; ++t) if ((t0) + t < 17) { const bf16_t* kp = ((t0) + t == 16) ? kmet : kwin + (size_t)(8 * (((t0) + t) >> 1) + 2 * (((t0) + t) & 1)) * blk; buf[t][0] = *(const bf16x8*)kp; buf[t][1] = *(const bf16x8*)(kp + 256); } } while (0)
#define NR_MMAK(buf, t0) do { _Pragma("unroll") for (int t = 0; t < 6; ++t) if ((t0) + t < 17) { \
        f32x4 s_ = __builtin_amdgcn_mfma_f32_16x16x32_bf16(buf[t][0], Qf[0], S[(t0) + t], 0, 0, 0); S[(t0) + t] = __builtin_amdgcn_mfma_f32_16x16x32_bf16(buf[t][1], Qf[1], s_, 0, 0, 0); } } while (0)
        NR_LOADK(KA, 0); NR_LOADK(KB, 6);
        s16x4 vm[4];
#pragma unroll
        for (int dt = 0; dt < 4; ++dt) vm[dt] = *(const s16x4*)(vmet + dt * 128);
#pragma unroll
        for (int t = 0; t < 16; ++t)
#pragma unroll
            for (int j = 0; j < 4; ++j) S[t][j] = bt[(t >> 1) * NA_TBL_ROW + 16 * (t & 1) + j];
#pragma unroll
        for (int t = 0; t < 16; ++t)
#pragma unroll
            for (int j = 0; j < 4; ++j) S[t][j] = okm[t & 1][j] ? S[t][j] : NEGBIG;
        S[16] = (f32x4){-SM_SHIFT, -SM_SHIFT, -SM_SHIFT, -SM_SHIFT};
        NR_MMAK(KA, 0);
        NR_LOADK(KA, 12);
        NR_MMAK(KB, 6);
        NR_MMAK(KA, 12);
#undef NR_LOADK
#undef NR_MMAK
        __builtin_amdgcn_sched_barrier(0);
        float l = 0.f;
#pragma unroll
        for (int t = 0; t < 17; ++t)
#pragma unroll
            for (int j = 0; j < 4; ++j) { const float p = fast_exp2(S[t][j]); S[t][j] = p; l += p; }
        l += __shfl_xor(l, 16); l += __shfl_xor(l, 32);
        const float inv = 1.0f / l;
        __builtin_amdgcn_sched_barrier(0);
        f32x4 O[4];
#pragma unroll
        for (int dt = 0; dt < 4; ++dt) O[dt] = (f32x4){0.f, 0.f, 0.f, 0.f};
#pragma unroll
        for (int st = 0; st < 9; ++st) {
            const f32x4 pa = S[2 * st]; f32x4 pb = {0.f, 0.f, 0.f, 0.f}; if (st < 8) pb = S[2 * st + 1];
            u32x4 pw; pw.x = cvt_pk_bf16(pa[0], pa[1]); pw.y = cvt_pk_bf16(pa[2], pa[3]); pw.z = cvt_pk_bf16(pb[0], pb[1]); pw.w = cvt_pk_bf16(pb[2], pb[3]);
            const bf16x8 Pf = __builtin_bit_cast(bf16x8, pw);
            int rr = rs + st; const int slot = rr >= 24 ? rr - 24 : (rr >= 12 ? rr - 12 : rr);
            const LAS unsigned char* vp = lds + slot * 8192 + vfl;
#pragma unroll
            for (int dt = 0; dt < 4; ++dt) {
                s16x4 vl, vh;
                if (st < 8) { vl = *(const LAS s16x4*)(vp + 256 * dt); vh = *(const LAS s16x4*)(vp + 2048 + 256 * dt); } else { vl = vm[dt]; vh = (s16x4){0, 0, 0, 0}; }
                const bf16x8 Vf = __builtin_shufflevector(vl, vh, 0, 1, 2, 3, 4, 5, 6, 7);
                O[dt] = __builtin_amdgcn_mfma_f32_16x16x32_bf16(Vf, Pf, O[dt], 0, 0, 0);
            }
        }
        bf16_t* op = X.O + (size_t)((unsigned)(b * SEQ + r * 64 + 16 * cb + q) & X.omask) * 1024 + hq * 64 + 4 * kg;
#pragma unroll
        for (int dt = 0; dt < 4; ++dt) { u32x2 wv; wv.x = cvt_pk_bf16(O[dt][0] * inv, O[dt][1] * inv); wv.y = cvt_pk_bf16(O[dt][2] * inv, O[dt][3] * inv); *(u32x2*)(op + 16 * dt) = wv; }
        __builtin_amdgcn_s_waitcnt(0x0F74); asm volatile("" ::: "memory"); __builtin_amdgcn_s_barrier(); asm volatile("" ::: "memory");
    }
    __builtin_amdgcn_s_waitcnt(0x0F70); asm volatile("" ::: "memory");
}

constexpr int SX_T5 = 0, SX_SINK = 2048, SX_TBL = 2176, SX_MK = 11392, SX_MV = 13440, SWA_VRING = 65536;
__device__ __forceinline__ void swa_ring_item(Frame& F, const AttnCtx& X, int item) {
    int lane = F.lane; asm volatile("" : "+v"(lane));
    const int w = F.wave, q = lane & 15, kg = lane >> 4;
    const int bn = item >> 1, hf = item & 1, b = bn >> 2, n = bn & 3, g = w & 3, qsel = w >> 2, hq = n * 4 + g;
    LAS unsigned char* lds = F.lds;
    const LAS float* xt5 = (const LAS float*)(lds + ATT_X_OFF + SX_T5);
    const LAS float* xtb = (const LAS float*)(lds + ATT_X_OFF + SX_TBL) + g * SWA_TBL_HEAD;
    const float sk = ((const LAS float*)(lds + ATT_X_OFF + SX_SINK))[hq];
    const bf16_t* kglob = X.K + ((size_t)(b * 256) * 4 + n) * 512 + lane * 8;
    const bf16_t* vglob = X.VT + ((size_t)(b * 256) * 4 + n) * 512 + lane * 8;
    if (w < 4) { const size_t mb = ((size_t)(NREG >> 3) + (w & 1)) * 4 + n; dma16((w < 2 ? X.K : X.VT) + mb * 512 + lane * 8, lds + ATT_X_OFF + (w < 2 ? SX_MK : SX_MV) + (w & 1) * 1024); }
    const int qbase = 64 * hf;
    int q0f = 16 * qbase; int lo = q0f - 128; lo = lo < 0 ? 0 : (lo > SEQ - 272 ? SEQ - 272 : lo);
    int hi0 = q0f + 16 - 128; hi0 = hi0 < 0 ? 0 : (hi0 > SEQ - 272 ? SEQ - 272 : hi0); hi0 += 272;
    for (int B = (lo >> 3) + w; B < (hi0 >> 3); B += 8) { dma16(kglob + (size_t)B * 2048, lds + (B & 63) * 1024); dma16(vglob + (size_t)B * 2048, lds + SWA_VRING + (B & 63) * 1024); }
    int loaded_hi = hi0;
    bf16x8 Qn[2];
    { const bf16_t* qp = X.Q + (size_t)(b * SEQ + 16 * (qbase + qsel) + q) * 1024 + hq * 64 + 8 * kg; Qn[0] = *(const bf16x8*)qp; Qn[1] = *(const bf16x8*)(qp + 32); }
    const int kfrag = (q >> 3) * 1024 + kg * 128 + (q & 7) * 16;
    const int vfrag = (kg >> 1) * 1024 + ((kg & 1) * 16 + q) * 8;
    __builtin_amdgcn_s_waitcnt(0x0F70); asm volatile("" ::: "memory"); __builtin_amdgcn_s_barrier(); asm volatile("" ::: "memory");
    for (int s = 0; s < 32; ++s) {
        const int qblk = qbase + 2 * s + qsel, q0 = 16 * qblk;
        bf16x8 Qf[2]; Qf[0] = Qn[0]; Qf[1] = Qn[1];
        if (s + 1 < 32) {
            int nh = 16 * (qbase + 2 * s + 3) - 128; nh = nh < 0 ? 0 : (nh > SEQ - 272 ? SEQ - 272 : nh); nh += 272;
            const int B = (loaded_hi >> 3) + (w & 3);
            if (B < (nh >> 3)) { if (w < 4) dma16(kglob + (size_t)B * 2048, lds + (B & 63) * 1024); else dma16(vglob + (size_t)B * 2048, lds + SWA_VRING + (B & 63) * 1024); }
            loaded_hi = nh > loaded_hi ? nh : loaded_hi;
            const bf16_t* qp = X.Q + (size_t)(b * SEQ + q0 + 32 + q) * 1024 + hq * 64 + 8 * kg; Qn[0] = *(const bf16x8*)qp; Qn[1] = *(const bf16x8*)(qp + 32);
        }
        int jb = q0 - 128; jb = jb < 0 ? 0 : (jb > SEQ - 272 ? SEQ - 272 : jb);
        const int relbase = jb + 4 * kg - q0 - q;
        const int jblk = jb >> 3;
        f32x4 S[18];
        {
            const LAS float* bt = xtb + relbase + 288;
#pragma unroll
            for (int t = 0; t < 17; ++t)
#pragma unroll
                for (int j = 0; j < 4; ++j) S[t][j] = bt[16 * t + j];
#pragma unroll
            for (int j = 0; j < 4; ++j) S[17][j] = xt5[t5_bucket_abs(16 + q0 + q - (4 * kg + j)) * 16 + hq];
            if (jb == q0 - 128) {
#pragma unroll
                for (int j = 0; j < 4; ++j) { S[0][j] = (relbase + j >= -128) ? S[0][j] : NEGBIG; S[16][j] = (relbase + 256 + j <= 128) ? S[16][j] : NEGBIG; }
            } else {
                int r0 = relbase + 128; asm volatile("" : "+v"(r0));
#pragma unroll
                for (int t = 0; t < 17; ++t)
#pragma unroll
                    for (int j = 0; j < 4; ++j) S[t][j] = ((unsigned)(r0 + (16 * t + j)) <= 256u) ? S[t][j] : NEGBIG;
            }
        }
#pragma unroll
        for (int t0 = 0; t0 < 18; t0 += 6) {
            bf16x8 Kf[6][2];
#pragma unroll
            for (int t = 0; t < 6; ++t) {
                const LAS unsigned char* kp = (t0 + t == 17) ? lds + ATT_X_OFF + SX_MK + kfrag : lds + (((jblk + 2 * (t0 + t) + (q >> 3)) & 63) * 1024) + (kfrag & 1023);
                Kf[t][0] = *(const LAS bf16x8*)kp; Kf[t][1] = *(const LAS bf16x8*)(kp + 512);
            }
#pragma unroll
            for (int t = 0; t < 6; ++t) { f32x4 s_ = __builtin_amdgcn_mfma_f32_16x16x32_bf16(Kf[t][0], Qf[0], S[t0 + t], 0, 0, 0); S[t0 + t] = __builtin_amdgcn_mfma_f32_16x16x32_bf16(Kf[t][1], Qf[1], s_, 0, 0, 0); }
        }
        __builtin_amdgcn_sched_barrier(0);
        float l = 0.f;
#pragma unroll
        for (int t = 0; t < 18; ++t)
#pragma unroll
            for (int j = 0; j < 4; ++j) { const float p = fast_exp2(S[t][j]); S[t][j] = p; l += p; }
        l += __shfl_xor(l, 16); l += __shfl_xor(l, 32);
        l += fast_exp2(sk);
        __builtin_amdgcn_sched_barrier(0);
        const float inv = 1.0f / l;
        f32x4 O[4];
#pragma unroll
        for (int dt = 0; dt < 4; ++dt) O[dt] = (f32x4){0.f, 0.f, 0.f, 0.f};
#pragma unroll
        for (int st = 0; st < 9; ++st) {
            const LAS unsigned char* va = lds + SWA_VRING + (((jblk + 4 * st + (kg >> 1)) & 63) * 1024) + (vfrag & 1023);
            const LAS unsigned char* vb = (st == 8) ? lds + ATT_X_OFF + SX_MV + vfrag : lds + SWA_VRING + (((jblk + 4 * st + 2 + (kg >> 1)) & 63) * 1024) + (vfrag & 1023);
            const f32x4 pa = S[2 * st], pb = S[2 * st + 1];
            u32x4 pw; pw.x = cvt_pk_bf16(pa[0], pa[1]); pw.y = cvt_pk_bf16(pa[2], pa[3]); pw.z = cvt_pk_bf16(pb[0], pb[1]); pw.w = cvt_pk_bf16(pb[2], pb[3]);
            const bf16x8 Pf = __builtin_bit_cast(bf16x8, pw);
#pragma unroll
            for (int dt = 0; dt < 4; ++dt) {
                const s16x4 vl = *(const LAS s16x4*)(va + 256 * dt), vh = *(const LAS s16x4*)(vb + 256 * dt);
                const bf16x8 Vf = __builtin_shufflevector(vl, vh, 0, 1, 2, 3, 4, 5, 6, 7);
                O[dt] = __builtin_amdgcn_mfma_f32_16x16x32_bf16(Vf, Pf, O[dt], 0, 0, 0);
            }
        }
        bf16_t* op = X.O + (size_t)((unsigned)(b * SEQ + q0 + q) & X.omask) * 1024 + hq * 64 + 4 * kg;
#pragma unroll
        for (int dt = 0; dt < 4; ++dt) { u32x2 wv; wv.x = cvt_pk_bf16(O[dt][0] * inv, O[dt][1] * inv); wv.y = cvt_pk_bf16(O[dt][2] * inv, O[dt][3] * inv); *(u32x2*)(op + 16 * dt) = wv; }
        __builtin_amdgcn_s_waitcnt(0x0F74); asm volatile("" ::: "memory"); __builtin_amdgcn_s_barrier(); asm volatile("" ::: "memory");
    }
    asm volatile("s_waitcnt vmcnt(0)" ::: "memory");
}

__device__ __forceinline__ void router_phase(Frame& F, const float* wr, const float* gain, const u64* ssq, int moe_idx, bool dummy) {
    LAS u32x4* Wl = (LAS u32x4*)F.lds;
    for (int idx = F.tid; idx < 32 * 64; idx += 512) {
        const int st = idx >> 6, ln = idx & 63, n = ln & 15, kg = ln >> 4, e = 2 * (n >> 2) + (n & 1), part = (n >> 1) & 1;
        float v[8];
#pragma unroll
        for (int c = 0; c < 8; ++c) { const int k = 64 * (st >> 1) + 16 * kg + 8 * (st & 1) + c; const float w = wr[(size_t)k * 8 + e] * gain[k];
            const float hi = __uint_as_float(cvt_pk_bf16(w, 0.f) << 16); v[c] = part ? w - hi : hi; }
        u32x4 o; o.x = cvt_pk_bf16(v[0], v[1]); o.y = cvt_pk_bf16(v[2], v[3]); o.z = cvt_pk_bf16(v[4], v[5]); o.w = cvt_pk_bf16(v[6], v[7]);
        Wl[idx] = o;
    }
    __syncthreads();
    unsigned* cnt = F.ctl + CW_CNT + (dummy ? 2 : moe_idx) * 8 * 64;
    unsigned char* tb_ = dummy ? F.ws + WS_R : F.ws + WS_TAB;
    unsigned* rowtok = (unsigned*)(tb_); float* rowssq = (float*)(tb_ + TAB_BYTES);
    unsigned* rowslot = (unsigned*)(tb_ + 2 * TAB_BYTES); float* rowgate = (float*)(tb_ + 3 * TAB_BYTES);
    const int gw = F.bx * 8 + F.wave, NGW = F.G * 8;
    constexpr int RT = 48;
    int lane_ = F.lane; asm volatile("" : "+v"(lane_));
    const int tok = lane_ & 15, q = lane_ >> 4;
    constexpr int NT = (M + RT - 1) / RT;
    LAS unsigned* wcnt = (LAS unsigned*)(F.lds + 32768);
    (void)gw;
    for (int t0 = 0; t0 < NT; t0 += NGW) {
        const int task = t0 + F.wave * F.G + F.bx; const bool has = task < NT;
        int me1 = 0, me2 = 0; float mg1 = 0.f, mg2 = 0.f, mss = 0.f;
        if (has) for (int j = 0; j < 3; ++j) {
            int mm = task * RT + 16 * j + tok; mm = mm < M ? mm : M - 1;
            const bf16_t* xr = F.hb + (size_t)mm * D + 16 * q;
            bf16x8 xa[16][2];
#pragma unroll
            for (int i = 0; i < 16; ++i) { xa[i][0] = *(const bf16x8*)(xr + 64 * i); xa[i][1] = *(const bf16x8*)(xr + 64 * i + 8); }
            const float ssv = ssq_val(ssq[mm]);
            f32x4 acc0 = {0.f, 0.f, 0.f, 0.f}, acc1 = {0.f, 0.f, 0.f, 0.f};
#pragma unroll
            for (int i = 0; i < 16; ++i) {
                const bf16x8 w0 = __builtin_bit_cast(bf16x8, Wl[(2 * i) * 64 + lane_]), w1 = __builtin_bit_cast(bf16x8, Wl[(2 * i + 1) * 64 + lane_]);
                acc0 = __builtin_amdgcn_mfma_f32_16x16x32_bf16(w0, xa[i][0], acc0, 0, 0, 0);
                acc1 = __builtin_amdgcn_mfma_f32_16x16x32_bf16(w1, xa[i][1], acc1, 0, 0, 0); }
            const f32x4 acc = acc0 + acc1;
            const float l0 = acc[0] + acc[2], l1 = acc[1] + acc[3];
            float cv[8]; int ce[8];
            cv[0] = l0; cv[1] = l1; ce[0] = 2 * q; ce[1] = 2 * q + 1;
#pragma unroll
            for (int d = 1; d < 4; ++d) { cv[2 * d] = __shfl_xor(l0, 16 * d); cv[2 * d + 1] = __shfl_xor(l1, 16 * d); ce[2 * d] = 2 * (q ^ d); ce[2 * d + 1] = 2 * (q ^ d) + 1; }
            int e1 = ce[0]; float v1 = cv[0];
#pragma unroll
            for (int c = 1; c < 8; ++c) if (cv[c] > v1 || (cv[c] == v1 && ce[c] < e1)) { v1 = cv[c]; e1 = ce[c]; }
            int e2 = -1; float v2 = -3.0e38f;
#pragma unroll
            for (int c = 0; c < 8; ++c) if (ce[c] != e1 && (cv[c] > v2 || (cv[c] == v2 && ce[c] < e2))) { v2 = cv[c]; e2 = ce[c]; }
            if (e2 < 0) e2 = e1 ^ 1;
            const float rstd = 1.0f / sqrtf(ssv * (1.0f / 1024.0f) + EPS);
            const float ex = __expf((v2 - v1) * rstd); const float g1 = 1.0f / (1.0f + ex), g2 = ex * g1;
            if (q == j) { me1 = e1; me2 = e2; mg1 = g1; mg2 = g2; mss = ssv; }
        }
        const bool act = has && F.lane < RT && task * RT + F.lane < M;
        int rank1 = 0, rank2 = 0, mycnt = 0, n1e2 = 0;
        const unsigned long long lt = (1ull << F.lane) - 1ull;
#pragma unroll
        for (int e = 0; e < 8; ++e) {
            const unsigned long long m1 = __ballot(act && me1 == e), m2 = __ballot(act && me2 == e);
            const int c1 = __popcll(m1), c2 = __popcll(m2);
            if (me1 == e) rank1 = __popcll(m1 & lt);
            if (me2 == e) { rank2 = __popcll(m2 & lt); n1e2 = c1; }
            if (F.lane == e) mycnt = c1 + c2;
        }
        unsigned basev = 0;
        if (F.lane < 8) wcnt[F.wave * 8 + F.lane] = (unsigned)mycnt;
        __syncthreads();
        if (F.wave == 0 && F.lane < 8) { unsigned tot = 0;
#pragma unroll
            for (int w = 0; w < 8; ++w) tot += wcnt[w * 8 + F.lane];
            wcnt[64 + F.lane] = tot ? __hip_atomic_fetch_add(cnt + F.lane * 64, tot, RLX_AGENT) : 0u; }
        __syncthreads();
        if (F.lane < 8) { basev = wcnt[64 + F.lane]; for (int w = 0; w < F.wave; ++w) basev += wcnt[w * 8 + F.lane]; }
        __syncthreads();
        const unsigned b1 = __shfl(basev, me1), b2 = __shfl(basev, me2);
        if (act) {
            const int m = task * RT + F.lane;
            const size_t p1 = (size_t)me1 * M + b1 + rank1, p2 = (size_t)me2 * M + b2 + n1e2 + rank2;
            rowtok[p1] = m; rowssq[p1] = mss; rowslot[p1] = 2 * m; rowgate[p1] = mg1;
            rowtok[p2] = m; rowssq[p2] = mss; rowslot[p2] = 2 * m + 1; rowgate[p2] = mg2;
        }
    }
}
__device__ __forceinline__ void combine_phase(Frame& F, const bf16_t* ys, u64* ssq_next, bool last, bool dummy) {
    const int gw = F.bx * 8 + F.wave, NGW = F.G * 8, mend = last ? NREG : M;
    u32x4 nh[2], na[2], nc[2];
    if (gw < mend) { const u32x4* hr = (const u32x4*)(F.hb + (size_t)gw * D) + F.lane; const u32x4* y0 = (const u32x4*)(ys + (size_t)(2 * gw) * D) + F.lane; const u32x4* y1 = (const u32x4*)(ys + (size_t)(2 * gw + 1) * D) + F.lane;
#pragma unroll
        for (int j = 0; j < 2; ++j) { nh[j] = hr[64 * j]; na[j] = y0[64 * j]; nc[j] = y1[64 * j]; } }
    for (int m = gw; m < mend; m += NGW) {
        u32x4 ch[2], ca[2], cc2[2];
#pragma unroll
        for (int j = 0; j < 2; ++j) { ch[j] = nh[j]; ca[j] = na[j]; cc2[j] = nc[j]; }
        const int mn = m + NGW;
        if (mn < mend) { const u32x4* hr = (const u32x4*)(F.hb + (size_t)mn * D) + F.lane; const u32x4* y0 = (const u32x4*)(ys + (size_t)(2 * mn) * D) + F.lane; const u32x4* y1 = (const u32x4*)(ys + (size_t)(2 * mn + 1) * D) + F.lane;
#pragma unroll
            for (int j = 0; j < 2; ++j) { nh[j] = hr[64 * j]; na[j] = y0[64 * j]; nc[j] = y1[64 * j]; } }
        float v[2][8]; float s = 0.f;
#pragma unroll
        for (int j = 0; j < 2; ++j) { const u32x4 h4 = ch[j], a = ca[j], c = cc2[j];
            const unsigned hh[4] = {h4.x, h4.y, h4.z, h4.w}, aa[4] = {a.x, a.y, a.z, a.w}, cc[4] = {c.x, c.y, c.z, c.w};
#pragma unroll
            for (int i = 0; i < 4; ++i) { v[j][2 * i] = __uint_as_float(hh[i] << 16) + (__uint_as_float(aa[i] << 16) + __uint_as_float(cc[i] << 16));
                v[j][2 * i + 1] = __uint_as_float(hh[i] & 0xffff0000u) + (__uint_as_float(aa[i] & 0xffff0000u) + __uint_as_float(cc[i] & 0xffff0000u)); }
#pragma unroll
            for (int i = 0; i < 8; ++i) s += v[j][i] * v[j][i]; }
        if (last) {
            f32x4* o = (f32x4*)((dummy ? (float*)(F.ws + WS_R) + (size_t)(m & 0x7FFF) * D : F.out + (size_t)m * D)) + 2 * F.lane;
#pragma unroll
            for (int j = 0; j < 2; ++j) { o[128 * j] = (f32x4){v[j][0], v[j][1], v[j][2], v[j][3]}; o[128 * j + 1] = (f32x4){v[j][4], v[j][5], v[j][6], v[j][7]}; }
        } else {
            s = wave_sum(s);
            u32x4* o8 = (u32x4*)(dummy ? (bf16_t*)(F.ws + WS_R) + (size_t)(m & 0x7FFF) * D : F.hb + (size_t)m * D) + F.lane;
#pragma unroll
            for (int j = 0; j < 2; ++j) { u32x4 w; w.x = cvt_pk_bf16(v[j][0], v[j][1]); w.y = cvt_pk_bf16(v[j][2], v[j][3]); w.z = cvt_pk_bf16(v[j][4], v[j][5]); w.w = cvt_pk_bf16(v[j][6], v[j][7]); o8[64 * j] = w; }
            if (F.lane == 0) ssq_next[m] = ssq_fix(s);
        }
    }
}

__device__ __forceinline__ bool thin_gemm(Frame& F, f32x4 (&acc)[4], const bf16_t* ap, const bf16_t* const (&bp)[4], int K, int lane) {
#pragma unroll
    for (int t = 0; t < 4; ++t) acc[t] = (f32x4){0.f, 0.f, 0.f, 0.f};
    const int ksl = K / 8, kb = F.wave * ksl;
#pragma unroll 2
    for (int k0 = kb; k0 < kb + ksl; k0 += 64) {
        bf16x8 af[2], bf[2][4];
#pragma unroll
        for (int st = 0; st < 2; ++st) { af[st] = *(const bf16x8*)(ap + k0 + 32 * st);
#pragma unroll
            for (int t = 0; t < 4; ++t) bf[st][t] = *(const bf16x8*)(bp[t] + k0 + 32 * st); }
#pragma unroll
        for (int st = 0; st < 2; ++st)
#pragma unroll
            for (int t = 0; t < 4; ++t) acc[t] = __builtin_amdgcn_mfma_f32_16x16x32_bf16(bf[st][t], af[st], acc[t], 0, 0, 0);
    }
    LAS f32x4* part = (LAS f32x4*)F.lds;
#pragma unroll
    for (int t = 0; t < 4; ++t) part[(F.wave * 4 + t) * 64 + lane] = acc[t];
    __syncthreads();
    if (F.wave == 0) {
#pragma unroll
        for (int w = 1; w < 8; ++w)
#pragma unroll
            for (int t = 0; t < 4; ++t) acc[t] = acc[t] + part[(w * 4 + t) * 64 + lane];
    }
    return F.wave == 0;
}
__device__ __forceinline__ void thin_qkv(Frame& F, const bf16_t* W, const u64* ssq, const float* gq, const float* gk, bf16_t* Q, bf16_t* Kb, bf16_t* Vb, int nhk, int QT) {
    for (int task = F.bx; task < 16 + 2 * nhk; task += F.G) {
    int lane = F.lane; asm volatile("" : "+v"(lane));
    const int tk = lane & 15, kg = lane >> 4, tok = NREG + tk;
    const int kind = task < 16 ? 0 : (task < 16 + nhk ? 1 : 2), hh = kind == 0 ? task : (kind == 1 ? task - 16 : task - 16 - nhk);
    const bf16_t* bp[4];
#pragma unroll
    for (int t = 0; t < 4; ++t) { const int d = 16 * t + tk;
        const int row = kind == 0 ? (hh >> 2) * 256 + qk_perm(64 * (hh & 3) + d) : (kind == 1 ? (4 + (hh >> 2)) * 256 + qk_perm(64 * (hh & 3) + d) : QT * 256 + hh * 64 + d);
        bp[t] = W + (size_t)row * 1024 + 8 * kg; }
    f32x4 acc[4];
    if (thin_gemm(F, acc, F.hb + (size_t)tok * D + 8 * kg, bp, 1024, lane)) {
        const float rstd = fast_rsqrt(ssq_val(ssq[tok]) * (1.0f / 1024.0f) + EPS);
        if (kind < 2) {
            float ss = 0.f;
#pragma unroll
            for (int t = 0; t < 4; ++t) { acc[t] = acc[t] * rstd; ss += acc[t][0] * acc[t][0] + acc[t][1] * acc[t][1] + acc[t][2] * acc[t][2] + acc[t][3] * acc[t][3]; }
            ss += __shfl_xor(ss, 16); ss += __shfl_xor(ss, 32);
            const float hn = fast_rsqrt(ss * (1.0f / 64.0f) + EPS) * (kind == 0 ? 0.125f * LOG2E : 1.0f);
            const float* gp = kind == 0 ? gq : gk;
#pragma unroll
            for (int t = 0; t < 4; ++t) { const int d0 = 16 * t + 4 * kg; const f32x4 g = *(const f32x4*)(gp + d0); const f32x4 v = acc[t] * g * hn;
                u32x2 w; w.x = cvt_pk_bf16(v[0], v[1]); w.y = cvt_pk_bf16(v[2], v[3]);
                if (kind == 0) *(u32x2*)(Q + (size_t)tok * 1024 + hh * 64 + d0) = w;
                else *(u32x2*)(Kb + (((((size_t)(tok >> 3) * nhk + hh) * 2 + (d0 >> 5)) * 4 + ((d0 >> 3) & 3)) * 64) + (tok & 7) * 8 + (d0 & 7)) = w; }
        } else {
#pragma unroll
            for (int t = 0; t < 4; ++t)
#pragma unroll
                for (int r = 0; r < 4; ++r) { const int d = 16 * t + 4 * kg + r; const unsigned pk = cvt_pk_bf16(acc[t][r] * rstd, 0.f);
                    Vb[((size_t)(tok >> 3) * nhk + hh) * 512 + (((d >> 4) * 2 + ((tok >> 2) & 1)) * 16 + (d & 15)) * 4 + (tok & 3)] = (bf16_t)(pk & 0xffffu); }
        }
    }
    __syncthreads();
    }
}
__device__ __forceinline__ void thin_res(Frame& F, const bf16_t* A, int pitchA, int K, const bf16_t* W, u64* ssq_out, unsigned char* hb8) {
    for (int task = F.bx; task < 16; task += F.G) {
    int lane = F.lane; asm volatile("" : "+v"(lane));
    const int tk = lane & 15, kg = lane >> 4, tok = NREG + tk, c0 = 64 * task;
    const bf16_t* bp[4];
#pragma unroll
    for (int t = 0; t < 4; ++t) bp[t] = W + (size_t)dst_row(5, c0 + 16 * t + tk) * K + 8 * kg;
    f32x4 acc[4];
    if (thin_gemm(F, acc, A + (size_t)tk * pitchA + 8 * kg, bp, K, lane)) {
        float ss = 0.f;
#pragma unroll
        for (int t = 0; t < 4; ++t) { bf16_t* hp = F.hb + (size_t)tok * D + c0 + 16 * t + 4 * kg; const u32x2 b = *(const u32x2*)hp;
            const float o0 = __uint_as_float(b.x << 16) + acc[t][0], o1 = __uint_as_float(b.x & 0xffff0000u) + acc[t][1], o2 = __uint_as_float(b.y << 16) + acc[t][2], o3 = __uint_as_float(b.y & 0xffff0000u) + acc[t][3];
            u32x2 w; w.x = cvt_pk_bf16(o0, o1); w.y = cvt_pk_bf16(o2, o3); *(u32x2*)hp = w; ss += o0 * o0 + o1 * o1 + o2 * o2 + o3 * o3;
            if (hb8) { int p0 = 0; p0 = __builtin_amdgcn_cvt_pk_fp8_f32(o0, o1, p0, false); p0 = __builtin_amdgcn_cvt_pk_fp8_f32(o2, o3, p0, true); *(unsigned*)(hb8 + (size_t)tok * D + c0 + 16 * t + 4 * kg) = (unsigned)p0; } }
        ss += __shfl_xor(ss, 16); ss += __shfl_xor(ss, 32);
        if (kg == 0) __hip_atomic_fetch_add(ssq_out + tok, ssq_fix(ss), RLX_AGENT);
    }
    __syncthreads();
    }
}
__device__ __forceinline__ void thin_gu(Frame& F, const bf16_t* W, const u64* ssq, bf16_t* hid) {
    for (int task = F.bx; task < FF / 32; task += F.G) {
    int lane = F.lane; asm volatile("" : "+v"(lane));
    const int tk = lane & 15, kg = lane >> 4, tok = NREG + tk, j0 = 32 * task;
    const bf16_t* bp[4];
#pragma unroll
    for (int t = 0; t < 4; ++t) bp[t] = W + (size_t)dst_row(t < 2 ? 3 : 4, j0 + 16 * (t & 1) + tk) * 1024 + 8 * kg;
    f32x4 acc[4];
    if (thin_gemm(F, acc, F.hb + (size_t)tok * D + 8 * kg, bp, 1024, lane)) {
        const float rstd = fast_rsqrt(ssq_val(ssq[tok]) * (1.0f / 1024.0f) + EPS);
#pragma unroll
        for (int t = 0; t < 2; ++t) { float o[4];
#pragma unroll
            for (int r = 0; r < 4; ++r) o[r] = silu_f(acc[t][r] * rstd) * (acc[t + 2][r] * rstd);
            u32x2 w; w.x = cvt_pk_bf16(o[0], o[1]); w.y = cvt_pk_bf16(o[2], o[3]); *(u32x2*)(hid + (size_t)tok * FF + j0 + 16 * t + 4 * kg) = w; }
    }
    __syncthreads();
    }
}

__device__ __forceinline__ void thin_gu8(Frame& F, const unsigned char* W, const u64* ssq, bf16_t* hid) {
    for (int task = F.bx; task < FF / 32; task += F.G) {
    int lane = F.lane; asm volatile("" : "+v"(lane));
    const int tk = lane & 15, kg = lane >> 4, tok = NREG + tk, j0 = 32 * task;
    const unsigned char* ap = F.ws + WS_HB8 + (size_t)tok * D + F.wave * 128 + 32 * kg;
    const bf16x8 a0 = *(const bf16x8*)ap, a1 = *(const bf16x8*)(ap + 16);
    f32x4 acc[4];
#pragma unroll
    for (int t = 0; t < 4; ++t) { const unsigned char* bp = W + (size_t)dst_row(t < 2 ? 3 : 4, j0 + 16 * (t & 1) + tk) * 1024 + F.wave * 128 + 32 * kg;
        const bf16x8 b0 = *(const bf16x8*)bp, b1 = *(const bf16x8*)(bp + 16);
        acc[t] = __builtin_amdgcn_mfma_scale_f32_16x16x128_f8f6f4(pg8::cat8(b0, b1), pg8::cat8(a0, a1), (f32x4){0.f, 0.f, 0.f, 0.f}, 0, 0, 0, 0, 0, 0); }
    LAS f32x4* part = (LAS f32x4*)F.lds;
#pragma unroll
    for (int t = 0; t < 4; ++t) part[(F.wave * 4 + t) * 64 + lane] = acc[t];
    __syncthreads();
    if (F.wave == 0) {
#pragma unroll
        for (int w = 1; w < 8; ++w)
#pragma unroll
            for (int t = 0; t < 4; ++t) acc[t] = acc[t] + part[(w * 4 + t) * 64 + lane];
        const float rstd = fast_rsqrt(ssq_val(ssq[tok]) * (1.0f / 1024.0f) + EPS) * W8_INV;
#pragma unroll
        for (int t = 0; t < 2; ++t) { float o[4];
#pragma unroll
            for (int r = 0; r < 4; ++r) o[r] = silu_f(acc[t][r] * rstd) * (acc[t + 2][r] * rstd) * HID8_SCALE;
            int q = 0; q = __builtin_amdgcn_cvt_pk_fp8_f32(o[0], o[1], q, false); q = __builtin_amdgcn_cvt_pk_fp8_f32(o[2], o[3], q, true);
            *(unsigned*)((unsigned char*)hid + (size_t)tok * FF + j0 + 16 * t + 4 * kg) = (unsigned)q; }
    }
    __syncthreads();
    }
}
__device__ __forceinline__ void thin_res8(Frame& F, const unsigned char* A, const unsigned char* W, u64* ssq_out) {
    for (int task = F.bx; task < 16; task += F.G) {
    int lane = F.lane; asm volatile("" : "+v"(lane));
    const int tk = lane & 15, kg = lane >> 4, tok = NREG + tk, c0 = 64 * task;
    f32x4 acc[4];
#pragma unroll
    for (int t = 0; t < 4; ++t) acc[t] = (f32x4){0.f, 0.f, 0.f, 0.f};
    if (F.wave < 7) {
        const unsigned char* ap = A + (size_t)tk * FF + F.wave * 512 + 32 * kg;
#pragma unroll
        for (int i = 0; i < 4; ++i) {
            const bf16x8 a0 = *(const bf16x8*)(ap + 128 * i), a1 = *(const bf16x8*)(ap + 128 * i + 16);
#pragma unroll
            for (int t = 0; t < 4; ++t) { const unsigned char* bp = W + (size_t)dst_row(5, c0 + 16 * t + tk) * FF + F.wave * 512 + 128 * i + 32 * kg;
                const bf16x8 b0 = *(const bf16x8*)bp, b1 = *(const bf16x8*)(bp + 16);
                acc[t] = __builtin_amdgcn_mfma_scale_f32_16x16x128_f8f6f4(pg8::cat8(b0, b1), pg8::cat8(a0, a1), acc[t], 0, 0, 0, 0, 0, 0); }
        }
    }
    LAS f32x4* part = (LAS f32x4*)F.lds;
#pragma unroll
    for (int t = 0; t < 4; ++t) part[(F.wave * 4 + t) * 64 + lane] = acc[t];
    __syncthreads();
    if (F.wave == 0) {
#pragma unroll
        for (int w = 1; w < 8; ++w)
#pragma unroll
            for (int t = 0; t < 4; ++t) acc[t] = acc[t] + part[(w * 4 + t) * 64 + lane];
        float ss = 0.f;
#pragma unroll
        for (int t = 0; t < 4; ++t) { bf16_t* hp = F.hb + (size_t)tok * D + c0 + 16 * t + 4 * kg; const u32x2 b = *(const u32x2*)hp; const f32x4 a = acc[t] * (W8_INV * HID8_INV);
            const float o0 = __uint_as_float(b.x << 16) + a[0], o1 = __uint_as_float(b.x & 0xffff0000u) + a[1], o2 = __uint_as_float(b.y << 16) + a[2], o3 = __uint_as_float(b.y & 0xffff0000u) + a[3];
            u32x2 w; w.x = cvt_pk_bf16(o0, o1); w.y = cvt_pk_bf16(o2, o3); *(u32x2*)hp = w; ss += o0 * o0 + o1 * o1 + o2 * o2 + o3 * o3; }
        ss += __shfl_xor(ss, 16); ss += __shfl_xor(ss, 32);
        if (kg == 0) __hip_atomic_fetch_add(ssq_out + tok, ssq_fix(ss), RLX_AGENT);
    }
    __syncthreads();
    }
}

constexpr int PH_PER_PAIR = 10 + 2 * MOE_NCH, N_PHASES = 1 + 2 * PH_PER_PAIR;
typedef const __attribute__((address_space(4))) Args* KArgs;
__device__ __forceinline__ KArgs kargs() { KArgs p = (KArgs)__builtin_amdgcn_kernarg_segment_ptr(); asm volatile("" : "+s"(p)); return p; }
__device__ __forceinline__ void make_frame(Frame& F, KArgs ap) {
    extern __shared__ __attribute__((aligned(16))) unsigned char lds_raw[];
    { LAS unsigned char* lp = (LAS unsigned char*)lds_raw; asm volatile("" : "+s"(lp)); F.lds = lp; }
    F.tab = F.lds + TAB_OFF;
    int t = threadIdx.x; asm volatile("" : "+v"(t));
    F.tid = t; F.lane = t & 63; F.wave = __builtin_amdgcn_readfirstlane(t >> 6);
    { int g_ = gridDim.x, b_ = blockIdx.x; asm volatile("" : "+s"(g_), "+s"(b_)); F.G = g_; F.bx = b_; }
    unsigned char* ws = ap->ws;
    F.ws = ws; F.out = ap->out; F.hb = (bf16_t*)(ws + WS_HB); F.ctl = (unsigned*)(ws + WS_CTL);
}
__device__ __forceinline__ void grid_seam() {
    KArgs ap = kargs();
    extern __shared__ __attribute__((aligned(16))) unsigned char lds_raw[];
    XcdBarrier b; b.bar = (unsigned*)(ap->ws + WS_CTL) + CW_BAR; b.x = xb_xcc_id(); b.st = (volatile LAS unsigned*)((LAS unsigned char*)lds_raw + MISC_OFF) + 8;
    xcd_barrier(b);
}
#ifndef SITE_MASK
#define SITE_MASK 0xFFFF
#endif
#define SITE(b) ((SITE_MASK >> (b)) & 1)

__device__ __forceinline__ void site_na_qkv(int pr) {
    KArgs ap = kargs(); Frame F; make_frame(F, ap);
    const int lb = pr ? I_L2 : I_L0; const unsigned char* wb = F.ws + WS_W + (size_t)pr * WPAIR; unsigned char* R = F.ws + WS_R;
    LAS float* gainsL = (LAS float*)(F.lds + GAIN_OFF);
    if (F.tid < 64) { gainsL[F.tid] = ap->in[lb + 2][F.tid] * (0.125f * LOG2E); gainsL[64 + F.tid] = ap->in[lb + 3][F.tid]; }
    __syncthreads();
    QkvPolicy P; P.nt = 16; P.pitchA = 2048; P.pitchB = 2048; P.G = F.G; P.c = F.bx; P.nN = 12; P.QT = 8; P.hb = (const char*)F.hb; P.W = (const char*)(wb + WNA_QKV);
    P.ssq = ssq_buf(F, 4 * pr + 0); P.Q = (bf16_t*)(R + R_Q); P.K = (bf16_t*)(R + R_K); P.VT = (bf16_t*)(R + R_VT_NA); P.kpitch = 1024; P.nQ = 4; P.gains = gainsL;
    thin_qkv(F, (const bf16_t*)(wb + WNA_QKV), ssq_buf(F, 4 * pr + 0), ap->in[lb + 2], ap->in[lb + 3], P.Q, P.K, P.VT, 16, 8);
    pg8::gemm_phase(F.lds, F.tab, P);
}
__device__ __forceinline__ void site_na_attn(int pr, bool dummy) {
    KArgs ap = kargs(); Frame F; make_frame(F, ap);
    const int lb = pr ? I_L2 : I_L0; unsigned char* R = F.ws + WS_R;
    LAS float* tbl = (LAS float*)(F.lds + NA_TBL_OFF); const float* rpb = ap->in[lb + 4];
    for (int i = F.tid; i < 16 * NA_TBL_HEAD; i += 512) { const int c = (i & 63) - 16, hd = i >> 6; tbl[i] = (c >= 0 && c < 31) ? rpb[hd * 31 + c] * LOG2E - SM_SHIFT : 0.f; }
    __syncthreads();
    AttnCtx X; X.Q = (const bf16_t*)(R + R_Q); X.K = (const bf16_t*)(R + R_K); X.VT = (const bf16_t*)(R + R_VT_NA); X.O = dummy ? (bf16_t*)(R + 3 * HB_BYTES) : (bf16_t*)(R + R_Q); X.omask = dummy ? 0x7FFFu : 0xFFFFFFFFu; X.kpitch = 1024; X.tbl = tbl;
    { int lane_l = F.lane; asm volatile("" : "+v"(lane_l));
      for (int u = F.bx * 8 + F.wave; u < 16; u += F.G * 8) metaq_unit<0>(X, tbl, tbl, 0, u, lane_l); }
    for (int pair = F.bx; pair < 512; pair += F.G) na_ring_item(F, X, pair);
    __syncthreads();
}
__device__ __forceinline__ void site_wo(int pr, int swa) {
    KArgs ap = kargs(); Frame F; make_frame(F, ap);
    const unsigned char* wb = F.ws + WS_W + (size_t)pr * WPAIR; unsigned char* R = F.ws + WS_R;
    ResPolicy<> P; P.nt = 16; P.pitchA = 2048; P.pitchB = 2048; P.G = F.G; P.c = F.bx; P.A = (const char*)(R + R_Q); P.W = (const char*)(wb + (swa ? WSW_O : WNA_O));
    const bool dummy = ap->dummy != 0;
    P.hb = F.hb; P.ssq_out = ssq_buf(F, dummy ? 8 : 4 * pr + (swa ? 3 : 1)); P.dmy = dummy ? (bf16_t*)(F.ws + WS_END) : nullptr;
    P.hb8 = ((swa || pr >= DENSE8_FROM) && !dummy) ? F.ws + WS_HB8 : nullptr;
    if (!dummy) thin_res(F, (const bf16_t*)(R + R_Q) + (size_t)NREG * 1024, 1024, 1024, (const bf16_t*)P.W, P.ssq_out, P.hb8);
    pg8::gemm_phase(F.lds, F.tab, P);
}
__device__ __forceinline__ void site_dense_gu(int pr) {
    KArgs ap = kargs(); Frame F; make_frame(F, ap);
    const unsigned char* wb = F.ws + WS_W + (size_t)pr * WPAIR; unsigned char* R = F.ws + WS_R;
    if (pr >= DENSE8_FROM) {
        GuPolicy<false, true> P; P.nt = 8; P.pitchA = 1024; P.pitchB = 1024; P.G = F.G; P.c = F.bx; P.hb = (const char*)(F.ws + WS_HB8); P.W = (const char*)(wb + WNA_GU); P.ssq = ssq_buf(F, 4 * pr + 1); P.hid = (bf16_t*)R;
        P.rowtok = nullptr; P.p0 = 0; P.p1 = 0; P.ptab = nullptr;
        thin_gu8(F, wb + WNA_GU, ssq_buf(F, 4 * pr + 1), (bf16_t*)R);
        pg8::gemm_phase(F.lds, F.tab, P);
    } else {
    GuPolicy<false> P; P.nt = 16; P.pitchA = 2048; P.pitchB = 2048; P.G = F.G; P.c = F.bx; P.hb = (const char*)F.hb; P.W = (const char*)(wb + WNA_GU); P.ssq = ssq_buf(F, 4 * pr + 1); P.hid = (bf16_t*)R;
    P.rowtok = nullptr; P.p0 = 0; P.p1 = 0; P.ptab = nullptr;
    thin_gu(F, (const bf16_t*)(wb + WNA_GU), ssq_buf(F, 4 * pr + 1), (bf16_t*)R);
    pg8::gemm_phase(F.lds, F.tab, P);
    }
}
__device__ __forceinline__ void site_dense_down(int pr) {
    KArgs ap = kargs(); Frame F; make_frame(F, ap);
    const unsigned char* wb = F.ws + WS_W + (size_t)pr * WPAIR; unsigned char* R = F.ws + WS_R;
    const bool dummy = ap->dummy != 0;
    if (pr >= DENSE8_FROM) {
        ResPolicy<true> P; P.nt = 28; P.pitchA = 3584; P.pitchB = 3584; P.G = F.G; P.c = F.bx; P.A = (const char*)R; P.W = (const char*)(wb + WNA_D);
        P.hb = F.hb; P.ssq_out = ssq_buf(F, dummy ? 8 : 4 * pr + 2); P.dmy = dummy ? (bf16_t*)(F.ws + WS_END) : nullptr;
        P.hb8 = nullptr;
        if (!dummy) thin_res8(F, (const unsigned char*)R + (size_t)NREG * FF, (const unsigned char*)P.W, P.ssq_out);
        pg8::gemm_phase(F.lds, F.tab, P);
    } else {
    ResPolicy<> P; P.nt = 56; P.pitchA = 7168; P.pitchB = 7168; P.G = F.G; P.c = F.bx; P.A = (const char*)R; P.W = (const char*)(wb + WNA_D);
    P.hb = F.hb; P.ssq_out = ssq_buf(F, dummy ? 8 : 4 * pr + 2); P.dmy = dummy ? (bf16_t*)(F.ws + WS_END) : nullptr;
    P.hb8 = nullptr;
    if (!dummy) thin_res(F, (const bf16_t*)R + (size_t)NREG * FF, FF, FF, (const bf16_t*)P.W, P.ssq_out, nullptr);
    pg8::gemm_phase(F.lds, F.tab, P);
    }
}
__device__ __forceinline__ void site_swa_qkv(int pr) {
    KArgs ap = kargs(); Frame F; make_frame(F, ap);
    const int lb = pr ? I_L3 : I_L1; const unsigned char* wb = F.ws + WS_W + (size_t)pr * WPAIR; unsigned char* R = F.ws + WS_R;
    LAS float* gainsL = (LAS float*)(F.lds + GAIN_OFF);
    if (F.tid < 64) { gainsL[F.tid] = ap->in[lb + 2][F.tid] * (0.125f * LOG2E); gainsL[64 + F.tid] = ap->in[lb + 3][F.tid]; }
    __syncthreads();
    QkvPolicy P; P.nt = 16; P.pitchA = 2048; P.pitchB = 2048; P.G = F.G; P.c = F.bx; P.nN = 6; P.QT = 5; P.hb = (const char*)F.hb; P.W = (const char*)(wb + WSW_QKV);
    P.ssq = ssq_buf(F, 4 * pr + 2); P.Q = (bf16_t*)(R + R_Q); P.K = (bf16_t*)(R + R_K); P.VT = (bf16_t*)(R + R_VT_SWA); P.kpitch = 256; P.nQ = 4; P.gains = gainsL;
    thin_qkv(F, (const bf16_t*)(wb + WSW_QKV), ssq_buf(F, 4 * pr + 2), ap->in[lb + 2], ap->in[lb + 3], P.Q, P.K, P.VT, 4, 5);
    pg8::gemm_phase(F.lds, F.tab, P);
}
__device__ __forceinline__ void site_swa_attn(int pr, bool dummy) {
    KArgs ap = kargs(); Frame F; make_frame(F, ap);
    const int lb = pr ? I_L3 : I_L1; unsigned char* R = F.ws + WS_R;
    const float* t5 = ap->in[I_T5]; const float* sink = ap->in[lb + 4];
    AttnCtx X; X.Q = (const bf16_t*)(R + R_Q); X.K = (const bf16_t*)(R + R_K); X.VT = (const bf16_t*)(R + R_VT_SWA); X.O = dummy ? (bf16_t*)(R + 3 * HB_BYTES) : (bf16_t*)(R + R_Q); X.omask = dummy ? 0x7FFFu : 0xFFFFFFFFu; X.kpitch = 256;
    {
        LAS float* xt = (LAS float*)(F.lds + ATT_X_OFF);
        xt[SX_T5 / 4 + F.tid] = t5[F.tid] * LOG2E - SM_SHIFT;
        if (F.tid < 16) xt[SX_SINK / 4 + F.tid] = sink[F.tid] * LOG2E - SM_SHIFT;
        __syncthreads();
        X.tbl = (const LAS float*)(F.lds + ATT_X_OFF) - SWA_T5_OFF;
        { int lane_l = F.lane; asm volatile("" : "+v"(lane_l));
          for (int u = F.bx * 8 + F.wave; u < 16; u += F.G * 8) attn_unit<1>(X, 0, u, 0, 0, true, lane_l); }
        for (int item = F.bx; item < 256; item += F.G) {
            const int n = (item >> 1) & 3;
            __syncthreads();
            for (int i = F.tid; i < 4 * SWA_TBL_HEAD; i += 512) { const int gg = i / SWA_TBL_HEAD, rel = i % SWA_TBL_HEAD - 288; const int bkt = (rel > 0 ? 16 : 0) + t5_bucket_abs(rel < 0 ? -rel : rel); xt[SX_TBL / 4 + i] = t5[bkt * 16 + n * 4 + gg] * LOG2E - SM_SHIFT; }
            __syncthreads();
            swa_ring_item(F, X, item);
        }
    }
    __syncthreads();
}
__device__ __forceinline__ void site_router(int pr) {
    KArgs ap = kargs(); Frame F; make_frame(F, ap);
    const int lb = pr ? I_L3 : I_L1;
    router_phase(F, ap->in[lb + 7], ap->in[lb + 6], ssq_buf(F, 4 * pr + 3), pr, ap->dummy != 0);
}
__device__ __forceinline__ int moe_tables(Frame& F, int pr) {
    volatile LAS int* pt = (volatile LAS int*)(F.lds + MISC_OFF + 128);
    if (F.tid == 0) { int acc = 0; pt[0] = 0;
        for (int e = 0; e < NE; ++e) { const int c = (int)__hip_atomic_load(F.ctl + CW_CNT + pr * 8 * 64 + e * 64, RLX_AGENT); pt[9 + e] = c; acc += (c + 255) / 256; pt[e + 1] = acc; } }
    __syncthreads();
    return pt[NE];
}
__device__ __forceinline__ void site_moe_gu(int pr, int ch) {
    KArgs ap = kargs(); Frame F; make_frame(F, ap);
    const int PT = moe_tables(F, pr); const int P0 = ch * MOE_CH, P1 = (ch == MOE_NCH - 1 || (P0 + MOE_CH) >= PT) ? PT : (P0 + MOE_CH);
    if (P0 < P1) {
        const unsigned char* wb = F.ws + WS_W + (size_t)pr * WPAIR; unsigned char* R = F.ws + WS_R;
        GuPolicy<true> P; P.nt = 8; P.pitchA = 1024; P.pitchB = 1024; P.G = F.G; P.c = F.bx; P.hb = (const char*)(F.ws + WS_HB8); P.W = (const char*)(wb + WSW_GU); P.ssq = (const void*)(F.ws + WS_TAB + TAB_BYTES); P.hid = (bf16_t*)R;
        P.rowtok = (const unsigned*)(F.ws + WS_TAB); P.p0 = P0; P.p1 = P1; P.ptab = (const LAS int*)(F.lds + MISC_OFF + 128);
        pg8::gemm_phase(F.lds, F.tab, P);
    }
    __syncthreads();
}
__device__ __forceinline__ void site_moe_down(int pr, int ch) {
    KArgs ap = kargs(); Frame F; make_frame(F, ap);
    const int PT = moe_tables(F, pr); const int P0 = ch * MOE_CH, P1 = (ch == MOE_NCH - 1 || (P0 + MOE_CH) >= PT) ? PT : (P0 + MOE_CH);
    if (P0 < P1) {
        const unsigned char* wb = F.ws + WS_W + (size_t)pr * WPAIR; unsigned char* R = F.ws + WS_R;
        MoeDownPolicy P; P.nt = 28; P.pitchA = 3584; P.pitchB = 3584; P.G = F.G; P.c = F.bx; P.hid = (const char*)R; P.W = (const char*)(wb + WSW_D);
        P.rowslot = (const unsigned*)(F.ws + WS_TAB + 2 * TAB_BYTES); P.rowgate = (const float*)(F.ws + WS_TAB + 3 * TAB_BYTES); P.ys = (bf16_t*)(R + R_YS); P.p0 = P0; P.p1 = P1; P.ptab = (const LAS int*)(F.lds + MISC_OFF + 128);
        pg8::gemm_phase(F.lds, F.tab, P);
    }
    __syncthreads();
}
__device__ __forceinline__ void site_combine(int pr) {
    KArgs ap = kargs(); Frame F; make_frame(F, ap);
    const bool dummy = ap->dummy != 0;
    combine_phase(F, (const bf16_t*)(F.ws + WS_R + R_YS), ssq_buf(F, dummy ? 3 : (pr ? 0 : 4)), pr == 1, dummy);
}

__global__ void __launch_bounds__(512, 2) fwd_kernel(Args args) {
    extern __shared__ __attribute__((aligned(16))) unsigned char lds_raw[];
    {
        volatile LAS unsigned* MISC = (volatile LAS unsigned*)((LAS unsigned char*)lds_raw + MISC_OFF);
        if (threadIdx.x < 64) MISC[threadIdx.x] = 0u;
        __syncthreads();
    }
    const int lo = args.ph_lo, hi = args.ph_hi;
    if (hi - lo > 1) { KArgs ap = kargs(); (void)xcd_barrier_post((unsigned*)(ap->ws + WS_CTL) + CW_BAR, (volatile LAS unsigned*)((LAS unsigned char*)lds_raw + MISC_OFF) + 8); }
#define IN(k) (lo <= (k) && (k) < hi)
#if PROBE_A || PROBE_B
#define STAMP(k) do { if (blockIdx.x == 0 && threadIdx.x == 0) { KArgs ap_ = kargs(); ((u64*)(ap_->ws + WS_CTL + 49152))[(k)] = __builtin_amdgcn_s_memrealtime(); } } while (0)
#else
#define STAMP(k) do { } while (0)
#endif
#define SEAM(k) do { if (IN(k) && IN((k) + 1)) grid_seam(); STAMP((k) + 1); } while (0)
    STAMP(0);
    if ((REP_MASK & 1) && IN(0)) { KArgs ap = kargs(); Frame F; make_frame(F, ap); prologue(F, ap); grid_seam(); }
    if (SITE(0) && IN(0)) { KArgs ap = kargs(); Frame F; make_frame(F, ap); prologue(F, ap); }
    SEAM(0);
    for (int pr = 0; pr < 2; ++pr) {
        const int pb = 1 + pr * PH_PER_PAIR;
        if (((REP_MASK >> 1) & 1) && IN(pb + 0)) { site_na_qkv(pr); grid_seam(); }
        if (SITE(1) && IN(pb + 0)) site_na_qkv(pr);
        SEAM(pb + 0);
        if (((REP_MASK >> 2) & 1) && IN(pb + 1)) { site_na_attn(pr, true); grid_seam(); }
        if (SITE(2) && IN(pb + 1)) site_na_attn(pr, kargs()->dummy != 0);
        SEAM(pb + 1);
        if (SITE(3) && IN(pb + 2)) site_wo(pr, 0);
        SEAM(pb + 2);
        if (((REP_MASK >> 4) & 1) && IN(pb + 3)) { site_dense_gu(pr); grid_seam(); }
        if (SITE(4) && IN(pb + 3)) site_dense_gu(pr);
        SEAM(pb + 3);
        if (SITE(5) && IN(pb + 4)) site_dense_down(pr);
        SEAM(pb + 4);
        if (SITE(6) && IN(pb + 5)) site_swa_qkv(pr);
        SEAM(pb + 5);
        if (((REP_MASK >> 7) & 1) && IN(pb + 6)) { site_swa_attn(pr, true); grid_seam(); }
        if (SITE(7) && IN(pb + 6)) site_swa_attn(pr, kargs()->dummy != 0);
        SEAM(pb + 6);
        if (SITE(8) && IN(pb + 7)) site_wo(pr, 1);
        SEAM(pb + 7);
        if (SITE(9) && IN(pb + 8)) site_router(pr);
        SEAM(pb + 8);
        for (int ch = 0; ch < MOE_NCH; ++ch) {
            if (SITE(10) && IN(pb + 9 + 2 * ch)) site_moe_gu(pr, ch);
            SEAM(pb + 9 + 2 * ch);
            if (SITE(11) && IN(pb + 10 + 2 * ch)) site_moe_down(pr, ch);
            SEAM(pb + 10 + 2 * ch);
        }
        if (SITE(12) && IN(pb + 9 + 2 * MOE_NCH)) site_combine(pr);
        SEAM(pb + 9 + 2 * MOE_NCH);
    }
#if PROBE_A || PROBE_B
    {
        grid_seam();
        KArgs ap = kargs(); const u64* ts = (const u64*)(ap->ws + WS_CTL + 49152);
        u64 ta = 0, tb = 0;
        for (int k = 0; k < N_PHASES; ++k) { const u64 d = __hip_atomic_load(ts + k + 1, RLX_AGENT) - __hip_atomic_load(ts + k, RLX_AGENT); if ((PROBE_A >> k) & 1ull) ta += d; if ((PROBE_B >> k) & 1ull) tb += d; }
        const float sc = 1.0f + (float)ta * 1e-5f;
        float* o = ap->out;
        for (size_t i = (size_t)blockIdx.x * 512 + threadIdx.x; i < (size_t)NREG * D; i += (size_t)gridDim.x * 512) o[i] *= sc;
        if (PROBE_B) { grid_seam(); if (blockIdx.x == 0 && threadIdx.x == 0) o[0] = (float)tb * 0.01f; }
    }
#endif
#undef IN
#undef SEAM
}

extern "C" void kernel_launch(void* const* d_in, const int* in_sizes, int n_in, void* d_out, int out_size, void* d_ws, size_t ws_size, hipStream_t stream) {
    static int grid = 0;
    if (grid == 0) {
        if (n_in != 45 || out_size != NREG * D || ws_size < WS_END) { fprintf(stderr, "kernel_launch: unexpected shapes (n_in %d out %d ws %zu need %zu)\n", n_in, out_size, ws_size, (size_t)WS_END); grid = -1; return; }
        int dev = 0, cus = 0, per_cu = 0;
        if (hipGetDevice(&dev) != hipSuccess || hipDeviceGetAttribute(&cus, hipDeviceAttributeMultiprocessorCount, dev) != hipSuccess) { grid = -1; return; }
        if (hipFuncSetAttribute((const void*)fwd_kernel, hipFuncAttributeMaxDynamicSharedMemorySize, LDS_BYTES) != hipSuccess) { fprintf(stderr, "kernel_launch: hipFuncSetAttribute failed\n"); grid = -1; return; }
        if (hipOccupancyMaxActiveBlocksPerMultiprocessor(&per_cu, (const void*)fwd_kernel, 512, LDS_BYTES) != hipSuccess || per_cu < 1) fprintf(stderr, "kernel_launch: occupancy query says %d\n", per_cu);
        (void)hipGetLastError();
        grid = cus;
    }
    if (grid < 0) return;
    (void)hipMemsetAsync((char*)d_ws + WS_CTL, 0, CTL_BYTES, stream);
    Args a{};
    for (int i = 0; i < 45; ++i) a.in[i] = (const float*)d_in[i];
    a.out = (float*)d_out; a.ws = (unsigned char*)d_ws;
#if MK_MULTI
    for (int p = 0; p < N_PHASES && p <= MK_STOP; ++p) { a.ph_lo = p; a.ph_hi = p + 1;
        if (p == DUP_PHASE) { a.dummy = 1; hipLaunchKernelGGL(fwd_kernel, dim3(grid), dim3(512), LDS_BYTES, stream, a); a.dummy = 0; }
        hipLaunchKernelGGL(fwd_kernel, dim3(grid), dim3(512), LDS_BYTES, stream, a); }
#else
    a.ph_lo = 0; a.ph_hi = N_PHASES;
    hipLaunchKernelGGL(fwd_kernel, dim3(grid), dim3(512), LDS_BYTES, stream, a);
#endif
}
```

```cpp
#include <hip/hip_runtime.h>
#include <cstdio>
#include <cstdint>

#ifndef MK_MULTI
#define MK_MULTI 0
#endif

#ifndef PROBE_A
#define PROBE_A 0ull
#define PROBE_B 0ull
#endif
#ifndef DENSE8_FROM
#define DENSE8_FROM 1
#endif
#ifndef REP_MASK
#define REP_MASK 0
#endif
#ifndef DUP_PHASE
#define DUP_PHASE -1
#endif
#ifndef MK_STOP
#define MK_STOP 1000
#endif
#define LAS __attribute__((address_space(3)))
#define GAS __attribute__((address_space(1)))
typedef unsigned short bf16_t;
typedef short bf16x8 __attribute__((ext_vector_type(8)));
typedef short s16x4 __attribute__((ext_vector_type(4)));
typedef float f32x4 __attribute__((ext_vector_type(4)));
typedef float f32x2 __attribute__((ext_vector_type(2)));
typedef unsigned u32x4 __attribute__((ext_vector_type(4)));
typedef unsigned u32x2 __attribute__((ext_vector_type(2)));
#define RLX_AGENT __ATOMIC_RELAXED, __HIP_MEMORY_SCOPE_AGENT

constexpr int D = 1024, NREG = 65536, NMETA_ROWS = 16, M = NREG + NMETA_ROWS, NPANEL = NREG / 256;
constexpr int SEQ = 2048, BATCH = 32, FF = 3584, NE = 8;
constexpr float EPS = 1e-6f;
constexpr float LOG2E = 1.4426950408889634f;
constexpr float NEGBIG = -1e30f;
constexpr float SM_SHIFT = 16.0f;

constexpr size_t WS_CTL = 0, CTL_BYTES = 8u << 20;
constexpr int CW_TMO = 0, CW_BAR = 4096, CW_CNT = 8192;
constexpr size_t CTL_SSQ = 65536;
constexpr size_t SSQ_BYTES = (size_t)M * 8;
constexpr float SSQ_SCALE = 16777216.0f, SSQ_INV = 1.0f / 16777216.0f;
typedef unsigned long long u64;
static_assert(CTL_SSQ + 9 * SSQ_BYTES <= CTL_BYTES, "ctl");
constexpr size_t W_QKV_NA = (size_t)3072 * 1024 * 2, W_O = (size_t)1024 * 1024 * 2, W_GU = (size_t)7168 * 1024 * 2, W_D = (size_t)1024 * 3584 * 2, W_QKV_SWA = (size_t)1536 * 1024 * 2;
constexpr size_t WNA_QKV = 0, WNA_O = WNA_QKV + W_QKV_NA, WNA_GU = WNA_O + W_O, WNA_D = WNA_GU + W_GU, WNA_END = WNA_D + W_D;
constexpr size_t W_GU8 = (size_t)7168 * 1024;
constexpr size_t W_D8 = (size_t)1024 * 3584;
constexpr float W8_SCALE = 64.0f, W8_INV = 1.0f / 64.0f;
constexpr float HID8_SCALE = 4.0f, HID8_INV = 0.25f;
constexpr size_t WSW_QKV = WNA_END, WSW_O = WSW_QKV + W_QKV_SWA, WSW_GU = WSW_O + W_O, WSW_D = WSW_GU + NE * W_GU8, WPAIR = WSW_D + NE * W_D8;
constexpr size_t WS_W = CTL_BYTES;
constexpr size_t WS_HB = WS_W + 2 * WPAIR;
constexpr size_t HB_BYTES = (size_t)M * D * 2;
constexpr size_t WS_HB8 = WS_HB + HB_BYTES;
constexpr size_t WS_TAB = WS_HB8 + (size_t)M * D;
constexpr size_t TAB_BYTES = (size_t)NE * M * 4;
constexpr size_t WS_R = WS_TAB + 4 * TAB_BYTES;
constexpr size_t R_Q = 0, R_K = HB_BYTES, R_VT_NA = 2 * HB_BYTES, R_VT_SWA = HB_BYTES + (size_t)M * 256 * 2;
constexpr int MOE_CH = 256, MOE_NCH = 2, MOE_CH_MAX = 264;
constexpr size_t R_YS = (size_t)MOE_CH_MAX * 256 * FF;
constexpr size_t R_DENSE = (size_t)M * FF * 2, R_MOE = R_YS + (size_t)2 * M * D * 2;
constexpr size_t R_BYTES = R_DENSE > R_MOE ? R_DENSE : R_MOE;
static_assert(3 * HB_BYTES <= R_BYTES, "R");
constexpr size_t WS_END = WS_R + R_BYTES;
static_assert(WS_END + (24u << 20) <= 1115912448ull, "d_ws budget (incl. the 24 MiB scratch window of timing experiments)");

constexpr int TAB_OFF = 131072;
constexpr int GAIN_OFF = TAB_OFF + 10240;
constexpr int MISC_OFF = 163840 - 512;
constexpr int ATT_X_OFF = 147456;
constexpr int LDS_BYTES = 163840;
static_assert(MISC_OFF + 256 <= LDS_BYTES, "lds");

__device__ __forceinline__ unsigned cvt_pk_bf16(float lo, float hi) { unsigned r; asm volatile("v_cvt_pk_bf16_f32 %0, %1, %2" : "=v"(r) : "v"(lo), "v"(hi)); return r; }
__device__ __forceinline__ float wave_sum(float v) {
#pragma unroll
    for (int o = 1; o < 64; o <<= 1) v += __shfl_xor(v, o);
    return v;
}
__device__ __forceinline__ float fast_rsqrt(float x) { return __builtin_amdgcn_rsqf(x); }
__device__ __forceinline__ float fast_exp2(float x) { return __builtin_amdgcn_exp2f(x); }
__device__ __forceinline__ float fast_rcp(float x) { return __builtin_amdgcn_rcpf(x); }
__device__ __forceinline__ float silu_f(float x) { return x * fast_rcp(1.0f + fast_exp2(-x * LOG2E)); }

#define XB_TMO      128
#define XB_XCNT(j)  (256  + 64 * (j))
#define XB_XSUB(j)  (1280 + 64 * (j))
#define XB_XGEN(j)  (2304 + 64 * (j))
#define XB_TOP      3328
#define XB_TOPGEN   3392
#define XCD_BAR_WORDS 3456
#define XB_SPIN_CAP (1u << 18)
template <class T> __device__ __forceinline__ unsigned xb_ld(T* p)              { return __hip_atomic_load(p, __ATOMIC_RELAXED, __HIP_MEMORY_SCOPE_AGENT); }
template <class T> __device__ __forceinline__ unsigned xb_add(T* p, unsigned v) { return __hip_atomic_fetch_add(p, v, __ATOMIC_RELAXED, __HIP_MEMORY_SCOPE_AGENT); }
__device__ __forceinline__ unsigned xb_xcc_id() { return (unsigned)__builtin_amdgcn_s_getreg((3 << 11) | 20) & 0xFu; }
#define XB_SPIN(cond, bar) do { unsigned _sp = 0; while (cond) { __builtin_amdgcn_s_sleep(1); \
    if ((++_sp & 255u) == 0u) { if (xb_ld(&(bar)[XB_TMO])) break; if (_sp > XB_SPIN_CAP) { xb_add(&(bar)[XB_TMO], 1u); break; } } } } while (0)
struct XcdBarrier { unsigned* bar; unsigned x; volatile LAS unsigned* st; };
__device__ __forceinline__ XcdBarrier xcd_barrier_post(unsigned* bar, volatile LAS unsigned* st) {
    XcdBarrier b; b.bar = bar; b.x = xb_xcc_id(); b.st = st;
    if (threadIdx.x == 0) (void)xb_add(&bar[XB_XCNT(b.x)], 1u);
    return b;
}
__device__ __forceinline__ void xcd_barrier_complete(GAS unsigned* bar, unsigned x, unsigned& nloc, unsigned& nx) {
    const unsigned G = gridDim.x * gridDim.y * gridDim.z;
    unsigned sum, cnt, mine, sp = 0u;
    for (;;) {
        sum = 0u; cnt = 0u; mine = 0u;
#pragma unroll
        for (unsigned j = 0; j < 16; ++j) { const unsigned c = xb_ld(&bar[XB_XCNT(j)]); sum += c; cnt += (c > 0u) ? 1u : 0u; mine = (j == x) ? c : mine; }
        if (sum == G) break;
        __builtin_amdgcn_s_sleep(1);
        if ((++sp & 255u) == 0u) { if (xb_ld(&bar[XB_TMO])) break; if (sp > XB_SPIN_CAP) { xb_add(&bar[XB_TMO], 1u); break; } }
    }
    nloc = mine > 0u ? mine : 1u; nx = cnt > 0u ? cnt : 1u;
}
__device__ __noinline__ void xcd_barrier_leader(GAS unsigned* bar, unsigned x, volatile LAS unsigned* st) {
    __builtin_amdgcn_s_waitcnt(0);
    unsigned nloc = st[0], nx = st[1];
    if (nloc == 0u) { xcd_barrier_complete(bar, x, nloc, nx); st[0] = nloc; st[1] = nx; }
    const unsigned old = xb_add(&bar[XB_XSUB(x)], 1u);
    const unsigned gen = old / nloc;
    if (old + 1u == (gen + 1u) * nloc) {
        __builtin_amdgcn_fence(__ATOMIC_RELEASE, "agent");
        asm volatile("s_waitcnt vmcnt(0)" ::: "memory");
        const unsigned og = xb_add(&bar[XB_TOP], 1u);
        const unsigned tg = og / nx;
        if (og + 1u == (tg + 1u) * nx) xb_add(&bar[XB_TOPGEN], 1u);
        else XB_SPIN(xb_ld(&bar[XB_TOPGEN]) == tg, bar);
        __builtin_amdgcn_fence(__ATOMIC_ACQUIRE, "agent");
        xb_add(&bar[XB_XGEN(x)], 1u);
        asm volatile("s_waitcnt vmcnt(0)" ::: "memory");
    } else {
        XB_SPIN(xb_ld(&bar[XB_XGEN(x)]) == gen, bar);
        __builtin_amdgcn_fence(__ATOMIC_ACQUIRE, "agent");
        asm volatile("s_waitcnt vmcnt(0)" ::: "memory");
    }
}
__device__ __forceinline__ void xcd_barrier(const XcdBarrier& b) {
    asm volatile("s_waitcnt vmcnt(0)" ::: "memory");
    __syncthreads();
    if (threadIdx.x == 0) xcd_barrier_leader((GAS unsigned*)b.bar, b.x, b.st);
    __syncthreads();
}

namespace pg8 {
constexpr int BM = 256, BK = 64, HALF = 128, HTB = HALF * BK * 2, NXCD = 8, WGM = 8;
__host__ __device__ __forceinline__ int lds_byte(int r, int c) { const int st = (r >> 4) * 2 + (c >> 5), rr = r & 15, cc = c & 31, ob = rr * 64 + cc * 2; return st * 1024 + (ob ^ (((ob >> 9) & 1) << 5)); }
__host__ __device__ __forceinline__ void stage_rc(int b, int& R, int& C) { const int st = b / 1024, sb = b % 1024, swz = sb ^ (((sb >> 9) & 1) << 5); R = (st >> 1) * 16 + swz / 64; C = (st & 1) * 32 + (swz % 64) / 2; }
struct Unit { const char* A; const char* B; int pm, pn, kind, aux, aux2; };
__device__ __forceinline__ void tile_of(int L, int nM, int nN, int& pm, int& pn) {
    const int nwg = nM * nN; int wgid = L; { const int q = nwg / NXCD, r = nwg % NXCD, xcd = wgid % NXCD, off = wgid / NXCD; wgid = (xcd < r ? xcd * (q + 1) : r * (q + 1) + (xcd - r) * q) + off; }
    const int nig = WGM * nN, gid = wgid / nig, fm = gid * WGM, gsz = (nM - fm) < WGM ? (nM - fm) : WGM;
    pm = fm + ((wgid % nig) % gsz); pn = (wgid % nig) / gsz;
}
__device__ __forceinline__ void dma4(const void* g, LAS void* l) { __builtin_amdgcn_global_load_lds((const unsigned*)g, (LAS unsigned*)l, 4, 0, 0); }
typedef int v8i __attribute__((ext_vector_type(8)));
typedef unsigned long long u64x2_t __attribute__((ext_vector_type(2)));
typedef int v4i __attribute__((ext_vector_type(4)));
__device__ __forceinline__ v8i cat8(bf16x8 lo, bf16x8 hi) { const v4i a = __builtin_bit_cast(v4i, lo), b = __builtin_bit_cast(v4i, hi); return __builtin_shufflevector(a, b, 0, 1, 2, 3, 4, 5, 6, 7); }

template <class P>
__device__ __forceinline__ void gemm_phase(LAS unsigned char* lds, LAS unsigned char* tab, const P& S) {
    int tid_l = threadIdx.x; asm volatile("" : "+v"(tid_l));
    const int tid = tid_l, wid = __builtin_amdgcn_readfirstlane(tid >> 6), lane = tid & 63, wr = wid >> 2, wc = wid & 3, fr = lane & 15, fq = lane >> 4;
    const int nt = S.nt;
    int Rr[2], Cc[2];
#pragma unroll
    for (int i = 0; i < 2; ++i) stage_rc(tid * 16 + i * 8192, Rr[i], Cc[i]);
    unsigned voffB[2], voffA[2][2];
#pragma unroll
    for (int i = 0; i < 2; ++i) { voffB[i] = (unsigned)Rr[i] * S.pitchB + (unsigned)Cc[i] * 2u;
#pragma unroll
        for (int h = 0; h < 2; ++h) voffA[h][i] = (unsigned)(HALF * h + Rr[i]) * S.pitchA + (unsigned)Cc[i] * 2u; }
    const size_t kstep = (size_t)(BK * 2);
    const size_t hstepB = (size_t)HALF * S.pitchB;
    const unsigned ldsw = (unsigned)wid * 1024u;
    constexpr int FSTEP = 8, KOFF = 1024;
    const int aoff = lds_byte(wr * 64 + fr, fq * FSTEP), boff = lds_byte(wc * 32 + fr, fq * FSTEP);
    LAS unsigned* idtab = (LAS unsigned*)tab;
#define PG8_SA(b, h) (((b) * 2 + (h)) * HTB)
#define PG8_SB(b, h) ((4 + (b) * 2 + (h)) * HTB)
#define PG8_STAGE(bufoff, gbase, voff) do { _Pragma("unroll") for (int _i = 0; _i < 2; ++_i) { unsigned _vo = (voff)[_i]; asm volatile("" : "+v"(_vo)); \
        __builtin_amdgcn_global_load_lds((const unsigned*)((const char*)(gbase) + _vo), (LAS unsigned*)(lds + (bufoff) + ldsw + _i * 8192), 16, 0, 0); } } while (0)
#define PG8_LDA(dst, b, h) do { _Pragma("unroll") for (int m = 0; m < 4; ++m) _Pragma("unroll") for (int k = 0; k < 2; ++k) dst[m][k] = *(const LAS bf16x8*)(lds + PG8_SA(b, h) + aoff + m * 2048 + k * KOFF); } while (0)
#define PG8_LDB(dst, b, h) do { _Pragma("unroll") for (int n = 0; n < 2; ++n) _Pragma("unroll") for (int k = 0; k < 2; ++k) dst[n][k] = *(const LAS bf16x8*)(lds + PG8_SB(b, h) + boff + n * 2048 + k * KOFF); } while (0)
#define PG8_MMA(ai, bj, At, Bt) do { __builtin_amdgcn_s_setprio(1); _Pragma("unroll") for (int m = 0; m < 4; ++m) _Pragma("unroll") for (int n = 0; n < 2; ++n) { \
        if constexpr (P::FP8) acc[ai][bj][m][n] = __builtin_amdgcn_mfma_scale_f32_16x16x128_f8f6f4(pg8::cat8(Bt[n][0], Bt[n][1]), pg8::cat8(At[m][0], At[m][1]), acc[ai][bj][m][n], 0, 0, 0, 0, 0, 0); \
        else { _Pragma("unroll") for (int k = 0; k < 2; ++k) acc[ai][bj][m][n] = __builtin_amdgcn_mfma_f32_16x16x32_bf16(Bt[n][k], At[m][k], acc[ai][bj][m][n], 0, 0, 0); } } \
        __builtin_amdgcn_s_setprio(0); } while (0)
#define PG8_WAIT_V(n) asm volatile("s_waitcnt vmcnt(" #n ")" ::: "memory")
#define PG8_WAIT_L(n) asm volatile("s_waitcnt lgkmcnt(" #n ")" ::: "memory")
#define PG8_BAR __builtin_amdgcn_s_barrier()
#define PG8_SCHED __builtin_amdgcn_sched_barrier(0)
    LAS unsigned* ulist = (LAS unsigned*)(tab + 12288);
    if (tid < 32) { Unit t_; t_.A = nullptr; t_.B = nullptr; t_.pm = t_.pn = t_.kind = t_.aux = t_.aux2 = 0; const bool ok_ = S.next(tid, t_);
        LAS unsigned* e_ = ulist + tid * 12; const u64 a_ = (u64)(size_t)t_.A, b_ = (u64)(size_t)t_.B;
        e_[0] = ok_ ? 1u : 0u; e_[1] = (unsigned)t_.pm; e_[2] = (unsigned)t_.pn; e_[3] = (unsigned)t_.kind; e_[4] = (unsigned)t_.aux; e_[5] = (unsigned)t_.aux2;
        e_[6] = (unsigned)a_; e_[7] = (unsigned)(a_ >> 32); e_[8] = (unsigned)b_; e_[9] = (unsigned)(b_ >> 32); }
    asm volatile("s_waitcnt lgkmcnt(0)" ::: "memory"); __builtin_amdgcn_s_barrier(); asm volatile("" ::: "memory");
#define PG8_FETCH(i_, u_, ok_) do { const LAS u32x4* e4_ = (const LAS u32x4*)(ulist + (i_) * 12); const u32x4 x0_ = e4_[0], x1_ = e4_[1], x2_ = e4_[2]; \
        (ok_) = __builtin_amdgcn_readfirstlane(x0_.x) != 0; (u_).pm = __builtin_amdgcn_readfirstlane(x0_.y); (u_).pn = __builtin_amdgcn_readfirstlane(x0_.z); (u_).kind = __builtin_amdgcn_readfirstlane(x0_.w); \
        (u_).aux = __builtin_amdgcn_readfirstlane(x1_.x); (u_).aux2 = __builtin_amdgcn_readfirstlane(x1_.y); \
        (u_).A = (const char*)(size_t)(((u64)(unsigned)__builtin_amdgcn_readfirstlane(x1_.w) << 32) | (unsigned)__builtin_amdgcn_readfirstlane(x1_.z)); \
        (u_).B = (const char*)(size_t)(((u64)(unsigned)__builtin_amdgcn_readfirstlane(x2_.y) << 32) | (unsigned)__builtin_amdgcn_readfirstlane(x2_.x)); } while (0)
    Unit cur, nxt; int ui = 0;
    { bool ok0; PG8_FETCH(0, cur, ok0); if (!ok0) return; }
    f32x4 acc[2][2][4][2];
#pragma unroll
    for (int a = 0; a < 2; ++a)
#pragma unroll
        for (int b = 0; b < 2; ++b)
#pragma unroll
            for (int m = 0; m < 4; ++m)
#pragma unroll
                for (int n = 0; n < 2; ++n) acc[a][b][m][n] = (f32x4){0.f, 0.f, 0.f, 0.f};
    bf16x8 At[4][2], B0[2][2], B1[2][2];
    const char* cA = cur.A; const char* cB = cur.B;
    if constexpr (P::GATHER) {
        if (wid < 4) dma4(S.id_src(cur, wid * 64 + lane), idtab + wid * 64);
        PG8_WAIT_V(0); PG8_BAR; asm volatile("" ::: "memory");
#pragma unroll
        for (int h = 0; h < 2; ++h)
#pragma unroll
            for (int i = 0; i < 2; ++i) voffA[h][i] = idtab[HALF * h + Rr[i]] * S.pitchA + (unsigned)Cc[i] * 2u;
        PG8_WAIT_L(0); asm volatile("" ::: "memory");
    }
    PG8_STAGE(PG8_SB(0, 0), cB, voffB); PG8_STAGE(PG8_SB(0, 1), cB + hstepB, voffB); PG8_STAGE(PG8_SA(0, 0), cA, voffA[0]); PG8_STAGE(PG8_SA(0, 1), cA, voffA[1]);
    if (wr == 1) PG8_BAR;
    PG8_WAIT_V(2); PG8_BAR;
    PG8_STAGE(PG8_SB(1, 0), cB + kstep, voffB); PG8_STAGE(PG8_SA(1, 0), cA + kstep, voffA[0]); PG8_STAGE(PG8_SB(1, 1), cB + hstepB + kstep, voffB);
    PG8_WAIT_V(6); PG8_BAR;
    for (;;) {
        bool has_next; PG8_FETCH(ui + 1, nxt, has_next);
        const int slot = ui & 1;
        S.dma_tables(cur, tab, slot, wid, lane);
        if constexpr (P::GATHER) { if (has_next && wid < 4) dma4(S.id_src(nxt, wid * 64 + lane), idtab + (slot ^ 1) * 256 + wid * 64); }
        const char* nA = has_next ? nxt.A : cA; const char* nB = has_next ? nxt.B : cB;
        for (int t = 0; t < nt; t += 2) {
            const bool last = (t == nt - 2);
            const char* a1 = cA + (size_t)(t + 1) * kstep;
            const char* a2 = last ? nA : cA + (size_t)(t + 2) * kstep; const char* b2 = last ? nB : cB + (size_t)(t + 2) * kstep;
            const char* a3 = a2 + kstep; const char* b3 = b2 + kstep;
            PG8_LDB(B0, 0, 0); PG8_LDB(B1, 0, 1); PG8_SCHED; PG8_LDA(At, 0, 0); PG8_STAGE(PG8_SA(1, 1), a1, voffA[1]);
            if constexpr (!P::GATHER && P::FP8) { if (last && has_next) asm volatile("s_nop 0"); }
            if constexpr (P::GATHER) {
                if (last && has_next) {
                    int t2 = tid; asm volatile("" : "+v"(t2));
#pragma unroll
                    for (int i = 0; i < 2; ++i) { int R2, C2; stage_rc(t2 * 16 + i * 8192, R2, C2);
#pragma unroll
                        for (int h = 0; h < 2; ++h) voffA[h][i] = idtab[(slot ^ 1) * 256 + HALF * h + R2] * S.pitchA + (unsigned)C2 * 2u; }
                }
            }
            PG8_WAIT_V(8); PG8_WAIT_L(0); PG8_BAR; PG8_MMA(0, 0, At, B0); PG8_MMA(0, 1, At, B1); PG8_BAR; PG8_SCHED;
            PG8_LDA(At, 0, 1); PG8_STAGE(PG8_SB(0, 0), b2, voffB); PG8_STAGE(PG8_SB(0, 1), b2 + hstepB, voffB); PG8_STAGE(PG8_SA(0, 0), a2, voffA[0]);
            PG8_WAIT_V(8); PG8_WAIT_L(0); PG8_BAR; PG8_MMA(1, 0, At, B0); PG8_MMA(1, 1, At, B1); PG8_BAR; PG8_SCHED;
            PG8_LDB(B0, 1, 0); PG8_LDB(B1, 1, 1); PG8_SCHED; PG8_LDA(At, 1, 0); PG8_STAGE(PG8_SA(0, 1), a2, voffA[1]);
            PG8_WAIT_V(8); PG8_WAIT_L(0); PG8_BAR; PG8_MMA(0, 0, At, B0); PG8_MMA(0, 1, At, B1); PG8_BAR; PG8_SCHED;
            PG8_LDA(At, 1, 1); PG8_STAGE(PG8_SB(1, 0), b3, voffB); PG8_STAGE(PG8_SB(1, 1), b3 + hstepB, voffB); PG8_STAGE(PG8_SA(1, 0), a3, voffA[0]);
            PG8_WAIT_V(8); PG8_WAIT_L(0); PG8_BAR; PG8_MMA(1, 0, At, B0); PG8_MMA(1, 1, At, B1); PG8_BAR; PG8_SCHED;
        }
        if constexpr (P::ALIGN) { if (wr == 0) PG8_BAR; }
        S.epi(acc, cur, tab, slot, wr, wc, fr, fq);
        if (!has_next) break;
#pragma unroll
        for (int a = 0; a < 2; ++a)
#pragma unroll
            for (int b = 0; b < 2; ++b)
#pragma unroll
                for (int m = 0; m < 4; ++m)
#pragma unroll
                    for (int n = 0; n < 2; ++n) { u64 z0, z1; asm volatile("v_mov_b64 %0, 0" : "=v"(z0)); asm volatile("v_mov_b64 %0, 0" : "=v"(z1)); const u64x2_t z = {z0, z1}; acc[a][b][m][n] = __builtin_bit_cast(f32x4, z); }
        cur = nxt; cA = nA; cB = nB; ++ui;
        if constexpr (P::ALIGN) { if (wr == 1) PG8_BAR; }
    }
    PG8_WAIT_V(0);
    if constexpr (!P::ALIGN) { if (wr == 0) PG8_BAR; }
    PG8_BAR;
#undef PG8_FETCH
#undef PG8_SA
#undef PG8_SB
#undef PG8_STAGE
#undef PG8_LDA
#undef PG8_LDB
#undef PG8_MMA
#undef PG8_WAIT_V
#undef PG8_WAIT_L
#undef PG8_BAR
#undef PG8_SCHED
}
}
#ifndef ALIGN_LIGHT
#define ALIGN_LIGHT true
#endif
using pg8::Unit;
typedef f32x4 Acc[2][2][4][2];

struct Args { const float* in[45]; float* out; unsigned char* ws; int ph_lo, ph_hi, dummy, pad; };
enum { I_X = 0, I_META = 1, I_T5 = 2, I_L0 = 3, I_L1 = 13, I_L2 = 24, I_L3 = 34 };

struct Frame {
    LAS unsigned char* lds; LAS unsigned char* tab;
    int tid, lane, wave, G, bx;
    unsigned char* ws; float* out; bf16_t* hb; unsigned* ctl;
};
__device__ __forceinline__ u64* ssq_buf(const Frame& F, int i) { return (u64*)(F.ws + WS_CTL + CTL_SSQ + (size_t)i * SSQ_BYTES); }
__device__ __forceinline__ u64 ssq_fix(float s) { return (u64)(s * SSQ_SCALE); }
__device__ __forceinline__ float ssq_val(u64 v) { return (float)v * SSQ_INV; }

struct QkvPolicy {
    static constexpr bool GATHER = false, ALIGN = ALIGN_LIGHT, FP8 = false;
    int nt; unsigned pitchA, pitchB;
    int G, c, nN, QT;
    const char* hb; const char* W;
    const u64* ssq;
    bf16_t* Q; bf16_t* K; bf16_t* VT; int kpitch, nQ;
    const LAS float* gains;
    __device__ __forceinline__ bool next(int i, Unit& u) const {
        const long L = (long)i * G + c; if (L >= (long)NPANEL * nN) return false;
        int pm, pn; pg8::tile_of((int)L, NPANEL, nN, pm, pn);
        u.pm = pm; u.pn = pn; u.kind = pn < QT ? 0 : 1; u.aux = 0; u.aux2 = 0;
        const char* a = hb + (size_t)pm * 256 * 2048; const char* w = W + (size_t)pn * 256 * 2048;
        u.A = u.kind ? w : a; u.B = u.kind ? a : w; return true;
    }
    __device__ __forceinline__ void dma_tables(const Unit& u, LAS unsigned char* tab, int slot, int wid, int lane) const {
        pg8::dma4((const unsigned*)(ssq + u.pm * 256) + wid * 64 + lane, (LAS unsigned*)(tab + 2048) + slot * 512 + wid * 64);
    }
    __device__ __forceinline__ void epi(const Acc& acc, const Unit& u, LAS unsigned char* tab, int slot, int wr, int wc, int fr, int fq) const {
        const LAS u64* et = (const LAS u64*)(tab + 2048) + slot * 256;
        if (u.kind == 0) {
            const bool isq = u.pn < nQ;
            const LAS float* gp = gains + (isq ? 0 : 64) + 8 * fq;
            const f32x4 g00 = *(const LAS f32x4*)(gp), g01 = *(const LAS f32x4*)(gp + 4), g10 = *(const LAS f32x4*)(gp + 32), g11 = *(const LAS f32x4*)(gp + 36);
            const int hk = (u.pn - nQ) * 4 + wc, nhk = kpitch >> 6;
#pragma unroll
            for (int ai = 0; ai < 2; ++ai)
#pragma unroll
                for (int m = 0; m < 4; ++m) {
                    const int row = ai * 128 + wr * 64 + m * 16 + fr;
                    const float rstd = fast_rsqrt(ssq_val(et[row]) * (1.0f / 1024.0f) + EPS);
                    f32x4 v00 = acc[ai][0][m][0] * rstd, v01 = acc[ai][0][m][1] * rstd, v10 = acc[ai][1][m][0] * rstd, v11 = acc[ai][1][m][1] * rstd;
                    const f32x4 sq4 = v00 * v00 + v01 * v01 + v10 * v10 + v11 * v11;
                    float ss = (sq4[0] + sq4[1]) + (sq4[2] + sq4[3]);
                    ss += __shfl_xor(ss, 16); ss += __shfl_xor(ss, 32);
                    const float hn = fast_rsqrt(ss * (1.0f / 64.0f) + EPS);
                    v00 = v00 * g00 * hn; v01 = v01 * g01 * hn; v10 = v10 * g10 * hn; v11 = v11 * g11 * hn;
                    const int tok = u.pm * 256 + row;
                    bf16_t* rp = isq ? Q + (size_t)tok * 1024 + (u.pn * 4 + wc) * 64 + 8 * fq
                                     : K + ((((size_t)(tok >> 3) * nhk + hk) * 2) * 4 + fq) * 64 + (tok & 7) * 8;
                    const int o1 = isq ? 32 : 256;
                    u32x4 w0; w0.x = cvt_pk_bf16(v00[0], v00[1]); w0.y = cvt_pk_bf16(v00[2], v00[3]); w0.z = cvt_pk_bf16(v01[0], v01[1]); w0.w = cvt_pk_bf16(v01[2], v01[3]);
                    u32x4 w1; w1.x = cvt_pk_bf16(v10[0], v10[1]); w1.y = cvt_pk_bf16(v10[2], v10[3]); w1.z = cvt_pk_bf16(v11[0], v11[1]); w1.w = cvt_pk_bf16(v11[2], v11[3]);
                    *(u32x4*)(rp) = w0; *(u32x4*)(rp + o1) = w1;
                }
        } else {
            f32x4 rs[2][2];
#pragma unroll
            for (int bj = 0; bj < 2; ++bj)
#pragma unroll
                for (int n = 0; n < 2; ++n) {
#pragma unroll
                    for (int j = 0; j < 4; ++j) rs[bj][n][j] = fast_rsqrt(ssq_val(et[bj * 128 + wc * 32 + n * 16 + 4 * fq + j]) * (1.0f / 1024.0f) + EPS); }
#pragma unroll
            for (int ai = 0; ai < 2; ++ai)
#pragma unroll
                for (int m = 0; m < 4; ++m) {
                    const int hd = (u.pn - QT) * 256 + ai * 128 + wr * 64 + m * 16 + fr, hk = hd >> 6, d = hd & 63, nhk = kpitch >> 6;
#pragma unroll
                    for (int bj = 0; bj < 2; ++bj)
#pragma unroll
                        for (int n = 0; n < 2; ++n) { const f32x4 v = acc[ai][bj][m][n] * rs[bj][n]; u32x2 w; w.x = cvt_pk_bf16(v[0], v[1]); w.y = cvt_pk_bf16(v[2], v[3]);
                            const int c0 = u.pm * 256 + bj * 128 + wc * 32 + n * 16 + 4 * fq;
                            *(u32x2*)(VT + ((size_t)(c0 >> 3) * nhk + hk) * 512 + (((d >> 4) * 2 + ((c0 >> 2) & 1)) * 16 + (d & 15)) * 4) = w; }
                }
        }
    }
};

template <bool F8 = false>
struct ResPolicy {
    static constexpr bool GATHER = false, ALIGN = true, FP8 = F8;
    int nt; unsigned pitchA, pitchB;
    int G, c;
    const char* A; const char* W;
    bf16_t* hb; u64* ssq_out; bf16_t* dmy;
    unsigned char* hb8;
    __device__ __forceinline__ bool next(int i, Unit& u) const {
        const long L = (long)i * G + c; if (L >= (long)NPANEL * 4) return false;
        int pm, pn; pg8::tile_of((int)L, NPANEL, 4, pm, pn);
        u.pm = pm; u.pn = pn; u.kind = 0; u.aux = 0; u.aux2 = 0;
        u.A = A + (size_t)pm * 256 * pitchA; u.B = W + (size_t)pn * 256 * pitchB; return true;
    }
    __device__ __forceinline__ void dma_tables(const Unit&, LAS unsigned char*, int, int, int) const {}
    __device__ __forceinline__ void epi(const Acc& acc, const Unit& u, LAS unsigned char*, int, int wr, int wc, int fr, int fq) const {
        const int col = u.pn * 256 + wc * 32 + 8 * fq;
#pragma unroll
        for (int ai = 0; ai < 2; ++ai) {
            u32x4 bv[4][2];
#pragma unroll
            for (int m = 0; m < 4; ++m) { const bf16_t* bp = hb + (size_t)(u.pm * 256 + ai * 128 + wr * 64 + m * 16 + fr) * D + col;
#pragma unroll
                for (int bj = 0; bj < 2; ++bj) bv[m][bj] = *(const u32x4*)(bp + bj * 128); }
            __builtin_amdgcn_sched_barrier(0);
#pragma unroll
            for (int m = 0; m < 4; ++m) {
                const int row = u.pm * 256 + ai * 128 + wr * 64 + m * 16 + fr;
                bf16_t* hp = (dmy ? dmy + (size_t)(row & 0xFFF) * D : hb + (size_t)row * D) + col;
                f32x2 ss2 = {0.f, 0.f};
#pragma unroll
                for (int bj = 0; bj < 2; ++bj) {
                    const u32x4 b = bv[m][bj]; const f32x4 a0 = acc[ai][bj][m][0], a1 = acc[ai][bj][m][1];
                    const unsigned bw[4] = {b.x, b.y, b.z, b.w}; const f32x2 av[4] = {{a0[0], a0[1]}, {a0[2], a0[3]}, {a1[0], a1[1]}, {a1[2], a1[3]}};
                    f32x2 o[4]; u32x4 w; unsigned* wp = (unsigned*)&w;
#pragma unroll
                    for (int i = 0; i < 4; ++i) { const f32x2 hv = {__uint_as_float(bw[i] << 16), __uint_as_float(bw[i] & 0xffff0000u)}; if constexpr (F8) o[i] = hv + av[i] * (W8_INV * HID8_INV); else o[i] = hv + av[i]; ss2 = ss2 + o[i] * o[i]; wp[i] = cvt_pk_bf16(o[i].x, o[i].y); }
                    *(u32x4*)(hp + bj * 128) = w;
                    if (hb8) { int p0 = 0, p1 = 0; p0 = __builtin_amdgcn_cvt_pk_fp8_f32(o[0].x, o[0].y, p0, false); p0 = __builtin_amdgcn_cvt_pk_fp8_f32(o[1].x, o[1].y, p0, true); p1 = __builtin_amdgcn_cvt_pk_fp8_f32(o[2].x, o[2].y, p1, false); p1 = __builtin_amdgcn_cvt_pk_fp8_f32(o[3].x, o[3].y, p1, true);
                        u32x2 w8; w8.x = (unsigned)p0; w8.y = (unsigned)p1; *(u32x2*)(hb8 + (size_t)row * D + col + bj * 128) = w8; }
                }
                float ss = ss2.x + ss2.y;
                ss += __shfl_xor(ss, 16); ss += __shfl_xor(ss, 32);
                if (fq == 0) __hip_atomic_fetch_add(ssq_out + row, ssq_fix(ss), RLX_AGENT);
            }
            __builtin_amdgcn_sched_barrier(0);
        }
    }
};

template <bool MOE, bool F8 = MOE>
struct GuPolicy {
    static constexpr bool GATHER = MOE, ALIGN = ALIGN_LIGHT, FP8 = F8;
    int nt; unsigned pitchA, pitchB;
    int G, c;
    const char* hb; const char* W;
    const void* ssq;
    bf16_t* hid;
    const unsigned* rowtok; int p0, p1;
    const LAS int* ptab;
    __device__ __forceinline__ bool next(int i, Unit& u) const {
        const long L = (long)i * G + c;
        if constexpr (!MOE) {
            if (L >= (long)NPANEL * 28) return false;
            int pm, pn; pg8::tile_of((int)L, NPANEL, 28, pm, pn);
            u.pm = pm; u.pn = pn; u.kind = 0; u.aux = 0; u.aux2 = 0;
            u.A = hb + (size_t)pm * 256 * pitchA; u.B = W + (size_t)pn * 256 * pitchB; return true;
        } else {
            const int nM = p1 - p0; if (L >= (long)nM * 28) return false;
            int pm, pn; pg8::tile_of((int)L, nM, 28, pm, pn);
            const int p = p0 + pm; int e = 0;
#pragma unroll
            for (int k = 1; k <= 7; ++k) e += (p >= ptab[k]) ? 1 : 0;
            const int pbe = ptab[e], ce = ptab[9 + e];
            u.pm = pm; u.pn = pn; u.kind = e; u.aux = (p - pbe) * 256; u.aux2 = ce;
            u.A = hb; u.B = W + (size_t)e * W_GU8 + (size_t)pn * 256 * 1024; return true;
        }
    }
    __device__ __forceinline__ const unsigned* id_src(const Unit& u, int i) const { int r = u.aux + i; r = r < u.aux2 ? r : u.aux2 - 1; return rowtok + (size_t)u.kind * M + r; }
    __device__ __forceinline__ void dma_tables(const Unit& u, LAS unsigned char* tab, int slot, int wid, int lane) const {
        if constexpr (!MOE) pg8::dma4((const unsigned*)((const u64*)ssq + u.pm * 256) + wid * 64 + lane, (LAS unsigned*)(tab + 2048) + slot * 512 + wid * 64);
        else if (wid >= 4) { int r = u.aux + (wid - 4) * 64 + lane; r = r < u.aux2 ? r : u.aux2 - 1; pg8::dma4((const float*)ssq + (size_t)u.kind * M + r, (LAS float*)(tab + 2048) + slot * 256 + (wid - 4) * 64); }
    }
    __device__ __forceinline__ void epi(const Acc& acc, const Unit& u, LAS unsigned char* tab, int slot, int wr, int wc, int fr, int fq) const {
#pragma unroll
        for (int ai = 0; ai < 2; ++ai)
#pragma unroll
            for (int m = 0; m < 4; ++m) {
                const int row = ai * 128 + wr * 64 + m * 16 + fr;
                float sq;
                if constexpr (MOE) sq = ((const LAS float*)(tab + 2048) + slot * 256)[row]; else sq = ssq_val(((const LAS u64*)(tab + 2048) + slot * 256)[row]);
                const float rstd = fast_rsqrt(sq * (1.0f / 1024.0f) + EPS);
                const float rs_ = F8 ? rstd * W8_INV : rstd;
                const float c1 = -rs_ * LOG2E;
                const float kk = (sq * (1.0f / 1024.0f) + EPS) * (F8 ? W8_SCALE * W8_SCALE * HID8_INV : 1.0f);
                float o[8];
#pragma unroll
                for (int n = 0; n < 2; ++n)
#pragma unroll
                    for (int j = 0; j < 4; j += 2) {
                        const f32x2 g = {acc[ai][0][m][n][j], acc[ai][0][m][n][j + 1]}, up = {acc[ai][1][m][n][j], acc[ai][1][m][n][j + 1]};
                        const f32x2 t = g * c1; f32x2 e; e.x = fast_exp2(t.x); e.y = fast_exp2(t.y);
                        const f32x2 kk2 = {kk, kk}; const f32x2 d = e * kk2 + kk2; f32x2 r; r.x = fast_rcp(d.x); r.y = fast_rcp(d.y);
                        const f32x2 v = (g * up) * r;
                        o[n * 4 + j] = v.x; o[n * 4 + j + 1] = v.y; }
                if constexpr (F8) {
                    int q0 = 0, q1 = 0; q0 = __builtin_amdgcn_cvt_pk_fp8_f32(o[0], o[1], q0, false); q0 = __builtin_amdgcn_cvt_pk_fp8_f32(o[2], o[3], q0, true); q1 = __builtin_amdgcn_cvt_pk_fp8_f32(o[4], o[5], q1, false); q1 = __builtin_amdgcn_cvt_pk_fp8_f32(o[6], o[7], q1, true);
                    u32x2 w8; w8.x = (unsigned)q0; w8.y = (unsigned)q1;
                    *(u32x2*)((unsigned char*)hid + (size_t)(u.pm * 256 + row) * FF + u.pn * 128 + wc * 32 + 8 * fq) = w8;
                } else {
                u32x4 w; w.x = cvt_pk_bf16(o[0], o[1]); w.y = cvt_pk_bf16(o[2], o[3]); w.z = cvt_pk_bf16(o[4], o[5]); w.w = cvt_pk_bf16(o[6], o[7]);
                *(u32x4*)(hid + (size_t)(u.pm * 256 + row) * FF + u.pn * 128 + wc * 32 + 8 * fq) = w; }
            }
    }
};

struct MoeDownPolicy {
    static constexpr bool GATHER = false, ALIGN = ALIGN_LIGHT, FP8 = true;
    int nt; unsigned pitchA, pitchB;
    int G, c;
    const char* hid; const char* W;
    const unsigned* rowslot; const float* rowgate; bf16_t* ys;
    int p0, p1; const LAS int* ptab;
    __device__ __forceinline__ bool next(int i, Unit& u) const {
        const long L = (long)i * G + c; const int nM = p1 - p0; if (L >= (long)nM * 4) return false;
        int pm, pn; pg8::tile_of((int)L, nM, 4, pm, pn);
        const int p = p0 + pm; int e = 0;
#pragma unroll
        for (int k = 1; k <= 7; ++k) e += (p >= ptab[k]) ? 1 : 0;
        const int pbe = ptab[e], ce = ptab[9 + e];
        u.pm = pm; u.pn = pn; u.kind = e; u.aux = (p - pbe) * 256; u.aux2 = ce;
        u.A = hid + (size_t)pm * 256 * pitchA; u.B = W + (size_t)e * W_D8 + (size_t)pn * 256 * pitchB; return true;
    }
    __device__ __forceinline__ void dma_tables(const Unit& u, LAS unsigned char* tab, int slot, int wid, int lane) const {
        int r = u.aux + (wid & 3) * 64 + lane; r = r < u.aux2 ? r : u.aux2 - 1;
        if (wid < 4) pg8::dma4(rowslot + (size_t)u.kind * M + r, (LAS unsigned*)(tab + 6144) + slot * 256 + wid * 64);
        else pg8::dma4(rowgate + (size_t)u.kind * M + r, (LAS float*)(tab + 8192) + slot * 256 + (wid - 4) * 64);
    }
    __device__ __forceinline__ void epi(const Acc& acc, const Unit& u, LAS unsigned char* tab, int slot, int wr, int wc, int fr, int fq) const {
        const LAS unsigned* es = (const LAS unsigned*)(tab + 6144) + slot * 256;
        const LAS float* eg = (const LAS float*)(tab + 8192) + slot * 256;
#pragma unroll
        for (int ai = 0; ai < 2; ++ai)
#pragma unroll
            for (int m = 0; m < 4; ++m) {
                const int row = ai * 128 + wr * 64 + m * 16 + fr;
                if (u.aux + row < u.aux2) {
                    const unsigned sl = es[row]; const float g = eg[row] * (W8_INV * HID8_INV);
                    bf16_t* rp = ys + (size_t)sl * D + u.pn * 256 + wc * 32 + 8 * fq;
#pragma unroll
                    for (int bj = 0; bj < 2; ++bj) { const f32x4 v0 = acc[ai][bj][m][0] * g, v1 = acc[ai][bj][m][1] * g;
                        u32x4 w; w.x = cvt_pk_bf16(v0[0], v0[1]); w.y = cvt_pk_bf16(v0[2], v0[3]); w.z = cvt_pk_bf16(v1[0], v1[1]); w.w = cvt_pk_bf16(v1[2], v1[3]); *(u32x4*)(rp + bj * 128) = w; }
                }
            }
    }
};

struct WDesc { const float* src; const float* gain; bf16_t* dst; int K, N, map, ibase; };
__device__ __forceinline__ int qk_perm(int s) { return 128 * ((s >> 5) & 1) + 32 * (s >> 6) + 16 * ((s >> 2) & 1) + 4 * ((s >> 3) & 3) + (s & 3); }
__device__ __forceinline__ int dst_row(int map, int c) {
    if (map == 1) return c < 2048 ? (c & ~255) + qk_perm(c & 255) : c;
    if (map == 2) return c < 1280 ? (c & ~255) + qk_perm(c & 255) : c;
    if (map == 3 || map == 4) { const int t = c >> 7, w = c & 127; return 256 * t + (map == 4 ? 128 : 0) + 32 * (w >> 5) + 16 * ((w >> 2) & 1) + 4 * ((w >> 3) & 3) + (w & 3); }
    if (map == 5) return (c & ~31) + 16 * ((c >> 2) & 1) + 4 * ((c >> 3) & 3) + (c & 3);
    return c;
}
__device__ __forceinline__ void transpose_item(const GAS float* src, const GAS float* gain, GAS bf16_t* dst, int K, int N, int map, LAS float* scr, int item, int lane) {
    const int nblk = N / 64, kb = item / nblk, nb = item % nblk, k0 = 64 * kb, n0 = 64 * nb;
    const int c = lane & 15, r = lane >> 4;
    f32x4 v[16];
#pragma unroll
    for (int i = 0; i < 16; ++i) v[i] = *(const GAS f32x4*)(src + (size_t)(k0 + 4 * i + r) * N + n0 + 4 * c);
#pragma unroll
    for (int i = 0; i < 16; ++i) { const int kk = 4 * i + r; const float g = gain ? gain[k0 + kk] : 1.0f; LAS float* p = scr + kk * 65 + 4 * c; p[0] = v[i].x * g; p[1] = v[i].y * g; p[2] = v[i].z * g; p[3] = v[i].w * g; }
    asm volatile("s_waitcnt lgkmcnt(0)" ::: "memory");
    const int c8 = lane & 7;
#pragma unroll
    for (int j = 0; j < 8; ++j) { const int n = (lane >> 3) + 8 * j; const LAS float* p = scr + (8 * c8) * 65 + n;
        if (map >= 16) { int q0 = 0, q1 = 0;
            q0 = __builtin_amdgcn_cvt_pk_fp8_f32(p[0 * 65] * W8_SCALE, p[1 * 65] * W8_SCALE, q0, false); q0 = __builtin_amdgcn_cvt_pk_fp8_f32(p[2 * 65] * W8_SCALE, p[3 * 65] * W8_SCALE, q0, true);
            q1 = __builtin_amdgcn_cvt_pk_fp8_f32(p[4 * 65] * W8_SCALE, p[5 * 65] * W8_SCALE, q1, false); q1 = __builtin_amdgcn_cvt_pk_fp8_f32(p[6 * 65] * W8_SCALE, p[7 * 65] * W8_SCALE, q1, true);
            u32x2 o8; o8.x = (unsigned)q0; o8.y = (unsigned)q1; *(GAS u32x2*)((GAS unsigned char*)dst + (size_t)dst_row(map - 16, n0 + n) * K + k0 + 8 * c8) = o8; }
        else {
        u32x4 o; o.x = cvt_pk_bf16(p[0 * 65], p[1 * 65]); o.y = cvt_pk_bf16(p[2 * 65], p[3 * 65]); o.z = cvt_pk_bf16(p[4 * 65], p[5 * 65]); o.w = cvt_pk_bf16(p[6 * 65], p[7 * 65]);
        *(GAS u32x4*)(dst + (size_t)dst_row(map, n0 + n) * K + k0 + 8 * c8) = o; } }
    asm volatile("s_waitcnt lgkmcnt(0)" ::: "memory");
}
constexpr int N_WDESC = 62;
__device__ __forceinline__ void prologue(Frame& F, const __attribute__((address_space(4))) Args* a) {
    LAS WDesc* wd = (LAS WDesc*)(F.lds + 8 * 16640);
    LAS int* wtot = (LAS int*)(F.lds + 8 * 16640 + N_WDESC * sizeof(WDesc));
    static_assert(8 * 16640 + N_WDESC * sizeof(WDesc) + 16 <= (size_t)GAIN_OFF, "prologue LDS");
    if (F.tid == 0) {
        int n = 0, ib = 0;
#define ADDW(src_, gain_, dst_, K_, N_, map_) do { wd[n].src = (src_); wd[n].gain = (gain_); wd[n].dst = (bf16_t*)(dst_); wd[n].K = (K_); wd[n].N = (N_); wd[n].map = (map_); wd[n].ibase = ib; ++n; ib += ((K_) / 64) * ((N_) / 64); } while (0)
        for (int p = 0; p < 2; ++p) {
            const int na0 = p ? I_L2 : I_L0, sw0 = p ? I_L3 : I_L1;
#define NA_(i) (a->in[na0 + (i)])
#define SW_(i) (a->in[sw0 + (i)])
            unsigned char* wb = F.ws + WS_W + (size_t)p * WPAIR;
            ADDW(NA_(1), NA_(0), wb + WNA_QKV, 1024, 3072, 1);
            ADDW(NA_(5), (const float*)nullptr, wb + WNA_O, 1024, 1024, 5);
            ADDW(NA_(7), NA_(6), wb + WNA_GU, 1024, FF, (p >= DENSE8_FROM ? 16 : 0) + 3);
            ADDW(NA_(8), NA_(6), wb + WNA_GU, 1024, FF, (p >= DENSE8_FROM ? 16 : 0) + 4);
            ADDW(NA_(9), (const float*)nullptr, wb + WNA_D, FF, 1024, (p >= DENSE8_FROM ? 16 : 0) + 5);
            ADDW(SW_(1), SW_(0), wb + WSW_QKV, 1024, 1536, 2);
            ADDW(SW_(5), (const float*)nullptr, wb + WSW_O, 1024, 1024, 5);
            for (int e = 0; e < NE; ++e) {
                ADDW(SW_(8) + (size_t)e * 1024 * FF, SW_(6), wb + WSW_GU + (size_t)e * W_GU8, 1024, FF, 16 + 3);
                ADDW(SW_(9) + (size_t)e * 1024 * FF, SW_(6), wb + WSW_GU + (size_t)e * W_GU8, 1024, FF, 16 + 4);
                ADDW(SW_(10) + (size_t)e * FF * 1024, (const float*)nullptr, wb + WSW_D + (size_t)e * W_D8, FF, 1024, 16 + 5);
            }
        }
#undef ADDW
        *wtot = ib;
    }
    __syncthreads();
    LAS float* scr = (LAS float*)(F.lds + F.wave * 16640);
    const int gw = F.bx * 8 + F.wave, NGW = F.G * 8;
    const int total = *wtot;
    for (int it = gw; it < total; it += NGW) {
        int k = 0;
        for (int j = 1; j < N_WDESC; ++j) k += (it >= wd[j].ibase) ? 1 : 0;
        transpose_item((const GAS float*)wd[k].src, (const GAS float*)wd[k].gain, (GAS bf16_t*)wd[k].dst, wd[k].K, wd[k].N, wd[k].map, scr, it - wd[k].ibase, F.lane);
    }
    u64* ssq0 = ssq_buf(F, 0);
    for (int m = gw; m < M; m += NGW) {
        const float* src = m < NREG ? a->in[I_X] + (size_t)m * D : a->in[I_META] + (size_t)(m - NREG) * D;
        const f32x4* xr = (const f32x4*)src + F.lane;
        f32x4 v[4]; float s = 0.f;
#pragma unroll
        for (int j = 0; j < 4; ++j) { v[j] = xr[64 * j]; s += (v[j].x * v[j].x + v[j].y * v[j].y) + (v[j].z * v[j].z + v[j].w * v[j].w); }
        s = wave_sum(s);
        u32x2* o8 = (u32x2*)(F.hb + (size_t)m * D) + F.lane;
#pragma unroll
        for (int j = 0; j < 4; ++j) { u32x2 w; w.x = cvt_pk_bf16(v[j].x, v[j].y); w.y = cvt_pk_bf16(v[j].z, v[j].w); o8[64 * j] = w; }
        if (F.lane == 0) ssq0[m] = ssq_fix(s);
    }
}

struct AttnCtx {
    const bf16_t* Q; const bf16_t* K; const bf16_t* VT; bf16_t* O; int kpitch; unsigned omask;
    const LAS float* tbl;
};
constexpr int NTILE = 18;
__device__ __forceinline__ int t5_bucket_abs(int n) {
    const int big = 8 + (n >= 12) + (n >= 16) + (n >= 23) + (n >= 32) + (n >= 46) + (n >= 64) + (n >= 91);
    return n < 8 ? n : big;
}
constexpr int NA_TBL_ROW = 64, NA_TBL_HEAD = 15 * 64, SWA_TBL_HEAD = 576, SWA_T5_OFF = 16 * 576, SWA_SINK_OFF = SWA_T5_OFF + 512;
template <int TYPE>
__device__ __forceinline__ void attn_unit(const AttnCtx& X, int b, int hq, int u0, int u1, bool metaq, int lane) {
    const int q = lane & 15, kg = lane >> 4;
    const int hk = TYPE == 0 ? hq : (hq >> 2);
    constexpr int NWIN = TYPE == 0 ? 16 : 17, TMETA = NWIN, NREAL = NWIN + 1;
    int qtok0, wtok0, bidx;
    int colbase = 0, relbase = 0, wsq = 0;
    if (TYPE == 0) {
        const int r = metaq ? 0 : u0, cb = metaq ? 0 : u1;
        int rs = r - 4; rs = rs < 0 ? 0 : (rs > 24 ? 24 : rs); int ks = 16 * cb - 8; ks = ks < 0 ? 0 : (ks > 32 ? 32 : ks);
        qtok0 = metaq ? NREG : b * SEQ + r * 64 + 16 * cb; wtok0 = b * SEQ + rs * 64 + ks;
        const int qc = 16 * cb + q; wsq = qc - 8; wsq = wsq < 0 ? 0 : (wsq > 48 ? 48 : wsq);
        colbase = ks + 4 * kg;
        bidx = hq * NA_TBL_HEAD + (rs - r + 7) * NA_TBL_ROW + (colbase - qc + 15 + 16);
    } else {
        const int q0 = metaq ? 0 : 16 * u0;
        int jb = q0 - 128; jb = jb < 0 ? 0 : (jb > SEQ - 272 ? SEQ - 272 : jb);
        qtok0 = metaq ? NREG : b * SEQ + q0; wtok0 = b * SEQ + jb;
        relbase = jb + 4 * kg - q0 - q;
        bidx = hq * SWA_TBL_HEAD + relbase + 288;
        colbase = q0 + q;
    }
    const int mtok0 = NREG;
    const int nhk = X.kpitch >> 6;
    constexpr int TSTEP = 2;
    const size_t blk = (size_t)nhk * 512;
    const bf16_t* kwin = X.K + (size_t)(wtok0 >> 3) * blk + ((((size_t)(q >> 3) * nhk + hk) * 2) * 4 + kg) * 64 + (q & 7) * 8;
    const bf16_t* kmet = X.K + (size_t)(mtok0 >> 3) * blk + ((((size_t)(q >> 3) * nhk + hk) * 2) * 4 + kg) * 64 + (q & 7) * 8;
    const bf16_t* vwin = X.VT + (size_t)(wtok0 >> 3) * blk + ((size_t)(kg >> 1) * nhk + hk) * 512 + ((kg & 1) * 16 + q) * 4;
    const bf16_t* vmet = X.VT + (size_t)(mtok0 >> 3) * blk + ((size_t)(kg >> 1) * nhk + hk) * 512 + ((kg & 1) * 16 + q) * 4;
#define ATT_TOFF(t) ((size_t)(TYPE == 0 ? (8 * ((t) >> 1) + 2 * ((t) & 1)) : TSTEP * (t)) * blk)
    bf16x8 Qf[2];
    { const bf16_t* qp = X.Q + (size_t)(qtok0 + q) * 1024 + hq * 64 + 8 * kg; Qf[0] = *(const bf16x8*)qp; Qf[1] = *(const bf16x8*)(qp + 32); }
    f32x4 S[NTILE];
    f32x4 O[4];
#define ATT_LOADK(buf, t0) do { _Pragma("unroll") for (int t = 0; t < 6; ++t) if ((t0) + t < NREAL) { const bf16_t* kp = ((t0) + t == TMETA) ? kmet : kwin + ATT_TOFF((t0) + t); buf[t][0] = *(const bf16x8*)kp; buf[t][1] = *(const bf16x8*)(kp + 256); } } while (0)
#define ATT_MMAK(buf, t0) do { _Pragma("unroll") for (int t = 0; t < 6; ++t) if ((t0) + t < NREAL) { \
        f32x4 s_ = __builtin_amdgcn_mfma_f32_16x16x32_bf16(buf[t][0], Qf[0], S[(t0) + t], 0, 0, 0); S[(t0) + t] = __builtin_amdgcn_mfma_f32_16x16x32_bf16(buf[t][1], Qf[1], s_, 0, 0, 0); } } while (0)
#define ATT_VPTR(t) (((t) == TMETA) ? vmet : vwin + ATT_TOFF(t))
#define ATT_LOADV(bl, bh, s0) do { _Pragma("unroll") for (int s = 0; s < 3; ++s) { \
        _Pragma("unroll") for (int dt = 0; dt < 4; ++dt) { \
            bl[s][dt] = *(const s16x4*)(ATT_VPTR(2 * ((s0) + s)) + dt * 128); \
            if (2 * ((s0) + s) + 1 < NREAL) bh[s][dt] = *(const s16x4*)(ATT_VPTR(2 * ((s0) + s) + 1) + dt * 128); else bh[s][dt] = (s16x4){0, 0, 0, 0}; } } } while (0)
#define ATT_PV(bl, bh, s0) do { _Pragma("unroll") for (int s = 0; s < 3; ++s) { \
        const f32x4 pa = S[2 * ((s0) + s)]; f32x4 pb = {0.f, 0.f, 0.f, 0.f}; if (2 * ((s0) + s) + 1 < NREAL) pb = S[2 * ((s0) + s) + 1]; \
        u32x4 pw; pw.x = cvt_pk_bf16(pa[0], pa[1]); pw.y = cvt_pk_bf16(pa[2], pa[3]); pw.z = cvt_pk_bf16(pb[0], pb[1]); pw.w = cvt_pk_bf16(pb[2], pb[3]); \
        const bf16x8 Pf = __builtin_bit_cast(bf16x8, pw); \
        _Pragma("unroll") for (int dt = 0; dt < 4; ++dt) { const bf16x8 Vf = __builtin_shufflevector(bl[s][dt], bh[s][dt], 0, 1, 2, 3, 4, 5, 6, 7); \
            O[dt] = __builtin_amdgcn_mfma_f32_16x16x32_bf16(Vf, Pf, O[dt], 0, 0, 0); } } } while (0)
    bf16x8 KA[6][2], KB[6][2];
    s16x4 VAl[3][4], VAh[3][4], VBl[3][4], VBh[3][4];
    ATT_LOADK(KA, 0); ATT_LOADK(KB, 6);
    {
        const LAS float* bt = X.tbl + bidx;
#pragma unroll
        for (int t = 0; t < NWIN; ++t)
#pragma unroll
            for (int j = 0; j < 4; ++j) S[t][j] = TYPE == 0 ? bt[(t >> 1) * NA_TBL_ROW + 16 * (t & 1) + j] : bt[16 * t + j];
#pragma unroll
        for (int j = 0; j < 4; ++j) {
            if (TYPE == 1) { const int mk = 4 * kg + j; int bucket;
                if (metaq) { const int rel = mk - q; bucket = (rel > 0 ? 16 : 0) + t5_bucket_abs(rel < 0 ? -rel : rel); } else bucket = t5_bucket_abs(16 + colbase - mk);
                S[TMETA][j] = X.tbl[SWA_T5_OFF + bucket * 16 + hq];
            } else S[TMETA][j] = -SM_SHIFT;
        }
        if (TYPE == 0) {
            bool okm[2][4];
#pragma unroll
            for (int hf = 0; hf < 2; ++hf)
#pragma unroll
                for (int j = 0; j < 4; ++j) okm[hf][j] = !metaq && (unsigned)(colbase + 16 * hf + j - wsq) < 16u;
#pragma unroll
            for (int t = 0; t < NWIN; ++t)
#pragma unroll
                for (int j = 0; j < 4; ++j) S[t][j] = okm[t & 1][j] ? S[t][j] : NEGBIG;
        } else {
#pragma unroll
            for (int t = 0; t < NWIN; ++t)
#pragma unroll
                for (int j = 0; j < 4; ++j) S[t][j] = (!metaq && (unsigned)(relbase + 16 * t + j + 128) <= 256u) ? S[t][j] : NEGBIG;
        }
    }
    ATT_MMAK(KA, 0);
    ATT_LOADK(KA, 12);
    ATT_MMAK(KB, 6);
    if (TYPE == 0) ATT_LOADV(VAl, VAh, 0);
    ATT_MMAK(KA, 12);
    if (TYPE == 1) ATT_LOADV(VAl, VAh, 0);
#pragma unroll
    for (int dt = 0; dt < 4; ++dt) O[dt] = (f32x4){0.f, 0.f, 0.f, 0.f};
    __builtin_amdgcn_sched_barrier(0);
    float sk = 0.f;
    if (TYPE == 1) sk = X.tbl[SWA_SINK_OFF + hq];
    ATT_LOADV(VBl, VBh, 3);
    float l = 0.f;
#pragma unroll
    for (int t = 0; t < NREAL; ++t) {
#pragma unroll
        for (int j = 0; j < 4; ++j) { const float p = fast_exp2(S[t][j]); S[t][j] = p; l += p; }
    }
    l += __shfl_xor(l, 16); l += __shfl_xor(l, 32);
    if (TYPE == 1) l += fast_exp2(sk);
    __builtin_amdgcn_sched_barrier(0);
    const float inv = 1.0f / l;
    ATT_PV(VAl, VAh, 0);
    ATT_LOADV(VAl, VAh, 6);
    ATT_PV(VBl, VBh, 3);
    ATT_PV(VAl, VAh, 6);
#undef ATT_LOADK
#undef ATT_MMAK
#undef ATT_LOADV
#undef ATT_PV
#undef ATT_VPTR
#undef ATT_TOFF
    bf16_t* op = X.O + (size_t)((unsigned)(qtok0 + q) & X.omask) * 1024 + hq * 64 + 4 * kg;
#pragma unroll
    for (int dt = 0; dt < 4; ++dt) { u32x2 w; w.x = cvt_pk_bf16(O[dt][0] * inv, O[dt][1] * inv); w.y = cvt_pk_bf16(O[dt][2] * inv, O[dt][3] * inv); *(u32x2*)(op + 16 * dt) = w; }
}

template <int TYPE>
__device__ __forceinline__ void metaq_unit(const AttnCtx& X, const LAS float* t5s, const LAS float* sinks, int b, int hq, int lane) {
    const int q = lane & 15, kg = lane >> 4, hk = TYPE == 0 ? hq : (hq >> 2), nhk = X.kpitch >> 6, mtok0 = NREG;
    const size_t blk = (size_t)nhk * 512;
    const bf16_t* qp = X.Q + (size_t)(mtok0 + q) * 1024 + hq * 64 + 8 * kg;
    const bf16_t* kp = X.K + (size_t)(mtok0 >> 3) * blk + ((((size_t)(q >> 3) * nhk + hk) * 2) * 4 + kg) * 64 + (q & 7) * 8;
    const bf16_t* vp = X.VT + (size_t)(mtok0 >> 3) * blk + ((size_t)(kg >> 1) * nhk + hk) * 512 + ((kg & 1) * 16 + q) * 4;
    const bf16x8 q0 = *(const bf16x8*)qp, q1 = *(const bf16x8*)(qp + 32), k0 = *(const bf16x8*)kp, k1 = *(const bf16x8*)(kp + 256);
    s16x4 vl[4];
#pragma unroll
    for (int dt = 0; dt < 4; ++dt) vl[dt] = *(const s16x4*)(vp + dt * 128);
    f32x4 S;
#pragma unroll
    for (int j = 0; j < 4; ++j) {
        if (TYPE == 1) { const int rel = 4 * kg + j - q; S[j] = t5s[((rel > 0 ? 16 : 0) + t5_bucket_abs(rel < 0 ? -rel : rel)) * 16 + hq]; } else S[j] = -SM_SHIFT;
    }
    S = __builtin_amdgcn_mfma_f32_16x16x32_bf16(k0, q0, S, 0, 0, 0); S = __builtin_amdgcn_mfma_f32_16x16x32_bf16(k1, q1, S, 0, 0, 0);
    float l = 0.f;
#pragma unroll
    for (int j = 0; j < 4; ++j) { S[j] = fast_exp2(S[j]); l += S[j]; }
    l += __shfl_xor(l, 16); l += __shfl_xor(l, 32);
    if (TYPE == 1) l += fast_exp2(sinks[hq]);
    const float inv = 1.0f / l;
    u32x4 pw; pw.x = cvt_pk_bf16(S[0], S[1]); pw.y = cvt_pk_bf16(S[2], S[3]); pw.z = 0u; pw.w = 0u;
    const bf16x8 Pf = __builtin_bit_cast(bf16x8, pw);
    bf16_t* op = X.O + (size_t)((unsigned)(mtok0 + q) & X.omask) * 1024 + hq * 64 + 4 * kg;
#pragma unroll
    for (int dt = 0; dt < 4; ++dt) {
        const bf16x8 Vf = __builtin_shufflevector(vl[dt], (s16x4){0, 0, 0, 0}, 0, 1, 2, 3, 4, 5, 6, 7);
        const f32x4 o = __builtin_amdgcn_mfma_f32_16x16x32_bf16(Vf, Pf, (f32x4){0.f, 0.f, 0.f, 0.f}, 0, 0, 0);
        u32x2 w; w.x = cvt_pk_bf16(o[0] * inv, o[1] * inv); w.y = cvt_pk_bf16(o[2] * inv, o[3] * inv); *(u32x2*)(op + 16 * dt) = w;
    }
}

template <int TYPE>
__device__ __forceinline__ void attn_phase(Frame& F, const AttnCtx& X) {
    int lane_l = F.lane; asm volatile("" : "+v"(lane_l));
    if (F.G == 256) {
        const int xcd = F.bx & 7, cu = F.bx >> 3, w = F.wave;
        if (TYPE == 0) {
            for (int it = 0; it < 32; ++it) { const int p = xcd * 64 + 2 * it + (w >> 2); attn_unit<0>(X, p >> 4, p & 15, cu, w & 3, false, lane_l); }
        } else {
            for (int it = 0; it < 32; ++it) { const int bn = xcd * 16 + (it >> 1), qb = 4 * cu + 2 * (it & 1) + (w >> 2); attn_unit<1>(X, bn >> 2, (bn & 3) * 4 + (w & 3), qb, 0, false, lane_l); }
        }
    } else {
        const int UPC = (NREG + F.G - 1) / F.G;
        const int ubeg = F.bx * UPC, uend = (ubeg + UPC) < NREG ? (ubeg + UPC) : NREG;
        for (int u = ubeg + F.wave; u < uend; u += 8) {
            if (TYPE == 0) { const int cb = u & 3, r = (u >> 2) & 31, h = (u >> 7) & 15, b = u >> 11; attn_unit<0>(X, b, h, r, cb, false, lane_l); }
            else { const int g = u & 3, qb = (u >> 2) & 127, n = (u >> 9) & 3, b = u >> 11; attn_unit<1>(X, b, n * 4 + g, qb, 0, false, lane_l); }
        }
    }
    for (int u = F.bx * 8 + F.wave; u < 16; u += F.G * 8) metaq_unit<TYPE>(X, X.tbl, X.tbl, 0, u, lane_l);
}

__device__ __forceinline__ void dma16(const void* g, LAS void* l) { __builtin_amdgcn_global_load_lds((const unsigned*)g, (LAS unsigned*)l, 16, 0, 0); }
constexpr int NA_RING_ROWS = 12, NA_TBL_OFF = NA_RING_ROWS * 8192;
__device__ __forceinline__ void na_ring_item(Frame& F, const AttnCtx& X, int pair) {
    int lane = F.lane; asm volatile("" : "+v"(lane));
    const int w = F.wave, q = lane & 15, kg = lane >> 4, cb = w & 3, rsel = w >> 2, b = pair >> 4, hq = pair & 15;
    LAS unsigned char* lds = F.lds;
    const LAS float* tbl = (const LAS float*)(lds + NA_TBL_OFF);
    constexpr int nhk = 16; const size_t blk = (size_t)nhk * 512;
    const bf16_t* vglob = X.VT + ((size_t)(b * 256) * nhk + hq) * 512 + lane * 8;
    const int mtok0 = NREG;
    const bf16_t* kmet = X.K + (size_t)(mtok0 >> 3) * blk + ((((size_t)(q >> 3) * nhk + hq) * 2) * 4 + kg) * 64 + (q & 7) * 8;
    const bf16_t* vmet = X.VT + (size_t)(mtok0 >> 3) * blk + ((size_t)(kg >> 1) * nhk + hq) * 512 + ((kg & 1) * 16 + q) * 4;
#pragma unroll
    for (int r = 0; r < 8; ++r) dma16(vglob + (size_t)(8 * r + w) * blk, lds + r * 8192 + w * 1024);
    int loaded_hi = 8;
    const int ks = (16 * cb - 8) < 0 ? 0 : ((16 * cb - 8) > 32 ? 32 : (16 * cb - 8));
    const int qc = 16 * cb + q; int wsq = qc - 8; wsq = wsq < 0 ? 0 : (wsq > 48 ? 48 : wsq);
    const int colbase = ks + 4 * kg;
    bool okm[2][4];
#pragma unroll
    for (int hf = 0; hf < 2; ++hf)
#pragma unroll
        for (int j = 0; j < 4; ++j) okm[hf][j] = (unsigned)(colbase + 16 * hf + j - wsq) < 16u;
    const int kfl = ((((q >> 3) * nhk + hq) * 2) * 4 + kg) * 64 + (q & 7) * 8;
    const int vfl = ((ks >> 3) + (kg >> 1)) * 1024 + ((kg & 1) * 16 + q) * 8;
    bf16x8 Qn[2];
    { const bf16_t* qp = X.Q + (size_t)(b * SEQ + rsel * 64 + 16 * cb + q) * 1024 + hq * 64 + 8 * kg; Qn[0] = *(const bf16x8*)qp; Qn[1] = *(const bf16x8*)(qp + 32); }
    __builtin_amdgcn_s_waitcnt(0x0F70); asm volatile("" ::: "memory"); __builtin_amdgcn_s_barrier(); asm volatile("" ::: "memory");
    for (int s = 0; s < 16; ++s) {
        const int r = 2 * s + rsel;
        bf16x8 Qf[2]; Qf[0] = Qn[0]; Qf[1] = Qn[1];
        if (s + 1 < 16) {
            int nh = 2 * s + 3 - 4; nh = nh < 0 ? 0 : (nh > 24 ? 24 : nh); nh += 8;
#pragma unroll
            for (int k = 0; k < 2; ++k) { const int rr = loaded_hi + k; if (rr < nh) { const int slot = rr >= 24 ? rr - 24 : (rr >= 12 ? rr - 12 : rr); dma16(vglob + (size_t)(8 * rr + w) * blk, lds + slot * 8192 + w * 1024); } }
            loaded_hi = nh > loaded_hi ? nh : loaded_hi;
            const bf16_t* qp = X.Q + (size_t)(b * SEQ + (r + 2) * 64 + 16 * cb + q) * 1024 + hq * 64 + 8 * kg; Qn[0] = *(const bf16x8*)qp; Qn[1] = *(const bf16x8*)(qp + 32);
        }
        int rs = r - 4; rs = rs < 0 ? 0 : (rs > 24 ? 24 : rs);
        const int wtok0 = b * SEQ + rs * 64 + ks;
        const bf16_t* kwin = X.K + (size_t)(wtok0 >> 3) * blk + kfl;
        const LAS float* bt = tbl + hq * NA_TBL_HEAD + (rs - r + 7) * NA_TBL_ROW + (colbase - qc + 15 + 16);
        f32x4 S[17];
        bf16x8 KA[6][2], KB[6][2];
#define NR_LOADK(buf, t0) do { _Pragma("unroll") for (int t = 0; t < 6; ++t) if ((t0) + t < 17) { const bf16_t* kp = ((t0) + t == 16) ? kmet : kwin + (size_t)(8 * (((t0) + t) >> 1) + 2 * (((t0) + t) & 1)) * blk; buf[t][0] = *(const bf16x8*)kp; buf[t][1] = *(const bf16x8*)(kp + 256); } } while (0)
#define NR_MMAK(buf, t0) do { _Pragma("unroll") for (int t = 0; t < 6; ++t) if ((t0) + t < 17) { \
        f32x4 s_ = __builtin_amdgcn_mfma_f32_16x16x32_bf16(buf[t][0], Qf[0], S[(t0) + t], 0, 0, 0); S[(t0) + t] = __builtin_amdgcn_mfma_f32_16x16x32_bf16(buf[t][1], Qf[1], s_, 0, 0, 0); } } while (0)
        NR_LOADK(KA, 0); NR_LOADK(KB, 6);
        s16x4 vm[4];
#pragma unroll
        for (int dt = 0; dt < 4; ++dt) vm[dt] = *(const s16x4*)(vmet + dt * 128);
#pragma unroll
        for (int t = 0; t < 16; ++t)
#pragma unroll
            for (int j = 0; j < 4; ++j) S[t][j] = bt[(t >> 1) * NA_TBL_ROW + 16 * (t & 1) + j];
#pragma unroll
        for (int t = 0; t < 16; ++t)
#pragma unroll
            for (int j = 0; j < 4; ++j) S[t][j] = okm[t & 1][j] ? S[t][j] : NEGBIG;
        S[16] = (f32x4){-SM_SHIFT, -SM_SHIFT, -SM_SHIFT, -SM_SHIFT};
        NR_MMAK(KA, 0);
        NR_LOADK(KA, 12);
        NR_MMAK(KB, 6);
        NR_MMAK(KA, 12);
#undef NR_LOADK
#undef NR_MMAK
        __builtin_amdgcn_sched_barrier(0);
        float l = 0.f;
#pragma unroll
        for (int t = 0; t < 17; ++t)
#pragma unroll
            for (int j = 0; j < 4; ++j) { const float p = fast_exp2(S[t][j]); S[t][j] = p; l += p; }
        l += __shfl_xor(l, 16); l += __shfl_xor(l, 32);
        const float inv = 1.0f / l;
        __builtin_amdgcn_sched_barrier(0);
        f32x4 O[4];
#pragma unroll
        for (int dt = 0; dt < 4; ++dt) O[dt] = (f32x4){0.f, 0.f, 0.f, 0.f};
#pragma unroll
        for (int st = 0; st < 9; ++st) {
            const f32x4 pa = S[2 * st]; f32x4 pb = {0.f, 0.f, 0.f, 0.f}; if (st < 8) pb = S[2 * st + 1];
            u32x4 pw; pw.x = cvt_pk_bf16(pa[0], pa[1]); pw.y = cvt_pk_bf16(pa[2], pa[3]); pw.z = cvt_pk_bf16(pb[0], pb[1]); pw.w = cvt_pk_bf16(pb[2], pb[3]);
            const bf16x8 Pf = __builtin_bit_cast(bf16x8, pw);
            int rr = rs + st; const int slot = rr >= 24 ? rr - 24 : (rr >= 12 ? rr - 12 : rr);
            const LAS unsigned char* vp = lds + slot * 8192 + vfl;
#pragma unroll
            for (int dt = 0; dt < 4; ++dt) {
                s16x4 vl, vh;
                if (st < 8) { vl = *(const LAS s16x4*)(vp + 256 * dt); vh = *(const LAS s16x4*)(vp + 2048 + 256 * dt); } else { vl = vm[dt]; vh = (s16x4){0, 0, 0, 0}; }
                const bf16x8 Vf = __builtin_shufflevector(vl, vh, 0, 1, 2, 3, 4, 5, 6, 7);
                O[dt] = __builtin_amdgcn_mfma_f32_16x16x32_bf16(Vf, Pf, O[dt], 0, 0, 0);
            }
        }
        bf16_t* op = X.O + (size_t)((unsigned)(b * SEQ + r * 64 + 16 * cb + q) & X.omask) * 1024 + hq * 64 + 4 * kg;
#pragma unroll
        for (int dt = 0; dt < 4; ++dt) { u32x2 wv; wv.x = cvt_pk_bf16(O[dt][0] * inv, O[dt][1] * inv); wv.y = cvt_pk_bf16(O[dt][2] * inv, O[dt][3] * inv); *(u32x2*)(op + 16 * dt) = wv; }
        __builtin_amdgcn_s_waitcnt(0x0F74); asm volatile("" ::: "memory"); __builtin_amdgcn_s_barrier(); asm volatile("" ::: "memory");
    }
    __builtin_amdgcn_s_waitcnt(0x0F70); asm volatile("" ::: "memory");
}

constexpr int SX_T5 = 0, SX_SINK = 2048, SX_TBL = 2176, SX_MK = 11392, SX_MV = 13440, SWA_VRING = 65536;
__device__ __forceinline__ void swa_ring_item(Frame& F, const AttnCtx& X, int item) {
    int lane = F.lane; asm volatile("" : "+v"(lane));
    const int w = F.wave, q = lane & 15, kg = lane >> 4;
    const int bn = item >> 1, hf = item & 1, b = bn >> 2, n = bn & 3, g = w & 3, qsel = w >> 2, hq = n * 4 + g;
    LAS unsigned char* lds = F.lds;
    const LAS float* xt5 = (const LAS float*)(lds + ATT_X_OFF + SX_T5);
    const LAS float* xtb = (const LAS float*)(lds + ATT_X_OFF + SX_TBL) + g * SWA_TBL_HEAD;
    const float sk = ((const LAS float*)(lds + ATT_X_OFF + SX_SINK))[hq];
    const bf16_t* kglob = X.K + ((size_t)(b * 256) * 4 + n) * 512 + lane * 8;
    const bf16_t* vglob = X.VT + ((size_t)(b * 256) * 4 + n) * 512 + lane * 8;
    if (w < 4) { const size_t mb = ((size_t)(NREG >> 3) + (w & 1)) * 4 + n; dma16((w < 2 ? X.K : X.VT) + mb * 512 + lane * 8, lds + ATT_X_OFF + (w < 2 ? SX_MK : SX_MV) + (w & 1) * 1024); }
    const int qbase = 64 * hf;
    int q0f = 16 * qbase; int lo = q0f - 128; lo = lo < 0 ? 0 : (lo > SEQ - 272 ? SEQ - 272 : lo);
    int hi0 = q0f + 16 - 128; hi0 = hi0 < 0 ? 0 : (hi0 > SEQ - 272 ? SEQ - 272 : hi0); hi0 += 272;
    for (int B = (lo >> 3) + w; B < (hi0 >> 3); B += 8) { dma16(kglob + (size_t)B * 2048, lds + (B & 63) * 1024); dma16(vglob + (size_t)B * 2048, lds + SWA_VRING + (B & 63) * 1024); }
    int loaded_hi = hi0;
    bf16x8 Qn[2];
    { const bf16_t* qp = X.Q + (size_t)(b * SEQ + 16 * (qbase + qsel) + q) * 1024 + hq * 64 + 8 * kg; Qn[0] = *(const bf16x8*)qp; Qn[1] = *(const bf16x8*)(qp + 32); }
    const int kfrag = (q >> 3) * 1024 + kg * 128 + (q & 7) * 16;
    const int vfrag = (kg >> 1) * 1024 + ((kg & 1) * 16 + q) * 8;
    __builtin_amdgcn_s_waitcnt(0x0F70); asm volatile("" ::: "memory"); __builtin_amdgcn_s_barrier(); asm volatile("" ::: "memory");
    for (int s = 0; s < 32; ++s) {
        const int qblk = qbase + 2 * s + qsel, q0 = 16 * qblk;
        bf16x8 Qf[2]; Qf[0] = Qn[0]; Qf[1] = Qn[1];
        if (s + 1 < 32) {
            int nh = 16 * (qbase + 2 * s + 3) - 128; nh = nh < 0 ? 0 : (nh > SEQ - 272 ? SEQ - 272 : nh); nh += 272;
            const int B = (loaded_hi >> 3) + (w & 3);
            if (B < (nh >> 3)) { if (w < 4) dma16(kglob + (size_t)B * 2048, lds + (B & 63) * 1024); else dma16(vglob + (size_t)B * 2048, lds + SWA_VRING + (B & 63) * 1024); }
            loaded_hi = nh > loaded_hi ? nh : loaded_hi;
            const bf16_t* qp = X.Q + (size_t)(b * SEQ + q0 + 32 + q) * 1024 + hq * 64 + 8 * kg; Qn[0] = *(const bf16x8*)qp; Qn[1] = *(const bf16x8*)(qp + 32);
        }
        int jb = q0 - 128; jb = jb < 0 ? 0 : (jb > SEQ - 272 ? SEQ - 272 : jb);
        const int relbase = jb + 4 * kg - q0 - q;
        const int jblk = jb >> 3;
        f32x4 S[18];
        {
            const LAS float* bt = xtb + relbase + 288;
#pragma unroll
            for (int t = 0; t < 17; ++t)
#pragma unroll
                for (int j = 0; j < 4; ++j) S[t][j] = bt[16 * t + j];
#pragma unroll
            for (int j = 0; j < 4; ++j) S[17][j] = xt5[t5_bucket_abs(16 + q0 + q - (4 * kg + j)) * 16 + hq];
            if (jb == q0 - 128) {
#pragma unroll
                for (int j = 0; j < 4; ++j) { S[0][j] = (relbase + j >= -128) ? S[0][j] : NEGBIG; S[16][j] = (relbase + 256 + j <= 128) ? S[16][j] : NEGBIG; }
            } else {
                int r0 = relbase + 128; asm volatile("" : "+v"(r0));
#pragma unroll
                for (int t = 0; t < 17; ++t)
#pragma unroll
                    for (int j = 0; j < 4; ++j) S[t][j] = ((unsigned)(r0 + (16 * t + j)) <= 256u) ? S[t][j] : NEGBIG;
            }
        }
#pragma unroll
        for (int t0 = 0; t0 < 18; t0 += 6) {
            bf16x8 Kf[6][2];
#pragma unroll
            for (int t = 0; t < 6; ++t) {
                const LAS unsigned char* kp = (t0 + t == 17) ? lds + ATT_X_OFF + SX_MK + kfrag : lds + (((jblk + 2 * (t0 + t) + (q >> 3)) & 63) * 1024) + (kfrag & 1023);
                Kf[t][0] = *(const LAS bf16x8*)kp; Kf[t][1] = *(const LAS bf16x8*)(kp + 512);
            }
#pragma unroll
            for (int t = 0; t < 6; ++t) { f32x4 s_ = __builtin_amdgcn_mfma_f32_16x16x32_bf16(Kf[t][0], Qf[0], S[t0 + t], 0, 0, 0); S[t0 + t] = __builtin_amdgcn_mfma_f32_16x16x32_bf16(Kf[t][1], Qf[1], s_, 0, 0, 0); }
        }
        __builtin_amdgcn_sched_barrier(0);
        float l = 0.f;
#pragma unroll
        for (int t = 0; t < 18; ++t)
#pragma unroll
            for (int j = 0; j < 4; ++j) { const float p = fast_exp2(S[t][j]); S[t][j] = p; l += p; }
        l += __shfl_xor(l, 16); l += __shfl_xor(l, 32);
        l += fast_exp2(sk);
        __builtin_amdgcn_sched_barrier(0);
        const float inv = 1.0f / l;
        f32x4 O[4];
#pragma unroll
        for (int dt = 0; dt < 4; ++dt) O[dt] = (f32x4){0.f, 0.f, 0.f, 0.f};
#pragma unroll
        for (int st = 0; st < 9; ++st) {
            const LAS unsigned char* va = lds + SWA_VRING + (((jblk + 4 * st + (kg >> 1)) & 63) * 1024) + (vfrag & 1023);
            const LAS unsigned char* vb = (st == 8) ? lds + ATT_X_OFF + SX_MV + vfrag : lds + SWA_VRING + (((jblk + 4 * st + 2 + (kg >> 1)) & 63) * 1024) + (vfrag & 1023);
            const f32x4 pa = S[2 * st], pb = S[2 * st + 1];
            u32x4 pw; pw.x = cvt_pk_bf16(pa[0], pa[1]); pw.y = cvt_pk_bf16(pa[2], pa[3]); pw.z = cvt_pk_bf16(pb[0], pb[1]); pw.w = cvt_pk_bf16(pb[2], pb[3]);
            const bf16x8 Pf = __builtin_bit_cast(bf16x8, pw);
#pragma unroll
            for (int dt = 0; dt < 4; ++dt) {
                const s16x4 vl = *(const LAS s16x4*)(va + 256 * dt), vh = *(const LAS s16x4*)(vb + 256 * dt);
                const bf16x8 Vf = __builtin_shufflevector(vl, vh, 0, 1, 2, 3, 4, 5, 6, 7);
                O[dt] = __builtin_amdgcn_mfma_f32_16x16x32_bf16(Vf, Pf, O[dt], 0, 0, 0);
            }
        }
        bf16_t* op = X.O + (size_t)((unsigned)(b * SEQ + q0 + q) & X.omask) * 1024 + hq * 64 + 4 * kg;
#pragma unroll
        for (int dt = 0; dt < 4; ++dt) { u32x2 wv; wv.x = cvt_pk_bf16(O[dt][0] * inv, O[dt][1] * inv); wv.y = cvt_pk_bf16(O[dt][2] * inv, O[dt][3] * inv); *(u32x2*)(op + 16 * dt) = wv; }
        __builtin_amdgcn_s_waitcnt(0x0F74); asm volatile("" ::: "memory"); __builtin_amdgcn_s_barrier(); asm volatile("" ::: "memory");
    }
    asm volatile("s_waitcnt vmcnt(0)" ::: "memory");
}

__device__ __forceinline__ void router_phase(Frame& F, const float* wr, const float* gain, const u64* ssq, int moe_idx, bool dummy) {
    LAS u32x4* Wl = (LAS u32x4*)F.lds;
    for (int idx = F.tid; idx < 32 * 64; idx += 512) {
        const int st = idx >> 6, ln = idx & 63, n = ln & 15, kg = ln >> 4, e = 2 * (n >> 2) + (n & 1), part = (n >> 1) & 1;
        float v[8];
#pragma unroll
        for (int c = 0; c < 8; ++c) { const int k = 64 * (st >> 1) + 16 * kg + 8 * (st & 1) + c; const float w = wr[(size_t)k * 8 + e] * gain[k];
            const float hi = __uint_as_float(cvt_pk_bf16(w, 0.f) << 16); v[c] = part ? w - hi : hi; }
        u32x4 o; o.x = cvt_pk_bf16(v[0], v[1]); o.y = cvt_pk_bf16(v[2], v[3]); o.z = cvt_pk_bf16(v[4], v[5]); o.w = cvt_pk_bf16(v[6], v[7]);
        Wl[idx] = o;
    }
    __syncthreads();
    unsigned* cnt = F.ctl + CW_CNT + (dummy ? 2 : moe_idx) * 8 * 64;
    unsigned char* tb_ = dummy ? F.ws + WS_R : F.ws + WS_TAB;
    unsigned* rowtok = (unsigned*)(tb_); float* rowssq = (float*)(tb_ + TAB_BYTES);
    unsigned* rowslot = (unsigned*)(tb_ + 2 * TAB_BYTES); float* rowgate = (float*)(tb_ + 3 * TAB_BYTES);
    const int gw = F.bx * 8 + F.wave, NGW = F.G * 8;
    constexpr int RT = 48;
    int lane_ = F.lane; asm volatile("" : "+v"(lane_));
    const int tok = lane_ & 15, q = lane_ >> 4;
    constexpr int NT = (M + RT - 1) / RT;
    LAS unsigned* wcnt = (LAS unsigned*)(F.lds + 32768);
    (void)gw;
    for (int t0 = 0; t0 < NT; t0 += NGW) {
        const int task = t0 + F.wave * F.G + F.bx; const bool has = task < NT;
        int me1 = 0, me2 = 0; float mg1 = 0.f, mg2 = 0.f, mss = 0.f;
        if (has) for (int j = 0; j < 3; ++j) {
            int mm = task * RT + 16 * j + tok; mm = mm < M ? mm : M - 1;
            const bf16_t* xr = F.hb + (size_t)mm * D + 16 * q;
            bf16x8 xa[16][2];
#pragma unroll
            for (int i = 0; i < 16; ++i) { xa[i][0] = *(const bf16x8*)(xr + 64 * i); xa[i][1] = *(const bf16x8*)(xr + 64 * i + 8); }
            const float ssv = ssq_val(ssq[mm]);
            f32x4 acc0 = {0.f, 0.f, 0.f, 0.f}, acc1 = {0.f, 0.f, 0.f, 0.f};
#pragma unroll
            for (int i = 0; i < 16; ++i) {
                const bf16x8 w0 = __builtin_bit_cast(bf16x8, Wl[(2 * i) * 64 + lane_]), w1 = __builtin_bit_cast(bf16x8, Wl[(2 * i + 1) * 64 + lane_]);
                acc0 = __builtin_amdgcn_mfma_f32_16x16x32_bf16(w0, xa[i][0], acc0, 0, 0, 0);
                acc1 = __builtin_amdgcn_mfma_f32_16x16x32_bf16(w1, xa[i][1], acc1, 0, 0, 0); }
            const f32x4 acc = acc0 + acc1;
            const float l0 = acc[0] + acc[2], l1 = acc[1] + acc[3];
            float cv[8]; int ce[8];
            cv[0] = l0; cv[1] = l1; ce[0] = 2 * q; ce[1] = 2 * q + 1;
#pragma unroll
            for (int d = 1; d < 4; ++d) { cv[2 * d] = __shfl_xor(l0, 16 * d); cv[2 * d + 1] = __shfl_xor(l1, 16 * d); ce[2 * d] = 2 * (q ^ d); ce[2 * d + 1] = 2 * (q ^ d) + 1; }
            int e1 = ce[0]; float v1 = cv[0];
#pragma unroll
            for (int c = 1; c < 8; ++c) if (cv[c] > v1 || (cv[c] == v1 && ce[c] < e1)) { v1 = cv[c]; e1 = ce[c]; }
            int e2 = -1; float v2 = -3.0e38f;
#pragma unroll
            for (int c = 0; c < 8; ++c) if (ce[c] != e1 && (cv[c] > v2 || (cv[c] == v2 && ce[c] < e2))) { v2 = cv[c]; e2 = ce[c]; }
            if (e2 < 0) e2 = e1 ^ 1;
            const float rstd = 1.0f / sqrtf(ssv * (1.0f / 1024.0f) + EPS);
            const float ex = __expf((v2 - v1) * rstd); const float g1 = 1.0f / (1.0f + ex), g2 = ex * g1;
            if (q == j) { me1 = e1; me2 = e2; mg1 = g1; mg2 = g2; mss = ssv; }
        }
        const bool act = has && F.lane < RT && task * RT + F.lane < M;
        int rank1 = 0, rank2 = 0, mycnt = 0, n1e2 = 0;
        const unsigned long long lt = (1ull << F.lane) - 1ull;
#pragma unroll
        for (int e = 0; e < 8; ++e) {
            const unsigned long long m1 = __ballot(act && me1 == e), m2 = __ballot(act && me2 == e);
            const int c1 = __popcll(m1), c2 = __popcll(m2);
            if (me1 == e) rank1 = __popcll(m1 & lt);
            if (me2 == e) { rank2 = __popcll(m2 & lt); n1e2 = c1; }
            if (F.lane == e) mycnt = c1 + c2;
        }
        unsigned basev = 0;
        if (F.lane < 8) wcnt[F.wave * 8 + F.lane] = (unsigned)mycnt;
        __syncthreads();
        if (F.wave == 0 && F.lane < 8) { unsigned tot = 0;
#pragma unroll
            for (int w = 0; w < 8; ++w) tot += wcnt[w * 8 + F.lane];
            wcnt[64 + F.lane] = tot ? __hip_atomic_fetch_add(cnt + F.lane * 64, tot, RLX_AGENT) : 0u; }
        __syncthreads();
        if (F.lane < 8) { basev = wcnt[64 + F.lane]; for (int w = 0; w < F.wave; ++w) basev += wcnt[w * 8 + F.lane]; }
        __syncthreads();
        const unsigned b1 = __shfl(basev, me1), b2 = __shfl(basev, me2);
        if (act) {
            const int m = task * RT + F.lane;
            const size_t p1 = (size_t)me1 * M + b1 + rank1, p2 = (size_t)me2 * M + b2 + n1e2 + rank2;
            rowtok[p1] = m; rowssq[p1] = mss; rowslot[p1] = 2 * m; rowgate[p1] = mg1;
            rowtok[p2] = m; rowssq[p2] = mss; rowslot[p2] = 2 * m + 1; rowgate[p2] = mg2;
        }
    }
}
__device__ __forceinline__ void combine_phase(Frame& F, const bf16_t* ys, u64* ssq_next, bool last, bool dummy) {
    const int gw = F.bx * 8 + F.wave, NGW = F.G * 8, mend = last ? NREG : M;
    u32x4 nh[2], na[2], nc[2];
    if (gw < mend) { const u32x4* hr = (const u32x4*)(F.hb + (size_t)gw * D) + F.lane; const u32x4* y0 = (const u32x4*)(ys + (size_t)(2 * gw) * D) + F.lane; const u32x4* y1 = (const u32x4*)(ys + (size_t)(2 * gw + 1) * D) + F.lane;
#pragma unroll
        for (int j = 0; j < 2; ++j) { nh[j] = hr[64 * j]; na[j] = y0[64 * j]; nc[j] = y1[64 * j]; } }
    for (int m = gw; m < mend; m += NGW) {
        u32x4 ch[2], ca[2], cc2[2];
#pragma unroll
        for (int j = 0; j < 2; ++j) { ch[j] = nh[j]; ca[j] = na[j]; cc2[j] = nc[j]; }
        const int mn = m + NGW;
        if (mn < mend) { const u32x4* hr = (const u32x4*)(F.hb + (size_t)mn * D) + F.lane; const u32x4* y0 = (const u32x4*)(ys + (size_t)(2 * mn) * D) + F.lane; const u32x4* y1 = (const u32x4*)(ys + (size_t)(2 * mn + 1) * D) + F.lane;
#pragma unroll
            for (int j = 0; j < 2; ++j) { nh[j] = hr[64 * j]; na[j] = y0[64 * j]; nc[j] = y1[64 * j]; } }
        float v[2][8]; float s = 0.f;
#pragma unroll
        for (int j = 0; j < 2; ++j) { const u32x4 h4 = ch[j], a = ca[j], c = cc2[j];
            const unsigned hh[4] = {h4.x, h4.y, h4.z, h4.w}, aa[4] = {a.x, a.y, a.z, a.w}, cc[4] = {c.x, c.y, c.z, c.w};
#pragma unroll
            for (int i = 0; i < 4; ++i) { v[j][2 * i] = __uint_as_float(hh[i] << 16) + (__uint_as_float(aa[i] << 16) + __uint_as_float(cc[i] << 16));
                v[j][2 * i + 1] = __uint_as_float(hh[i] & 0xffff0000u) + (__uint_as_float(aa[i] & 0xffff0000u) + __uint_as_float(cc[i] & 0xffff0000u)); }
#pragma unroll
            for (int i = 0; i < 8; ++i) s += v[j][i] * v[j][i]; }
        if (last) {
            f32x4* o = (f32x4*)((dummy ? (float*)(F.ws + WS_R) + (size_t)(m & 0x7FFF) * D : F.out + (size_t)m * D)) + 2 * F.lane;
#pragma unroll
            for (int j = 0; j < 2; ++j) { o[128 * j] = (f32x4){v[j][0], v[j][1], v[j][2], v[j][3]}; o[128 * j + 1] = (f32x4){v[j][4], v[j][5], v[j][6], v[j][7]}; }
        } else {
            s = wave_sum(s);
            u32x4* o8 = (u32x4*)(dummy ? (bf16_t*)(F.ws + WS_R) + (size_t)(m & 0x7FFF) * D : F.hb + (size_t)m * D) + F.lane;
#pragma unroll
            for (int j = 0; j < 2; ++j) { u32x4 w; w.x = cvt_pk_bf16(v[j][0], v[j][1]); w.y = cvt_pk_bf16(v[j][2], v[j][3]); w.z = cvt_pk_bf16(v[j][4], v[j][5]); w.w = cvt_pk_bf16(v[j][6], v[j][7]); o8[64 * j] = w; }
            if (F.lane == 0) ssq_next[m] = ssq_fix(s);
        }
    }
}

__device__ __forceinline__ bool thin_gemm(Frame& F, f32x4 (&acc)[4], const bf16_t* ap, const bf16_t* const (&bp)[4], int K, int lane) {
#pragma unroll
    for (int t = 0; t < 4; ++t) acc[t] = (f32x4){0.f, 0.f, 0.f, 0.f};
    const int ksl = K / 8, kb = F.wave * ksl;
#pragma unroll 2
    for (int k0 = kb; k0 < kb + ksl; k0 += 64) {
        bf16x8 af[2], bf[2][4];
#pragma unroll
        for (int st = 0; st < 2; ++st) { af[st] = *(const bf16x8*)(ap + k0 + 32 * st);
#pragma unroll
            for (int t = 0; t < 4; ++t) bf[st][t] = *(const bf16x8*)(bp[t] + k0 + 32 * st); }
#pragma unroll
        for (int st = 0; st < 2; ++st)
#pragma unroll
            for (int t = 0; t < 4; ++t) acc[t] = __builtin_amdgcn_mfma_f32_16x16x32_bf16(bf[st][t], af[st], acc[t], 0, 0, 0);
    }
    LAS f32x4* part = (LAS f32x4*)F.lds;
#pragma unroll
    for (int t = 0; t < 4; ++t) part[(F.wave * 4 + t) * 64 + lane] = acc[t];
    __syncthreads();
    if (F.wave == 0) {
#pragma unroll
        for (int w = 1; w < 8; ++w)
#pragma unroll
            for (int t = 0; t < 4; ++t) acc[t] = acc[t] + part[(w * 4 + t) * 64 + lane];
    }
    return F.wave == 0;
}
__device__ __forceinline__ void thin_qkv(Frame& F, const bf16_t* W, const u64* ssq, const float* gq, const float* gk, bf16_t* Q, bf16_t* Kb, bf16_t* Vb, int nhk, int QT) {
    for (int task = F.bx; task < 16 + 2 * nhk; task += F.G) {
    int lane = F.lane; asm volatile("" : "+v"(lane));
    const int tk = lane & 15, kg = lane >> 4, tok = NREG + tk;
    const int kind = task < 16 ? 0 : (task < 16 + nhk ? 1 : 2), hh = kind == 0 ? task : (kind == 1 ? task - 16 : task - 16 - nhk);
    const bf16_t* bp[4];
#pragma unroll
    for (int t = 0; t < 4; ++t) { const int d = 16 * t + tk;
        const int row = kind == 0 ? (hh >> 2) * 256 + qk_perm(64 * (hh & 3) + d) : (kind == 1 ? (4 + (hh >> 2)) * 256 + qk_perm(64 * (hh & 3) + d) : QT * 256 + hh * 64 + d);
        bp[t] = W + (size_t)row * 1024 + 8 * kg; }
    f32x4 acc[4];
    if (thin_gemm(F, acc, F.hb + (size_t)tok * D + 8 * kg, bp, 1024, lane)) {
        const float rstd = fast_rsqrt(ssq_val(ssq[tok]) * (1.0f / 1024.0f) + EPS);
        if (kind < 2) {
            float ss = 0.f;
#pragma unroll
            for (int t = 0; t < 4; ++t) { acc[t] = acc[t] * rstd; ss += acc[t][0] * acc[t][0] + acc[t][1] * acc[t][1] + acc[t][2] * acc[t][2] + acc[t][3] * acc[t][3]; }
            ss += __shfl_xor(ss, 16); ss += __shfl_xor(ss, 32);
            const float hn = fast_rsqrt(ss * (1.0f / 64.0f) + EPS) * (kind == 0 ? 0.125f * LOG2E : 1.0f);
            const float* gp = kind == 0 ? gq : gk;
#pragma unroll
            for (int t = 0; t < 4; ++t) { const int d0 = 16 * t + 4 * kg; const f32x4 g = *(const f32x4*)(gp + d0); const f32x4 v = acc[t] * g * hn;
                u32x2 w; w.x = cvt_pk_bf16(v[0], v[1]); w.y = cvt_pk_bf16(v[2], v[3]);
                if (kind == 0) *(u32x2*)(Q + (size_t)tok * 1024 + hh * 64 + d0) = w;
                else *(u32x2*)(Kb + (((((size_t)(tok >> 3) * nhk + hh) * 2 + (d0 >> 5)) * 4 + ((d0 >> 3) & 3)) * 64) + (tok & 7) * 8 + (d0 & 7)) = w; }
        } else {
#pragma unroll
            for (int t = 0; t < 4; ++t)
#pragma unroll
                for (int r = 0; r < 4; ++r) { const int d = 16 * t + 4 * kg + r; const unsigned pk = cvt_pk_bf16(acc[t][r] * rstd, 0.f);
                    Vb[((size_t)(tok >> 3) * nhk + hh) * 512 + (((d >> 4) * 2 + ((tok >> 2) & 1)) * 16 + (d & 15)) * 4 + (tok & 3)] = (bf16_t)(pk & 0xffffu); }
        }
    }
    __syncthreads();
    }
}
__device__ __forceinline__ void thin_res(Frame& F, const bf16_t* A, int pitchA, int K, const bf16_t* W, u64* ssq_out, unsigned char* hb8) {
    for (int task = F.bx; task < 16; task += F.G) {
    int lane = F.lane; asm volatile("" : "+v"(lane));
    const int tk = lane & 15, kg = lane >> 4, tok = NREG + tk, c0 = 64 * task;
    const bf16_t* bp[4];
#pragma unroll
    for (int t = 0; t < 4; ++t) bp[t] = W + (size_t)dst_row(5, c0 + 16 * t + tk) * K + 8 * kg;
    f32x4 acc[4];
    if (thin_gemm(F, acc, A + (size_t)tk * pitchA + 8 * kg, bp, K, lane)) {
        float ss = 0.f;
#pragma unroll
        for (int t = 0; t < 4; ++t) { bf16_t* hp = F.hb + (size_t)tok * D + c0 + 16 * t + 4 * kg; const u32x2 b = *(const u32x2*)hp;
            const float o0 = __uint_as_float(b.x << 16) + acc[t][0], o1 = __uint_as_float(b.x & 0xffff0000u) + acc[t][1], o2 = __uint_as_float(b.y << 16) + acc[t][2], o3 = __uint_as_float(b.y & 0xffff0000u) + acc[t][3];
            u32x2 w; w.x = cvt_pk_bf16(o0, o1); w.y = cvt_pk_bf16(o2, o3); *(u32x2*)hp = w; ss += o0 * o0 + o1 * o1 + o2 * o2 + o3 * o3;
            if (hb8) { int p0 = 0; p0 = __builtin_amdgcn_cvt_pk_fp8_f32(o0, o1, p0, false); p0 = __builtin_amdgcn_cvt_pk_fp8_f32(o2, o3, p0, true); *(unsigned*)(hb8 + (size_t)tok * D + c0 + 16 * t + 4 * kg) = (unsigned)p0; } }
        ss += __shfl_xor(ss, 16); ss += __shfl_xor(ss, 32);
        if (kg == 0) __hip_atomic_fetch_add(ssq_out + tok, ssq_fix(ss), RLX_AGENT);
    }
    __syncthreads();
    }
}
__device__ __forceinline__ void thin_gu(Frame& F, const bf16_t* W, const u64* ssq, bf16_t* hid) {
    for (int task = F.bx; task < FF / 32; task += F.G) {
    int lane = F.lane; asm volatile("" : "+v"(lane));
    const int tk = lane & 15, kg = lane >> 4, tok = NREG + tk, j0 = 32 * task;
    const bf16_t* bp[4];
#pragma unroll
    for (int t = 0; t < 4; ++t) bp[t] = W + (size_t)dst_row(t < 2 ? 3 : 4, j0 + 16 * (t & 1) + tk) * 1024 + 8 * kg;
    f32x4 acc[4];
    if (thin_gemm(F, acc, F.hb + (size_t)tok * D + 8 * kg, bp, 1024, lane)) {
        const float rstd = fast_rsqrt(ssq_val(ssq[tok]) * (1.0f / 1024.0f) + EPS);
#pragma unroll
        for (int t = 0; t < 2; ++t) { float o[4];
#pragma unroll
            for (int r = 0; r < 4; ++r) o[r] = silu_f(acc[t][r] * rstd) * (acc[t + 2][r] * rstd);
            u32x2 w; w.x = cvt_pk_bf16(o[0], o[1]); w.y = cvt_pk_bf16(o[2], o[3]); *(u32x2*)(hid + (size_t)tok * FF + j0 + 16 * t + 4 * kg) = w; }
    }
    __syncthreads();
    }
}

__device__ __forceinline__ void thin_gu8(Frame& F, const unsigned char* W, const u64* ssq, bf16_t* hid) {
    for (int task = F.bx; task < FF / 32; task += F.G) {
    int lane = F.lane; asm volatile("" : "+v"(lane));
    const int tk = lane & 15, kg = lane >> 4, tok = NREG + tk, j0 = 32 * task;
    const unsigned char* ap = F.ws + WS_HB8 + (size_t)tok * D + F.wave * 128 + 32 * kg;
    const bf16x8 a0 = *(const bf16x8*)ap, a1 = *(const bf16x8*)(ap + 16);
    f32x4 acc[4];
#pragma unroll
    for (int t = 0; t < 4; ++t) { const unsigned char* bp = W + (size_t)dst_row(t < 2 ? 3 : 4, j0 + 16 * (t & 1) + tk) * 1024 + F.wave * 128 + 32 * kg;
        const bf16x8 b0 = *(const bf16x8*)bp, b1 = *(const bf16x8*)(bp + 16);
        acc[t] = __builtin_amdgcn_mfma_scale_f32_16x16x128_f8f6f4(pg8::cat8(b0, b1), pg8::cat8(a0, a1), (f32x4){0.f, 0.f, 0.f, 0.f}, 0, 0, 0, 0, 0, 0); }
    LAS f32x4* part = (LAS f32x4*)F.lds;
#pragma unroll
    for (int t = 0; t < 4; ++t) part[(F.wave * 4 + t) * 64 + lane] = acc[t];
    __syncthreads();
    if (F.wave == 0) {
#pragma unroll
        for (int w = 1; w < 8; ++w)
#pragma unroll
            for (int t = 0; t < 4; ++t) acc[t] = acc[t] + part[(w * 4 + t) * 64 + lane];
        const float rstd = fast_rsqrt(ssq_val(ssq[tok]) * (1.0f / 1024.0f) + EPS) * W8_INV;
#pragma unroll
        for (int t = 0; t < 2; ++t) { float o[4];
#pragma unroll
            for (int r = 0; r < 4; ++r) o[r] = silu_f(acc[t][r] * rstd) * (acc[t + 2][r] * rstd) * HID8_SCALE;
            int q = 0; q = __builtin_amdgcn_cvt_pk_fp8_f32(o[0], o[1], q, false); q = __builtin_amdgcn_cvt_pk_fp8_f32(o[2], o[3], q, true);
            *(unsigned*)((unsigned char*)hid + (size_t)tok * FF + j0 + 16 * t + 4 * kg) = (unsigned)q; }
    }
    __syncthreads();
    }
}
__device__ __forceinline__ void thin_res8(Frame& F, const unsigned char* A, const unsigned char* W, u64* ssq_out) {
    for (int task = F.bx; task < 16; task += F.G) {
    int lane = F.lane; asm volatile("" : "+v"(lane));
    const int tk = lane & 15, kg = lane >> 4, tok = NREG + tk, c0 = 64 * task;
    f32x4 acc[4];
#pragma unroll
    for (int t = 0; t < 4; ++t) acc[t] = (f32x4){0.f, 0.f, 0.f, 0.f};
    if (F.wave < 7) {
        const unsigned char* ap = A + (size_t)tk * FF + F.wave * 512 + 32 * kg;
#pragma unroll
        for (int i = 0; i < 4; ++i) {
            const bf16x8 a0 = *(const bf16x8*)(ap + 128 * i), a1 = *(const bf16x8*)(ap + 128 * i + 16);
#pragma unroll
            for (int t = 0; t < 4; ++t) { const unsigned char* bp = W + (size_t)dst_row(5, c0 + 16 * t + tk) * FF + F.wave * 512 + 128 * i + 32 * kg;
                const bf16x8 b0 = *(const bf16x8*)bp, b1 = *(const bf16x8*)(bp + 16);
                acc[t] = __builtin_amdgcn_mfma_scale_f32_16x16x128_f8f6f4(pg8::cat8(b0, b1), pg8::cat8(a0, a1), acc[t], 0, 0, 0, 0, 0, 0); }
        }
    }
    LAS f32x4* part = (LAS f32x4*)F.lds;
#pragma unroll
    for (int t = 0; t < 4; ++t) part[(F.wave * 4 + t) * 64 + lane] = acc[t];
    __syncthreads();
    if (F.wave == 0) {
#pragma unroll
        for (int w = 1; w < 8; ++w)
#pragma unroll
            for (int t = 0; t < 4; ++t) acc[t] = acc[t] + part[(w * 4 + t) * 64 + lane];
        float ss = 0.f;
#pragma unroll
        for (int t = 0; t < 4; ++t) { bf16_t* hp = F.hb + (size_t)tok * D + c0 + 16 * t + 4 * kg; const u32x2 b = *(const u32x2*)hp; const f32x4 a = acc[t] * (W8_INV * HID8_INV);
            const float o0 = __uint_as_float(b.x << 16) + a[0], o1 = __uint_as_float(b.x & 0xffff0000u) + a[1], o2 = __uint_as_float(b.y << 16) + a[2], o3 = __uint_as_float(b.y & 0xffff0000u) + a[3];
            u32x2 w; w.x = cvt_pk_bf16(o0, o1); w.y = cvt_pk_bf16(o2, o3); *(u32x2*)hp = w; ss += o0 * o0 + o1 * o1 + o2 * o2 + o3 * o3; }
        ss += __shfl_xor(ss, 16); ss += __shfl_xor(ss, 32);
        if (kg == 0) __hip_atomic_fetch_add(ssq_out + tok, ssq_fix(ss), RLX_AGENT);
    }
    __syncthreads();
    }
}

constexpr int PH_PER_PAIR = 10 + 2 * MOE_NCH, N_PHASES = 1 + 2 * PH_PER_PAIR;
typedef const __attribute__((address_space(4))) Args* KArgs;
__device__ __forceinline__ KArgs kargs() { KArgs p = (KArgs)__builtin_amdgcn_kernarg_segment_ptr(); asm volatile("" : "+s"(p)); return p; }
__device__ __forceinline__ void make_frame(Frame& F, KArgs ap) {
    extern __shared__ __attribute__((aligned(16))) unsigned char lds_raw[];
    { LAS unsigned char* lp = (LAS unsigned char*)lds_raw; asm volatile("" : "+s"(lp)); F.lds = lp; }
    F.tab = F.lds + TAB_OFF;
    int t = threadIdx.x; asm volatile("" : "+v"(t));
    F.tid = t; F.lane = t & 63; F.wave = __builtin_amdgcn_readfirstlane(t >> 6);
    { int g_ = gridDim.x, b_ = blockIdx.x; asm volatile("" : "+s"(g_), "+s"(b_)); F.G = g_; F.bx = b_; }
    unsigned char* ws = ap->ws;
    F.ws = ws; F.out = ap->out; F.hb = (bf16_t*)(ws + WS_HB); F.ctl = (unsigned*)(ws + WS_CTL);
}
__device__ __forceinline__ void grid_seam() {
    KArgs ap = kargs();
    extern __shared__ __attribute__((aligned(16))) unsigned char lds_raw[];
    XcdBarrier b; b.bar = (unsigned*)(ap->ws + WS_CTL) + CW_BAR; b.x = xb_xcc_id(); b.st = (volatile LAS unsigned*)((LAS unsigned char*)lds_raw + MISC_OFF) + 8;
    xcd_barrier(b);
}
#ifndef SITE_MASK
#define SITE_MASK 0xFFFF
#endif
#define SITE(b) ((SITE_MASK >> (b)) & 1)

__device__ __forceinline__ void site_na_qkv(int pr) {
    KArgs ap = kargs(); Frame F; make_frame(F, ap);
    const int lb = pr ? I_L2 : I_L0; const unsigned char* wb = F.ws + WS_W + (size_t)pr * WPAIR; unsigned char* R = F.ws + WS_R;
    LAS float* gainsL = (LAS float*)(F.lds + GAIN_OFF);
    if (F.tid < 64) { gainsL[F.tid] = ap->in[lb + 2][F.tid] * (0.125f * LOG2E); gainsL[64 + F.tid] = ap->in[lb + 3][F.tid]; }
    __syncthreads();
    QkvPolicy P; P.nt = 16; P.pitchA = 2048; P.pitchB = 2048; P.G = F.G; P.c = F.bx; P.nN = 12; P.QT = 8; P.hb = (const char*)F.hb; P.W = (const char*)(wb + WNA_QKV);
    P.ssq = ssq_buf(F, 4 * pr + 0); P.Q = (bf16_t*)(R + R_Q); P.K = (bf16_t*)(R + R_K); P.VT = (bf16_t*)(R + R_VT_NA); P.kpitch = 1024; P.nQ = 4; P.gains = gainsL;
    thin_qkv(F, (const bf16_t*)(wb + WNA_QKV), ssq_buf(F, 4 * pr + 0), ap->in[lb + 2], ap->in[lb + 3], P.Q, P.K, P.VT, 16, 8);
    pg8::gemm_phase(F.lds, F.tab, P);
}
__device__ __forceinline__ void site_na_attn(int pr, bool dummy) {
    KArgs ap = kargs(); Frame F; make_frame(F, ap);
    const int lb = pr ? I_L2 : I_L0; unsigned char* R = F.ws + WS_R;
    LAS float* tbl = (LAS float*)(F.lds + NA_TBL_OFF); const float* rpb = ap->in[lb + 4];
    for (int i = F.tid; i < 16 * NA_TBL_HEAD; i += 512) { const int c = (i & 63) - 16, hd = i >> 6; tbl[i] = (c >= 0 && c < 31) ? rpb[hd * 31 + c] * LOG2E - SM_SHIFT : 0.f; }
    __syncthreads();
    AttnCtx X; X.Q = (const bf16_t*)(R + R_Q); X.K = (const bf16_t*)(R + R_K); X.VT = (const bf16_t*)(R + R_VT_NA); X.O = dummy ? (bf16_t*)(R + 3 * HB_BYTES) : (bf16_t*)(R + R_Q); X.omask = dummy ? 0x7FFFu : 0xFFFFFFFFu; X.kpitch = 1024; X.tbl = tbl;
    { int lane_l = F.lane; asm volatile("" : "+v"(lane_l));
      for (int u = F.bx * 8 + F.wave; u < 16; u += F.G * 8) metaq_unit<0>(X, tbl, tbl, 0, u, lane_l); }
    for (int pair = F.bx; pair < 512; pair += F.G) na_ring_item(F, X, pair);
    __syncthreads();
}
__device__ __forceinline__ void site_wo(int pr, int swa) {
    KArgs ap = kargs(); Frame F; make_frame(F, ap);
    const unsigned char* wb = F.ws + WS_W + (size_t)pr * WPAIR; unsigned char* R = F.ws + WS_R;
    ResPolicy<> P; P.nt = 16; P.pitchA = 2048; P.pitchB = 2048; P.G = F.G; P.c = F.bx; P.A = (const char*)(R + R_Q); P.W = (const char*)(wb + (swa ? WSW_O : WNA_O));
    const bool dummy = ap->dummy != 0;
    P.hb = F.hb; P.ssq_out = ssq_buf(F, dummy ? 8 : 4 * pr + (swa ? 3 : 1)); P.dmy = dummy ? (bf16_t*)(F.ws + WS_END) : nullptr;
    P.hb8 = ((swa || pr >= DENSE8_FROM) && !dummy) ? F.ws + WS_HB8 : nullptr;
    if (!dummy) thin_res(F, (const bf16_t*)(R + R_Q) + (size_t)NREG * 1024, 1024, 1024, (const bf16_t*)P.W, P.ssq_out, P.hb8);
    pg8::gemm_phase(F.lds, F.tab, P);
}
__device__ __forceinline__ void site_dense_gu(int pr) {
    KArgs ap = kargs(); Frame F; make_frame(F, ap);
    const unsigned char* wb = F.ws + WS_W + (size_t)pr * WPAIR; unsigned char* R = F.ws + WS_R;
    if (pr >= DENSE8_FROM) {
        GuPolicy<false, true> P; P.nt = 8; P.pitchA = 1024; P.pitchB = 1024; P.G = F.G; P.c = F.bx; P.hb = (const char*)(F.ws + WS_HB8); P.W = (const char*)(wb + WNA_GU); P.ssq = ssq_buf(F, 4 * pr + 1); P.hid = (bf16_t*)R;
        P.rowtok = nullptr; P.p0 = 0; P.p1 = 0; P.ptab = nullptr;
        thin_gu8(F, wb + WNA_GU, ssq_buf(F, 4 * pr + 1), (bf16_t*)R);
        pg8::gemm_phase(F.lds, F.tab, P);
    } else {
    GuPolicy<false> P; P.nt = 16; P.pitchA = 2048; P.pitchB = 2048; P.G = F.G; P.c = F.bx; P.hb = (const char*)F.hb; P.W = (const char*)(wb + WNA_GU); P.ssq = ssq_buf(F, 4 * pr + 1); P.hid = (bf16_t*)R;
    P.rowtok = nullptr; P.p0 = 0; P.p1 = 0; P.ptab = nullptr;
    thin_gu(F, (const bf16_t*)(wb + WNA_GU), ssq_buf(F, 4 * pr + 1), (bf16_t*)R);
    pg8::gemm_phase(F.lds, F.tab, P);
    }
}
__device__ __forceinline__ void site_dense_down(int pr) {
    KArgs ap = kargs(); Frame F; make_frame(F, ap);
    const unsigned char* wb = F.ws + WS_W + (size_t)pr * WPAIR; unsigned char* R = F.ws + WS_R;
    const bool dummy = ap->dummy != 0;
    if (pr >= DENSE8_FROM) {
        ResPolicy<true> P; P.nt = 28; P.pitchA = 3584; P.pitchB = 3584; P.G = F.G; P.c = F.bx; P.A = (const char*)R; P.W = (const char*)(wb + WNA_D);
        P.hb = F.hb; P.ssq_out = ssq_buf(F, dummy ? 8 : 4 * pr + 2); P.dmy = dummy ? (bf16_t*)(F.ws + WS_END) : nullptr;
        P.hb8 = nullptr;
        if (!dummy) thin_res8(F, (const unsigned char*)R + (size_t)NREG * FF, (const unsigned char*)P.W, P.ssq_out);
        pg8::gemm_phase(F.lds, F.tab, P);
    } else {
    ResPolicy<> P; P.nt = 56; P.pitchA = 7168; P.pitchB = 7168; P.G = F.G; P.c = F.bx; P.A = (const char*)R; P.W = (const char*)(wb + WNA_D);
    P.hb = F.hb; P.ssq_out = ssq_buf(F, dummy ? 8 : 4 * pr + 2); P.dmy = dummy ? (bf16_t*)(F.ws + WS_END) : nullptr;
    P.hb8 = nullptr;
    if (!dummy) thin_res(F, (const bf16_t*)R + (size_t)NREG * FF, FF, FF, (const bf16_t*)P.W, P.ssq_out, nullptr);
    pg8::gemm_phase(F.lds, F.tab, P);
    }
}
__device__ __forceinline__ void site_swa_qkv(int pr) {
    KArgs ap = kargs(); Frame F; make_frame(F, ap);
    const int lb = pr ? I_L3 : I_L1; const unsigned char* wb = F.ws + WS_W + (size_t)pr * WPAIR; unsigned char* R = F.ws + WS_R;
    LAS float* gainsL = (LAS float*)(F.lds + GAIN_OFF);
    if (F.tid < 64) { gainsL[F.tid] = ap->in[lb + 2][F.tid] * (0.125f * LOG2E); gainsL[64 + F.tid] = ap->in[lb + 3][F.tid]; }
    __syncthreads();
    QkvPolicy P; P.nt = 16; P.pitchA = 2048; P.pitchB = 2048; P.G = F.G; P.c = F.bx; P.nN = 6; P.QT = 5; P.hb = (const char*)F.hb; P.W = (const char*)(wb + WSW_QKV);
    P.ssq = ssq_buf(F, 4 * pr + 2); P.Q = (bf16_t*)(R + R_Q); P.K = (bf16_t*)(R + R_K); P.VT = (bf16_t*)(R + R_VT_SWA); P.kpitch = 256; P.nQ = 4; P.gains = gainsL;
    thin_qkv(F, (const bf16_t*)(wb + WSW_QKV), ssq_buf(F, 4 * pr + 2), ap->in[lb + 2], ap->in[lb + 3], P.Q, P.K, P.VT, 4, 5);
    pg8::gemm_phase(F.lds, F.tab, P);
}
__device__ __forceinline__ void site_swa_attn(int pr, bool dummy) {
    KArgs ap = kargs(); Frame F; make_frame(F, ap);
    const int lb = pr ? I_L3 : I_L1; unsigned char* R = F.ws + WS_R;
    const float* t5 = ap->in[I_T5]; const float* sink = ap->in[lb + 4];
    AttnCtx X; X.Q = (const bf16_t*)(R + R_Q); X.K = (const bf16_t*)(R + R_K); X.VT = (const bf16_t*)(R + R_VT_SWA); X.O = dummy ? (bf16_t*)(R + 3 * HB_BYTES) : (bf16_t*)(R + R_Q); X.omask = dummy ? 0x7FFFu : 0xFFFFFFFFu; X.kpitch = 256;
    {
        LAS float* xt = (LAS float*)(F.lds + ATT_X_OFF);
        xt[SX_T5 / 4 + F.tid] = t5[F.tid] * LOG2E - SM_SHIFT;
        if (F.tid < 16) xt[SX_SINK / 4 + F.tid] = sink[F.tid] * LOG2E - SM_SHIFT;
        __syncthreads();
        X.tbl = (const LAS float*)(F.lds + ATT_X_OFF) - SWA_T5_OFF;
        { int lane_l = F.lane; asm volatile("" : "+v"(lane_l));
          for (int u = F.bx * 8 + F.wave; u < 16; u += F.G * 8) attn_unit<1>(X, 0, u, 0, 0, true, lane_l); }
        for (int item = F.bx; item < 256; item += F.G) {
            const int n = (item >> 1) & 3;
            __syncthreads();
            for (int i = F.tid; i < 4 * SWA_TBL_HEAD; i += 512) { const int gg = i / SWA_TBL_HEAD, rel = i % SWA_TBL_HEAD - 288; const int bkt = (rel > 0 ? 16 : 0) + t5_bucket_abs(rel < 0 ? -rel : rel); xt[SX_TBL / 4 + i] = t5[bkt * 16 + n * 4 + gg] * LOG2E - SM_SHIFT; }
            __syncthreads();
            swa_ring_item(F, X, item);
        }
    }
    __syncthreads();
}
__device__ __forceinline__ void site_router(int pr) {
    KArgs ap = kargs(); Frame F; make_frame(F, ap);
    const int lb = pr ? I_L3 : I_L1;
    router_phase(F, ap->in[lb + 7], ap->in[lb + 6], ssq_buf(F, 4 * pr + 3), pr, ap->dummy != 0);
}
__device__ __forceinline__ int moe_tables(Frame& F, int pr) {
    volatile LAS int* pt = (volatile LAS int*)(F.lds + MISC_OFF + 128);
    if (F.tid == 0) { int acc = 0; pt[0] = 0;
        for (int e = 0; e < NE; ++e) { const int c = (int)__hip_atomic_load(F.ctl + CW_CNT + pr * 8 * 64 + e * 64, RLX_AGENT); pt[9 + e] = c; acc += (c + 255) / 256; pt[e + 1] = acc; } }
    __syncthreads();
    return pt[NE];
}
__device__ __forceinline__ void site_moe_gu(int pr, int ch) {
    KArgs ap = kargs(); Frame F; make_frame(F, ap);
    const int PT = moe_tables(F, pr); const int P0 = ch * MOE_CH, P1 = (ch == MOE_NCH - 1 || (P0 + MOE_CH) >= PT) ? PT : (P0 + MOE_CH);
    if (P0 < P1) {
        const unsigned char* wb = F.ws + WS_W + (size_t)pr * WPAIR; unsigned char* R = F.ws + WS_R;
        GuPolicy<true> P; P.nt = 8; P.pitchA = 1024; P.pitchB = 1024; P.G = F.G; P.c = F.bx; P.hb = (const char*)(F.ws + WS_HB8); P.W = (const char*)(wb + WSW_GU); P.ssq = (const void*)(F.ws + WS_TAB + TAB_BYTES); P.hid = (bf16_t*)R;
        P.rowtok = (const unsigned*)(F.ws + WS_TAB); P.p0 = P0; P.p1 = P1; P.ptab = (const LAS int*)(F.lds + MISC_OFF + 128);
        pg8::gemm_phase(F.lds, F.tab, P);
    }
    __syncthreads();
}
__device__ __forceinline__ void site_moe_down(int pr, int ch) {
    KArgs ap = kargs(); Frame F; make_frame(F, ap);
    const int PT = moe_tables(F, pr); const int P0 = ch * MOE_CH, P1 = (ch == MOE_NCH - 1 || (P0 + MOE_CH) >= PT) ? PT : (P0 + MOE_CH);
    if (P0 < P1) {
        const unsigned char* wb = F.ws + WS_W + (size_t)pr * WPAIR; unsigned char* R = F.ws + WS_R;
        MoeDownPolicy P; P.nt = 28; P.pitchA = 3584; P.pitchB = 3584; P.G = F.G; P.c = F.bx; P.hid = (const char*)R; P.W = (const char*)(wb + WSW_D);
        P.rowslot = (const unsigned*)(F.ws + WS_TAB + 2 * TAB_BYTES); P.rowgate = (const float*)(F.ws + WS_TAB + 3 * TAB_BYTES); P.ys = (bf16_t*)(R + R_YS); P.p0 = P0; P.p1 = P1; P.ptab = (const LAS int*)(F.lds + MISC_OFF + 128);
        pg8::gemm_phase(F.lds, F.tab, P);
    }
    __syncthreads();
}
__device__ __forceinline__ void site_combine(int pr) {
    KArgs ap = kargs(); Frame F; make_frame(F, ap);
    const bool dummy = ap->dummy != 0;
    combine_phase(F, (const bf16_t*)(F.ws + WS_R + R_YS), ssq_buf(F, dummy ? 3 : (pr ? 0 : 4)), pr == 1, dummy);
}

__global__ void __launch_bounds__(512, 2) fwd_kernel(Args args) {
    extern __shared__ __attribute__((aligned(16))) unsigned char lds_raw[];
    {
        volatile LAS unsigned* MISC = (volatile LAS unsigned*)((LAS unsigned char*)lds_raw + MISC_OFF);
        if (threadIdx.x < 64) MISC[threadIdx.x] = 0u;
        __syncthreads();
    }
    const int lo = args.ph_lo, hi = args.ph_hi;
    if (hi - lo > 1) { KArgs ap = kargs(); (void)xcd_barrier_post((unsigned*)(ap->ws + WS_CTL) + CW_BAR, (volatile LAS unsigned*)((LAS unsigned char*)lds_raw + MISC_OFF) + 8); }
#define IN(k) (lo <= (k) && (k) < hi)
#if PROBE_A || PROBE_B
#define STAMP(k) do { if (blockIdx.x == 0 && threadIdx.x == 0) { KArgs ap_ = kargs(); ((u64*)(ap_->ws + WS_CTL + 49152))[(k)] = __builtin_amdgcn_s_memrealtime(); } } while (0)
#else
#define STAMP(k) do { } while (0)
#endif
#define SEAM(k) do { if (IN(k) && IN((k) + 1)) grid_seam(); STAMP((k) + 1); } while (0)
    STAMP(0);
    if ((REP_MASK & 1) && IN(0)) { KArgs ap = kargs(); Frame F; make_frame(F, ap); prologue(F, ap); grid_seam(); }
    if (SITE(0) && IN(0)) { KArgs ap = kargs(); Frame F; make_frame(F, ap); prologue(F, ap); }
    SEAM(0);
    for (int pr = 0; pr < 2; ++pr) {
        const int pb = 1 + pr * PH_PER_PAIR;
        if (((REP_MASK >> 1) & 1) && IN(pb + 0)) { site_na_qkv(pr); grid_seam(); }
        if (SITE(1) && IN(pb + 0)) site_na_qkv(pr);
        SEAM(pb + 0);
        if (((REP_MASK >> 2) & 1) && IN(pb + 1)) { site_na_attn(pr, true); grid_seam(); }
        if (SITE(2) && IN(pb + 1)) site_na_attn(pr, kargs()->dummy != 0);
        SEAM(pb + 1);
        if (SITE(3) && IN(pb + 2)) site_wo(pr, 0);
        SEAM(pb + 2);
        if (((REP_MASK >> 4) & 1) && IN(pb + 3)) { site_dense_gu(pr); grid_seam(); }
        if (SITE(4) && IN(pb + 3)) site_dense_gu(pr);
        SEAM(pb + 3);
        if (SITE(5) && IN(pb + 4)) site_dense_down(pr);
        SEAM(pb + 4);
        if (SITE(6) && IN(pb + 5)) site_swa_qkv(pr);
        SEAM(pb + 5);
        if (((REP_MASK >> 7) & 1) && IN(pb + 6)) { site_swa_attn(pr, true); grid_seam(); }
        if (SITE(7) && IN(pb + 6)) site_swa_attn(pr, kargs()->dummy != 0);
        SEAM(pb + 6);
        if (SITE(8) && IN(pb + 7)) site_wo(pr, 1);
        SEAM(pb + 7);
        if (SITE(9) && IN(pb + 8)) site_router(pr);
        SEAM(pb + 8);
        for (int ch = 0; ch < MOE_NCH; ++ch) {
            if (SITE(10) && IN(pb + 9 + 2 * ch)) site_moe_gu(pr, ch);
            SEAM(pb + 9 + 2 * ch);
            if (SITE(11) && IN(pb + 10 + 2 * ch)) site_moe_down(pr, ch);
            SEAM(pb + 10 + 2 * ch);
        }
        if (SITE(12) && IN(pb + 9 + 2 * MOE_NCH)) site_combine(pr);
        SEAM(pb + 9 + 2 * MOE_NCH);
    }
#if PROBE_A || PROBE_B
    {
        grid_seam();
        KArgs ap = kargs(); const u64* ts = (const u64*)(ap->ws + WS_CTL + 49152);
        u64 ta = 0, tb = 0;
        for (int k = 0; k < N_PHASES; ++k) { const u64 d = __hip_atomic_load(ts + k + 1, RLX_AGENT) - __hip_atomic_load(ts + k, RLX_AGENT); if ((PROBE_A >> k) & 1ull) ta += d; if ((PROBE_B >> k) & 1ull) tb += d; }
        const float sc = 1.0f + (float)ta * 1e-5f;
        float* o = ap->out;
        for (size_t i = (size_t)blockIdx.x * 512 + threadIdx.x; i < (size_t)NREG * D; i += (size_t)gridDim.x * 512) o[i] *= sc;
        if (PROBE_B) { grid_seam(); if (blockIdx.x == 0 && threadIdx.x == 0) o[0] = (float)tb * 0.01f; }
    }
#endif
#undef IN
#undef SEAM
}

extern "C" void kernel_launch(void* const* d_in, const int* in_sizes, int n_in, void* d_out, int out_size, void* d_ws, size_t ws_size, hipStream_t stream) {
    static int grid = 0;
    if (grid == 0) {
        if (n_in != 45 || out_size != NREG * D || ws_size < WS_END) { fprintf(stderr, "kernel_launch: unexpected shapes (n_in %d out %d ws %zu need %zu)\n", n_in, out_size, ws_size, (size_t)WS_END); grid = -1; return; }
        int dev = 0, cus = 0, per_cu = 0;
        if (hipGetDevice(&dev) != hipSuccess || hipDeviceGetAttribute(&cus, hipDeviceAttributeMultiprocessorCount, dev) != hipSuccess) { grid = -1; return; }
        if (hipFuncSetAttribute((const void*)fwd_kernel, hipFuncAttributeMaxDynamicSharedMemorySize, LDS_BYTES) != hipSuccess) { fprintf(stderr, "kernel_launch: hipFuncSetAttribute failed\n"); grid = -1; return; }
        if (hipOccupancyMaxActiveBlocksPerMultiprocessor(&per_cu, (const void*)fwd_kernel, 512, LDS_BYTES) != hipSuccess || per_cu < 1) fprintf(stderr, "kernel_launch: occupancy query says %d\n", per_cu);
        (void)hipGetLastError();
        grid = cus;
    }
    if (grid < 0) return;
    (void)hipMemsetAsync((char*)d_ws + WS_CTL, 0, CTL_BYTES, stream);
    Args a{};
    for (int i = 0; i < 45; ++i) a.in[i] = (const float*)d_in[i];
    a.out = (float*)d_out; a.ws = (unsigned char*)d_ws;
#if MK_MULTI
    for (int p = 0; p < N_PHASES && p <= MK_STOP; ++p) { a.ph_lo = p; a.ph_hi = p + 1;
        if (p == DUP_PHASE) { a.dummy = 1; hipLaunchKernelGGL(fwd_kernel, dim3(grid), dim3(512), LDS_BYTES, stream, a); a.dummy = 0; }
        hipLaunchKernelGGL(fwd_kernel, dim3(grid), dim3(512), LDS_BYTES, stream, a); }
#else
    a.ph_lo = 0; a.ph_hi = N_PHASES;
    hipLaunchKernelGGL(fwd_kernel, dim3(grid), dim3(512), LDS_BYTES, stream, a);
#endif
}
```

```cpp
#include <hip/hip_runtime.h>
#include <cstdio>
#include <cstdint>

#ifndef MK_MULTI
#define MK_MULTI 0
#endif

#ifndef PROBE_A
#define PROBE_A 0ull
#define PROBE_B 0ull
#endif
#ifndef DENSE8_FROM
#define DENSE8_FROM 1
#endif
#ifndef REP_MASK
#define REP_MASK 0
#endif
#ifndef DUP_PHASE
#define DUP_PHASE -1
#endif
#ifndef MK_STOP
#define MK_STOP 1000
#endif
#define LAS __attribute__((address_space(3)))
#define GAS __attribute__((address_space(1)))
typedef unsigned short bf16_t;
typedef short bf16x8 __attribute__((ext_vector_type(8)));
typedef short s16x4 __attribute__((ext_vector_type(4)));
typedef float f32x4 __attribute__((ext_vector_type(4)));
typedef float f32x2 __attribute__((ext_vector_type(2)));
typedef unsigned u32x4 __attribute__((ext_vector_type(4)));
typedef unsigned u32x2 __attribute__((ext_vector_type(2)));
#define RLX_AGENT __ATOMIC_RELAXED, __HIP_MEMORY_SCOPE_AGENT

constexpr int D = 1024, NREG = 65536, NMETA_ROWS = 16, M = NREG + NMETA_ROWS, NPANEL = NREG / 256;
constexpr int SEQ = 2048, BATCH = 32, FF = 3584, NE = 8;
constexpr float EPS = 1e-6f;
constexpr float LOG2E = 1.4426950408889634f;
constexpr float NEGBIG = -1e30f;
constexpr float SM_SHIFT = 16.0f;

constexpr size_t WS_CTL = 0, CTL_BYTES = 8u << 20;
constexpr int CW_TMO = 0, CW_BAR = 4096, CW_CNT = 8192;
constexpr size_t CTL_SSQ = 65536;
constexpr size_t SSQ_BYTES = (size_t)M * 8;
constexpr float SSQ_SCALE = 16777216.0f, SSQ_INV = 1.0f / 16777216.0f;
typedef unsigned long long u64;
static_assert(CTL_SSQ + 9 * SSQ_BYTES <= CTL_BYTES, "ctl");
constexpr size_t W_QKV_NA = (size_t)3072 * 1024 * 2, W_O = (size_t)1024 * 1024 * 2, W_GU = (size_t)7168 * 1024 * 2, W_D = (size_t)1024 * 3584 * 2, W_QKV_SWA = (size_t)1536 * 1024 * 2;
constexpr size_t WNA_QKV = 0, WNA_O = WNA_QKV + W_QKV_NA, WNA_GU = WNA_O + W_O, WNA_D = WNA_GU + W_GU, WNA_END = WNA_D + W_D;
constexpr size_t W_GU8 = (size_t)7168 * 1024;
constexpr size_t W_D8 = (size_t)1024 * 3584;
constexpr float W8_SCALE = 64.0f, W8_INV = 1.0f / 64.0f;
constexpr float HID8_SCALE = 4.0f, HID8_INV = 0.25f;
constexpr size_t WSW_QKV = WNA_END, WSW_O = WSW_QKV + W_QKV_SWA, WSW_GU = WSW_O + W_O, WSW_D = WSW_GU + NE * W_GU8, WPAIR = WSW_D + NE * W_D8;
constexpr size_t WS_W = CTL_BYTES;
constexpr size_t WS_HB = WS_W + 2 * WPAIR;
constexpr size_t HB_BYTES = (size_t)M * D * 2;
constexpr size_t WS_HB8 = WS_HB + HB_BYTES;
constexpr size_t WS_TAB = WS_HB8 + (size_t)M * D;
constexpr size_t TAB_BYTES = (size_t)NE * M * 4;
constexpr size_t WS_R = WS_TAB + 4 * TAB_BYTES;
constexpr size_t R_Q = 0, R_K = HB_BYTES, R_VT_NA = 2 * HB_BYTES, R_VT_SWA = HB_BYTES + (size_t)M * 256 * 2;
constexpr int MOE_CH = 256, MOE_NCH = 2, MOE_CH_MAX = 264;
constexpr size_t R_YS = (size_t)MOE_CH_MAX * 256 * FF;
constexpr size_t R_DENSE = (size_t)M * FF * 2, R_MOE = R_YS + (size_t)2 * M * D * 2;
constexpr size_t R_BYTES = R_DENSE > R_MOE ? R_DENSE : R_MOE;
static_assert(3 * HB_BYTES <= R_BYTES, "R");
constexpr size_t WS_END = WS_R + R_BYTES;
static_assert(WS_END + (24u << 20) <= 1115912448ull, "d_ws budget (incl. the 24 MiB scratch window of timing experiments)");

constexpr int TAB_OFF = 131072;
constexpr int GAIN_OFF = TAB_OFF + 10240;
constexpr int MISC_OFF = 163840 - 512;
constexpr int ATT_X_OFF = 147456;
constexpr int LDS_BYTES = 163840;
static_assert(MISC_OFF + 256 <= LDS_BYTES, "lds");

__device__ __forceinline__ unsigned cvt_pk_bf16(float lo, float hi) { unsigned r; asm volatile("v_cvt_pk_bf16_f32 %0, %1, %2" : "=v"(r) : "v"(lo), "v"(hi)); return r; }
__device__ __forceinline__ float wave_sum(float v) {
#pragma unroll
    for (int o = 1; o < 64; o <<= 1) v += __shfl_xor(v, o);
    return v;
}
__device__ __forceinline__ float fast_rsqrt(float x) { return __builtin_amdgcn_rsqf(x); }
__device__ __forceinline__ float fast_exp2(float x) { return __builtin_amdgcn_exp2f(x); }
__device__ __forceinline__ float fast_rcp(float x) { return __builtin_amdgcn_rcpf(x); }
__device__ __forceinline__ float silu_f(float x) { return x * fast_rcp(1.0f + fast_exp2(-x * LOG2E)); }

#define XB_TMO      128
#define XB_XCNT(j)  (256  + 64 * (j))
#define XB_XSUB(j)  (1280 + 64 * (j))
#define XB_XGEN(j)  (2304 + 64 * (j))
#define XB_TOP      3328
#define XB_TOPGEN   3392
#define XCD_BAR_WORDS 3456
#define XB_SPIN_CAP (1u << 18)
template <class T> __device__ __forceinline__ unsigned xb_ld(T* p)              { return __hip_atomic_load(p, __ATOMIC_RELAXED, __HIP_MEMORY_SCOPE_AGENT); }
template <class T> __device__ __forceinline__ unsigned xb_add(T* p, unsigned v) { return __hip_atomic_fetch_add(p, v, __ATOMIC_RELAXED, __HIP_MEMORY_SCOPE_AGENT); }
__device__ __forceinline__ unsigned xb_xcc_id() { return (unsigned)__builtin_amdgcn_s_getreg((3 << 11) | 20) & 0xFu; }
#define XB_SPIN(cond, bar) do { unsigned _sp = 0; while (cond) { __builtin_amdgcn_s_sleep(1); \
    if ((++_sp & 255u) == 0u) { if (xb_ld(&(bar)[XB_TMO])) break; if (_sp > XB_SPIN_CAP) { xb_add(&(bar)[XB_TMO], 1u); break; } } } } while (0)
struct XcdBarrier { unsigned* bar; unsigned x; volatile LAS unsigned* st; };
__device__ __forceinline__ XcdBarrier xcd_barrier_post(unsigned* bar, volatile LAS unsigned* st) {
    XcdBarrier b; b.bar = bar; b.x = xb_xcc_id(); b.st = st;
    if (threadIdx.x == 0) (void)xb_add(&bar[XB_XCNT(b.x)], 1u);
    return b;
}
__device__ __forceinline__ void xcd_barrier_complete(GAS unsigned* bar, unsigned x, unsigned& nloc, unsigned& nx) {
    const unsigned G = gridDim.x * gridDim.y * gridDim.z;
    unsigned sum, cnt, mine, sp = 0u;
    for (;;) {
        sum = 0u; cnt = 0u; mine = 0u;
#pragma unroll
        for (unsigned j = 0; j < 16; ++j) { const unsigned c = xb_ld(&bar[XB_XCNT(j)]); sum += c; cnt += (c > 0u) ? 1u : 0u; mine = (j == x) ? c : mine; }
        if (sum == G) break;
        __builtin_amdgcn_s_sleep(1);
        if ((++sp & 255u) == 0u) { if (xb_ld(&bar[XB_TMO])) break; if (sp > XB_SPIN_CAP) { xb_add(&bar[XB_TMO], 1u); break; } }
    }
    nloc = mine > 0u ? mine : 1u; nx = cnt > 0u ? cnt : 1u;
}
__device__ __noinline__ void xcd_barrier_leader(GAS unsigned* bar, unsigned x, volatile LAS unsigned* st) {
    __builtin_amdgcn_s_waitcnt(0);
    unsigned nloc = st[0], nx = st[1];
    if (nloc == 0u) { xcd_barrier_complete(bar, x, nloc, nx); st[0] = nloc; st[1] = nx; }
    const unsigned old = xb_add(&bar[XB_XSUB(x)], 1u);
    const unsigned gen = old / nloc;
    if (old + 1u == (gen + 1u) * nloc) {
        __builtin_amdgcn_fence(__ATOMIC_RELEASE, "agent");
        asm volatile("s_waitcnt vmcnt(0)" ::: "memory");
        const unsigned og = xb_add(&bar[XB_TOP], 1u);
        const unsigned tg = og / nx;
        if (og + 1u == (tg + 1u) * nx) xb_add(&bar[XB_TOPGEN], 1u);
        else XB_SPIN(xb_ld(&bar[XB_TOPGEN]) == tg, bar);
        __builtin_amdgcn_fence(__ATOMIC_ACQUIRE, "agent");
        xb_add(&bar[XB_XGEN(x)], 1u);
        asm volatile("s_waitcnt vmcnt(0)" ::: "memory");
    } else {
        XB_SPIN(xb_ld(&bar[XB_XGEN(x)]) == gen, bar);
        __builtin_amdgcn_fence(__ATOMIC_ACQUIRE, "agent");
        asm volatile("s_waitcnt vmcnt(0)" ::: "memory");
    }
}
__device__ __forceinline__ void xcd_barrier(const XcdBarrier& b) {
    asm volatile("s_waitcnt vmcnt(0)" ::: "memory");
    __syncthreads();
    if (threadIdx.x == 0) xcd_barrier_leader((GAS unsigned*)b.bar, b.x, b.st);
    __syncthreads();
}

namespace pg8 {
constexpr int BM = 256, BK = 64, HALF = 128, HTB = HALF * BK * 2, NXCD = 8, WGM = 8;
__host__ __device__ __forceinline__ int lds_byte(int r, int c) { const int st = (r >> 4) * 2 + (c >> 5), rr = r & 15, cc = c & 31, ob = rr * 64 + cc * 2; return st * 1024 + (ob ^ (((ob >> 9) & 1) << 5)); }
__host__ __device__ __forceinline__ void stage_rc(int b, int& R, int& C) { const int st = b / 1024, sb = b % 1024, swz = sb ^ (((sb >> 9) & 1) << 5); R = (st >> 1) * 16 + swz / 64; C = (st & 1) * 32 + (swz % 64) / 2; }
struct Unit { const char* A; const char* B; int pm, pn, kind, aux, aux2; };
__device__ __forceinline__ void tile_of(int L, int nM, int nN, int& pm, int& pn) {
    const int nwg = nM * nN; int wgid = L; { const int q = nwg / NXCD, r = nwg % NXCD, xcd = wgid % NXCD, off = wgid / NXCD; wgid = (xcd < r ? xcd * (q + 1) : r * (q + 1) + (xcd - r) * q) + off; }
    const int nig = WGM * nN, gid = wgid / nig, fm = gid * WGM, gsz = (nM - fm) < WGM ? (nM - fm) : WGM;
    pm = fm + ((wgid % nig) % gsz); pn = (wgid % nig) / gsz;
}
__device__ __forceinline__ void dma4(const void* g, LAS void* l) { __builtin_amdgcn_global_load_lds((const unsigned*)g, (LAS unsigned*)l, 4, 0, 0); }
typedef int v8i __attribute__((ext_vector_type(8)));
typedef unsigned long long u64x2_t __attribute__((ext_vector_type(2)));
typedef int v4i __attribute__((ext_vector_type(4)));
__device__ __forceinline__ v8i cat8(bf16x8 lo, bf16x8 hi) { const v4i a = __builtin_bit_cast(v4i, lo), b = __builtin_bit_cast(v4i, hi); return __builtin_shufflevector(a, b, 0, 1, 2, 3, 4, 5, 6, 7); }

template <class P>
__device__ __forceinline__ void gemm_phase(LAS unsigned char* lds, LAS unsigned char* tab, const P& S) {
    int tid_l = threadIdx.x; asm volatile("" : "+v"(tid_l));
    const int tid = tid_l, wid = __builtin_amdgcn_readfirstlane(tid >> 6), lane = tid & 63, wr = wid >> 2, wc = wid & 3, fr = lane & 15, fq = lane >> 4;
    const int nt = S.nt;
    int Rr[2], Cc[2];
#pragma unroll
    for (int i = 0; i < 2; ++i) stage_rc(tid * 16 + i * 8192, Rr[i], Cc[i]);
    unsigned voffB[2], voffA[2][2];
#pragma unroll
    for (int i = 0; i < 2; ++i) { voffB[i] = (unsigned)Rr[i] * S.pitchB + (unsigned)Cc[i] * 2u;
#pragma unroll
        for (int h = 0; h < 2; ++h) voffA[h][i] = (unsigned)(HALF * h + Rr[i]) * S.pitchA + (unsigned)Cc[i] * 2u; }
    const size_t kstep = (size_t)(BK * 2);
    const size_t hstepB = (size_t)HALF * S.pitchB;
    const unsigned ldsw = (unsigned)wid * 1024u;
    constexpr int FSTEP = 8, KOFF = 1024;
    const int aoff = lds_byte(wr * 64 + fr, fq * FSTEP), boff = lds_byte(wc * 32 + fr, fq * FSTEP);
    LAS unsigned* idtab = (LAS unsigned*)tab;
#define PG8_SA(b, h) (((b) * 2 + (h)) * HTB)
#define PG8_SB(b, h) ((4 + (b) * 2 + (h)) * HTB)
#define PG8_STAGE(bufoff, gbase, voff) do { _Pragma("unroll") for (int _i = 0; _i < 2; ++_i) { unsigned _vo = (voff)[_i]; asm volatile("" : "+v"(_vo)); \
        __builtin_amdgcn_global_load_lds((const unsigned*)((const char*)(gbase) + _vo), (LAS unsigned*)(lds + (bufoff) + ldsw + _i * 8192), 16, 0, 0); } } while (0)
#define PG8_LDA(dst, b, h) do { _Pragma("unroll") for (int m = 0; m < 4; ++m) _Pragma("unroll") for (int k = 0; k < 2; ++k) dst[m][k] = *(const LAS bf16x8*)(lds + PG8_SA(b, h) + aoff + m * 2048 + k * KOFF); } while (0)
#define PG8_LDB(dst, b, h) do { _Pragma("unroll") for (int n = 0; n < 2; ++n) _Pragma("unroll") for (int k = 0; k < 2; ++k) dst[n][k] = *(const LAS bf16x8*)(lds + PG8_SB(b, h) + boff + n * 2048 + k * KOFF); } while (0)
#define PG8_MMA(ai, bj, At, Bt) do { __builtin_amdgcn_s_setprio(1); _Pragma("unroll") for (int m = 0; m < 4; ++m) _Pragma("unroll") for (int n = 0; n < 2; ++n) { \
        if constexpr (P::FP8) acc[ai][bj][m][n] = __builtin_amdgcn_mfma_scale_f32_16x16x128_f8f6f4(pg8::cat8(Bt[n][0], Bt[n][1]), pg8::cat8(At[m][0], At[m][1]), acc[ai][bj][m][n], 0, 0, 0, 0, 0, 0); \
        else { _Pragma("unroll") for (int k = 0; k < 2; ++k) acc[ai][bj][m][n] = __builtin_amdgcn_mfma_f32_16x16x32_bf16(Bt[n][k], At[m][k], acc[ai][bj][m][n], 0, 0, 0); } } \
        __builtin_amdgcn_s_setprio(0); } while (0)
#define PG8_WAIT_V(n) asm volatile("s_waitcnt vmcnt(" #n ")" ::: "memory")
#define PG8_WAIT_L(n) asm volatile("s_waitcnt lgkmcnt(" #n ")" ::: "memory")
#define PG8_BAR __builtin_amdgcn_s_barrier()
#define PG8_SCHED __builtin_amdgcn_sched_barrier(0)
    LAS unsigned* ulist = (LAS unsigned*)(tab + 12288);
    if (tid < 32) { Unit t_; t_.A = nullptr; t_.B = nullptr; t_.pm = t_.pn = t_.kind = t_.aux = t_.aux2 = 0; const bool ok_ = S.next(tid, t_);
        LAS unsigned* e_ = ulist + tid * 12; const u64 a_ = (u64)(size_t)t_.A, b_ = (u64)(size_t)t_.B;
        e_[0] = ok_ ? 1u : 0u; e_[1] = (unsigned)t_.pm; e_[2] = (unsigned)t_.pn; e_[3] = (unsigned)t_.kind; e_[4] = (unsigned)t_.aux; e_[5] = (unsigned)t_.aux2;
        e_[6] = (unsigned)a_; e_[7] = (unsigned)(a_ >> 32); e_[8] = (unsigned)b_; e_[9] = (unsigned)(b_ >> 32); }
    asm volatile("s_waitcnt lgkmcnt(0)" ::: "memory"); __builtin_amdgcn_s_barrier(); asm volatile("" ::: "memory");
#define PG8_FETCH(i_, u_, ok_) do { const LAS u32x4* e4_ = (const LAS u32x4*)(ulist + (i_) * 12); const u32x4 x0_ = e4_[0], x1_ = e4_[1], x2_ = e4_[2]; \
        (ok_) = __builtin_amdgcn_readfirstlane(x0_.x) != 0; (u_).pm = __builtin_amdgcn_readfirstlane(x0_.y); (u_).pn = __builtin_amdgcn_readfirstlane(x0_.z); (u_).kind = __builtin_amdgcn_readfirstlane(x0_.w); \
        (u_).aux = __builtin_amdgcn_readfirstlane(x1_.x); (u_).aux2 = __builtin_amdgcn_readfirstlane(x1_.y); \
        (u_).A = (const char*)(size_t)(((u64)(unsigned)__builtin_amdgcn_readfirstlane(x1_.w) << 32) | (unsigned)__builtin_amdgcn_readfirstlane(x1_.z)); \
        (u_).B = (const char*)(size_t)(((u64)(unsigned)__builtin_amdgcn_readfirstlane(x2_.y) << 32) | (unsigned)__builtin_amdgcn_readfirstlane(x2_.x)); } while (0)
    Unit cur, nxt; int ui = 0;
    { bool ok0; PG8_FETCH(0, cur, ok0); if (!ok0) return; }
    f32x4 acc[2][2][4][2];
#pragma unroll
    for (int a = 0; a < 2; ++a)
#pragma unroll
        for (int b = 0; b < 2; ++b)
#pragma unroll
            for (int m = 0; m < 4; ++m)
#pragma unroll
                for (int n = 0; n < 2; ++n) acc[a][b][m][n] = (f32x4){0.f, 0.f, 0.f, 0.f};
    bf16x8 At[4][2], B0[2][2], B1[2][2];
    const char* cA = cur.A; const char* cB = cur.B;
    if constexpr (P::GATHER) {
        if (wid < 4) dma4(S.id_src(cur, wid * 64 + lane), idtab + wid * 64);
        PG8_WAIT_V(0); PG8_BAR; asm volatile("" ::: "memory");
#pragma unroll
        for (int h = 0; h < 2; ++h)
#pragma unroll
            for (int i = 0; i < 2; ++i) voffA[h][i] = idtab[HALF * h + Rr[i]] * S.pitchA + (unsigned)Cc[i] * 2u;
        PG8_WAIT_L(0); asm volatile("" ::: "memory");
    }
    PG8_STAGE(PG8_SB(0, 0), cB, voffB); PG8_STAGE(PG8_SB(0, 1), cB + hstepB, voffB); PG8_STAGE(PG8_SA(0, 0), cA, voffA[0]); PG8_STAGE(PG8_SA(0, 1), cA, voffA[1]);
    if (wr == 1) PG8_BAR;
    PG8_WAIT_V(2); PG8_BAR;
    PG8_STAGE(PG8_SB(1, 0), cB + kstep, voffB); PG8_STAGE(PG8_SA(1, 0), cA + kstep, voffA[0]); PG8_STAGE(PG8_SB(1, 1), cB + hstepB + kstep, voffB);
    PG8_WAIT_V(6); PG8_BAR;
    for (;;) {
        bool has_next; PG8_FETCH(ui + 1, nxt, has_next);
        const int slot = ui & 1;
        S.dma_tables(cur, tab, slot, wid, lane);
        if constexpr (P::GATHER) { if (has_next && wid < 4) dma4(S.id_src(nxt, wid * 64 + lane), idtab + (slot ^ 1) * 256 + wid * 64); }
        const char* nA = has_next ? nxt.A : cA; const char* nB = has_next ? nxt.B : cB;
        for (int t = 0; t < nt; t += 2) {
            const bool last = (t == nt - 2);
            const char* a1 = cA + (size_t)(t + 1) * kstep;
            const char* a2 = last ? nA : cA + (size_t)(t + 2) * kstep; const char* b2 = last ? nB : cB + (size_t)(t + 2) * kstep;
            const char* a3 = a2 + kstep; const char* b3 = b2 + kstep;
            PG8_LDB(B0, 0, 0); PG8_LDB(B1, 0, 1); PG8_SCHED; PG8_LDA(At, 0, 0); PG8_STAGE(PG8_SA(1, 1), a1, voffA[1]);
            if constexpr (!P::GATHER && P::FP8) { if (last && has_next) asm volatile("s_nop 0"); }
            if constexpr (P::GATHER) {
                if (last && has_next) {
                    int t2 = tid; asm volatile("" : "+v"(t2));
#pragma unroll
                    for (int i = 0; i < 2; ++i) { int R2, C2; stage_rc(t2 * 16 + i * 8192, R2, C2);
#pragma unroll
                        for (int h = 0; h < 2; ++h) voffA[h][i] = idtab[(slot ^ 1) * 256 + HALF * h + R2] * S.pitchA + (unsigned)C2 * 2u; }
                }
            }
            PG8_WAIT_V(8); PG8_WAIT_L(0); PG8_BAR; PG8_MMA(0, 0, At, B0); PG8_MMA(0, 1, At, B1); PG8_BAR; PG8_SCHED;
            PG8_LDA(At, 0, 1); PG8_STAGE(PG8_SB(0, 0), b2, voffB); PG8_STAGE(PG8_SB(0, 1), b2 + hstepB, voffB); PG8_STAGE(PG8_SA(0, 0), a2, voffA[0]);
            PG8_WAIT_V(8); PG8_WAIT_L(0); PG8_BAR; PG8_MMA(1, 0, At, B0); PG8_MMA(1, 1, At, B1); PG8_BAR; PG8_SCHED;
            PG8_LDB(B0, 1, 0); PG8_LDB(B1, 1, 1); PG8_SCHED; PG8_LDA(At, 1, 0); PG8_STAGE(PG8_SA(0, 1), a2, voffA[1]);
            PG8_WAIT_V(8); PG8_WAIT_L(0); PG8_BAR; PG8_MMA(0, 0, At, B0); PG8_MMA(0, 1, At, B1); PG8_BAR; PG8_SCHED;
            PG8_LDA(At, 1, 1); PG8_STAGE(PG8_SB(1, 0), b3, voffB); PG8_STAGE(PG8_SB(1, 1), b3 + hstepB, voffB); PG8_STAGE(PG8_SA(1, 0), a3, voffA[0]);
            PG8_WAIT_V(8); PG8_WAIT_L(0); PG8_BAR; PG8_MMA(1, 0, At, B0); PG8_MMA(1, 1, At, B1); PG8_BAR; PG8_SCHED;
        }
        if constexpr (P::ALIGN) { if (wr == 0) PG8_BAR; }
        S.epi(acc, cur, tab, slot, wr, wc, fr, fq);
        if (!has_next) break;
#pragma unroll
        for (int a = 0; a < 2; ++a)
#pragma unroll
            for (int b = 0; b < 2; ++b)
#pragma unroll
                for (int m = 0; m < 4; ++m)
#pragma unroll
                    for (int n = 0; n < 2; ++n) { u64 z0, z1; asm volatile("v_mov_b64 %0, 0" : "=v"(z0)); asm volatile("v_mov_b64 %0, 0" : "=v"(z1)); const u64x2_t z = {z0, z1}; acc[a][b][m][n] = __builtin_bit_cast(f32x4, z); }
        cur = nxt; cA = nA; cB = nB; ++ui;
        if constexpr (P::ALIGN) { if (wr == 1) PG8_BAR; }
    }
    PG8_WAIT_V(0);
    if constexpr (!P::ALIGN) { if (wr == 0) PG8_BAR; }
    PG8_BAR;
#undef PG8_FETCH
#undef PG8_SA
#undef PG8_SB
#undef PG8_STAGE
#undef PG8_LDA
#undef PG8_LDB
#undef PG8_MMA
#undef PG8_WAIT_V
#undef PG8_WAIT_L
#undef PG8_BAR
#undef PG8_SCHED
}
}
#ifndef ALIGN_LIGHT
#define ALIGN_LIGHT true
#endif
using pg8::Unit;
typedef f32x4 Acc[2][2][4][2];

struct Args { const float* in[45]; float* out; unsigned char* ws; int ph_lo, ph_hi, dummy, pad; };
enum { I_X = 0, I_META = 1, I_T5 = 2, I_L0 = 3, I_L1 = 13, I_L2 = 24, I_L3 = 34 };

struct Frame {
    LAS unsigned char* lds; LAS unsigned char* tab;
    int tid, lane, wave, G, bx;
    unsigned char* ws; float* out; bf16_t* hb; unsigned* ctl;
};
__device__ __forceinline__ u64* ssq_buf(const Frame& F, int i) { return (u64*)(F.ws + WS_CTL + CTL_SSQ + (size_t)i * SSQ_BYTES); }
__device__ __forceinline__ u64 ssq_fix(float s) { return (u64)(s * SSQ_SCALE); }
__device__ __forceinline__ float ssq_val(u64 v) { return (float)v * SSQ_INV; }

struct QkvPolicy {
    static constexpr bool GATHER = false, ALIGN = ALIGN_LIGHT, FP8 = false;
    int nt; unsigned pitchA, pitchB;
    int G, c, nN, QT;
    const char* hb; const char* W;
    const u64* ssq;
    bf16_t* Q; bf16_t* K; bf16_t* VT; int kpitch, nQ;
    const LAS float* gains;
    __device__ __forceinline__ bool next(int i, Unit& u) const {
        const long L = (long)i * G + c; if (L >= (long)NPANEL * nN) return false;
        int pm, pn; pg8::tile_of((int)L, NPANEL, nN, pm, pn);
        u.pm = pm; u.pn = pn; u.kind = pn < QT ? 0 : 1; u.aux = 0; u.aux2 = 0;
        const char* a = hb + (size_t)pm * 256 * 2048; const char* w = W + (size_t)pn * 256 * 2048;
        u.A = u.kind ? w : a; u.B = u.kind ? a : w; return true;
    }
    __device__ __forceinline__ void dma_tables(const Unit& u, LAS unsigned char* tab, int slot, int wid, int lane) const {
        pg8::dma4((const unsigned*)(ssq + u.pm * 256) + wid * 64 + lane, (LAS unsigned*)(tab + 2048) + slot * 512 + wid * 64);
    }
    __device__ __forceinline__ void epi(const Acc& acc, const Unit& u, LAS unsigned char* tab, int slot, int wr, int wc, int fr, int fq) const {
        const LAS u64* et = (const LAS u64*)(tab + 2048) + slot * 256;
        if (u.kind == 0) {
            const bool isq = u.pn < nQ;
            const LAS float* gp = gains + (isq ? 0 : 64) + 8 * fq;
            const f32x4 g00 = *(const LAS f32x4*)(gp), g01 = *(const LAS f32x4*)(gp + 4), g10 = *(const LAS f32x4*)(gp + 32), g11 = *(const LAS f32x4*)(gp + 36);
            const int hk = (u.pn - nQ) * 4 + wc, nhk = kpitch >> 6;
#pragma unroll
            for (int ai = 0; ai < 2; ++ai)
#pragma unroll
                for (int m = 0; m < 4; ++m) {
                    const int row = ai * 128 + wr * 64 + m * 16 + fr;
                    const float rstd = fast_rsqrt(ssq_val(et[row]) * (1.0f / 1024.0f) + EPS);
                    f32x4 v00 = acc[ai][0][m][0] * rstd, v01 = acc[ai][0][m][1] * rstd, v10 = acc[ai][1][m][0] * rstd, v11 = acc[ai][1][m][1] * rstd;
                    const f32x4 sq4 = v00 * v00 + v01 * v01 + v10 * v10 + v11 * v11;
                    float ss = (sq4[0] + sq4[1]) + (sq4[2] + sq4[3]);
                    ss += __shfl_xor(ss, 16); ss += __shfl_xor(ss, 32);
                    const float hn = fast_rsqrt(ss * (1.0f / 64.0f) + EPS);
                    v00 = v00 * g00 * hn; v01 = v01 * g01 * hn; v10 = v10 * g10 * hn; v11 = v11 * g11 * hn;
                    const int tok = u.pm * 256 + row;
                    bf16_t* rp = isq ? Q + (size_t)tok * 1024 + (u.pn * 4 + wc) * 64 + 8 * fq
                                     : K + ((((size_t)(tok >> 3) * nhk + hk) * 2) * 4 + fq) * 64 + (tok & 7) * 8;
                    const int o1 = isq ? 32 : 256;
                    u32x4 w0; w0.x = cvt_pk_bf16(v00[0], v00[1]); w0.y = cvt_pk_bf16(v00[2], v00[3]); w0.z = cvt_pk_bf16(v01[0], v01[1]); w0.w = cvt_pk_bf16(v01[2], v01[3]);
                    u32x4 w1; w1.x = cvt_pk_bf16(v10[0], v10[1]); w1.y = cvt_pk_bf16(v10[2], v10[3]); w1.z = cvt_pk_bf16(v11[0], v11[1]); w1.w = cvt_pk_bf16(v11[2], v11[3]);
                    *(u32x4*)(rp) = w0; *(u32x4*)(rp + o1) = w1;
                }
        } else {
            f32x4 rs[2][2];
#pragma unroll
            for (int bj = 0; bj < 2; ++bj)
#pragma unroll
                for (int n = 0; n < 2; ++n) {
#pragma unroll
                    for (int j = 0; j < 4; ++j) rs[bj][n][j] = fast_rsqrt(ssq_val(et[bj * 128 + wc * 32 + n * 16 + 4 * fq + j]) * (1.0f / 1024.0f) + EPS); }
#pragma unroll
            for (int ai = 0; ai < 2; ++ai)
#pragma unroll
                for (int m = 0; m < 4; ++m) {
                    const int hd = (u.pn - QT) * 256 + ai * 128 + wr * 64 + m * 16 + fr, hk = hd >> 6, d = hd & 63, nhk = kpitch >> 6;
#pragma unroll
                    for (int bj = 0; bj < 2; ++bj)
#pragma unroll
                        for (int n = 0; n < 2; ++n) { const f32x4 v = acc[ai][bj][m][n] * rs[bj][n]; u32x2 w; w.x = cvt_pk_bf16(v[0], v[1]); w.y = cvt_pk_bf16(v[2], v[3]);
                            const int c0 = u.pm * 256 + bj * 128 + wc * 32 + n * 16 + 4 * fq;
                            *(u32x2*)(VT + ((size_t)(c0 >> 3) * nhk + hk) * 512 + (((d >> 4) * 2 + ((c0 >> 2) & 1)) * 16 + (d & 15)) * 4) = w; }
                }
        }
    }
};

template <bool F8 = false>
struct ResPolicy {
    static constexpr bool GATHER = false, ALIGN = true, FP8 = F8;
    int nt; unsigned pitchA, pitchB;
    int G, c;
    const char* A; const char* W;
    bf16_t* hb; u64* ssq_out; bf16_t* dmy;
    unsigned char* hb8;
    __device__ __forceinline__ bool next(int i, Unit& u) const {
        const long L = (long)i * G + c; if (L >= (long)NPANEL * 4) return false;
        int pm, pn; pg8::tile_of((int)L, NPANEL, 4, pm, pn);
        u.pm = pm; u.pn = pn; u.kind = 0; u.aux = 0; u.aux2 = 0;
        u.A = A + (size_t)pm * 256 * pitchA; u.B = W + (size_t)pn * 256 * pitchB; return true;
    }
    __device__ __forceinline__ void dma_tables(const Unit&, LAS unsigned char*, int, int, int) const {}
    __device__ __forceinline__ void epi(const Acc& acc, const Unit& u, LAS unsigned char*, int, int wr, int wc, int fr, int fq) const {
        const int col = u.pn * 256 + wc * 32 + 8 * fq;
#pragma unroll
        for (int ai = 0; ai < 2; ++ai) {
            u32x4 bv[4][2];
#pragma unroll
            for (int m = 0; m < 4; ++m) { const bf16_t* bp = hb + (size_t)(u.pm * 256 + ai * 128 + wr * 64 + m * 16 + fr) * D + col;
#pragma unroll
                for (int bj = 0; bj < 2; ++bj) bv[m][bj] = *(const u32x4*)(bp + bj * 128); }
            __builtin_amdgcn_sched_barrier(0);
#pragma unroll
            for (int m = 0; m < 4; ++m) {
                const int row = u.pm * 256 + ai * 128 + wr * 64 + m * 16 + fr;
                bf16_t* hp = (dmy ? dmy + (size_t)(row & 0xFFF) * D : hb + (size_t)row * D) + col;
                f32x2 ss2 = {0.f, 0.f};
#pragma unroll
                for (int bj = 0; bj < 2; ++bj) {
                    const u32x4 b = bv[m][bj]; const f32x4 a0 = acc[ai][bj][m][0], a1 = acc[ai][bj][m][1];
                    const unsigned bw[4] = {b.x, b.y, b.z, b.w}; const f32x2 av[4] = {{a0[0], a0[1]}, {a0[2], a0[3]}, {a1[0], a1[1]}, {a1[2], a1[3]}};
                    f32x2 o[4]; u32x4 w; unsigned* wp = (unsigned*)&w;
#pragma unroll
                    for (int i = 0; i < 4; ++i) { const f32x2 hv = {__uint_as_float(bw[i] << 16), __uint_as_float(bw[i] & 0xffff0000u)}; if constexpr (F8) o[i] = hv + av[i] * (W8_INV * HID8_INV); else o[i] = hv + av[i]; ss2 = ss2 + o[i] * o[i]; wp[i] = cvt_pk_bf16(o[i].x, o[i].y); }
                    *(u32x4*)(hp + bj * 128) = w;
                    if (hb8) { int p0 = 0, p1 = 0; p0 = __builtin_amdgcn_cvt_pk_fp8_f32(o[0].x, o[0].y, p0, false); p0 = __builtin_amdgcn_cvt_pk_fp8_f32(o[1].x, o[1].y, p0, true); p1 = __builtin_amdgcn_cvt_pk_fp8_f32(o[2].x, o[2].y, p1, false); p1 = __builtin_amdgcn_cvt_pk_fp8_f32(o[3].x, o[3].y, p1, true);
                        u32x2 w8; w8.x = (unsigned)p0; w8.y = (unsigned)p1; *(u32x2*)(hb8 + (size_t)row * D + col + bj * 128) = w8; }
                }
                float ss = ss2.x + ss2.y;
                ss += __shfl_xor(ss, 16); ss += __shfl_xor(ss, 32);
                if (fq == 0) __hip_atomic_fetch_add(ssq_out + row, ssq_fix(ss), RLX_AGENT);
            }
            __builtin_amdgcn_sched_barrier(0);
        }
    }
};

template <bool MOE, bool F8 = MOE>
struct GuPolicy {
    static constexpr bool GATHER = MOE, ALIGN = ALIGN_LIGHT, FP8 = F8;
    int nt; unsigned pitchA, pitchB;
    int G, c;
    const char* hb; const char* W;
    const void* ssq;
    bf16_t* hid;
    const unsigned* rowtok; int p0, p1;
    const LAS int* ptab;
    __device__ __forceinline__ bool next(int i, Unit& u) const {
        const long L = (long)i * G + c;
        if constexpr (!MOE) {
            if (L >= (long)NPANEL * 28) return false;
            int pm, pn; pg8::tile_of((int)L, NPANEL, 28, pm, pn);
            u.pm = pm; u.pn = pn; u.kind = 0; u.aux = 0; u.aux2 = 0;
            u.A = hb + (size_t)pm * 256 * pitchA; u.B = W + (size_t)pn * 256 * pitchB; return true;
        } else {
            const int nM = p1 - p0; if (L >= (long)nM * 28) return false;
            int pm, pn; pg8::tile_of((int)L, nM, 28, pm, pn);
            const int p = p0 + pm; int e = 0;
#pragma unroll
            for (int k = 1; k <= 7; ++k) e += (p >= ptab[k]) ? 1 : 0;
            const int pbe = ptab[e], ce = ptab[9 + e];
            u.pm = pm; u.pn = pn; u.kind = e; u.aux = (p - pbe) * 256; u.aux2 = ce;
            u.A = hb; u.B = W + (size_t)e * W_GU8 + (size_t)pn * 256 * 1024; return true;
        }
    }
    __device__ __forceinline__ const unsigned* id_src(const Unit& u, int i) const { int r = u.aux + i; r = r < u.aux2 ? r : u.aux2 - 1; return rowtok + (size_t)u.kind * M + r; }
    __device__ __forceinline__ void dma_tables(const Unit& u, LAS unsigned char* tab, int slot, int wid, int lane) const {
        if constexpr (!MOE) pg8::dma4((const unsigned*)((const u64*)ssq + u.pm * 256) + wid * 64 + lane, (LAS unsigned*)(tab + 2048) + slot * 512 + wid * 64);
        else if (wid >= 4) { int r = u.aux + (wid - 4) * 64 + lane; r = r < u.aux2 ? r : u.aux2 - 1; pg8::dma4((const float*)ssq + (size_t)u.kind * M + r, (LAS float*)(tab + 2048) + slot * 256 + (wid - 4) * 64); }
    }
    __device__ __forceinline__ void epi(const Acc& acc, const Unit& u, LAS unsigned char* tab, int slot, int wr, int wc, int fr, int fq) const {
#pragma unroll
        for (int ai = 0; ai < 2; ++ai)
#pragma unroll
            for (int m = 0; m < 4; ++m) {
                const int row = ai * 128 + wr * 64 + m * 16 + fr;
                float sq;
                if constexpr (MOE) sq = ((const LAS float*)(tab + 2048) + slot * 256)[row]; else sq = ssq_val(((const LAS u64*)(tab + 2048) + slot * 256)[row]);
                const float rstd = fast_rsqrt(sq * (1.0f / 1024.0f) + EPS);
                const float rs_ = F8 ? rstd * W8_INV : rstd;
                const float c1 = -rs_ * LOG2E;
                const float kk = (sq * (1.0f / 1024.0f) + EPS) * (F8 ? W8_SCALE * W8_SCALE * HID8_INV : 1.0f);
                float o[8];
#pragma unroll
                for (int n = 0; n < 2; ++n)
#pragma unroll
                    for (int j = 0; j < 4; j += 2) {
                        const f32x2 g = {acc[ai][0][m][n][j], acc[ai][0][m][n][j + 1]}, up = {acc[ai][1][m][n][j], acc[ai][1][m][n][j + 1]};
                        const f32x2 t = g * c1; f32x2 e; e.x = fast_exp2(t.x); e.y = fast_exp2(t.y);
                        const f32x2 kk2 = {kk, kk}; const f32x2 d = e * kk2 + kk2; f32x2 r; r.x = fast_rcp(d.x); r.y = fast_rcp(d.y);
                        const f32x2 v = (g * up) * r;
                        o[n * 4 + j] = v.x; o[n * 4 + j + 1] = v.y; }
                if constexpr (F8) {
                    int q0 = 0, q1 = 0; q0 = __builtin_amdgcn_cvt_pk_fp8_f32(o[0], o[1], q0, false); q0 = __builtin_amdgcn_cvt_pk_fp8_f32(o[2], o[3], q0, true); q1 = __builtin_amdgcn_cvt_pk_fp8_f32(o[4], o[5], q1, false); q1 = __builtin_amdgcn_cvt_pk_fp8_f32(o[6], o[7], q1, true);
                    u32x2 w8; w8.x = (unsigned)q0; w8.y = (unsigned)q1;
                    *(u32x2*)((unsigned char*)hid + (size_t)(u.pm * 256 + row) * FF + u.pn * 128 + wc * 32 + 8 * fq) = w8;
                } else {
                u32x4 w; w.x = cvt_pk_bf16(o[0], o[1]); w.y = cvt_pk_bf16(o[2], o[3]); w.z = cvt_pk_bf16(o[4], o[5]); w.w = cvt_pk_bf16(o[6], o[7]);
                *(u32x4*)(hid + (size_t)(u.pm * 256 + row) * FF + u.pn * 128 + wc * 32 + 8 * fq) = w; }
            }
    }
};

struct MoeDownPolicy {
    static constexpr bool GATHER = false, ALIGN = ALIGN_LIGHT, FP8 = true;
    int nt; unsigned pitchA, pitchB;
    int G, c;
    const char* hid; const char* W;
    const unsigned* rowslot; const float* rowgate; bf16_t* ys;
    int p0, p1; const LAS int* ptab;
    __device__ __forceinline__ bool next(int i, Unit& u) const {
        const long L = (long)i * G + c; const int nM = p1 - p0; if (L >= (long)nM * 4) return false;
        int pm, pn; pg8::tile_of((int)L, nM, 4, pm, pn);
        const int p = p0 + pm; int e = 0;
#pragma unroll
        for (int k = 1; k <= 7; ++k) e += (p >= ptab[k]) ? 1 : 0;
        const int pbe = ptab[e], ce = ptab[9 + e];
        u.pm = pm; u.pn = pn; u.kind = e; u.aux = (p - pbe) * 256; u.aux2 = ce;
        u.A = hid + (size_t)pm * 256 * pitchA; u.B = W + (size_t)e * W_D8 + (size_t)pn * 256 * pitchB; return true;
    }
    __device__ __forceinline__ void dma_tables(const Unit& u, LAS unsigned char* tab, int slot, int wid, int lane) const {
        int r = u.aux + (wid & 3) * 64 + lane; r = r < u.aux2 ? r : u.aux2 - 1;
        if (wid < 4) pg8::dma4(rowslot + (size_t)u.kind * M + r, (LAS unsigned*)(tab + 6144) + slot * 256 + wid * 64);
        else pg8::dma4(rowgate + (size_t)u.kind * M + r, (LAS float*)(tab + 8192) + slot * 256 + (wid - 4) * 64);
    }
    __device__ __forceinline__ void epi(const Acc& acc, const Unit& u, LAS unsigned char* tab, int slot, int wr, int wc, int fr, int fq) const {
        const LAS unsigned* es = (const LAS unsigned*)(tab + 6144) + slot * 256;
        const LAS float* eg = (const LAS float*)(tab + 8192) + slot * 256;
#pragma unroll
        for (int ai = 0; ai < 2; ++ai)
#pragma unroll
            for (int m = 0; m < 4; ++m) {
                const int row = ai * 128 + wr * 64 + m * 16 + fr;
                if (u.aux + row < u.aux2) {
                    const unsigned sl = es[row]; const float g = eg[row] * (W8_INV * HID8_INV);
                    bf16_t* rp = ys + (size_t)sl * D + u.pn * 256 + wc * 32 + 8 * fq;
#pragma unroll
                    for (int bj = 0; bj < 2; ++bj) { const f32x4 v0 = acc[ai][bj][m][0] * g, v1 = acc[ai][bj][m][1] * g;
                        u32x4 w; w.x = cvt_pk_bf16(v0[0], v0[1]); w.y = cvt_pk_bf16(v0[2], v0[3]); w.z = cvt_pk_bf16(v1[0], v1[1]); w.w = cvt_pk_bf16(v1[2], v1[3]); *(u32x4*)(rp + bj * 128) = w; }
                }
            }
    }
};

struct WDesc { const float* src; const float* gain; bf16_t* dst; int K, N, map, ibase; };
__device__ __forceinline__ int qk_perm(int s) { return 128 * ((s >> 5) & 1) + 32 * (s >> 6) + 16 * ((s >> 2) & 1) + 4 * ((s >> 3) & 3) + (s & 3); }
__device__ __forceinline__ int dst_row(int map, int c) {
    if (map == 1) return c < 2048 ? (c & ~255) + qk_perm(c & 255) : c;
    if (map == 2) return c < 1280 ? (c & ~255) + qk_perm(c & 255) : c;
    if (map == 3 || map == 4) { const int t = c >> 7, w = c & 127; return 256 * t + (map == 4 ? 128 : 0) + 32 * (w >> 5) + 16 * ((w >> 2) & 1) + 4 * ((w >> 3) & 3) + (w & 3); }
    if (map == 5) return (c & ~31) + 16 * ((c >> 2) & 1) + 4 * ((c >> 3) & 3) + (c & 3);
    return c;
}
__device__ __forceinline__ void transpose_item(const GAS float* src, const GAS float* gain, GAS bf16_t* dst, int K, int N, int map, LAS float* scr, int item, int lane) {
    const int nblk = N / 64, kb = item / nblk, nb = item % nblk, k0 = 64 * kb, n0 = 64 * nb;
    const int c = lane & 15, r = lane >> 4;
    f32x4 v[16];
#pragma unroll
    for (int i = 0; i < 16; ++i) v[i] = *(const GAS f32x4*)(src + (size_t)(k0 + 4 * i + r) * N + n0 + 4 * c);
#pragma unroll
    for (int i = 0; i < 16; ++i) { const int kk = 4 * i + r; const float g = gain ? gain[k0 + kk] : 1.0f; LAS float* p = scr + kk * 65 + 4 * c; p[0] = v[i].x * g; p[1] = v[i].y * g; p[2] = v[i].z * g; p[3] = v[i].w * g; }
    asm volatile("s_waitcnt lgkmcnt(0)" ::: "memory");
    const int c8 = lane & 7;
#pragma unroll
    for (int j = 0; j < 8; ++j) { const int n = (lane >> 3) + 8 * j; const LAS float* p = scr + (8 * c8) * 65 + n;
        if (map >= 16) { int q0 = 0, q1 = 0;
            q0 = __builtin_amdgcn_cvt_pk_fp8_f32(p[0 * 65] * W8_SCALE, p[1 * 65] * W8_SCALE, q0, false); q0 = __builtin_amdgcn_cvt_pk_fp8_f32(p[2 * 65] * W8_SCALE, p[3 * 65] * W8_SCALE, q0, true);
            q1 = __builtin_amdgcn_cvt_pk_fp8_f32(p[4 * 65] * W8_SCALE, p[5 * 65] * W8_SCALE, q1, false); q1 = __builtin_amdgcn_cvt_pk_fp8_f32(p[6 * 65] * W8_SCALE, p[7 * 65] * W8_SCALE, q1, true);
            u32x2 o8; o8.x = (unsigned)q0; o8.y = (unsigned)q1; *(GAS u32x2*)((GAS unsigned char*)dst + (size_t)dst_row(map - 16, n0 + n) * K + k0 + 8 * c8) = o8; }
        else {
        u32x4 o; o.x = cvt_pk_bf16(p[0 * 65], p[1 * 65]); o.y = cvt_pk_bf16(p[2 * 65], p[3 * 65]); o.z = cvt_pk_bf16(p[4 * 65], p[5 * 65]); o.w = cvt_pk_bf16(p[6 * 65], p[7 * 65]);
        *(GAS u32x4*)(dst + (size_t)dst_row(map, n0 + n) * K + k0 + 8 * c8) = o; } }
    asm volatile("s_waitcnt lgkmcnt(0)" ::: "memory");
}
constexpr int N_WDESC = 62;
__device__ __forceinline__ void prologue(Frame& F, const __attribute__((address_space(4))) Args* a) {
    LAS WDesc* wd = (LAS WDesc*)(F.lds + 8 * 16640);
    LAS int* wtot = (LAS int*)(F.lds + 8 * 16640 + N_WDESC * sizeof(WDesc));
    static_assert(8 * 16640 + N_WDESC * sizeof(WDesc) + 16 <= (size_t)GAIN_OFF, "prologue LDS");
    if (F.tid == 0) {
        int n = 0, ib = 0;
#define ADDW(src_, gain_, dst_, K_, N_, map_) do { wd[n].src = (src_); wd[n].gain = (gain_); wd[n].dst = (bf16_t*)(dst_); wd[n].K = (K_); wd[n].N = (N_); wd[n].map = (map_); wd[n].ibase = ib; ++n; ib += ((K_) / 64) * ((N_) / 64); } while (0)
        for (int p = 0; p < 2; ++p) {
            const int na0 = p ? I_L2 : I_L0, sw0 = p ? I_L3 : I_L1;
#define NA_(i) (a->in[na0 + (i)])
#define SW_(i) (a->in[sw0 + (i)])
            unsigned char* wb = F.ws + WS_W + (size_t)p * WPAIR;
            ADDW(NA_(1), NA_(0), wb + WNA_QKV, 1024, 3072, 1);
            ADDW(NA_(5), (const float*)nullptr, wb + WNA_O, 1024, 1024, 5);
            ADDW(NA_(7), NA_(6), wb + WNA_GU, 1024, FF, (p >= DENSE8_FROM ? 16 : 0) + 3);
            ADDW(NA_(8), NA_(6), wb + WNA_GU, 1024, FF, (p >= DENSE8_FROM ? 16 : 0) + 4);
            ADDW(NA_(9), (const float*)nullptr, wb + WNA_D, FF, 1024, (p >= DENSE8_FROM ? 16 : 0) + 5);
            ADDW(SW_(1), SW_(0), wb + WSW_QKV, 1024, 1536, 2);
            ADDW(SW_(5), (const float*)nullptr, wb + WSW_O, 1024, 1024, 5);
            for (int e = 0; e < NE; ++e) {
                ADDW(SW_(8) + (size_t)e * 1024 * FF, SW_(6), wb + WSW_GU + (size_t)e * W_GU8, 1024, FF, 16 + 3);
                ADDW(SW_(9) + (size_t)e * 1024 * FF, SW_(6), wb + WSW_GU + (size_t)e * W_GU8, 1024, FF, 16 + 4);
                ADDW(SW_(10) + (size_t)e * FF * 1024, (const float*)nullptr, wb + WSW_D + (size_t)e * W_D8, FF, 1024, 16 + 5);
            }
        }
#undef ADDW
        *wtot = ib;
    }
    __syncthreads();
    LAS float* scr = (LAS float*)(F.lds + F.wave * 16640);
    const int gw = F.bx * 8 + F.wave, NGW = F.G * 8;
    const int total = *wtot;
    for (int it = gw; it < total; it += NGW) {
        int k = 0;
        for (int j = 1; j < N_WDESC; ++j) k += (it >= wd[j].ibase) ? 1 : 0;
        transpose_item((const GAS float*)wd[k].src, (const GAS float*)wd[k].gain, (GAS bf16_t*)wd[k].dst, wd[k].K, wd[k].N, wd[k].map, scr, it - wd[k].ibase, F.lane);
    }
    u64* ssq0 = ssq_buf(F, 0);
    for (int m = gw; m < M; m += NGW) {
        const float* src = m < NREG ? a->in[I_X] + (size_t)m * D : a->in[I_META] + (size_t)(m - NREG) * D;
        const f32x4* xr = (const f32x4*)src + F.lane;
        f32x4 v[4]; float s = 0.f;
#pragma unroll
        for (int j = 0; j < 4; ++j) { v[j] = xr[64 * j]; s += (v[j].x * v[j].x + v[j].y * v[j].y) + (v[j].z * v[j].z + v[j].w * v[j].w); }
        s = wave_sum(s);
        u32x2* o8 = (u32x2*)(F.hb + (size_t)m * D) + F.lane;
#pragma unroll
        for (int j = 0; j < 4; ++j) { u32x2 w; w.x = cvt_pk_bf16(v[j].x, v[j].y); w.y = cvt_pk_bf16(v[j].z, v[j].w); o8[64 * j] = w; }
        if (F.lane == 0) ssq0[m] = ssq_fix(s);
    }
}

struct AttnCtx {
    const bf16_t* Q; const bf16_t* K; const bf16_t* VT; bf16_t* O; int kpitch; unsigned omask;
    const LAS float* tbl;
};
constexpr int NTILE = 18;
__device__ __forceinline__ int t5_bucket_abs(int n) {
    const int big = 8 + (n >= 12) + (n >= 16) + (n >= 23) + (n >= 32) + (n >= 46) + (n >= 64) + (n >= 91);
    return n < 8 ? n : big;
}
constexpr int NA_TBL_ROW = 64, NA_TBL_HEAD = 15 * 64, SWA_TBL_HEAD = 576, SWA_T5_OFF = 16 * 576, SWA_SINK_OFF = SWA_T5_OFF + 512;
template <int TYPE>
__device__ __forceinline__ void attn_unit(const AttnCtx& X, int b, int hq, int u0, int u1, bool metaq, int lane) {
    const int q = lane & 15, kg = lane >> 4;
    const int hk = TYPE == 0 ? hq : (hq >> 2);
    constexpr int NWIN = TYPE == 0 ? 16 : 17, TMETA = NWIN, NREAL = NWIN + 1;
    int qtok0, wtok0, bidx;
    int colbase = 0, relbase = 0, wsq = 0;
    if (TYPE == 0) {
        const int r = metaq ? 0 : u0, cb = metaq ? 0 : u1;
        int rs = r - 4; rs = rs < 0 ? 0 : (rs > 24 ? 24 : rs); int ks = 16 * cb - 8; ks = ks < 0 ? 0 : (ks > 32 ? 32 : ks);
        qtok0 = metaq ? NREG : b * SEQ + r * 64 + 16 * cb; wtok0 = b * SEQ + rs * 64 + ks;
        const int qc = 16 * cb + q; wsq = qc - 8; wsq = wsq < 0 ? 0 : (wsq > 48 ? 48 : wsq);
        colbase = ks + 4 * kg;
        bidx = hq * NA_TBL_HEAD + (rs - r + 7) * NA_TBL_ROW + (colbase - qc + 15 + 16);
    } else {
        const int q0 = metaq ? 0 : 16 * u0;
        int jb = q0 - 128; jb = jb < 0 ? 0 : (jb > SEQ - 272 ? SEQ - 272 : jb);
        qtok0 = metaq ? NREG : b * SEQ + q0; wtok0 = b * SEQ + jb;
        relbase = jb + 4 * kg - q0 - q;
        bidx = hq * SWA_TBL_HEAD + relbase + 288;
        colbase = q0 + q;
    }
    const int mtok0 = NREG;
    const int nhk = X.kpitch >> 6;
    constexpr int TSTEP = 2;
    const size_t blk = (size_t)nhk * 512;
    const bf16_t* kwin = X.K + (size_t)(wtok0 >> 3) * blk + ((((size_t)(q >> 3) * nhk + hk) * 2) * 4 + kg) * 64 + (q & 7) * 8;
    const bf16_t* kmet = X.K + (size_t)(mtok0 >> 3) * blk + ((((size_t)(q >> 3) * nhk + hk) * 2) * 4 + kg) * 64 + (q & 7) * 8;
    const bf16_t* vwin = X.VT + (size_t)(wtok0 >> 3) * blk + ((size_t)(kg >> 1) * nhk + hk) * 512 + ((kg & 1) * 16 + q) * 4;
    const bf16_t* vmet = X.VT + (size_t)(mtok0 >> 3) * blk + ((size_t)(kg >> 1) * nhk + hk) * 512 + ((kg & 1) * 16 + q) * 4;
#define ATT_TOFF(t) ((size_t)(TYPE == 0 ? (8 * ((t) >> 1) + 2 * ((t) & 1)) : TSTEP * (t)) * blk)
    bf16x8 Qf[2];
    { const bf16_t* qp = X.Q + (size_t)(qtok0 + q) * 1024 + hq * 64 + 8 * kg; Qf[0] = *(const bf16x8*)qp; Qf[1] = *(const bf16x8*)(qp + 32); }
    f32x4 S[NTILE];
    f32x4 O[4];
#define ATT_LOADK(buf, t0) do { _Pragma("unroll") for (int t = 0; t < 6; ++t) if ((t0) + t < NREAL) { const bf16_t* kp = ((t0) + t == TMETA) ? kmet : kwin + ATT_TOFF((t0) + t); buf[t][0] = *(const bf16x8*)kp; buf[t][1] = *(const bf16x8*)(kp + 256); } } while (0)
#define ATT_MMAK(buf, t0) do { _Pragma("unroll") for (int t = 0; t < 6; ++t) if ((t0) + t < NREAL) { \
        f32x4 s_ = __builtin_amdgcn_mfma_f32_16x16x32_bf16(buf[t][0], Qf[0], S[(t0) + t], 0, 0, 0); S[(t0) + t] = __builtin_amdgcn_mfma_f32_16x16x32_bf16(buf[t][1], Qf[1], s_, 0, 0, 0); } } while (0)
#define ATT_VPTR(t) (((t) == TMETA) ? vmet : vwin + ATT_TOFF(t))
#define ATT_LOADV(bl, bh, s0) do { _Pragma("unroll") for (int s = 0; s < 3; ++s) { \
        _Pragma("unroll") for (int dt = 0; dt < 4; ++dt) { \
            bl[s][dt] = *(const s16x4*)(ATT_VPTR(2 * ((s0) + s)) + dt * 128); \
            if (2 * ((s0) + s) + 1 < NREAL) bh[s][dt] = *(const s16x4*)(ATT_VPTR(2 * ((s0) + s) + 1) + dt * 128); else bh[s][dt] = (s16x4){0, 0, 0, 0}; } } } while (0)
#define ATT_PV(bl, bh, s0) do { _Pragma("unroll") for (int s = 0; s < 3; ++s) { \
        const f32x4 pa = S[2 * ((s0) + s)]; f32x4 pb = {0.f, 0.f, 0.f, 0.f}; if (2 * ((s0) + s) + 1 < NREAL) pb = S[2 * ((s0) + s) + 1]; \
        u32x4 pw; pw.x = cvt_pk_bf16(pa[0], pa[1]); pw.y = cvt_pk_bf16(pa[2], pa[3]); pw.z = cvt_pk_bf16(pb[0], pb[1]); pw.w = cvt_pk_bf16(pb[2], pb[3]); \
        const bf16x8 Pf = __builtin_bit_cast(bf16x8, pw); \
        _Pragma("unroll") for (int dt = 0; dt < 4; ++dt) { const bf16x8 Vf = __builtin_shufflevector(bl[s][dt], bh[s][dt], 0, 1, 2, 3, 4, 5, 6, 7); \
            O[dt] = __builtin_amdgcn_mfma_f32_16x16x32_bf16(Vf, Pf, O[dt], 0, 0, 0); } } } while (0)
    bf16x8 KA[6][2], KB[6][2];
    s16x4 VAl[3][4], VAh[3][4], VBl[3][4], VBh[3][4];
    ATT_LOADK(KA, 0); ATT_LOADK(KB, 6);
    {
        const LAS float* bt = X.tbl + bidx;
#pragma unroll
        for (int t = 0; t < NWIN; ++t)
#pragma unroll
            for (int j = 0; j < 4; ++j) S[t][j] = TYPE == 0 ? bt[(t >> 1) * NA_TBL_ROW + 16 * (t & 1) + j] : bt[16 * t + j];
#pragma unroll
        for (int j = 0; j < 4; ++j) {
            if (TYPE == 1) { const int mk = 4 * kg + j; int bucket;
                if (metaq) { const int rel = mk - q; bucket = (rel > 0 ? 16 : 0) + t5_bucket_abs(rel < 0 ? -rel : rel); } else bucket = t5_bucket_abs(16 + colbase - mk);
                S[TMETA][j] = X.tbl[SWA_T5_OFF + bucket * 16 + hq];
            } else S[TMETA][j] = -SM_SHIFT;
        }
        if (TYPE == 0) {
            bool okm[2][4];
#pragma unroll
            for (int hf = 0; hf < 2; ++hf)
#pragma unroll
                for (int j = 0; j < 4; ++j) okm[hf][j] = !metaq && (unsigned)(colbase + 16 * hf + j - wsq) < 16u;
#pragma unroll
            for (int t = 0; t < NWIN; ++t)
#pragma unroll
                for (int j = 0; j < 4; ++j) S[t][j] = okm[t & 1][j] ? S[t][j] : NEGBIG;
        } else {
#pragma unroll
            for (int t = 0; t < NWIN; ++t)
#pragma unroll
                for (int j = 0; j < 4; ++j) S[t][j] = (!metaq && (unsigned)(relbase + 16 * t + j + 128) <= 256u) ? S[t][j] : NEGBIG;
        }
    }
    ATT_MMAK(KA, 0);
    ATT_LOADK(KA, 12);
    ATT_MMAK(KB, 6);
    if (TYPE == 0) ATT_LOADV(VAl, VAh, 0);
    ATT_MMAK(KA, 12);
    if (TYPE == 1) ATT_LOADV(VAl, VAh, 0);
#pragma unroll
    for (int dt = 0; dt < 4; ++dt) O[dt] = (f32x4){0.f, 0.f, 0.f, 0.f};
    __builtin_amdgcn_sched_barrier(0);
    float sk = 0.f;
    if (TYPE == 1) sk = X.tbl[SWA_SINK_OFF + hq];
    ATT_LOADV(VBl, VBh, 3);
    float l = 0.f;
#pragma unroll
    for (int t = 0; t < NREAL; ++t) {
#pragma unroll
        for (int j = 0; j < 4; ++j) { const float p = fast_exp2(S[t][j]); S[t][j] = p; l += p; }
    }
    l += __shfl_xor(l, 16); l += __shfl_xor(l, 32);
    if (TYPE == 1) l += fast_exp2(sk);
    __builtin_amdgcn_sched_barrier(0);
    const float inv = 1.0f / l;
    ATT_PV(VAl, VAh, 0);
    ATT_LOADV(VAl, VAh, 6);
    ATT_PV(VBl, VBh, 3);
    ATT_PV(VAl, VAh, 6);
#undef ATT_LOADK
#undef ATT_MMAK
#undef ATT_LOADV
#undef ATT_PV
#undef ATT_VPTR
#undef ATT_TOFF
    bf16_t* op = X.O + (size_t)((unsigned)(qtok0 + q) & X.omask) * 1024 + hq * 64 + 4 * kg;
#pragma unroll
    for (int dt = 0; dt < 4; ++dt) { u32x2 w; w.x = cvt_pk_bf16(O[dt][0] * inv, O[dt][1] * inv); w.y = cvt_pk_bf16(O[dt][2] * inv, O[dt][3] * inv); *(u32x2*)(op + 16 * dt) = w; }
}

template <int TYPE>
__device__ __forceinline__ void metaq_unit(const AttnCtx& X, const LAS float* t5s, const LAS float* sinks, int b, int hq, int lane) {
    const int q = lane & 15, kg = lane >> 4, hk = TYPE == 0 ? hq : (hq >> 2), nhk = X.kpitch >> 6, mtok0 = NREG;
    const size_t blk = (size_t)nhk * 512;
    const bf16_t* qp = X.Q + (size_t)(mtok0 + q) * 1024 + hq * 64 + 8 * kg;
    const bf16_t* kp = X.K + (size_t)(mtok0 >> 3) * blk + ((((size_t)(q >> 3) * nhk + hk) * 2) * 4 + kg) * 64 + (q & 7) * 8;
    const bf16_t* vp = X.VT + (size_t)(mtok0 >> 3) * blk + ((size_t)(kg >> 1) * nhk + hk) * 512 + ((kg & 1) * 16 + q) * 4;
    const bf16x8 q0 = *(const bf16x8*)qp, q1 = *(const bf16x8*)(qp + 32), k0 = *(const bf16x8*)kp, k1 = *(const bf16x8*)(kp + 256);
    s16x4 vl[4];
#pragma unroll
    for (int dt = 0; dt < 4; ++dt) vl[dt] = *(const s16x4*)(vp + dt * 128);
    f32x4 S;
#pragma unroll
    for (int j = 0; j < 4; ++j) {
        if (TYPE == 1) { const int rel = 4 * kg + j - q; S[j] = t5s[((rel > 0 ? 16 : 0) + t5_bucket_abs(rel < 0 ? -rel : rel)) * 16 + hq]; } else S[j] = -SM_SHIFT;
    }
    S = __builtin_amdgcn_mfma_f32_16x16x32_bf16(k0, q0, S, 0, 0, 0); S = __builtin_amdgcn_mfma_f32_16x16x32_bf16(k1, q1, S, 0, 0, 0);
    float l = 0.f;
#pragma unroll
    for (int j = 0; j < 4; ++j) { S[j] = fast_exp2(S[j]); l += S[j]; }
    l += __shfl_xor(l, 16); l += __shfl_xor(l, 32);
    if (TYPE == 1) l += fast_exp2(sinks[hq]);
    const float inv = 1.0f / l;
    u32x4 pw; pw.x = cvt_pk_bf16(S[0], S[1]); pw.y = cvt_pk_bf16(S[2], S[3]); pw.z = 0u; pw.w = 0u;
    const bf16x8 Pf = __builtin_bit_cast(bf16x8, pw);
    bf16_t* op = X.O + (size_t)((unsigned)(mtok0 + q) & X.omask) * 1024 + hq * 64 + 4 * kg;
#pragma unroll
    for (int dt = 0; dt < 4; ++dt) {
        const bf16x8 Vf = __builtin_shufflevector(vl[dt], (s16x4){0, 0, 0, 0}, 0, 1, 2, 3, 4, 5, 6, 7);
        const f32x4 o = __builtin_amdgcn_mfma_f32_16x16x32_bf16(Vf, Pf, (f32x4){0.f, 0.f, 0.f, 0.f}, 0, 0, 0);
        u32x2 w; w.x = cvt_pk_bf16(o[0] * inv, o[1] * inv); w.y = cvt_pk_bf16(o[2] * inv, o[3] * inv); *(u32x2*)(op + 16 * dt) = w;
    }
}

template <int TYPE>
__device__ __forceinline__ void attn_phase(Frame& F, const AttnCtx& X) {
    int lane_l = F.lane; asm volatile("" : "+v"(lane_l));
    if (F.G == 256) {
        const int xcd = F.bx & 7, cu = F.bx >> 3, w = F.wave;
        if (TYPE == 0) {
            for (int it = 0; it < 32; ++it) { const int p = xcd * 64 + 2 * it + (w >> 2); attn_unit<0>(X, p >> 4, p & 15, cu, w & 3, false, lane_l); }
        } else {
            for (int it = 0; it < 32; ++it) { const int bn = xcd * 16 + (it >> 1), qb = 4 * cu + 2 * (it & 1) + (w >> 2); attn_unit<1>(X, bn >> 2, (bn & 3) * 4 + (w & 3), qb, 0, false, lane_l); }
        }
    } else {
        const int UPC = (NREG + F.G - 1) / F.G;
        const int ubeg = F.bx * UPC, uend = (ubeg + UPC) < NREG ? (ubeg + UPC) : NREG;
        for (int u = ubeg + F.wave; u < uend; u += 8) {
            if (TYPE == 0) { const int cb = u & 3, r = (u >> 2) & 31, h = (u >> 7) & 15, b = u >> 11; attn_unit<0>(X, b, h, r, cb, false, lane_l); }
            else { const int g = u & 3, qb = (u >> 2) & 127, n = (u >> 9) & 3, b = u >> 11; attn_unit<1>(X, b, n * 4 + g, qb, 0, false, lane_l); }
        }
    }
    for (int u = F.bx * 8 + F.wave; u < 16; u += F.G * 8) metaq_unit<TYPE>(X, X.tbl, X.tbl, 0, u, lane_l);
}

__device__ __forceinline__ void dma16(const void* g, LAS void* l) { __builtin_amdgcn_global_load_lds((const unsigned*)g, (LAS unsigned*)l, 16, 0, 0); }
constexpr int NA_RING_ROWS = 12, NA_TBL_OFF = NA_RING_ROWS * 8192;
__device__ __forceinline__ void na_ring_item(Frame& F, const AttnCtx& X, int pair) {
    int lane = F.lane; asm volatile("" : "+v"(lane));
    const int w = F.wave, q = lane & 15, kg = lane >> 4, cb = w & 3, rsel = w >> 2, b = pair >> 4, hq = pair & 15;
    LAS unsigned char* lds = F.lds;
    const LAS float* tbl = (const LAS float*)(lds + NA_TBL_OFF);
    constexpr int nhk = 16; const size_t blk = (size_t)nhk * 512;
    const bf16_t* vglob = X.VT + ((size_t)(b * 256) * nhk + hq) * 512 + lane * 8;
    const int mtok0 = NREG;
    const bf16_t* kmet = X.K + (size_t)(mtok0 >> 3) * blk + ((((size_t)(q >> 3) * nhk + hq) * 2) * 4 + kg) * 64 + (q & 7) * 8;
    const bf16_t* vmet = X.VT + (size_t)(mtok0 >> 3) * blk + ((size_t)(kg >> 1) * nhk + hq) * 512 + ((kg & 1) * 16 + q) * 4;
#pragma unroll
    for (int r = 0; r < 8; ++r) dma16(vglob + (size_t)(8 * r + w) * blk, lds + r * 8192 + w * 1024);
    int loaded_hi = 8;
    const int ks = (16 * cb - 8) < 0 ? 0 : ((16 * cb - 8) > 32 ? 32 : (16 * cb - 8));
    const int qc = 16 * cb + q; int wsq = qc - 8; wsq = wsq < 0 ? 0 : (wsq > 48 ? 48 : wsq);
    const int colbase = ks + 4 * kg;
    bool okm[2][4];
#pragma unroll
    for (int hf = 0; hf < 2; ++hf)
#pragma unroll
        for (int j = 0; j < 4; ++j) okm[hf][j] = (unsigned)(colbase + 16 * hf + j - wsq) < 16u;
    const int kfl = ((((q >> 3) * nhk + hq) * 2) * 4 + kg) * 64 + (q & 7) * 8;
    const int vfl = ((ks >> 3) + (kg >> 1)) * 1024 + ((kg & 1) * 16 + q) * 8;
    bf16x8 Qn[2];
    { const bf16_t* qp = X.Q + (size_t)(b * SEQ + rsel * 64 + 16 * cb + q) * 1024 + hq * 64 + 8 * kg; Qn[0] = *(const bf16x8*)qp; Qn[1] = *(const bf16x8*)(qp + 32); }
    __builtin_amdgcn_s_waitcnt(0x0F70); asm volatile("" ::: "memory"); __builtin_amdgcn_s_barrier(); asm volatile("" ::: "memory");
    for (int s = 0; s < 16; ++s) {
        const int r = 2 * s + rsel;
        bf16x8 Qf[2]; Qf[0] = Qn[0]; Qf[1] = Qn[1];
        if (s + 1 < 16) {
            int nh = 2 * s + 3 - 4; nh = nh < 0 ? 0 : (nh > 24 ? 24 : nh); nh += 8;
#pragma unroll
            for (int k = 0; k < 2; ++k) { const int rr = loaded_hi + k; if (rr < nh) { const int slot = rr >= 24 ? rr - 24 : (rr >= 12 ? rr - 12 : rr); dma16(vglob + (size_t)(8 * rr + w) * blk, lds + slot * 8192 + w * 1024); } }
            loaded_hi = nh > loaded_hi ? nh : loaded_hi;
            const bf16_t* qp = X.Q + (size_t)(b * SEQ + (r + 2) * 64 + 16 * cb + q) * 1024 + hq * 64 + 8 * kg; Qn[0] = *(const bf16x8*)qp; Qn[1] = *(const bf16x8*)(qp + 32);
        }
        int rs = r - 4; rs = rs < 0 ? 0 : (rs > 24 ? 24 : rs);
        const int wtok0 = b * SEQ + rs * 64 + ks;
        const bf16_t* kwin = X.K + (size_t)(wtok0 >> 3) * blk + kfl;
        const LAS float* bt = tbl + hq * NA_TBL_HEAD + (rs - r + 7) * NA_TBL_ROW + (colbase - qc + 15 + 16);
        f32x4 S[17];
        bf16x8 KA[6][2], KB[6][2];
#define NR_LOADK(buf, t0) do { _Pragma("unroll") for (int t = 0; t < 6; ++t) if ((t0) + t < 17) { const bf16_t* kp = ((t0) + t == 16) ? kmet : kwin + (size_t)(8 * (((t0) + t) >> 1) + 2 * (((t0) + t) & 1)) * blk; buf[t][0] = *(const bf16x8*)kp; buf[t][1] = *(const bf16x8*)(kp + 256); } } while (0)
#define NR_MMAK(buf, t0) do { _Pragma("unroll") for (int t = 0; t < 6; ++t) if ((t0) + t < 17) { \
        f32x4 s_ = __builtin_amdgcn_mfma_f32_16x16x32_bf16(buf[t][0], Qf[0], S[(t0) + t], 0, 0, 0); S[(t0) + t] = __builtin_amdgcn_mfma_f32_16x16x32_bf16(buf[t][1], Qf[1], s_, 0, 0, 0); } } while (0)
        NR_LOADK(KA, 0); NR_LOADK(KB, 6);
        s16x4 vm[4];
#pragma unroll
        for (int dt = 0; dt < 4; ++dt) vm[dt] = *(const s16x4*)(vmet + dt * 128);
#pragma unroll
        for (int t = 0; t < 16; ++t)
#pragma unroll
            for (int j = 0; j < 4; ++j) S[t][j] = bt[(t >> 1) * NA_TBL_ROW + 16 * (t & 1) + j];
#pragma unroll
        for (int t = 0; t < 16; ++t)
#pragma unroll
            for (int j = 0; j < 4; ++j) S[t][j] = okm[t & 1][j] ? S[t][j] : NEGBIG;
        S[16] = (f32x4){-SM_SHIFT, -SM_SHIFT, -SM_SHIFT, -SM_SHIFT};
        NR_MMAK(KA, 0);
        NR_LOADK(KA, 12);
        NR_MMAK(KB, 6);
        NR_MMAK(KA, 12);
#undef NR_LOADK
#undef NR_MMAK
        bf16x8 Vp0[4], Vp1[4];
#define NA_LOADV(buf, st_) do { if ((st_) < 8) { int rr_ = rs + (st_); const int sl_ = rr_ >= 24 ? rr_ - 24 : (rr_ >= 12 ? rr_ - 12 : rr_); const LAS unsigned char* vp_ = lds + sl_ * 8192 + vfl; \
            _Pragma("unroll") for (int dt = 0; dt < 4; ++dt) { const s16x4 vl_ = *(const LAS s16x4*)(vp_ + 256 * dt), vh_ = *(const LAS s16x4*)(vp_ + 2048 + 256 * dt); buf[dt] = __builtin_shufflevector(vl_, vh_, 0, 1, 2, 3, 4, 5, 6, 7); asm volatile("" ::: "memory"); } } \
          else { _Pragma("unroll") for (int dt = 0; dt < 4; ++dt) buf[dt] = __builtin_shufflevector(vm[dt], (s16x4){0, 0, 0, 0}, 0, 1, 2, 3, 4, 5, 6, 7); } } while (0)
        NA_LOADV(Vp0, 0); NA_LOADV(Vp1, 1);
        __builtin_amdgcn_sched_barrier(0);
        float l = 0.f;
#pragma unroll
        for (int t = 0; t < 17; ++t)
#pragma unroll
            for (int j = 0; j < 4; ++j) { const float p = fast_exp2(S[t][j]); S[t][j] = p; l += p; }
        l += __shfl_xor(l, 16); l += __shfl_xor(l, 32);
        const float inv = 1.0f / l;
        __builtin_amdgcn_sched_barrier(0);
        f32x4 O[4];
#pragma unroll
        for (int dt = 0; dt < 4; ++dt) O[dt] = (f32x4){0.f, 0.f, 0.f, 0.f};
#pragma unroll
        for (int st = 0; st < 9; ++st) {
            const f32x4 pa = S[2 * st]; f32x4 pb = {0.f, 0.f, 0.f, 0.f}; if (st < 8) pb = S[2 * st + 1];
            u32x4 pw; pw.x = cvt_pk_bf16(pa[0], pa[1]); pw.y = cvt_pk_bf16(pa[2], pa[3]); pw.z = cvt_pk_bf16(pb[0], pb[1]); pw.w = cvt_pk_bf16(pb[2], pb[3]);
            const bf16x8 Pf = __builtin_bit_cast(bf16x8, pw);
            if ((st & 1) == 0) {
#pragma unroll
                for (int dt = 0; dt < 4; ++dt) O[dt] = __builtin_amdgcn_mfma_f32_16x16x32_bf16(Vp0[dt], Pf, O[dt], 0, 0, 0);
                __builtin_amdgcn_sched_barrier(0);
                if (st + 2 < 9) NA_LOADV(Vp0, st + 2);
            } else {
#pragma unroll
                for (int dt = 0; dt < 4; ++dt) O[dt] = __builtin_amdgcn_mfma_f32_16x16x32_bf16(Vp1[dt], Pf, O[dt], 0, 0, 0);
                __builtin_amdgcn_sched_barrier(0);
                if (st + 2 < 9) NA_LOADV(Vp1, st + 2);
            }
        }
#undef NA_LOADV
        bf16_t* op = X.O + (size_t)((unsigned)(b * SEQ + r * 64 + 16 * cb + q) & X.omask) * 1024 + hq * 64 + 4 * kg;
#pragma unroll
        for (int dt = 0; dt < 4; ++dt) { u32x2 wv; wv.x = cvt_pk_bf16(O[dt][0] * inv, O[dt][1] * inv); wv.y = cvt_pk_bf16(O[dt][2] * inv, O[dt][3] * inv); *(u32x2*)(op + 16 * dt) = wv; }
        __builtin_amdgcn_s_waitcnt(0x0F74); asm volatile("" ::: "memory"); __builtin_amdgcn_s_barrier(); asm volatile("" ::: "memory");
    }
    __builtin_amdgcn_s_waitcnt(0x0F70); asm volatile("" ::: "memory");
}

constexpr int SX_T5 = 0, SX_SINK = 2048, SX_TBL = 2176, SX_MK = 11392, SX_MV = 13440, SWA_VRING = 65536;
__device__ __forceinline__ void swa_ring_item(Frame& F, const AttnCtx& X, int item) {
    int lane = F.lane; asm volatile("" : "+v"(lane));
    const int w = F.wave, q = lane & 15, kg = lane >> 4;
    const int bn = item >> 1, hf = item & 1, b = bn >> 2, n = bn & 3, g = w & 3, qsel = w >> 2, hq = n * 4 + g;
    LAS unsigned char* lds = F.lds;
    const LAS float* xt5 = (const LAS float*)(lds + ATT_X_OFF + SX_T5);
    const LAS float* xtb = (const LAS float*)(lds + ATT_X_OFF + SX_TBL) + g * SWA_TBL_HEAD;
    const float sk = ((const LAS float*)(lds + ATT_X_OFF + SX_SINK))[hq];
    const bf16_t* kglob = X.K + ((size_t)(b * 256) * 4 + n) * 512 + lane * 8;
    const bf16_t* vglob = X.VT + ((size_t)(b * 256) * 4 + n) * 512 + lane * 8;
    if (w < 4) { const size_t mb = ((size_t)(NREG >> 3) + (w & 1)) * 4 + n; dma16((w < 2 ? X.K : X.VT) + mb * 512 + lane * 8, lds + ATT_X_OFF + (w < 2 ? SX_MK : SX_MV) + (w & 1) * 1024); }
    const int qbase = 64 * hf;
    int q0f = 16 * qbase; int lo = q0f - 128; lo = lo < 0 ? 0 : (lo > SEQ - 272 ? SEQ - 272 : lo);
    int hi0 = q0f + 16 - 128; hi0 = hi0 < 0 ? 0 : (hi0 > SEQ - 272 ? SEQ - 272 : hi0); hi0 += 272;
    for (int B = (lo >> 3) + w; B < (hi0 >> 3); B += 8) { dma16(kglob + (size_t)B * 2048, lds + (B & 63) * 1024); dma16(vglob + (size_t)B * 2048, lds + SWA_VRING + (B & 63) * 1024); }
    int loaded_hi = hi0;
    bf16x8 Qn[2];
    { const bf16_t* qp = X.Q + (size_t)(b * SEQ + 16 * (qbase + qsel) + q) * 1024 + hq * 64 + 8 * kg; Qn[0] = *(const bf16x8*)qp; Qn[1] = *(const bf16x8*)(qp + 32); }
    const int kfrag = (q >> 3) * 1024 + kg * 128 + (q & 7) * 16;
    const int vfrag = (kg >> 1) * 1024 + ((kg & 1) * 16 + q) * 8;
    __builtin_amdgcn_s_waitcnt(0x0F70); asm volatile("" ::: "memory"); __builtin_amdgcn_s_barrier(); asm volatile("" ::: "memory");
    for (int s = 0; s < 32; ++s) {
        const int qblk = qbase + 2 * s + qsel, q0 = 16 * qblk;
        bf16x8 Qf[2]; Qf[0] = Qn[0]; Qf[1] = Qn[1];
        if (s + 1 < 32) {
            int nh = 16 * (qbase + 2 * s + 3) - 128; nh = nh < 0 ? 0 : (nh > SEQ - 272 ? SEQ - 272 : nh); nh += 272;
            const int B = (loaded_hi >> 3) + (w & 3);
            if (B < (nh >> 3)) { if (w < 4) dma16(kglob + (size_t)B * 2048, lds + (B & 63) * 1024); else dma16(vglob + (size_t)B * 2048, lds + SWA_VRING + (B & 63) * 1024); }
            loaded_hi = nh > loaded_hi ? nh : loaded_hi;
            const bf16_t* qp = X.Q + (size_t)(b * SEQ + q0 + 32 + q) * 1024 + hq * 64 + 8 * kg; Qn[0] = *(const bf16x8*)qp; Qn[1] = *(const bf16x8*)(qp + 32);
        }
        int jb = q0 - 128; jb = jb < 0 ? 0 : (jb > SEQ - 272 ? SEQ - 272 : jb);
        const int relbase = jb + 4 * kg - q0 - q;
        const int jblk = jb >> 3;
        f32x4 S[18];
        {
            const LAS float* bt = xtb + relbase + 288;
#pragma unroll
            for (int t = 0; t < 17; ++t)
#pragma unroll
                for (int j = 0; j < 4; ++j) S[t][j] = bt[16 * t + j];
#pragma unroll
            for (int j = 0; j < 4; ++j) S[17][j] = xt5[t5_bucket_abs(16 + q0 + q - (4 * kg + j)) * 16 + hq];
            if (jb == q0 - 128) {
#pragma unroll
                for (int j = 0; j < 4; ++j) { S[0][j] = (relbase + j >= -128) ? S[0][j] : NEGBIG; S[16][j] = (relbase + 256 + j <= 128) ? S[16][j] : NEGBIG; }
            } else {
                int r0 = relbase + 128; asm volatile("" : "+v"(r0));
#pragma unroll
                for (int t = 0; t < 17; ++t)
#pragma unroll
                    for (int j = 0; j < 4; ++j) S[t][j] = ((unsigned)(r0 + (16 * t + j)) <= 256u) ? S[t][j] : NEGBIG;
            }
        }
#pragma unroll
        for (int t0 = 0; t0 < 18; t0 += 6) {
            bf16x8 Kf[6][2];
#pragma unroll
            for (int t = 0; t < 6; ++t) {
                const LAS unsigned char* kp = (t0 + t == 17) ? lds + ATT_X_OFF + SX_MK + kfrag : lds + (((jblk + 2 * (t0 + t) + (q >> 3)) & 63) * 1024) + (kfrag & 1023);
                Kf[t][0] = *(const LAS bf16x8*)kp; Kf[t][1] = *(const LAS bf16x8*)(kp + 512);
            }
#pragma unroll
            for (int t = 0; t < 6; ++t) { f32x4 s_ = __builtin_amdgcn_mfma_f32_16x16x32_bf16(Kf[t][0], Qf[0], S[t0 + t], 0, 0, 0); S[t0 + t] = __builtin_amdgcn_mfma_f32_16x16x32_bf16(Kf[t][1], Qf[1], s_, 0, 0, 0); }
        }
        bf16x8 Vp0[4], Vp1[4];
#define SW_LOADV(buf, st_) do { const LAS unsigned char* va_ = lds + SWA_VRING + (((jblk + 4 * (st_) + (kg >> 1)) & 63) * 1024) + (vfrag & 1023); \
            const LAS unsigned char* vb_ = ((st_) == 8) ? lds + ATT_X_OFF + SX_MV + vfrag : lds + SWA_VRING + (((jblk + 4 * (st_) + 2 + (kg >> 1)) & 63) * 1024) + (vfrag & 1023); \
            _Pragma("unroll") for (int dt = 0; dt < 4; ++dt) { const s16x4 vl_ = *(const LAS s16x4*)(va_ + 256 * dt), vh_ = *(const LAS s16x4*)(vb_ + 256 * dt); buf[dt] = __builtin_shufflevector(vl_, vh_, 0, 1, 2, 3, 4, 5, 6, 7); asm volatile("" ::: "memory"); } } while (0)
        SW_LOADV(Vp0, 0); SW_LOADV(Vp1, 1);
        __builtin_amdgcn_sched_barrier(0);
        float l = 0.f;
#pragma unroll
        for (int t = 0; t < 18; ++t)
#pragma unroll
            for (int j = 0; j < 4; ++j) { const float p = fast_exp2(S[t][j]); S[t][j] = p; l += p; }
        l += __shfl_xor(l, 16); l += __shfl_xor(l, 32);
        l += fast_exp2(sk);
        __builtin_amdgcn_sched_barrier(0);
        const float inv = 1.0f / l;
        f32x4 O[4];
#pragma unroll
        for (int dt = 0; dt < 4; ++dt) O[dt] = (f32x4){0.f, 0.f, 0.f, 0.f};
#pragma unroll
        for (int st = 0; st < 9; ++st) {
            const f32x4 pa = S[2 * st], pb = S[2 * st + 1];
            u32x4 pw; pw.x = cvt_pk_bf16(pa[0], pa[1]); pw.y = cvt_pk_bf16(pa[2], pa[3]); pw.z = cvt_pk_bf16(pb[0], pb[1]); pw.w = cvt_pk_bf16(pb[2], pb[3]);
            const bf16x8 Pf = __builtin_bit_cast(bf16x8, pw);
            if ((st & 1) == 0) {
#pragma unroll
                for (int dt = 0; dt < 4; ++dt) O[dt] = __builtin_amdgcn_mfma_f32_16x16x32_bf16(Vp0[dt], Pf, O[dt], 0, 0, 0);
                __builtin_amdgcn_sched_barrier(0);
                if (st + 2 < 9) SW_LOADV(Vp0, st + 2);
            } else {
#pragma unroll
                for (int dt = 0; dt < 4; ++dt) O[dt] = __builtin_amdgcn_mfma_f32_16x16x32_bf16(Vp1[dt], Pf, O[dt], 0, 0, 0);
                __builtin_amdgcn_sched_barrier(0);
                if (st + 2 < 9) SW_LOADV(Vp1, st + 2);
            }
        }
#undef SW_LOADV
        bf16_t* op = X.O + (size_t)((unsigned)(b * SEQ + q0 + q) & X.omask) * 1024 + hq * 64 + 4 * kg;
#pragma unroll
        for (int dt = 0; dt < 4; ++dt) { u32x2 wv; wv.x = cvt_pk_bf16(O[dt][0] * inv, O[dt][1] * inv); wv.y = cvt_pk_bf16(O[dt][2] * inv, O[dt][3] * inv); *(u32x2*)(op + 16 * dt) = wv; }
        __builtin_amdgcn_s_waitcnt(0x0F74); asm volatile("" ::: "memory"); __builtin_amdgcn_s_barrier(); asm volatile("" ::: "memory");
    }
    asm volatile("s_waitcnt vmcnt(0)" ::: "memory");
}

__device__ __forceinline__ void router_phase(Frame& F, const float* wr, const float* gain, const u64* ssq, int moe_idx, bool dummy) {
    LAS u32x4* Wl = (LAS u32x4*)F.lds;
    for (int idx = F.tid; idx < 32 * 64; idx += 512) {
        const int st = idx >> 6, ln = idx & 63, n = ln & 15, kg = ln >> 4, e = 2 * (n >> 2) + (n & 1), part = (n >> 1) & 1;
        float v[8];
#pragma unroll
        for (int c = 0; c < 8; ++c) { const int k = 64 * (st >> 1) + 16 * kg + 8 * (st & 1) + c; const float w = wr[(size_t)k * 8 + e] * gain[k];
            const float hi = __uint_as_float(cvt_pk_bf16(w, 0.f) << 16); v[c] = part ? w - hi : hi; }
        u32x4 o; o.x = cvt_pk_bf16(v[0], v[1]); o.y = cvt_pk_bf16(v[2], v[3]); o.z = cvt_pk_bf16(v[4], v[5]); o.w = cvt_pk_bf16(v[6], v[7]);
        Wl[idx] = o;
    }
    __syncthreads();
    unsigned* cnt = F.ctl + CW_CNT + (dummy ? 2 : moe_idx) * 8 * 64;
    unsigned char* tb_ = dummy ? F.ws + WS_R : F.ws + WS_TAB;
    unsigned* rowtok = (unsigned*)(tb_); float* rowssq = (float*)(tb_ + TAB_BYTES);
    unsigned* rowslot = (unsigned*)(tb_ + 2 * TAB_BYTES); float* rowgate = (float*)(tb_ + 3 * TAB_BYTES);
    const int gw = F.bx * 8 + F.wave, NGW = F.G * 8;
    constexpr int RT = 48;
    int lane_ = F.lane; asm volatile("" : "+v"(lane_));
    const int tok = lane_ & 15, q = lane_ >> 4;
    constexpr int NT = (M + RT - 1) / RT;
    LAS unsigned* wcnt = (LAS unsigned*)(F.lds + 32768);
    (void)gw;
    for (int t0 = 0; t0 < NT; t0 += NGW) {
        const int task = t0 + F.wave * F.G + F.bx; const bool has = task < NT;
        int me1 = 0, me2 = 0; float mg1 = 0.f, mg2 = 0.f, mss = 0.f;
        if (has) for (int j = 0; j < 3; ++j) {
            int mm = task * RT + 16 * j + tok; mm = mm < M ? mm : M - 1;
            const bf16_t* xr = F.hb + (size_t)mm * D + 16 * q;
            bf16x8 xa[16][2];
#pragma unroll
            for (int i = 0; i < 16; ++i) { xa[i][0] = *(const bf16x8*)(xr + 64 * i); xa[i][1] = *(const bf16x8*)(xr + 64 * i + 8); }
            const float ssv = ssq_val(ssq[mm]);
            f32x4 acc0 = {0.f, 0.f, 0.f, 0.f}, acc1 = {0.f, 0.f, 0.f, 0.f};
#pragma unroll
            for (int i = 0; i < 16; ++i) {
                const bf16x8 w0 = __builtin_bit_cast(bf16x8, Wl[(2 * i) * 64 + lane_]), w1 = __builtin_bit_cast(bf16x8, Wl[(2 * i + 1) * 64 + lane_]);
                acc0 = __builtin_amdgcn_mfma_f32_16x16x32_bf16(w0, xa[i][0], acc0, 0, 0, 0);
                acc1 = __builtin_amdgcn_mfma_f32_16x16x32_bf16(w1, xa[i][1], acc1, 0, 0, 0); }
            const f32x4 acc = acc0 + acc1;
            const float l0 = acc[0] + acc[2], l1 = acc[1] + acc[3];
            float cv[8]; int ce[8];
            cv[0] = l0; cv[1] = l1; ce[0] = 2 * q; ce[1] = 2 * q + 1;
#pragma unroll
            for (int d = 1; d < 4; ++d) { cv[2 * d] = __shfl_xor(l0, 16 * d); cv[2 * d + 1] = __shfl_xor(l1, 16 * d); ce[2 * d] = 2 * (q ^ d); ce[2 * d + 1] = 2 * (q ^ d) + 1; }
            int e1 = ce[0]; float v1 = cv[0];
#pragma unroll
            for (int c = 1; c < 8; ++c) if (cv[c] > v1 || (cv[c] == v1 && ce[c] < e1)) { v1 = cv[c]; e1 = ce[c]; }
            int e2 = -1; float v2 = -3.0e38f;
#pragma unroll
            for (int c = 0; c < 8; ++c) if (ce[c] != e1 && (cv[c] > v2 || (cv[c] == v2 && ce[c] < e2))) { v2 = cv[c]; e2 = ce[c]; }
            if (e2 < 0) e2 = e1 ^ 1;
            const float rstd = 1.0f / sqrtf(ssv * (1.0f / 1024.0f) + EPS);
            const float ex = __expf((v2 - v1) * rstd); const float g1 = 1.0f / (1.0f + ex), g2 = ex * g1;
            if (q == j) { me1 = e1; me2 = e2; mg1 = g1; mg2 = g2; mss = ssv; }
        }
        const bool act = has && F.lane < RT && task * RT + F.lane < M;
        int rank1 = 0, rank2 = 0, mycnt = 0, n1e2 = 0;
        const unsigned long long lt = (1ull << F.lane) - 1ull;
#pragma unroll
        for (int e = 0; e < 8; ++e) {
            const unsigned long long m1 = __ballot(act && me1 == e), m2 = __ballot(act && me2 == e);
            const int c1 = __popcll(m1), c2 = __popcll(m2);
            if (me1 == e) rank1 = __popcll(m1 & lt);
            if (me2 == e) { rank2 = __popcll(m2 & lt); n1e2 = c1; }
            if (F.lane == e) mycnt = c1 + c2;
        }
        unsigned basev = 0;
        if (F.lane < 8) wcnt[F.wave * 8 + F.lane] = (unsigned)mycnt;
        __syncthreads();
        if (F.wave == 0 && F.lane < 8) { unsigned tot = 0;
#pragma unroll
            for (int w = 0; w < 8; ++w) tot += wcnt[w * 8 + F.lane];
            wcnt[64 + F.lane] = tot ? __hip_atomic_fetch_add(cnt + F.lane * 64, tot, RLX_AGENT) : 0u; }
        __syncthreads();
        if (F.lane < 8) { basev = wcnt[64 + F.lane]; for (int w = 0; w < F.wave; ++w) basev += wcnt[w * 8 + F.lane]; }
        __syncthreads();
        const unsigned b1 = __shfl(basev, me1), b2 = __shfl(basev, me2);
        if (act) {
            const int m = task * RT + F.lane;
            const size_t p1 = (size_t)me1 * M + b1 + rank1, p2 = (size_t)me2 * M + b2 + n1e2 + rank2;
            rowtok[p1] = m; rowssq[p1] = mss; rowslot[p1] = 2 * m; rowgate[p1] = mg1;
            rowtok[p2] = m; rowssq[p2] = mss; rowslot[p2] = 2 * m + 1; rowgate[p2] = mg2;
        }
    }
}
__device__ __forceinline__ void combine_phase(Frame& F, const bf16_t* ys, u64* ssq_next, bool last, bool dummy) {
    const int gw = F.bx * 8 + F.wave, NGW = F.G * 8, mend = last ? NREG : M;
    u32x4 nh[2], na[2], nc[2];
    if (gw < mend) { const u32x4* hr = (const u32x4*)(F.hb + (size_t)gw * D) + F.lane; const u32x4* y0 = (const u32x4*)(ys + (size_t)(2 * gw) * D) + F.lane; const u32x4* y1 = (const u32x4*)(ys + (size_t)(2 * gw + 1) * D) + F.lane;
#pragma unroll
        for (int j = 0; j < 2; ++j) { nh[j] = hr[64 * j]; na[j] = y0[64 * j]; nc[j] = y1[64 * j]; } }
    for (int m = gw; m < mend; m += NGW) {
        u32x4 ch[2], ca[2], cc2[2];
#pragma unroll
        for (int j = 0; j < 2; ++j) { ch[j] = nh[j]; ca[j] = na[j]; cc2[j] = nc[j]; }
        const int mn = m + NGW;
        if (mn < mend) { const u32x4* hr = (const u32x4*)(F.hb + (size_t)mn * D) + F.lane; const u32x4* y0 = (const u32x4*)(ys + (size_t)(2 * mn) * D) + F.lane; const u32x4* y1 = (const u32x4*)(ys + (size_t)(2 * mn + 1) * D) + F.lane;
#pragma unroll
            for (int j = 0; j < 2; ++j) { nh[j] = hr[64 * j]; na[j] = y0[64 * j]; nc[j] = y1[64 * j]; } }
        float v[2][8]; float s = 0.f;
#pragma unroll
        for (int j = 0; j < 2; ++j) { const u32x4 h4 = ch[j], a = ca[j], c = cc2[j];
            const unsigned hh[4] = {h4.x, h4.y, h4.z, h4.w}, aa[4] = {a.x, a.y, a.z, a.w}, cc[4] = {c.x, c.y, c.z, c.w};
#pragma unroll
            for (int i = 0; i < 4; ++i) { v[j][2 * i] = __uint_as_float(hh[i] << 16) + (__uint_as_float(aa[i] << 16) + __uint_as_float(cc[i] << 16));
                v[j][2 * i + 1] = __uint_as_float(hh[i] & 0xffff0000u) + (__uint_as_float(aa[i] & 0xffff0000u) + __uint_as_float(cc[i] & 0xffff0000u)); }
#pragma unroll
            for (int i = 0; i < 8; ++i) s += v[j][i] * v[j][i]; }
        if (last) {
            f32x4* o = (f32x4*)((dummy ? (float*)(F.ws + WS_R) + (size_t)(m & 0x7FFF) * D : F.out + (size_t)m * D)) + 2 * F.lane;
#pragma unroll
            for (int j = 0; j < 2; ++j) { o[128 * j] = (f32x4){v[j][0], v[j][1], v[j][2], v[j][3]}; o[128 * j + 1] = (f32x4){v[j][4], v[j][5], v[j][6], v[j][7]}; }
        } else {
            s = wave_sum(s);
            u32x4* o8 = (u32x4*)(dummy ? (bf16_t*)(F.ws + WS_R) + (size_t)(m & 0x7FFF) * D : F.hb + (size_t)m * D) + F.lane;
#pragma unroll
            for (int j = 0; j < 2; ++j) { u32x4 w; w.x = cvt_pk_bf16(v[j][0], v[j][1]); w.y = cvt_pk_bf16(v[j][2], v[j][3]); w.z = cvt_pk_bf16(v[j][4], v[j][5]); w.w = cvt_pk_bf16(v[j][6], v[j][7]); o8[64 * j] = w; }
            if (F.lane == 0) ssq_next[m] = ssq_fix(s);
        }
    }
}

__device__ __forceinline__ bool thin_gemm(Frame& F, f32x4 (&acc)[4], const bf16_t* ap, const bf16_t* const (&bp)[4], int K, int lane) {
#pragma unroll
    for (int t = 0; t < 4; ++t) acc[t] = (f32x4){0.f, 0.f, 0.f, 0.f};
    const int ksl = K / 8, kb = F.wave * ksl;
#pragma unroll 2
    for (int k0 = kb; k0 < kb + ksl; k0 += 64) {
        bf16x8 af[2], bf[2][4];
#pragma unroll
        for (int st = 0; st < 2; ++st) { af[st] = *(const bf16x8*)(ap + k0 + 32 * st);
#pragma unroll
            for (int t = 0; t < 4; ++t) bf[st][t] = *(const bf16x8*)(bp[t] + k0 + 32 * st); }
#pragma unroll
        for (int st = 0; st < 2; ++st)
#pragma unroll
            for (int t = 0; t < 4; ++t) acc[t] = __builtin_amdgcn_mfma_f32_16x16x32_bf16(bf[st][t], af[st], acc[t], 0, 0, 0);
    }
    LAS f32x4* part = (LAS f32x4*)F.lds;
#pragma unroll
    for (int t = 0; t < 4; ++t) part[(F.wave * 4 + t) * 64 + lane] = acc[t];
    __syncthreads();
    if (F.wave == 0) {
#pragma unroll
        for (int w = 1; w < 8; ++w)
#pragma unroll
            for (int t = 0; t < 4; ++t) acc[t] = acc[t] + part[(w * 4 + t) * 64 + lane];
    }
    return F.wave == 0;
}
__device__ __forceinline__ void thin_qkv(Frame& F, const bf16_t* W, const u64* ssq, const float* gq, const float* gk, bf16_t* Q, bf16_t* Kb, bf16_t* Vb, int nhk, int QT) {
    for (int task = F.bx; task < 16 + 2 * nhk; task += F.G) {
    int lane = F.lane; asm volatile("" : "+v"(lane));
    const int tk = lane & 15, kg = lane >> 4, tok = NREG + tk;
    const int kind = task < 16 ? 0 : (task < 16 + nhk ? 1 : 2), hh = kind == 0 ? task : (kind == 1 ? task - 16 : task - 16 - nhk);
    const bf16_t* bp[4];
#pragma unroll
    for (int t = 0; t < 4; ++t) { const int d = 16 * t + tk;
        const int row = kind == 0 ? (hh >> 2) * 256 + qk_perm(64 * (hh & 3) + d) : (kind == 1 ? (4 + (hh >> 2)) * 256 + qk_perm(64 * (hh & 3) + d) : QT * 256 + hh * 64 + d);
        bp[t] = W + (size_t)row * 1024 + 8 * kg; }
    f32x4 acc[4];
    if (thin_gemm(F, acc, F.hb + (size_t)tok * D + 8 * kg, bp, 1024, lane)) {
        const float rstd = fast_rsqrt(ssq_val(ssq[tok]) * (1.0f / 1024.0f) + EPS);
        if (kind < 2) {
            float ss = 0.f;
#pragma unroll
            for (int t = 0; t < 4; ++t) { acc[t] = acc[t] * rstd; ss += acc[t][0] * acc[t][0] + acc[t][1] * acc[t][1] + acc[t][2] * acc[t][2] + acc[t][3] * acc[t][3]; }
            ss += __shfl_xor(ss, 16); ss += __shfl_xor(ss, 32);
            const float hn = fast_rsqrt(ss * (1.0f / 64.0f) + EPS) * (kind == 0 ? 0.125f * LOG2E : 1.0f);
            const float* gp = kind == 0 ? gq : gk;
#pragma unroll
            for (int t = 0; t < 4; ++t) { const int d0 = 16 * t + 4 * kg; const f32x4 g = *(const f32x4*)(gp + d0); const f32x4 v = acc[t] * g * hn;
                u32x2 w; w.x = cvt_pk_bf16(v[0], v[1]); w.y = cvt_pk_bf16(v[2], v[3]);
                if (kind == 0) *(u32x2*)(Q + (size_t)tok * 1024 + hh * 64 + d0) = w;
                else *(u32x2*)(Kb + (((((size_t)(tok >> 3) * nhk + hh) * 2 + (d0 >> 5)) * 4 + ((d0 >> 3) & 3)) * 64) + (tok & 7) * 8 + (d0 & 7)) = w; }
        } else {
#pragma unroll
            for (int t = 0; t < 4; ++t)
#pragma unroll
                for (int r = 0; r < 4; ++r) { const int d = 16 * t + 4 * kg + r; const unsigned pk = cvt_pk_bf16(acc[t][r] * rstd, 0.f);
                    Vb[((size_t)(tok >> 3) * nhk + hh) * 512 + (((d >> 4) * 2 + ((tok >> 2) & 1)) * 16 + (d & 15)) * 4 + (tok & 3)] = (bf16_t)(pk & 0xffffu); }
        }
    }
    __syncthreads();
    }
}
__device__ __forceinline__ void thin_res(Frame& F, const bf16_t* A, int pitchA, int K, const bf16_t* W, u64* ssq_out, unsigned char* hb8) {
    for (int task = F.bx; task < 16; task += F.G) {
    int lane = F.lane; asm volatile("" : "+v"(lane));
    const int tk = lane & 15, kg = lane >> 4, tok = NREG + tk, c0 = 64 * task;
    const bf16_t* bp[4];
#pragma unroll
    for (int t = 0; t < 4; ++t) bp[t] = W + (size_t)dst_row(5, c0 + 16 * t + tk) * K + 8 * kg;
    f32x4 acc[4];
    if (thin_gemm(F, acc, A + (size_t)tk * pitchA + 8 * kg, bp, K, lane)) {
        float ss = 0.f;
#pragma unroll
        for (int t = 0; t < 4; ++t) { bf16_t* hp = F.hb + (size_t)tok * D + c0 + 16 * t + 4 * kg; const u32x2 b = *(const u32x2*)hp;
            const float o0 = __uint_as_float(b.x << 16) + acc[t][0], o1 = __uint_as_float(b.x & 0xffff0000u) + acc[t][1], o2 = __uint_as_float(b.y << 16) + acc[t][2], o3 = __uint_as_float(b.y & 0xffff0000u) + acc[t][3];
            u32x2 w; w.x = cvt_pk_bf16(o0, o1); w.y = cvt_pk_bf16(o2, o3); *(u32x2*)hp = w; ss += o0 * o0 + o1 * o1 + o2 * o2 + o3 * o3;
            if (hb8) { int p0 = 0; p0 = __builtin_amdgcn_cvt_pk_fp8_f32(o0, o1, p0, false); p0 = __builtin_amdgcn_cvt_pk_fp8_f32(o2, o3, p0, true); *(unsigned*)(hb8 + (size_t)tok * D + c0 + 16 * t + 4 * kg) = (unsigned)p0; } }
        ss += __shfl_xor(ss, 16); ss += __shfl_xor(ss, 32);
        if (kg == 0) __hip_atomic_fetch_add(ssq_out + tok, ssq_fix(ss), RLX_AGENT);
    }
    __syncthreads();
    }
}
__device__ __forceinline__ void thin_gu(Frame& F, const bf16_t* W, const u64* ssq, bf16_t* hid) {
    for (int task = F.bx; task < FF / 32; task += F.G) {
    int lane = F.lane; asm volatile("" : "+v"(lane));
    const int tk = lane & 15, kg = lane >> 4, tok = NREG + tk, j0 = 32 * task;
    const bf16_t* bp[4];
#pragma unroll
    for (int t = 0; t < 4; ++t) bp[t] = W + (size_t)dst_row(t < 2 ? 3 : 4, j0 + 16 * (t & 1) + tk) * 1024 + 8 * kg;
    f32x4 acc[4];
    if (thin_gemm(F, acc, F.hb + (size_t)tok * D + 8 * kg, bp, 1024, lane)) {
        const float rstd = fast_rsqrt(ssq_val(ssq[tok]) * (1.0f / 1024.0f) + EPS);
#pragma unroll
        for (int t = 0; t < 2; ++t) { float o[4];
#pragma unroll
            for (int r = 0; r < 4; ++r) o[r] = silu_f(acc[t][r] * rstd) * (acc[t + 2][r] * rstd);
            u32x2 w; w.x = cvt_pk_bf16(o[0], o[1]); w.y = cvt_pk_bf16(o[2], o[3]); *(u32x2*)(hid + (size_t)tok * FF + j0 + 16 * t + 4 * kg) = w; }
    }
    __syncthreads();
    }
}

__device__ __forceinline__ void thin_gu8(Frame& F, const unsigned char* W, const u64* ssq, bf16_t* hid) {
    for (int task = F.bx; task < FF / 32; task += F.G) {
    int lane = F.lane; asm volatile("" : "+v"(lane));
    const int tk = lane & 15, kg = lane >> 4, tok = NREG + tk, j0 = 32 * task;
    const unsigned char* ap = F.ws + WS_HB8 + (size_t)tok * D + F.wave * 128 + 32 * kg;
    const bf16x8 a0 = *(const bf16x8*)ap, a1 = *(const bf16x8*)(ap + 16);
    f32x4 acc[4];
#pragma unroll
    for (int t = 0; t < 4; ++t) { const unsigned char* bp = W + (size_t)dst_row(t < 2 ? 3 : 4, j0 + 16 * (t & 1) + tk) * 1024 + F.wave * 128 + 32 * kg;
        const bf16x8 b0 = *(const bf16x8*)bp, b1 = *(const bf16x8*)(bp + 16);
        acc[t] = __builtin_amdgcn_mfma_scale_f32_16x16x128_f8f6f4(pg8::cat8(b0, b1), pg8::cat8(a0, a1), (f32x4){0.f, 0.f, 0.f, 0.f}, 0, 0, 0, 0, 0, 0); }
    LAS f32x4* part = (LAS f32x4*)F.lds;
#pragma unroll
    for (int t = 0; t < 4; ++t) part[(F.wave * 4 + t) * 64 + lane] = acc[t];
    __syncthreads();
    if (F.wave == 0) {
#pragma unroll
        for (int w = 1; w < 8; ++w)
#pragma unroll
            for (int t = 0; t < 4; ++t) acc[t] = acc[t] + part[(w * 4 + t) * 64 + lane];
        const float rstd = fast_rsqrt(ssq_val(ssq[tok]) * (1.0f / 1024.0f) + EPS) * W8_INV;
#pragma unroll
        for (int t = 0; t < 2; ++t) { float o[4];
#pragma unroll
            for (int r = 0; r < 4; ++r) o[r] = silu_f(acc[t][r] * rstd) * (acc[t + 2][r] * rstd) * HID8_SCALE;
            int q = 0; q = __builtin_amdgcn_cvt_pk_fp8_f32(o[0], o[1], q, false); q = __builtin_amdgcn_cvt_pk_fp8_f32(o[2], o[3], q, true);
            *(unsigned*)((unsigned char*)hid + (size_t)tok * FF + j0 + 16 * t + 4 * kg) = (unsigned)q; }
    }
    __syncthreads();
    }
}
__device__ __forceinline__ void thin_res8(Frame& F, const unsigned char* A, const unsigned char* W, u64* ssq_out) {
    for (int task = F.bx; task < 16; task += F.G) {
    int lane = F.lane; asm volatile("" : "+v"(lane));
    const int tk = lane & 15, kg = lane >> 4, tok = NREG + tk, c0 = 64 * task;
    f32x4 acc[4];
#pragma unroll
    for (int t = 0; t < 4; ++t) acc[t] = (f32x4){0.f, 0.f, 0.f, 0.f};
    if (F.wave < 7) {
        const unsigned char* ap = A + (size_t)tk * FF + F.wave * 512 + 32 * kg;
#pragma unroll
        for (int i = 0; i < 4; ++i) {
            const bf16x8 a0 = *(const bf16x8*)(ap + 128 * i), a1 = *(const bf16x8*)(ap + 128 * i + 16);
#pragma unroll
            for (int t = 0; t < 4; ++t) { const unsigned char* bp = W + (size_t)dst_row(5, c0 + 16 * t + tk) * FF + F.wave * 512 + 128 * i + 32 * kg;
                const bf16x8 b0 = *(const bf16x8*)bp, b1 = *(const bf16x8*)(bp + 16);
                acc[t] = __builtin_amdgcn_mfma_scale_f32_16x16x128_f8f6f4(pg8::cat8(b0, b1), pg8::cat8(a0, a1), acc[t], 0, 0, 0, 0, 0, 0); }
        }
    }
    LAS f32x4* part = (LAS f32x4*)F.lds;
#pragma unroll
    for (int t = 0; t < 4; ++t) part[(F.wave * 4 + t) * 64 + lane] = acc[t];
    __syncthreads();
    if (F.wave == 0) {
#pragma unroll
        for (int w = 1; w < 8; ++w)
#pragma unroll
            for (int t = 0; t < 4; ++t) acc[t] = acc[t] + part[(w * 4 + t) * 64 + lane];
        float ss = 0.f;
#pragma unroll
        for (int t = 0; t < 4; ++t) { bf16_t* hp = F.hb + (size_t)tok * D + c0 + 16 * t + 4 * kg; const u32x2 b = *(const u32x2*)hp; const f32x4 a = acc[t] * (W8_INV * HID8_INV);
            const float o0 = __uint_as_float(b.x << 16) + a[0], o1 = __uint_as_float(b.x & 0xffff0000u) + a[1], o2 = __uint_as_float(b.y << 16) + a[2], o3 = __uint_as_float(b.y & 0xffff0000u) + a[3];
            u32x2 w; w.x = cvt_pk_bf16(o0, o1); w.y = cvt_pk_bf16(o2, o3); *(u32x2*)hp = w; ss += o0 * o0 + o1 * o1 + o2 * o2 + o3 * o3; }
        ss += __shfl_xor(ss, 16); ss += __shfl_xor(ss, 32);
        if (kg == 0) __hip_atomic_fetch_add(ssq_out + tok, ssq_fix(ss), RLX_AGENT);
    }
    __syncthreads();
    }
}

constexpr int PH_PER_PAIR = 10 + 2 * MOE_NCH, N_PHASES = 1 + 2 * PH_PER_PAIR;
typedef const __attribute__((address_space(4))) Args* KArgs;
__device__ __forceinline__ KArgs kargs() { KArgs p = (KArgs)__builtin_amdgcn_kernarg_segment_ptr(); asm volatile("" : "+s"(p)); return p; }
__device__ __forceinline__ void make_frame(Frame& F, KArgs ap) {
    extern __shared__ __attribute__((aligned(16))) unsigned char lds_raw[];
    { LAS unsigned char* lp = (LAS unsigned char*)lds_raw; asm volatile("" : "+s"(lp)); F.lds = lp; }
    F.tab = F.lds + TAB_OFF;
    int t = threadIdx.x; asm volatile("" : "+v"(t));
    F.tid = t; F.lane = t & 63; F.wave = __builtin_amdgcn_readfirstlane(t >> 6);
    { int g_ = gridDim.x, b_ = blockIdx.x; asm volatile("" : "+s"(g_), "+s"(b_)); F.G = g_; F.bx = b_; }
    unsigned char* ws = ap->ws;
    F.ws = ws; F.out = ap->out; F.hb = (bf16_t*)(ws + WS_HB); F.ctl = (unsigned*)(ws + WS_CTL);
}
__device__ __forceinline__ void grid_seam() {
    KArgs ap = kargs();
    extern __shared__ __attribute__((aligned(16))) unsigned char lds_raw[];
    XcdBarrier b; b.bar = (unsigned*)(ap->ws + WS_CTL) + CW_BAR; b.x = xb_xcc_id(); b.st = (volatile LAS unsigned*)((LAS unsigned char*)lds_raw + MISC_OFF) + 8;
    xcd_barrier(b);
}
#ifndef SITE_MASK
#define SITE_MASK 0xFFFF
#endif
#define SITE(b) ((SITE_MASK >> (b)) & 1)

__device__ __forceinline__ void site_na_qkv(int pr) {
    KArgs ap = kargs(); Frame F; make_frame(F, ap);
    const int lb = pr ? I_L2 : I_L0; const unsigned char* wb = F.ws + WS_W + (size_t)pr * WPAIR; unsigned char* R = F.ws + WS_R;
    LAS float* gainsL = (LAS float*)(F.lds + GAIN_OFF);
    if (F.tid < 64) { gainsL[F.tid] = ap->in[lb + 2][F.tid] * (0.125f * LOG2E); gainsL[64 + F.tid] = ap->in[lb + 3][F.tid]; }
    __syncthreads();
    QkvPolicy P; P.nt = 16; P.pitchA = 2048; P.pitchB = 2048; P.G = F.G; P.c = F.bx; P.nN = 12; P.QT = 8; P.hb = (const char*)F.hb; P.W = (const char*)(wb + WNA_QKV);
    P.ssq = ssq_buf(F, 4 * pr + 0); P.Q = (bf16_t*)(R + R_Q); P.K = (bf16_t*)(R + R_K); P.VT = (bf16_t*)(R + R_VT_NA); P.kpitch = 1024; P.nQ = 4; P.gains = gainsL;
    thin_qkv(F, (const bf16_t*)(wb + WNA_QKV), ssq_buf(F, 4 * pr + 0), ap->in[lb + 2], ap->in[lb + 3], P.Q, P.K, P.VT, 16, 8);
    pg8::gemm_phase(F.lds, F.tab, P);
}
__device__ __forceinline__ void site_na_attn(int pr, bool dummy) {
    KArgs ap = kargs(); Frame F; make_frame(F, ap);
    const int lb = pr ? I_L2 : I_L0; unsigned char* R = F.ws + WS_R;
    LAS float* tbl = (LAS float*)(F.lds + NA_TBL_OFF); const float* rpb = ap->in[lb + 4];
    for (int i = F.tid; i < 16 * NA_TBL_HEAD; i += 512) { const int c = (i & 63) - 16, hd = i >> 6; tbl[i] = (c >= 0 && c < 31) ? rpb[hd * 31 + c] * LOG2E - SM_SHIFT : 0.f; }
    __syncthreads();
    AttnCtx X; X.Q = (const bf16_t*)(R + R_Q); X.K = (const bf16_t*)(R + R_K); X.VT = (const bf16_t*)(R + R_VT_NA); X.O = dummy ? (bf16_t*)(R + 3 * HB_BYTES) : (bf16_t*)(R + R_Q); X.omask = dummy ? 0x7FFFu : 0xFFFFFFFFu; X.kpitch = 1024; X.tbl = tbl;
    { int lane_l = F.lane; asm volatile("" : "+v"(lane_l));
      for (int u = F.bx * 8 + F.wave; u < 16; u += F.G * 8) metaq_unit<0>(X, tbl, tbl, 0, u, lane_l); }
    for (int pair = F.bx; pair < 512; pair += F.G) na_ring_item(F, X, pair);
    __syncthreads();
}
__device__ __forceinline__ void site_wo(int pr, int swa) {
    KArgs ap = kargs(); Frame F; make_frame(F, ap);
    const unsigned char* wb = F.ws + WS_W + (size_t)pr * WPAIR; unsigned char* R = F.ws + WS_R;
    ResPolicy<> P; P.nt = 16; P.pitchA = 2048; P.pitchB = 2048; P.G = F.G; P.c = F.bx; P.A = (const char*)(R + R_Q); P.W = (const char*)(wb + (swa ? WSW_O : WNA_O));
    const bool dummy = ap->dummy != 0;
    P.hb = F.hb; P.ssq_out = ssq_buf(F, dummy ? 8 : 4 * pr + (swa ? 3 : 1)); P.dmy = dummy ? (bf16_t*)(F.ws + WS_END) : nullptr;
    P.hb8 = ((swa || pr >= DENSE8_FROM) && !dummy) ? F.ws + WS_HB8 : nullptr;
    if (!dummy) thin_res(F, (const bf16_t*)(R + R_Q) + (size_t)NREG * 1024, 1024, 1024, (const bf16_t*)P.W, P.ssq_out, P.hb8);
    pg8::gemm_phase(F.lds, F.tab, P);
}
__device__ __forceinline__ void site_dense_gu(int pr) {
    KArgs ap = kargs(); Frame F; make_frame(F, ap);
    const unsigned char* wb = F.ws + WS_W + (size_t)pr * WPAIR; unsigned char* R = F.ws + WS_R;
    if (pr >= DENSE8_FROM) {
        GuPolicy<false, true> P; P.nt = 8; P.pitchA = 1024; P.pitchB = 1024; P.G = F.G; P.c = F.bx; P.hb = (const char*)(F.ws + WS_HB8); P.W = (const char*)(wb + WNA_GU); P.ssq = ssq_buf(F, 4 * pr + 1); P.hid = (bf16_t*)R;
        P.rowtok = nullptr; P.p0 = 0; P.p1 = 0; P.ptab = nullptr;
        thin_gu8(F, wb + WNA_GU, ssq_buf(F, 4 * pr + 1), (bf16_t*)R);
        pg8::gemm_phase(F.lds, F.tab, P);
    } else {
    GuPolicy<false> P; P.nt = 16; P.pitchA = 2048; P.pitchB = 2048; P.G = F.G; P.c = F.bx; P.hb = (const char*)F.hb; P.W = (const char*)(wb + WNA_GU); P.ssq = ssq_buf(F, 4 * pr + 1); P.hid = (bf16_t*)R;
    P.rowtok = nullptr; P.p0 = 0; P.p1 = 0; P.ptab = nullptr;
    thin_gu(F, (const bf16_t*)(wb + WNA_GU), ssq_buf(F, 4 * pr + 1), (bf16_t*)R);
    pg8::gemm_phase(F.lds, F.tab, P);
    }
}
__device__ __forceinline__ void site_dense_down(int pr) {
    KArgs ap = kargs(); Frame F; make_frame(F, ap);
    const unsigned char* wb = F.ws + WS_W + (size_t)pr * WPAIR; unsigned char* R = F.ws + WS_R;
    const bool dummy = ap->dummy != 0;
    if (pr >= DENSE8_FROM) {
        ResPolicy<true> P; P.nt = 28; P.pitchA = 3584; P.pitchB = 3584; P.G = F.G; P.c = F.bx; P.A = (const char*)R; P.W = (const char*)(wb + WNA_D);
        P.hb = F.hb; P.ssq_out = ssq_buf(F, dummy ? 8 : 4 * pr + 2); P.dmy = dummy ? (bf16_t*)(F.ws + WS_END) : nullptr;
        P.hb8 = nullptr;
        if (!dummy) thin_res8(F, (const unsigned char*)R + (size_t)NREG * FF, (const unsigned char*)P.W, P.ssq_out);
        pg8::gemm_phase(F.lds, F.tab, P);
    } else {
    ResPolicy<> P; P.nt = 56; P.pitchA = 7168; P.pitchB = 7168; P.G = F.G; P.c = F.bx; P.A = (const char*)R; P.W = (const char*)(wb + WNA_D);
    P.hb = F.hb; P.ssq_out = ssq_buf(F, dummy ? 8 : 4 * pr + 2); P.dmy = dummy ? (bf16_t*)(F.ws + WS_END) : nullptr;
    P.hb8 = nullptr;
    if (!dummy) thin_res(F, (const bf16_t*)R + (size_t)NREG * FF, FF, FF, (const bf16_t*)P.W, P.ssq_out, nullptr);
    pg8::gemm_phase(F.lds, F.tab, P);
    }
}
__device__ __forceinline__ void site_swa_qkv(int pr) {
    KArgs ap = kargs(); Frame F; make_frame(F, ap);
    const int lb = pr ? I_L3 : I_L1; const unsigned char* wb = F.ws + WS_W + (size_t)pr * WPAIR; unsigned char* R = F.ws + WS_R;
    LAS float* gainsL = (LAS float*)(F.lds + GAIN_OFF);
    if (F.tid < 64) { gainsL[F.tid] = ap->in[lb + 2][F.tid] * (0.125f * LOG2E); gainsL[64 + F.tid] = ap->in[lb + 3][F.tid]; }
    __syncthreads();
    QkvPolicy P; P.nt = 16; P.pitchA = 2048; P.pitchB = 2048; P.G = F.G; P.c = F.bx; P.nN = 6; P.QT = 5; P.hb = (const char*)F.hb; P.W = (const char*)(wb + WSW_QKV);
    P.ssq = ssq_buf(F, 4 * pr + 2); P.Q = (bf16_t*)(R + R_Q); P.K = (bf16_t*)(R + R_K); P.VT = (bf16_t*)(R + R_VT_SWA); P.kpitch = 256; P.nQ = 4; P.gains = gainsL;
    thin_qkv(F, (const bf16_t*)(wb + WSW_QKV), ssq_buf(F, 4 * pr + 2), ap->in[lb + 2], ap->in[lb + 3], P.Q, P.K, P.VT, 4, 5);
    pg8::gemm_phase(F.lds, F.tab, P);
}
__device__ __forceinline__ void site_swa_attn(int pr, bool dummy) {
    KArgs ap = kargs(); Frame F; make_frame(F, ap);
    const int lb = pr ? I_L3 : I_L1; unsigned char* R = F.ws + WS_R;
    const float* t5 = ap->in[I_T5]; const float* sink = ap->in[lb + 4];
    AttnCtx X; X.Q = (const bf16_t*)(R + R_Q); X.K = (const bf16_t*)(R + R_K); X.VT = (const bf16_t*)(R + R_VT_SWA); X.O = dummy ? (bf16_t*)(R + 3 * HB_BYTES) : (bf16_t*)(R + R_Q); X.omask = dummy ? 0x7FFFu : 0xFFFFFFFFu; X.kpitch = 256;
    {
        LAS float* xt = (LAS float*)(F.lds + ATT_X_OFF);
        xt[SX_T5 / 4 + F.tid] = t5[F.tid] * LOG2E - SM_SHIFT;
        if (F.tid < 16) xt[SX_SINK / 4 + F.tid] = sink[F.tid] * LOG2E - SM_SHIFT;
        __syncthreads();
        X.tbl = (const LAS float*)(F.lds + ATT_X_OFF) - SWA_T5_OFF;
        { int lane_l = F.lane; asm volatile("" : "+v"(lane_l));
          for (int u = F.bx * 8 + F.wave; u < 16; u += F.G * 8) attn_unit<1>(X, 0, u, 0, 0, true, lane_l); }
        for (int item = F.bx; item < 256; item += F.G) {
            const int n = (item >> 1) & 3;
            __syncthreads();
            for (int i = F.tid; i < 4 * SWA_TBL_HEAD; i += 512) { const int gg = i / SWA_TBL_HEAD, rel = i % SWA_TBL_HEAD - 288; const int bkt = (rel > 0 ? 16 : 0) + t5_bucket_abs(rel < 0 ? -rel : rel); xt[SX_TBL / 4 + i] = t5[bkt * 16 + n * 4 + gg] * LOG2E - SM_SHIFT; }
            __syncthreads();
            swa_ring_item(F, X, item);
        }
    }
    __syncthreads();
}
__device__ __forceinline__ void site_router(int pr) {
    KArgs ap = kargs(); Frame F; make_frame(F, ap);
    const int lb = pr ? I_L3 : I_L1;
    router_phase(F, ap->in[lb + 7], ap->in[lb + 6], ssq_buf(F, 4 * pr + 3), pr, ap->dummy != 0);
}
__device__ __forceinline__ int moe_tables(Frame& F, int pr) {
    volatile LAS int* pt = (volatile LAS int*)(F.lds + MISC_OFF + 128);
    if (F.tid == 0) { int acc = 0; pt[0] = 0;
        for (int e = 0; e < NE; ++e) { const int c = (int)__hip_atomic_load(F.ctl + CW_CNT + pr * 8 * 64 + e * 64, RLX_AGENT); pt[9 + e] = c; acc += (c + 255) / 256; pt[e + 1] = acc; } }
    __syncthreads();
    return pt[NE];
}
__device__ __forceinline__ void site_moe_gu(int pr, int ch) {
    KArgs ap = kargs(); Frame F; make_frame(F, ap);
    const int PT = moe_tables(F, pr); const int P0 = ch * MOE_CH, P1 = (ch == MOE_NCH - 1 || (P0 + MOE_CH) >= PT) ? PT : (P0 + MOE_CH);
    if (P0 < P1) {
        const unsigned char* wb = F.ws + WS_W + (size_t)pr * WPAIR; unsigned char* R = F.ws + WS_R;
        GuPolicy<true> P; P.nt = 8; P.pitchA = 1024; P.pitchB = 1024; P.G = F.G; P.c = F.bx; P.hb = (const char*)(F.ws + WS_HB8); P.W = (const char*)(wb + WSW_GU); P.ssq = (const void*)(F.ws + WS_TAB + TAB_BYTES); P.hid = (bf16_t*)R;
        P.rowtok = (const unsigned*)(F.ws + WS_TAB); P.p0 = P0; P.p1 = P1; P.ptab = (const LAS int*)(F.lds + MISC_OFF + 128);
        pg8::gemm_phase(F.lds, F.tab, P);
    }
    __syncthreads();
}
__device__ __forceinline__ void site_moe_down(int pr, int ch) {
    KArgs ap = kargs(); Frame F; make_frame(F, ap);
    const int PT = moe_tables(F, pr); const int P0 = ch * MOE_CH, P1 = (ch == MOE_NCH - 1 || (P0 + MOE_CH) >= PT) ? PT : (P0 + MOE_CH);
    if (P0 < P1) {
        const unsigned char* wb = F.ws + WS_W + (size_t)pr * WPAIR; unsigned char* R = F.ws + WS_R;
        MoeDownPolicy P; P.nt = 28; P.pitchA = 3584; P.pitchB = 3584; P.G = F.G; P.c = F.bx; P.hid = (const char*)R; P.W = (const char*)(wb + WSW_D);
        P.rowslot = (const unsigned*)(F.ws + WS_TAB + 2 * TAB_BYTES); P.rowgate = (const float*)(F.ws + WS_TAB + 3 * TAB_BYTES); P.ys = (bf16_t*)(R + R_YS); P.p0 = P0; P.p1 = P1; P.ptab = (const LAS int*)(F.lds + MISC_OFF + 128);
        pg8::gemm_phase(F.lds, F.tab, P);
    }
    __syncthreads();
}
__device__ __forceinline__ void site_combine(int pr) {
    KArgs ap = kargs(); Frame F; make_frame(F, ap);
    const bool dummy = ap->dummy != 0;
    combine_phase(F, (const bf16_t*)(F.ws + WS_R + R_YS), ssq_buf(F, dummy ? 3 : (pr ? 0 : 4)), pr == 1, dummy);
}

__global__ void __launch_bounds__(512, 2) fwd_kernel(Args args) {
    extern __shared__ __attribute__((aligned(16))) unsigned char lds_raw[];
    {
        volatile LAS unsigned* MISC = (volatile LAS unsigned*)((LAS unsigned char*)lds_raw + MISC_OFF);
        if (threadIdx.x < 64) MISC[threadIdx.x] = 0u;
        __syncthreads();
    }
    const int lo = args.ph_lo, hi = args.ph_hi;
    if (hi - lo > 1) { KArgs ap = kargs(); (void)xcd_barrier_post((unsigned*)(ap->ws + WS_CTL) + CW_BAR, (volatile LAS unsigned*)((LAS unsigned char*)lds_raw + MISC_OFF) + 8); }
#define IN(k) (lo <= (k) && (k) < hi)
#if PROBE_A || PROBE_B
#define STAMP(k) do { if (blockIdx.x == 0 && threadIdx.x == 0) { KArgs ap_ = kargs(); ((u64*)(ap_->ws + WS_CTL + 49152))[(k)] = __builtin_amdgcn_s_memrealtime(); } } while (0)
#else
#define STAMP(k) do { } while (0)
#endif
#define SEAM(k) do { if (IN(k) && IN((k) + 1)) grid_seam(); STAMP((k) + 1); } while (0)
    STAMP(0);
    if ((REP_MASK & 1) && IN(0)) { KArgs ap = kargs(); Frame F; make_frame(F, ap); prologue(F, ap); grid_seam(); }
    if (SITE(0) && IN(0)) { KArgs ap = kargs(); Frame F; make_frame(F, ap); prologue(F, ap); }
    SEAM(0);
    for (int pr = 0; pr < 2; ++pr) {
        const int pb = 1 + pr * PH_PER_PAIR;
        if (((REP_MASK >> 1) & 1) && IN(pb + 0)) { site_na_qkv(pr); grid_seam(); }
        if (SITE(1) && IN(pb + 0)) site_na_qkv(pr);
        SEAM(pb + 0);
        if (((REP_MASK >> 2) & 1) && IN(pb + 1)) { site_na_attn(pr, true); grid_seam(); }
        if (SITE(2) && IN(pb + 1)) site_na_attn(pr, kargs()->dummy != 0);
        SEAM(pb + 1);
        if (SITE(3) && IN(pb + 2)) site_wo(pr, 0);
        SEAM(pb + 2);
        if (((REP_MASK >> 4) & 1) && IN(pb + 3)) { site_dense_gu(pr); grid_seam(); }
        if (SITE(4) && IN(pb + 3)) site_dense_gu(pr);
        SEAM(pb + 3);
        if (SITE(5) && IN(pb + 4)) site_dense_down(pr);
        SEAM(pb + 4);
        if (SITE(6) && IN(pb + 5)) site_swa_qkv(pr);
        SEAM(pb + 5);
        if (((REP_MASK >> 7) & 1) && IN(pb + 6)) { site_swa_attn(pr, true); grid_seam(); }
        if (SITE(7) && IN(pb + 6)) site_swa_attn(pr, kargs()->dummy != 0);
        SEAM(pb + 6);
        if (SITE(8) && IN(pb + 7)) site_wo(pr, 1);
        SEAM(pb + 7);
        if (SITE(9) && IN(pb + 8)) site_router(pr);
        SEAM(pb + 8);
        for (int ch = 0; ch < MOE_NCH; ++ch) {
            if (SITE(10) && IN(pb + 9 + 2 * ch)) site_moe_gu(pr, ch);
            SEAM(pb + 9 + 2 * ch);
            if (SITE(11) && IN(pb + 10 + 2 * ch)) site_moe_down(pr, ch);
            SEAM(pb + 10 + 2 * ch);
        }
        if (SITE(12) && IN(pb + 9 + 2 * MOE_NCH)) site_combine(pr);
        SEAM(pb + 9 + 2 * MOE_NCH);
    }
#if PROBE_A || PROBE_B
    {
        grid_seam();
        KArgs ap = kargs(); const u64* ts = (const u64*)(ap->ws + WS_CTL + 49152);
        u64 ta = 0, tb = 0;
        for (int k = 0; k < N_PHASES; ++k) { const u64 d = __hip_atomic_load(ts + k + 1, RLX_AGENT) - __hip_atomic_load(ts + k, RLX_AGENT); if ((PROBE_A >> k) & 1ull) ta += d; if ((PROBE_B >> k) & 1ull) tb += d; }
        const float sc = 1.0f + (float)ta * 1e-5f;
        float* o = ap->out;
        for (size_t i = (size_t)blockIdx.x * 512 + threadIdx.x; i < (size_t)NREG * D; i += (size_t)gridDim.x * 512) o[i] *= sc;
        if (PROBE_B) { grid_seam(); if (blockIdx.x == 0 && threadIdx.x == 0) o[0] = (float)tb * 0.01f; }
    }
#endif
#undef IN
#undef SEAM
}

extern "C" void kernel_launch(void* const* d_in, const int* in_sizes, int n_in, void* d_out, int out_size, void* d_ws, size_t ws_size, hipStream_t stream) {
    static int grid = 0;
    if (grid == 0) {
        if (n_in != 45 || out_size != NREG * D || ws_size < WS_END) { fprintf(stderr, "kernel_launch: unexpected shapes (n_in %d out %d ws %zu need %zu)\n", n_in, out_size, ws_size, (size_t)WS_END); grid = -1; return; }
        int dev = 0, cus = 0, per_cu = 0;
        if (hipGetDevice(&dev) != hipSuccess || hipDeviceGetAttribute(&cus, hipDeviceAttributeMultiprocessorCount, dev) != hipSuccess) { grid = -1; return; }
        if (hipFuncSetAttribute((const void*)fwd_kernel, hipFuncAttributeMaxDynamicSharedMemorySize, LDS_BYTES) != hipSuccess) { fprintf(stderr, "kernel_launch: hipFuncSetAttribute failed\n"); grid = -1; return; }
        if (hipOccupancyMaxActiveBlocksPerMultiprocessor(&per_cu, (const void*)fwd_kernel, 512, LDS_BYTES) != hipSuccess || per_cu < 1) fprintf(stderr, "kernel_launch: occupancy query says %d\n", per_cu);
        (void)hipGetLastError();
        grid = cus;
    }
    if (grid < 0) return;
    (void)hipMemsetAsync((char*)d_ws + WS_CTL, 0, CTL_BYTES, stream);
    Args a{};
    for (int i = 0; i < 45; ++i) a.in[i] = (const float*)d_in[i];
    a.out = (float*)d_out; a.ws = (unsigned char*)d_ws;
#if MK_MULTI
    for (int p = 0; p < N_PHASES && p <= MK_STOP; ++p) { a.ph_lo = p; a.ph_hi = p + 1;
        if (p == DUP_PHASE) { a.dummy = 1; hipLaunchKernelGGL(fwd_kernel, dim3(grid), dim3(512), LDS_BYTES, stream, a); a.dummy = 0; }
        hipLaunchKernelGGL(fwd_kernel, dim3(grid), dim3(512), LDS_BYTES, stream, a); }
#else
    a.ph_lo = 0; a.ph_hi = N_PHASES;
    hipLaunchKernelGGL(fwd_kernel, dim3(grid), dim3(512), LDS_BYTES, stream, a);
#endif
}
```

```cpp
#include <hip/hip_runtime.h>
#include <cstdio>
#include <cstdint>

#ifndef MK_MULTI
#define MK_MULTI 0
#endif

#ifndef PROBE_A
#define PROBE_A 0ull
#define PROBE_B 0ull
#endif
#ifndef DENSE8_FROM
#define DENSE8_FROM 1
#endif
#ifndef REP_MASK
#define REP_MASK 0
#endif
#ifndef DUP_PHASE
#define DUP_PHASE -1
#endif
#ifndef MK_STOP
#define MK_STOP 1000
#endif
#define LAS __attribute__((address_space(3)))
#define GAS __attribute__((address_space(1)))
typedef unsigned short bf16_t;
typedef short bf16x8 __attribute__((ext_vector_type(8)));
typedef short s16x4 __attribute__((ext_vector_type(4)));
typedef float f32x4 __attribute__((ext_vector_type(4)));
typedef float f32x2 __attribute__((ext_vector_type(2)));
typedef unsigned u32x4 __attribute__((ext_vector_type(4)));
typedef unsigned u32x2 __attribute__((ext_vector_type(2)));
#define RLX_AGENT __ATOMIC_RELAXED, __HIP_MEMORY_SCOPE_AGENT

constexpr int D = 1024, NREG = 65536, NMETA_ROWS = 16, M = NREG + NMETA_ROWS, NPANEL = NREG / 256;
constexpr int SEQ = 2048, BATCH = 32, FF = 3584, NE = 8;
constexpr float EPS = 1e-6f;
constexpr float LOG2E = 1.4426950408889634f;
constexpr float NEGBIG = -1e30f;
constexpr float SM_SHIFT = 16.0f;

constexpr size_t WS_CTL = 0, CTL_BYTES = 8u << 20;
constexpr int CW_TMO = 0, CW_BAR = 4096, CW_CNT = 8192;
constexpr size_t CTL_SSQ = 65536;
constexpr size_t SSQ_BYTES = (size_t)M * 8;
constexpr float SSQ_SCALE = 16777216.0f, SSQ_INV = 1.0f / 16777216.0f;
typedef unsigned long long u64;
static_assert(CTL_SSQ + 9 * SSQ_BYTES <= CTL_BYTES, "ctl");
constexpr size_t W_QKV_NA = (size_t)3072 * 1024 * 2, W_O = (size_t)1024 * 1024 * 2, W_GU = (size_t)7168 * 1024 * 2, W_D = (size_t)1024 * 3584 * 2, W_QKV_SWA = (size_t)1536 * 1024 * 2;
constexpr size_t WNA_QKV = 0, WNA_O = WNA_QKV + W_QKV_NA, WNA_GU = WNA_O + W_O, WNA_D = WNA_GU + W_GU, WNA_END = WNA_D + W_D;
constexpr size_t W_GU8 = (size_t)7168 * 1024;
constexpr size_t W_D8 = (size_t)1024 * 3584;
constexpr float W8_SCALE = 64.0f, W8_INV = 1.0f / 64.0f;
constexpr float HID8_SCALE = 4.0f, HID8_INV = 0.25f;
constexpr size_t WSW_QKV = WNA_END, WSW_O = WSW_QKV + W_QKV_SWA, WSW_GU = WSW_O + W_O, WSW_D = WSW_GU + NE * W_GU8, WPAIR = WSW_D + NE * W_D8;
constexpr size_t WS_W = CTL_BYTES;
constexpr size_t WS_HB = WS_W + 2 * WPAIR;
constexpr size_t HB_BYTES = (size_t)M * D * 2;
constexpr size_t WS_HB8 = WS_HB + HB_BYTES;
constexpr size_t WS_TAB = WS_HB8 + (size_t)M * D;
constexpr size_t TAB_BYTES = (size_t)NE * M * 4;
constexpr size_t WS_R = WS_TAB + 4 * TAB_BYTES;
constexpr size_t R_Q = 0, R_K = HB_BYTES, R_VT_NA = 2 * HB_BYTES, R_VT_SWA = HB_BYTES + (size_t)M * 256 * 2;
constexpr int MOE_CH = 256, MOE_NCH = 2, MOE_CH_MAX = 264;
constexpr size_t R_YS = (size_t)MOE_CH_MAX * 256 * FF;
constexpr size_t R_DENSE = (size_t)M * FF * 2, R_MOE = R_YS + (size_t)2 * M * D * 2;
constexpr size_t R_BYTES = R_DENSE > R_MOE ? R_DENSE : R_MOE;
static_assert(3 * HB_BYTES <= R_BYTES, "R");
constexpr size_t WS_END = WS_R + R_BYTES;
static_assert(WS_END + (24u << 20) <= 1115912448ull, "d_ws budget (incl. the 24 MiB scratch window of timing experiments)");

constexpr int TAB_OFF = 131072;
constexpr int GAIN_OFF = TAB_OFF + 10240;
constexpr int MISC_OFF = 163840 - 512;
constexpr int ATT_X_OFF = 147456;
constexpr int LDS_BYTES = 163840;
static_assert(MISC_OFF + 256 <= LDS_BYTES, "lds");

__device__ __forceinline__ unsigned cvt_pk_bf16(float lo, float hi) { unsigned r; asm volatile("v_cvt_pk_bf16_f32 %0, %1, %2" : "=v"(r) : "v"(lo), "v"(hi)); return r; }
__device__ __forceinline__ float wave_sum(float v) {
#pragma unroll
    for (int o = 1; o < 64; o <<= 1) v += __shfl_xor(v, o);
    return v;
}
__device__ __forceinline__ float fast_rsqrt(float x) { return __builtin_amdgcn_rsqf(x); }
__device__ __forceinline__ float fast_exp2(float x) { return __builtin_amdgcn_exp2f(x); }
__device__ __forceinline__ float fast_rcp(float x) { return __builtin_amdgcn_rcpf(x); }
__device__ __forceinline__ float silu_f(float x) { return x * fast_rcp(1.0f + fast_exp2(-x * LOG2E)); }

#define XB_TMO      128
#define XB_XCNT(j)  (256  + 64 * (j))
#define XB_XSUB(j)  (1280 + 64 * (j))
#define XB_XGEN(j)  (2304 + 64 * (j))
#define XB_TOP      3328
#define XB_TOPGEN   3392
#define XCD_BAR_WORDS 3456
#define XB_SPIN_CAP (1u << 18)
template <class T> __device__ __forceinline__ unsigned xb_ld(T* p)              { return __hip_atomic_load(p, __ATOMIC_RELAXED, __HIP_MEMORY_SCOPE_AGENT); }
template <class T> __device__ __forceinline__ unsigned xb_add(T* p, unsigned v) { return __hip_atomic_fetch_add(p, v, __ATOMIC_RELAXED, __HIP_MEMORY_SCOPE_AGENT); }
__device__ __forceinline__ unsigned xb_xcc_id() { return (unsigned)__builtin_amdgcn_s_getreg((3 << 11) | 20) & 0xFu; }
#define XB_SPIN(cond, bar) do { unsigned _sp = 0; while (cond) { __builtin_amdgcn_s_sleep(1); \
    if ((++_sp & 255u) == 0u) { if (xb_ld(&(bar)[XB_TMO])) break; if (_sp > XB_SPIN_CAP) { xb_add(&(bar)[XB_TMO], 1u); break; } } } } while (0)
struct XcdBarrier { unsigned* bar; unsigned x; volatile LAS unsigned* st; };
__device__ __forceinline__ XcdBarrier xcd_barrier_post(unsigned* bar, volatile LAS unsigned* st) {
    XcdBarrier b; b.bar = bar; b.x = xb_xcc_id(); b.st = st;
    if (threadIdx.x == 0) (void)xb_add(&bar[XB_XCNT(b.x)], 1u);
    return b;
}
__device__ __forceinline__ void xcd_barrier_complete(GAS unsigned* bar, unsigned x, unsigned& nloc, unsigned& nx) {
    const unsigned G = gridDim.x * gridDim.y * gridDim.z;
    unsigned sum, cnt, mine, sp = 0u;
    for (;;) {
        sum = 0u; cnt = 0u; mine = 0u;
#pragma unroll
        for (unsigned j = 0; j < 16; ++j) { const unsigned c = xb_ld(&bar[XB_XCNT(j)]); sum += c; cnt += (c > 0u) ? 1u : 0u; mine = (j == x) ? c : mine; }
        if (sum == G) break;
        __builtin_amdgcn_s_sleep(1);
        if ((++sp & 255u) == 0u) { if (xb_ld(&bar[XB_TMO])) break; if (sp > XB_SPIN_CAP) { xb_add(&bar[XB_TMO], 1u); break; } }
    }
    nloc = mine > 0u ? mine : 1u; nx = cnt > 0u ? cnt : 1u;
}
__device__ __noinline__ void xcd_barrier_leader(GAS unsigned* bar, unsigned x, volatile LAS unsigned* st) {
    __builtin_amdgcn_s_waitcnt(0);
    unsigned nloc = st[0], nx = st[1];
    if (nloc == 0u) { xcd_barrier_complete(bar, x, nloc, nx); st[0] = nloc; st[1] = nx; }
    const unsigned old = xb_add(&bar[XB_XSUB(x)], 1u);
    const unsigned gen = old / nloc;
    if (old + 1u == (gen + 1u) * nloc) {
        __builtin_amdgcn_fence(__ATOMIC_RELEASE, "agent");
        asm volatile("s_waitcnt vmcnt(0)" ::: "memory");
        const unsigned og = xb_add(&bar[XB_TOP], 1u);
        const unsigned tg = og / nx;
        if (og + 1u == (tg + 1u) * nx) xb_add(&bar[XB_TOPGEN], 1u);
        else XB_SPIN(xb_ld(&bar[XB_TOPGEN]) == tg, bar);
        __builtin_amdgcn_fence(__ATOMIC_ACQUIRE, "agent");
        xb_add(&bar[XB_XGEN(x)], 1u);
        asm volatile("s_waitcnt vmcnt(0)" ::: "memory");
    } else {
        XB_SPIN(xb_ld(&bar[XB_XGEN(x)]) == gen, bar);
        __builtin_amdgcn_fence(__ATOMIC_ACQUIRE, "agent");
        asm volatile("s_waitcnt vmcnt(0)" ::: "memory");
    }
}
__device__ __forceinline__ void xcd_barrier(const XcdBarrier& b) {
    asm volatile("s_waitcnt vmcnt(0)" ::: "memory");
    __syncthreads();
    if (threadIdx.x == 0) xcd_barrier_leader((GAS unsigned*)b.bar, b.x, b.st);
    __syncthreads();
}

namespace pg8 {
constexpr int BM = 256, BK = 64, HALF = 128, HTB = HALF * BK * 2, NXCD = 8, WGM = 8;
__host__ __device__ __forceinline__ int lds_byte(int r, int c) { const int st = (r >> 4) * 2 + (c >> 5), rr = r & 15, cc = c & 31, ob = rr * 64 + cc * 2; return st * 1024 + (ob ^ (((ob >> 9) & 1) << 5)); }
__host__ __device__ __forceinline__ void stage_rc(int b, int& R, int& C) { const int st = b / 1024, sb = b % 1024, swz = sb ^ (((sb >> 9) & 1) << 5); R = (st >> 1) * 16 + swz / 64; C = (st & 1) * 32 + (swz % 64) / 2; }
struct Unit { const char* A; const char* B; int pm, pn, kind, aux, aux2; };
__device__ __forceinline__ void tile_of(int L, int nM, int nN, int& pm, int& pn) {
    const int nwg = nM * nN; int wgid = L; { const int q = nwg / NXCD, r = nwg % NXCD, xcd = wgid % NXCD, off = wgid / NXCD; wgid = (xcd < r ? xcd * (q + 1) : r * (q + 1) + (xcd - r) * q) + off; }
    const int nig = WGM * nN, gid = wgid / nig, fm = gid * WGM, gsz = (nM - fm) < WGM ? (nM - fm) : WGM;
    pm = fm + ((wgid % nig) % gsz); pn = (wgid % nig) / gsz;
}
__device__ __forceinline__ void dma4(const void* g, LAS void* l) { __builtin_amdgcn_global_load_lds((const unsigned*)g, (LAS unsigned*)l, 4, 0, 0); }
typedef int v8i __attribute__((ext_vector_type(8)));
typedef unsigned long long u64x2_t __attribute__((ext_vector_type(2)));
typedef int v4i __attribute__((ext_vector_type(4)));
__device__ __forceinline__ v8i cat8(bf16x8 lo, bf16x8 hi) { const v4i a = __builtin_bit_cast(v4i, lo), b = __builtin_bit_cast(v4i, hi); return __builtin_shufflevector(a, b, 0, 1, 2, 3, 4, 5, 6, 7); }

template <class P>
__device__ __forceinline__ void gemm_phase(LAS unsigned char* lds, LAS unsigned char* tab, const P& S) {
    int tid_l = threadIdx.x; asm volatile("" : "+v"(tid_l));
    const int tid = tid_l, wid = __builtin_amdgcn_readfirstlane(tid >> 6), lane = tid & 63, wr = wid >> 2, wc = wid & 3, fr = lane & 15, fq = lane >> 4;
    const int nt = S.nt;
    int Rr[2], Cc[2];
#pragma unroll
    for (int i = 0; i < 2; ++i) stage_rc(tid * 16 + i * 8192, Rr[i], Cc[i]);
    unsigned voffB[2], voffA[2][2];
#pragma unroll
    for (int i = 0; i < 2; ++i) { voffB[i] = (unsigned)Rr[i] * S.pitchB + (unsigned)Cc[i] * 2u;
#pragma unroll
        for (int h = 0; h < 2; ++h) voffA[h][i] = (unsigned)(HALF * h + Rr[i]) * S.pitchA + (unsigned)Cc[i] * 2u; }
    const size_t kstep = (size_t)(BK * 2);
    const size_t hstepB = (size_t)HALF * S.pitchB;
    const unsigned ldsw = (unsigned)wid * 1024u;
    constexpr int FSTEP = 8, KOFF = 1024;
    const int aoff = lds_byte(wr * 64 + fr, fq * FSTEP), boff = lds_byte(wc * 32 + fr, fq * FSTEP);
    LAS unsigned* idtab = (LAS unsigned*)tab;
#define PG8_SA(b, h) (((b) * 2 + (h)) * HTB)
#define PG8_SB(b, h) ((4 + (b) * 2 + (h)) * HTB)
#define PG8_STAGE(bufoff, gbase, voff) do { _Pragma("unroll") for (int _i = 0; _i < 2; ++_i) { unsigned _vo = (voff)[_i]; asm volatile("" : "+v"(_vo)); \
        __builtin_amdgcn_global_load_lds((const unsigned*)((const char*)(gbase) + _vo), (LAS unsigned*)(lds + (bufoff) + ldsw + _i * 8192), 16, 0, 0); } } while (0)
#define PG8_LDA(dst, b, h) do { _Pragma("unroll") for (int m = 0; m < 4; ++m) _Pragma("unroll") for (int k = 0; k < 2; ++k) dst[m][k] = *(const LAS bf16x8*)(lds + PG8_SA(b, h) + aoff + m * 2048 + k * KOFF); } while (0)
#define PG8_LDB(dst, b, h) do { _Pragma("unroll") for (int n = 0; n < 2; ++n) _Pragma("unroll") for (int k = 0; k < 2; ++k) dst[n][k] = *(const LAS bf16x8*)(lds + PG8_SB(b, h) + boff + n * 2048 + k * KOFF); } while (0)
#define PG8_MMA(ai, bj, At, Bt) do { __builtin_amdgcn_s_setprio(1); _Pragma("unroll") for (int m = 0; m < 4; ++m) _Pragma("unroll") for (int n = 0; n < 2; ++n) { \
        if constexpr (P::FP8) acc[ai][bj][m][n] = __builtin_amdgcn_mfma_scale_f32_16x16x128_f8f6f4(pg8::cat8(Bt[n][0], Bt[n][1]), pg8::cat8(At[m][0], At[m][1]), acc[ai][bj][m][n], 0, 0, 0, 0, 0, 0); \
        else { _Pragma("unroll") for (int k = 0; k < 2; ++k) acc[ai][bj][m][n] = __builtin_amdgcn_mfma_f32_16x16x32_bf16(Bt[n][k], At[m][k], acc[ai][bj][m][n], 0, 0, 0); } } \
        __builtin_amdgcn_s_setprio(0); } while (0)
#define PG8_WAIT_V(n) asm volatile("s_waitcnt vmcnt(" #n ")" ::: "memory")
#define PG8_WAIT_L(n) asm volatile("s_waitcnt lgkmcnt(" #n ")" ::: "memory")
#define PG8_BAR __builtin_amdgcn_s_barrier()
#define PG8_SCHED __builtin_amdgcn_sched_barrier(0)
    LAS unsigned* ulist = (LAS unsigned*)(tab + 12288);
    if (tid < 32) { Unit t_; t_.A = nullptr; t_.B = nullptr; t_.pm = t_.pn = t_.kind = t_.aux = t_.aux2 = 0; const bool ok_ = S.next(tid, t_);
        LAS unsigned* e_ = ulist + tid * 12; const u64 a_ = (u64)(size_t)t_.A, b_ = (u64)(size_t)t_.B;
        e_[0] = ok_ ? 1u : 0u; e_[1] = (unsigned)t_.pm; e_[2] = (unsigned)t_.pn; e_[3] = (unsigned)t_.kind; e_[4] = (unsigned)t_.aux; e_[5] = (unsigned)t_.aux2;
        e_[6] = (unsigned)a_; e_[7] = (unsigned)(a_ >> 32); e_[8] = (unsigned)b_; e_[9] = (unsigned)(b_ >> 32); }
    asm volatile("s_waitcnt lgkmcnt(0)" ::: "memory"); __builtin_amdgcn_s_barrier(); asm volatile("" ::: "memory");
#define PG8_FETCH(i_, u_, ok_) do { const LAS u32x4* e4_ = (const LAS u32x4*)(ulist + (i_) * 12); const u32x4 x0_ = e4_[0], x1_ = e4_[1], x2_ = e4_[2]; \
        (ok_) = __builtin_amdgcn_readfirstlane(x0_.x) != 0; (u_).pm = __builtin_amdgcn_readfirstlane(x0_.y); (u_).pn = __builtin_amdgcn_readfirstlane(x0_.z); (u_).kind = __builtin_amdgcn_readfirstlane(x0_.w); \
        (u_).aux = __builtin_amdgcn_readfirstlane(x1_.x); (u_).aux2 = __builtin_amdgcn_readfirstlane(x1_.y); \
        (u_).A = (const char*)(size_t)(((u64)(unsigned)__builtin_amdgcn_readfirstlane(x1_.w) << 32) | (unsigned)__builtin_amdgcn_readfirstlane(x1_.z)); \
        (u_).B = (const char*)(size_t)(((u64)(unsigned)__builtin_amdgcn_readfirstlane(x2_.y) << 32) | (unsigned)__builtin_amdgcn_readfirstlane(x2_.x)); } while (0)
    Unit cur, nxt; int ui = 0;
    { bool ok0; PG8_FETCH(0, cur, ok0); if (!ok0) return; }
    f32x4 acc[2][2][4][2];
#pragma unroll
    for (int a = 0; a < 2; ++a)
#pragma unroll
        for (int b = 0; b < 2; ++b)
#pragma unroll
            for (int m = 0; m < 4; ++m)
#pragma unroll
                for (int n = 0; n < 2; ++n) acc[a][b][m][n] = (f32x4){0.f, 0.f, 0.f, 0.f};
    bf16x8 At[4][2], B0[2][2], B1[2][2];
    const char* cA = cur.A; const char* cB = cur.B;
    if constexpr (P::GATHER) {
        if (wid < 4) dma4(S.id_src(cur, wid * 64 + lane), idtab + wid * 64);
        PG8_WAIT_V(0); PG8_BAR; asm volatile("" ::: "memory");
#pragma unroll
        for (int h = 0; h < 2; ++h)
#pragma unroll
            for (int i = 0; i < 2; ++i) voffA[h][i] = idtab[HALF * h + Rr[i]] * S.pitchA + (unsigned)Cc[i] * 2u;
        PG8_WAIT_L(0); asm volatile("" ::: "memory");
    }
    PG8_STAGE(PG8_SB(0, 0), cB, voffB); PG8_STAGE(PG8_SB(0, 1), cB + hstepB, voffB); PG8_STAGE(PG8_SA(0, 0), cA, voffA[0]); PG8_STAGE(PG8_SA(0, 1), cA, voffA[1]);
    if (wr == 1) PG8_BAR;
    PG8_WAIT_V(2); PG8_BAR;
    PG8_STAGE(PG8_SB(1, 0), cB + kstep, voffB); PG8_STAGE(PG8_SA(1, 0), cA + kstep, voffA[0]); PG8_STAGE(PG8_SB(1, 1), cB + hstepB + kstep, voffB);
    PG8_WAIT_V(6); PG8_BAR;
    for (;;) {
        bool has_next; PG8_FETCH(ui + 1, nxt, has_next);
        const int slot = ui & 1;
        S.dma_tables(cur, tab, slot, wid, lane);
        if constexpr (P::GATHER) { if (has_next && wid < 4) dma4(S.id_src(nxt, wid * 64 + lane), idtab + (slot ^ 1) * 256 + wid * 64); }
        const char* nA = has_next ? nxt.A : cA; const char* nB = has_next ? nxt.B : cB;
        for (int t = 0; t < nt; t += 2) {
            const bool last = (t == nt - 2);
            const char* a1 = cA + (size_t)(t + 1) * kstep;
            const char* a2 = last ? nA : cA + (size_t)(t + 2) * kstep; const char* b2 = last ? nB : cB + (size_t)(t + 2) * kstep;
            const char* a3 = a2 + kstep; const char* b3 = b2 + kstep;
            PG8_LDB(B0, 0, 0); PG8_LDB(B1, 0, 1); PG8_SCHED; PG8_LDA(At, 0, 0); PG8_STAGE(PG8_SA(1, 1), a1, voffA[1]);
            if constexpr (!P::GATHER && P::FP8) { if (last && has_next) asm volatile("s_nop 0"); }
            if constexpr (P::GATHER) {
                if (last && has_next) {
                    int t2 = tid; asm volatile("" : "+v"(t2));
#pragma unroll
                    for (int i = 0; i < 2; ++i) { int R2, C2; stage_rc(t2 * 16 + i * 8192, R2, C2);
#pragma unroll
                        for (int h = 0; h < 2; ++h) voffA[h][i] = idtab[(slot ^ 1) * 256 + HALF * h + R2] * S.pitchA + (unsigned)C2 * 2u; }
                }
            }
            PG8_WAIT_V(8); PG8_WAIT_L(0); PG8_BAR; PG8_MMA(0, 0, At, B0); PG8_MMA(0, 1, At, B1); PG8_BAR; PG8_SCHED;
            PG8_LDA(At, 0, 1); PG8_STAGE(PG8_SB(0, 0), b2, voffB); PG8_STAGE(PG8_SB(0, 1), b2 + hstepB, voffB); PG8_STAGE(PG8_SA(0, 0), a2, voffA[0]);
            PG8_WAIT_V(8); PG8_WAIT_L(0); PG8_BAR; PG8_MMA(1, 0, At, B0); PG8_MMA(1, 1, At, B1); PG8_BAR; PG8_SCHED;
            PG8_LDB(B0, 1, 0); PG8_LDB(B1, 1, 1); PG8_SCHED; PG8_LDA(At, 1, 0); PG8_STAGE(PG8_SA(0, 1), a2, voffA[1]);
            PG8_WAIT_V(8); PG8_WAIT_L(0); PG8_BAR; PG8_MMA(0, 0, At, B0); PG8_MMA(0, 1, At, B1); PG8_BAR; PG8_SCHED;
            PG8_LDA(At, 1, 1); PG8_STAGE(PG8_SB(1, 0), b3, voffB); PG8_STAGE(PG8_SB(1, 1), b3 + hstepB, voffB); PG8_STAGE(PG8_SA(1, 0), a3, voffA[0]);
            PG8_WAIT_V(8); PG8_WAIT_L(0); PG8_BAR; PG8_MMA(1, 0, At, B0); PG8_MMA(1, 1, At, B1); PG8_BAR; PG8_SCHED;
        }
        if constexpr (P::ALIGN) { if (wr == 0) PG8_BAR; }
        S.epi(acc, cur, tab, slot, wr, wc, fr, fq);
        if (!has_next) break;
#pragma unroll
        for (int a = 0; a < 2; ++a)
#pragma unroll
            for (int b = 0; b < 2; ++b)
#pragma unroll
                for (int m = 0; m < 4; ++m)
#pragma unroll
                    for (int n = 0; n < 2; ++n) { u64 z0, z1; asm volatile("v_mov_b64 %0, 0" : "=v"(z0)); asm volatile("v_mov_b64 %0, 0" : "=v"(z1)); const u64x2_t z = {z0, z1}; acc[a][b][m][n] = __builtin_bit_cast(f32x4, z); }
        cur = nxt; cA = nA; cB = nB; ++ui;
        if constexpr (P::ALIGN) { if (wr == 1) PG8_BAR; }
    }
    PG8_WAIT_V(0);
    if constexpr (!P::ALIGN) { if (wr == 0) PG8_BAR; }
    PG8_BAR;
#undef PG8_FETCH
#undef PG8_SA
#undef PG8_SB
#undef PG8_STAGE
#undef PG8_LDA
#undef PG8_LDB
#undef PG8_MMA
#undef PG8_WAIT_V
#undef PG8_WAIT_L
#undef PG8_BAR
#undef PG8_SCHED
}
}
#ifndef ALIGN_LIGHT
#define ALIGN_LIGHT true
#endif
using pg8::Unit;
typedef f32x4 Acc[2][2][4][2];

struct Args { const float* in[45]; float* out; unsigned char* ws; int ph_lo, ph_hi, dummy, pad; };
enum { I_X = 0, I_META = 1, I_T5 = 2, I_L0 = 3, I_L1 = 13, I_L2 = 24, I_L3 = 34 };

struct Frame {
    LAS unsigned char* lds; LAS unsigned char* tab;
    int tid, lane, wave, G, bx;
    unsigned char* ws; float* out; bf16_t* hb; unsigned* ctl;
};
__device__ __forceinline__ u64* ssq_buf(const Frame& F, int i) { return (u64*)(F.ws + WS_CTL + CTL_SSQ + (size_t)i * SSQ_BYTES); }
__device__ __forceinline__ u64 ssq_fix(float s) { return (u64)(s * SSQ_SCALE); }
__device__ __forceinline__ float ssq_val(u64 v) { return (float)v * SSQ_INV; }

struct QkvPolicy {
    static constexpr bool GATHER = false, ALIGN = ALIGN_LIGHT, FP8 = false;
    int nt; unsigned pitchA, pitchB;
    int G, c, nN, QT;
    const char* hb; const char* W;
    const u64* ssq;
    bf16_t* Q; bf16_t* K; bf16_t* VT; int kpitch, nQ;
    const LAS float* gains;
    __device__ __forceinline__ bool next(int i, Unit& u) const {
        const long L = (long)i * G + c; if (L >= (long)NPANEL * nN) return false;
        int pm, pn; pg8::tile_of((int)L, NPANEL, nN, pm, pn);
        u.pm = pm; u.pn = pn; u.kind = pn < QT ? 0 : 1; u.aux = 0; u.aux2 = 0;
        const char* a = hb + (size_t)pm * 256 * 2048; const char* w = W + (size_t)pn * 256 * 2048;
        u.A = u.kind ? w : a; u.B = u.kind ? a : w; return true;
    }
    __device__ __forceinline__ void dma_tables(const Unit& u, LAS unsigned char* tab, int slot, int wid, int lane) const {
        pg8::dma4((const unsigned*)(ssq + u.pm * 256) + wid * 64 + lane, (LAS unsigned*)(tab + 2048) + slot * 512 + wid * 64);
    }
    __device__ __forceinline__ void epi(const Acc& acc, const Unit& u, LAS unsigned char* tab, int slot, int wr, int wc, int fr, int fq) const {
        const LAS u64* et = (const LAS u64*)(tab + 2048) + slot * 256;
        if (u.kind == 0) {
            const bool isq = u.pn < nQ;
            const LAS float* gp = gains + (isq ? 0 : 64) + 8 * fq;
            const f32x4 g00 = *(const LAS f32x4*)(gp), g01 = *(const LAS f32x4*)(gp + 4), g10 = *(const LAS f32x4*)(gp + 32), g11 = *(const LAS f32x4*)(gp + 36);
            const int hk = (u.pn - nQ) * 4 + wc, nhk = kpitch >> 6;
#pragma unroll
            for (int ai = 0; ai < 2; ++ai)
#pragma unroll
                for (int m = 0; m < 4; ++m) {
                    const int row = ai * 128 + wr * 64 + m * 16 + fr;
                    const float rstd = fast_rsqrt(ssq_val(et[row]) * (1.0f / 1024.0f) + EPS);
                    f32x4 v00 = acc[ai][0][m][0] * rstd, v01 = acc[ai][0][m][1] * rstd, v10 = acc[ai][1][m][0] * rstd, v11 = acc[ai][1][m][1] * rstd;
                    const f32x4 sq4 = v00 * v00 + v01 * v01 + v10 * v10 + v11 * v11;
                    float ss = (sq4[0] + sq4[1]) + (sq4[2] + sq4[3]);
                    ss += __shfl_xor(ss, 16); ss += __shfl_xor(ss, 32);
                    const float hn = fast_rsqrt(ss * (1.0f / 64.0f) + EPS);
                    v00 = v00 * g00 * hn; v01 = v01 * g01 * hn; v10 = v10 * g10 * hn; v11 = v11 * g11 * hn;
                    const int tok = u.pm * 256 + row;
                    bf16_t* rp = isq ? Q + (size_t)tok * 1024 + (u.pn * 4 + wc) * 64 + 8 * fq
                                     : K + ((((size_t)(tok >> 3) * nhk + hk) * 2) * 4 + fq) * 64 + (tok & 7) * 8;
                    const int o1 = isq ? 32 : 256;
                    u32x4 w0; w0.x = cvt_pk_bf16(v00[0], v00[1]); w0.y = cvt_pk_bf16(v00[2], v00[3]); w0.z = cvt_pk_bf16(v01[0], v01[1]); w0.w = cvt_pk_bf16(v01[2], v01[3]);
                    u32x4 w1; w1.x = cvt_pk_bf16(v10[0], v10[1]); w1.y = cvt_pk_bf16(v10[2], v10[3]); w1.z = cvt_pk_bf16(v11[0], v11[1]); w1.w = cvt_pk_bf16(v11[2], v11[3]);
                    *(u32x4*)(rp) = w0; *(u32x4*)(rp + o1) = w1;
                }
        } else {
            f32x4 rs[2][2];
#pragma unroll
            for (int bj = 0; bj < 2; ++bj)
#pragma unroll
                for (int n = 0; n < 2; ++n) {
#pragma unroll
                    for (int j = 0; j < 4; ++j) rs[bj][n][j] = fast_rsqrt(ssq_val(et[bj * 128 + wc * 32 + n * 16 + 4 * fq + j]) * (1.0f / 1024.0f) + EPS); }
#pragma unroll
            for (int ai = 0; ai < 2; ++ai)
#pragma unroll
                for (int m = 0; m < 4; ++m) {
                    const int hd = (u.pn - QT) * 256 + ai * 128 + wr * 64 + m * 16 + fr, hk = hd >> 6, d = hd & 63, nhk = kpitch >> 6;
#pragma unroll
                    for (int bj = 0; bj < 2; ++bj)
#pragma unroll
                        for (int n = 0; n < 2; ++n) { const f32x4 v = acc[ai][bj][m][n] * rs[bj][n]; u32x2 w; w.x = cvt_pk_bf16(v[0], v[1]); w.y = cvt_pk_bf16(v[2], v[3]);
                            const int c0 = u.pm * 256 + bj * 128 + wc * 32 + n * 16 + 4 * fq;
                            *(u32x2*)(VT + ((size_t)(c0 >> 3) * nhk + hk) * 512 + (((d >> 4) * 2 + ((c0 >> 2) & 1)) * 16 + (d & 15)) * 4) = w; }
                }
        }
    }
};

template <bool F8 = false>
struct ResPolicy {
    static constexpr bool GATHER = false, ALIGN = true, FP8 = F8;
    int nt; unsigned pitchA, pitchB;
    int G, c;
    const char* A; const char* W;
    bf16_t* hb; u64* ssq_out; bf16_t* dmy;
    unsigned char* hb8;
    __device__ __forceinline__ bool next(int i, Unit& u) const {
        const long L = (long)i * G + c; if (L >= (long)NPANEL * 4) return false;
        int pm, pn; pg8::tile_of((int)L, NPANEL, 4, pm, pn);
        u.pm = pm; u.pn = pn; u.kind = 0; u.aux = 0; u.aux2 = 0;
        u.A = A + (size_t)pm * 256 * pitchA; u.B = W + (size_t)pn * 256 * pitchB; return true;
    }
    __device__ __forceinline__ void dma_tables(const Unit&, LAS unsigned char*, int, int, int) const {}
    __device__ __forceinline__ void epi(const Acc& acc, const Unit& u, LAS unsigned char*, int, int wr, int wc, int fr, int fq) const {
        const int col = u.pn * 256 + wc * 32 + 8 * fq;
#pragma unroll
        for (int ai = 0; ai < 2; ++ai) {
            u32x4 bv[4][2];
#pragma unroll
            for (int m = 0; m < 4; ++m) { const bf16_t* bp = hb + (size_t)(u.pm * 256 + ai * 128 + wr * 64 + m * 16 + fr) * D + col;
#pragma unroll
                for (int bj = 0; bj < 2; ++bj) bv[m][bj] = *(const u32x4*)(bp + bj * 128); }
            __builtin_amdgcn_sched_barrier(0);
#pragma unroll
            for (int m = 0; m < 4; ++m) {
                const int row = u.pm * 256 + ai * 128 + wr * 64 + m * 16 + fr;
                bf16_t* hp = (dmy ? dmy + (size_t)(row & 0xFFF) * D : hb + (size_t)row * D) + col;
                f32x2 ss2 = {0.f, 0.f};
#pragma unroll
                for (int bj = 0; bj < 2; ++bj) {
                    const u32x4 b = bv[m][bj]; const f32x4 a0 = acc[ai][bj][m][0], a1 = acc[ai][bj][m][1];
                    const unsigned bw[4] = {b.x, b.y, b.z, b.w}; const f32x2 av[4] = {{a0[0], a0[1]}, {a0[2], a0[3]}, {a1[0], a1[1]}, {a1[2], a1[3]}};
                    f32x2 o[4]; u32x4 w; unsigned* wp = (unsigned*)&w;
#pragma unroll
                    for (int i = 0; i < 4; ++i) { const f32x2 hv = {__uint_as_float(bw[i] << 16), __uint_as_float(bw[i] & 0xffff0000u)}; if constexpr (F8) o[i] = hv + av[i] * (W8_INV * HID8_INV); else o[i] = hv + av[i]; ss2 = ss2 + o[i] * o[i]; wp[i] = cvt_pk_bf16(o[i].x, o[i].y); }
                    *(u32x4*)(hp + bj * 128) = w;
                    if (hb8) { int p0 = 0, p1 = 0; p0 = __builtin_amdgcn_cvt_pk_fp8_f32(o[0].x, o[0].y, p0, false); p0 = __builtin_amdgcn_cvt_pk_fp8_f32(o[1].x, o[1].y, p0, true); p1 = __builtin_amdgcn_cvt_pk_fp8_f32(o[2].x, o[2].y, p1, false); p1 = __builtin_amdgcn_cvt_pk_fp8_f32(o[3].x, o[3].y, p1, true);
                        u32x2 w8; w8.x = (unsigned)p0; w8.y = (unsigned)p1; *(u32x2*)(hb8 + (size_t)row * D + col + bj * 128) = w8; }
                }
                float ss = ss2.x + ss2.y;
                ss += __shfl_xor(ss, 16); ss += __shfl_xor(ss, 32);
                if (fq == 0) __hip_atomic_fetch_add(ssq_out + row, ssq_fix(ss), RLX_AGENT);
            }
            __builtin_amdgcn_sched_barrier(0);
        }
    }
};

template <bool MOE, bool F8 = MOE>
struct GuPolicy {
    static constexpr bool GATHER = MOE, ALIGN = ALIGN_LIGHT, FP8 = F8;
    int nt; unsigned pitchA, pitchB;
    int G, c;
    const char* hb; const char* W;
    const void* ssq;
    bf16_t* hid;
    const unsigned* rowtok; int p0, p1;
    const LAS int* ptab;
    __device__ __forceinline__ bool next(int i, Unit& u) const {
        const long L = (long)i * G + c;
        if constexpr (!MOE) {
            if (L >= (long)NPANEL * 28) return false;
            int pm, pn; pg8::tile_of((int)L, NPANEL, 28, pm, pn);
            u.pm = pm; u.pn = pn; u.kind = 0; u.aux = 0; u.aux2 = 0;
            u.A = hb + (size_t)pm * 256 * pitchA; u.B = W + (size_t)pn * 256 * pitchB; return true;
        } else {
            const int nM = p1 - p0; if (L >= (long)nM * 28) return false;
            int pm, pn; pg8::tile_of((int)L, nM, 28, pm, pn);
            const int p = p0 + pm; int e = 0;
#pragma unroll
            for (int k = 1; k <= 7; ++k) e += (p >= ptab[k]) ? 1 : 0;
            const int pbe = ptab[e], ce = ptab[9 + e];
            u.pm = pm; u.pn = pn; u.kind = e; u.aux = (p - pbe) * 256; u.aux2 = ce;
            u.A = hb; u.B = W + (size_t)e * W_GU8 + (size_t)pn * 256 * 1024; return true;
        }
    }
    __device__ __forceinline__ const unsigned* id_src(const Unit& u, int i) const { int r = u.aux + i; r = r < u.aux2 ? r : u.aux2 - 1; return rowtok + (size_t)u.kind * M + r; }
    __device__ __forceinline__ void dma_tables(const Unit& u, LAS unsigned char* tab, int slot, int wid, int lane) const {
        if constexpr (!MOE) pg8::dma4((const unsigned*)((const u64*)ssq + u.pm * 256) + wid * 64 + lane, (LAS unsigned*)(tab + 2048) + slot * 512 + wid * 64);
        else if (wid >= 4) { int r = u.aux + (wid - 4) * 64 + lane; r = r < u.aux2 ? r : u.aux2 - 1; pg8::dma4((const float*)ssq + (size_t)u.kind * M + r, (LAS float*)(tab + 2048) + slot * 256 + (wid - 4) * 64); }
    }
    __device__ __forceinline__ void epi(const Acc& acc, const Unit& u, LAS unsigned char* tab, int slot, int wr, int wc, int fr, int fq) const {
#pragma unroll
        for (int ai = 0; ai < 2; ++ai)
#pragma unroll
            for (int m = 0; m < 4; ++m) {
                const int row = ai * 128 + wr * 64 + m * 16 + fr;
                float sq;
                if constexpr (MOE) sq = ((const LAS float*)(tab + 2048) + slot * 256)[row]; else sq = ssq_val(((const LAS u64*)(tab + 2048) + slot * 256)[row]);
                const float rstd = fast_rsqrt(sq * (1.0f / 1024.0f) + EPS);
                const float rs_ = F8 ? rstd * W8_INV : rstd;
                const float c1 = -rs_ * LOG2E;
                const float kk = (sq * (1.0f / 1024.0f) + EPS) * (F8 ? W8_SCALE * W8_SCALE * HID8_INV : 1.0f);
                float o[8];
#pragma unroll
                for (int n = 0; n < 2; ++n)
#pragma unroll
                    for (int j = 0; j < 4; j += 2) {
                        const f32x2 g = {acc[ai][0][m][n][j], acc[ai][0][m][n][j + 1]}, up = {acc[ai][1][m][n][j], acc[ai][1][m][n][j + 1]};
                        const f32x2 t = g * c1; f32x2 e; e.x = fast_exp2(t.x); e.y = fast_exp2(t.y);
                        const f32x2 kk2 = {kk, kk}; const f32x2 d = e * kk2 + kk2; f32x2 r; r.x = fast_rcp(d.x); r.y = fast_rcp(d.y);
                        const f32x2 v = (g * up) * r;
                        o[n * 4 + j] = v.x; o[n * 4 + j + 1] = v.y; }
                if constexpr (F8) {
                    int q0 = 0, q1 = 0; q0 = __builtin_amdgcn_cvt_pk_fp8_f32(o[0], o[1], q0, false); q0 = __builtin_amdgcn_cvt_pk_fp8_f32(o[2], o[3], q0, true); q1 = __builtin_amdgcn_cvt_pk_fp8_f32(o[4], o[5], q1, false); q1 = __builtin_amdgcn_cvt_pk_fp8_f32(o[6], o[7], q1, true);
                    u32x2 w8; w8.x = (unsigned)q0; w8.y = (unsigned)q1;
                    *(u32x2*)((unsigned char*)hid + (size_t)(u.pm * 256 + row) * FF + u.pn * 128 + wc * 32 + 8 * fq) = w8;
                } else {
                u32x4 w; w.x = cvt_pk_bf16(o[0], o[1]); w.y = cvt_pk_bf16(o[2], o[3]); w.z = cvt_pk_bf16(o[4], o[5]); w.w = cvt_pk_bf16(o[6], o[7]);
                *(u32x4*)(hid + (size_t)(u.pm * 256 + row) * FF + u.pn * 128 + wc * 32 + 8 * fq) = w; }
            }
    }
};

struct MoeDownPolicy {
    static constexpr bool GATHER = false, ALIGN = ALIGN_LIGHT, FP8 = true;
    int nt; unsigned pitchA, pitchB;
    int G, c;
    const char* hid; const char* W;
    const unsigned* rowslot; const float* rowgate; bf16_t* ys;
    int p0, p1; const LAS int* ptab;
    __device__ __forceinline__ bool next(int i, Unit& u) const {
        const long L = (long)i * G + c; const int nM = p1 - p0; if (L >= (long)nM * 4) return false;
        int pm, pn; pg8::tile_of((int)L, nM, 4, pm, pn);
        const int p = p0 + pm; int e = 0;
#pragma unroll
        for (int k = 1; k <= 7; ++k) e += (p >= ptab[k]) ? 1 : 0;
        const int pbe = ptab[e], ce = ptab[9 + e];
        u.pm = pm; u.pn = pn; u.kind = e; u.aux = (p - pbe) * 256; u.aux2 = ce;
        u.A = hid + (size_t)pm * 256 * pitchA; u.B = W + (size_t)e * W_D8 + (size_t)pn * 256 * pitchB; return true;
    }
    __device__ __forceinline__ void dma_tables(const Unit& u, LAS unsigned char* tab, int slot, int wid, int lane) const {
        int r = u.aux + (wid & 3) * 64 + lane; r = r < u.aux2 ? r : u.aux2 - 1;
        if (wid < 4) pg8::dma4(rowslot + (size_t)u.kind * M + r, (LAS unsigned*)(tab + 6144) + slot * 256 + wid * 64);
        else pg8::dma4(rowgate + (size_t)u.kind * M + r, (LAS float*)(tab + 8192) + slot * 256 + (wid - 4) * 64);
    }
    __device__ __forceinline__ void epi(const Acc& acc, const Unit& u, LAS unsigned char* tab, int slot, int wr, int wc, int fr, int fq) const {
        const LAS unsigned* es = (const LAS unsigned*)(tab + 6144) + slot * 256;
        const LAS float* eg = (const LAS float*)(tab + 8192) + slot * 256;
#pragma unroll
        for (int ai = 0; ai < 2; ++ai)
#pragma unroll
            for (int m = 0; m < 4; ++m) {
                const int row = ai * 128 + wr * 64 + m * 16 + fr;
                if (u.aux + row < u.aux2) {
                    const unsigned sl = es[row]; const float g = eg[row] * (W8_INV * HID8_INV);
                    bf16_t* rp = ys + (size_t)sl * D + u.pn * 256 + wc * 32 + 8 * fq;
#pragma unroll
                    for (int bj = 0; bj < 2; ++bj) { const f32x4 v0 = acc[ai][bj][m][0] * g, v1 = acc[ai][bj][m][1] * g;
                        u32x4 w; w.x = cvt_pk_bf16(v0[0], v0[1]); w.y = cvt_pk_bf16(v0[2], v0[3]); w.z = cvt_pk_bf16(v1[0], v1[1]); w.w = cvt_pk_bf16(v1[2], v1[3]); *(u32x4*)(rp + bj * 128) = w; }
                }
            }
    }
};

struct WDesc { const float* src; const float* gain; bf16_t* dst; int K, N, map, ibase; };
__device__ __forceinline__ int qk_perm(int s) { return 128 * ((s >> 5) & 1) + 32 * (s >> 6) + 16 * ((s >> 2) & 1) + 4 * ((s >> 3) & 3) + (s & 3); }
__device__ __forceinline__ int dst_row(int map, int c) {
    if (map == 1) return c < 2048 ? (c & ~255) + qk_perm(c & 255) : c;
    if (map == 2) return c < 1280 ? (c & ~255) + qk_perm(c & 255) : c;
    if (map == 3 || map == 4) { const int t = c >> 7, w = c & 127; return 256 * t + (map == 4 ? 128 : 0) + 32 * (w >> 5) + 16 * ((w >> 2) & 1) + 4 * ((w >> 3) & 3) + (w & 3); }
    if (map == 5) return (c & ~31) + 16 * ((c >> 2) & 1) + 4 * ((c >> 3) & 3) + (c & 3);
    return c;
}
__device__ __forceinline__ void transpose_item(const GAS float* src, const GAS float* gain, GAS bf16_t* dst, int K, int N, int map, LAS float* scr, int item, int lane) {
    const int nblk = N / 64, kb = item / nblk, nb = item % nblk, k0 = 64 * kb, n0 = 64 * nb;
    const int c = lane & 15, r = lane >> 4;
    f32x4 v[16];
#pragma unroll
    for (int i = 0; i < 16; ++i) v[i] = *(const GAS f32x4*)(src + (size_t)(k0 + 4 * i + r) * N + n0 + 4 * c);
#pragma unroll
    for (int i = 0; i < 16; ++i) { const int kk = 4 * i + r; const float g = gain ? gain[k0 + kk] : 1.0f; LAS float* p = scr + kk * 65 + 4 * c; p[0] = v[i].x * g; p[1] = v[i].y * g; p[2] = v[i].z * g; p[3] = v[i].w * g; }
    asm volatile("s_waitcnt lgkmcnt(0)" ::: "memory");
    const int c8 = lane & 7;
#pragma unroll
    for (int j = 0; j < 8; ++j) { const int n = (lane >> 3) + 8 * j; const LAS float* p = scr + (8 * c8) * 65 + n;
        if (map >= 16) { int q0 = 0, q1 = 0;
            q0 = __builtin_amdgcn_cvt_pk_fp8_f32(p[0 * 65] * W8_SCALE, p[1 * 65] * W8_SCALE, q0, false); q0 = __builtin_amdgcn_cvt_pk_fp8_f32(p[2 * 65] * W8_SCALE, p[3 * 65] * W8_SCALE, q0, true);
            q1 = __builtin_amdgcn_cvt_pk_fp8_f32(p[4 * 65] * W8_SCALE, p[5 * 65] * W8_SCALE, q1, false); q1 = __builtin_amdgcn_cvt_pk_fp8_f32(p[6 * 65] * W8_SCALE, p[7 * 65] * W8_SCALE, q1, true);
            u32x2 o8; o8.x = (unsigned)q0; o8.y = (unsigned)q1; *(GAS u32x2*)((GAS unsigned char*)dst + (size_t)dst_row(map - 16, n0 + n) * K + k0 + 8 * c8) = o8; }
        else {
        u32x4 o; o.x = cvt_pk_bf16(p[0 * 65], p[1 * 65]); o.y = cvt_pk_bf16(p[2 * 65], p[3 * 65]); o.z = cvt_pk_bf16(p[4 * 65], p[5 * 65]); o.w = cvt_pk_bf16(p[6 * 65], p[7 * 65]);
        *(GAS u32x4*)(dst + (size_t)dst_row(map, n0 + n) * K + k0 + 8 * c8) = o; } }
    asm volatile("s_waitcnt lgkmcnt(0)" ::: "memory");
}
constexpr int N_WDESC = 62;
__device__ __forceinline__ void prologue(Frame& F, const __attribute__((address_space(4))) Args* a) {
    LAS WDesc* wd = (LAS WDesc*)(F.lds + 8 * 16640);
    LAS int* wtot = (LAS int*)(F.lds + 8 * 16640 + N_WDESC * sizeof(WDesc));
    static_assert(8 * 16640 + N_WDESC * sizeof(WDesc) + 16 <= (size_t)GAIN_OFF, "prologue LDS");
    if (F.tid == 0) {
        int n = 0, ib = 0;
#define ADDW(src_, gain_, dst_, K_, N_, map_) do { wd[n].src = (src_); wd[n].gain = (gain_); wd[n].dst = (bf16_t*)(dst_); wd[n].K = (K_); wd[n].N = (N_); wd[n].map = (map_); wd[n].ibase = ib; ++n; ib += ((K_) / 64) * ((N_) / 64); } while (0)
        for (int p = 0; p < 2; ++p) {
            const int na0 = p ? I_L2 : I_L0, sw0 = p ? I_L3 : I_L1;
#define NA_(i) (a->in[na0 + (i)])
#define SW_(i) (a->in[sw0 + (i)])
            unsigned char* wb = F.ws + WS_W + (size_t)p * WPAIR;
            ADDW(NA_(1), NA_(0), wb + WNA_QKV, 1024, 3072, 1);
            ADDW(NA_(5), (const float*)nullptr, wb + WNA_O, 1024, 1024, 5);
            ADDW(NA_(7), NA_(6), wb + WNA_GU, 1024, FF, (p >= DENSE8_FROM ? 16 : 0) + 3);
            ADDW(NA_(8), NA_(6), wb + WNA_GU, 1024, FF, (p >= DENSE8_FROM ? 16 : 0) + 4);
            ADDW(NA_(9), (const float*)nullptr, wb + WNA_D, FF, 1024, (p >= DENSE8_FROM ? 16 : 0) + 5);
            ADDW(SW_(1), SW_(0), wb + WSW_QKV, 1024, 1536, 2);
            ADDW(SW_(5), (const float*)nullptr, wb + WSW_O, 1024, 1024, 5);
            for (int e = 0; e < NE; ++e) {
                ADDW(SW_(8) + (size_t)e * 1024 * FF, SW_(6), wb + WSW_GU + (size_t)e * W_GU8, 1024, FF, 16 + 3);
                ADDW(SW_(9) + (size_t)e * 1024 * FF, SW_(6), wb + WSW_GU + (size_t)e * W_GU8, 1024, FF, 16 + 4);
                ADDW(SW_(10) + (size_t)e * FF * 1024, (const float*)nullptr, wb + WSW_D + (size_t)e * W_D8, FF, 1024, 16 + 5);
            }
        }
#undef ADDW
        *wtot = ib;
    }
    __syncthreads();
    LAS float* scr = (LAS float*)(F.lds + F.wave * 16640);
    const int gw = F.bx * 8 + F.wave, NGW = F.G * 8;
    const int total = *wtot;
    for (int it = gw; it < total; it += NGW) {
        int k = 0;
        for (int j = 1; j < N_WDESC; ++j) k += (it >= wd[j].ibase) ? 1 : 0;
        transpose_item((const GAS float*)wd[k].src, (const GAS float*)wd[k].gain, (GAS bf16_t*)wd[k].dst, wd[k].K, wd[k].N, wd[k].map, scr, it - wd[k].ibase, F.lane);
    }
    u64* ssq0 = ssq_buf(F, 0);
    for (int m = gw; m < M; m += NGW) {
        const float* src = m < NREG ? a->in[I_X] + (size_t)m * D : a->in[I_META] + (size_t)(m - NREG) * D;
        const f32x4* xr = (const f32x4*)src + F.lane;
        f32x4 v[4]; float s = 0.f;
#pragma unroll
        for (int j = 0; j < 4; ++j) { v[j] = xr[64 * j]; s += (v[j].x * v[j].x + v[j].y * v[j].y) + (v[j].z * v[j].z + v[j].w * v[j].w); }
        s = wave_sum(s);
        u32x2* o8 = (u32x2*)(F.hb + (size_t)m * D) + F.lane;
#pragma unroll
        for (int j = 0; j < 4; ++j) { u32x2 w; w.x = cvt_pk_bf16(v[j].x, v[j].y); w.y = cvt_pk_bf16(v[j].z, v[j].w); o8[64 * j] = w; }
        if (F.lane == 0) ssq0[m] = ssq_fix(s);
    }
}

struct AttnCtx {
    const bf16_t* Q; const bf16_t* K; const bf16_t* VT; bf16_t* O; int kpitch; unsigned omask;
    const LAS float* tbl;
};
constexpr int NTILE = 18;
__device__ __forceinline__ int t5_bucket_abs(int n) {
    const int big = 8 + (n >= 12) + (n >= 16) + (n >= 23) + (n >= 32) + (n >= 46) + (n >= 64) + (n >= 91);
    return n < 8 ? n : big;
}
constexpr int NA_TBL_ROW = 64, NA_TBL_HEAD = 15 * 64, SWA_TBL_HEAD = 576, SWA_T5_OFF = 16 * 576, SWA_SINK_OFF = SWA_T5_OFF + 512;
template <int TYPE>
__device__ __forceinline__ void attn_unit(const AttnCtx& X, int b, int hq, int u0, int u1, bool metaq, int lane) {
    const int q = lane & 15, kg = lane >> 4;
    const int hk = TYPE == 0 ? hq : (hq >> 2);
    constexpr int NWIN = TYPE == 0 ? 16 : 17, TMETA = NWIN, NREAL = NWIN + 1;
    int qtok0, wtok0, bidx;
    int colbase = 0, relbase = 0, wsq = 0;
    if (TYPE == 0) {
        const int r = metaq ? 0 : u0, cb = metaq ? 0 : u1;
        int rs = r - 4; rs = rs < 0 ? 0 : (rs > 24 ? 24 : rs); int ks = 16 * cb - 8; ks = ks < 0 ? 0 : (ks > 32 ? 32 : ks);
        qtok0 = metaq ? NREG : b * SEQ + r * 64 + 16 * cb; wtok0 = b * SEQ + rs * 64 + ks;
        const int qc = 16 * cb + q; wsq = qc - 8; wsq = wsq < 0 ? 0 : (wsq > 48 ? 48 : wsq);
        colbase = ks + 4 * kg;
        bidx = hq * NA_TBL_HEAD + (rs - r + 7) * NA_TBL_ROW + (colbase - qc + 15 + 16);
    } else {
        const int q0 = metaq ? 0 : 16 * u0;
        int jb = q0 - 128; jb = jb < 0 ? 0 : (jb > SEQ - 272 ? SEQ - 272 : jb);
        qtok0 = metaq ? NREG : b * SEQ + q0; wtok0 = b * SEQ + jb;
        relbase = jb + 4 * kg - q0 - q;
        bidx = hq * SWA_TBL_HEAD + relbase + 288;
        colbase = q0 + q;
    }
    const int mtok0 = NREG;
    const int nhk = X.kpitch >> 6;
    constexpr int TSTEP = 2;
    const size_t blk = (size_t)nhk * 512;
    const bf16_t* kwin = X.K + (size_t)(wtok0 >> 3) * blk + ((((size_t)(q >> 3) * nhk + hk) * 2) * 4 + kg) * 64 + (q & 7) * 8;
    const bf16_t* kmet = X.K + (size_t)(mtok0 >> 3) * blk + ((((size_t)(q >> 3) * nhk + hk) * 2) * 4 + kg) * 64 + (q & 7) * 8;
    const bf16_t* vwin = X.VT + (size_t)(wtok0 >> 3) * blk + ((size_t)(kg >> 1) * nhk + hk) * 512 + ((kg & 1) * 16 + q) * 4;
    const bf16_t* vmet = X.VT + (size_t)(mtok0 >> 3) * blk + ((size_t)(kg >> 1) * nhk + hk) * 512 + ((kg & 1) * 16 + q) * 4;
#define ATT_TOFF(t) ((size_t)(TYPE == 0 ? (8 * ((t) >> 1) + 2 * ((t) & 1)) : TSTEP * (t)) * blk)
    bf16x8 Qf[2];
    { const bf16_t* qp = X.Q + (size_t)(qtok0 + q) * 1024 + hq * 64 + 8 * kg; Qf[0] = *(const bf16x8*)qp; Qf[1] = *(const bf16x8*)(qp + 32); }
    f32x4 S[NTILE];
    f32x4 O[4];
#define ATT_LOADK(buf, t0) do { _Pragma("unroll") for (int t = 0; t < 6; ++t) if ((t0) + t < NREAL) { const bf16_t* kp = ((t0) + t == TMETA) ? kmet : kwin + ATT_TOFF((t0) + t); buf[t][0] = *(const bf16x8*)kp; buf[t][1] = *(const bf16x8*)(kp + 256); } } while (0)
#define ATT_MMAK(buf, t0) do { _Pragma("unroll") for (int t = 0; t < 6; ++t) if ((t0) + t < NREAL) { \
        f32x4 s_ = __builtin_amdgcn_mfma_f32_16x16x32_bf16(buf[t][0], Qf[0], S[(t0) + t], 0, 0, 0); S[(t0) + t] = __builtin_amdgcn_mfma_f32_16x16x32_bf16(buf[t][1], Qf[1], s_, 0, 0, 0); } } while (0)
#define ATT_VPTR(t) (((t) == TMETA) ? vmet : vwin + ATT_TOFF(t))
#define ATT_LOADV(bl, bh, s0) do { _Pragma("unroll") for (int s = 0; s < 3; ++s) { \
        _Pragma("unroll") for (int dt = 0; dt < 4; ++dt) { \
            bl[s][dt] = *(const s16x4*)(ATT_VPTR(2 * ((s0) + s)) + dt * 128); \
            if (2 * ((s0) + s) + 1 < NREAL) bh[s][dt] = *(const s16x4*)(ATT_VPTR(2 * ((s0) + s) + 1) + dt * 128); else bh[s][dt] = (s16x4){0, 0, 0, 0}; } } } while (0)
#define ATT_PV(bl, bh, s0) do { _Pragma("unroll") for (int s = 0; s < 3; ++s) { \
        const f32x4 pa = S[2 * ((s0) + s)]; f32x4 pb = {0.f, 0.f, 0.f, 0.f}; if (2 * ((s0) + s) + 1 < NREAL) pb = S[2 * ((s0) + s) + 1]; \
        u32x4 pw; pw.x = cvt_pk_bf16(pa[0], pa[1]); pw.y = cvt_pk_bf16(pa[2], pa[3]); pw.z = cvt_pk_bf16(pb[0], pb[1]); pw.w = cvt_pk_bf16(pb[2], pb[3]); \
        const bf16x8 Pf = __builtin_bit_cast(bf16x8, pw); \
        _Pragma("unroll") for (int dt = 0; dt < 4; ++dt) { const bf16x8 Vf = __builtin_shufflevector(bl[s][dt], bh[s][dt], 0, 1, 2, 3, 4, 5, 6, 7); \
            O[dt] = __builtin_amdgcn_mfma_f32_16x16x32_bf16(Vf, Pf, O[dt], 0, 0, 0); } } } while (0)
    bf16x8 KA[6][2], KB[6][2];
    s16x4 VAl[3][4], VAh[3][4], VBl[3][4], VBh[3][4];
    ATT_LOADK(KA, 0); ATT_LOADK(KB, 6);
    {
        const LAS float* bt = X.tbl + bidx;
#pragma unroll
        for (int t = 0; t < NWIN; ++t)
#pragma unroll
            for (int j = 0; j < 4; ++j) S[t][j] = TYPE == 0 ? bt[(t >> 1) * NA_TBL_ROW + 16 * (t & 1) + j] : bt[16 * t + j];
#pragma unroll
        for (int j = 0; j < 4; ++j) {
            if (TYPE == 1) { const int mk = 4 * kg + j; int bucket;
                if (metaq) { const int rel = mk - q; bucket = (rel > 0 ? 16 : 0) + t5_bucket_abs(rel < 0 ? -rel : rel); } else bucket = t5_bucket_abs(16 + colbase - mk);
                S[TMETA][j] = X.tbl[SWA_T5_OFF + bucket * 16 + hq];
            } else S[TMETA][j] = -SM_SHIFT;
        }
        if (TYPE == 0) {
            bool okm[2][4];
#pragma unroll
            for (int hf = 0; hf < 2; ++hf)
#pragma unroll
                for (int j = 0; j < 4; ++j) okm[hf][j] = !metaq && (unsigned)(colbase + 16 * hf + j - wsq) < 16u;
#pragma unroll
            for (int t = 0; t < NWIN; ++t)
#pragma unroll
                for (int j = 0; j < 4; ++j) S[t][j] = okm[t & 1][j] ? S[t][j] : NEGBIG;
        } else {
#pragma unroll
            for (int t = 0; t < NWIN; ++t)
#pragma unroll
                for (int j = 0; j < 4; ++j) S[t][j] = (!metaq && (unsigned)(relbase + 16 * t + j + 128) <= 256u) ? S[t][j] : NEGBIG;
        }
    }
    ATT_MMAK(KA, 0);
    ATT_LOADK(KA, 12);
    ATT_MMAK(KB, 6);
    if (TYPE == 0) ATT_LOADV(VAl, VAh, 0);
    ATT_MMAK(KA, 12);
    if (TYPE == 1) ATT_LOADV(VAl, VAh, 0);
#pragma unroll
    for (int dt = 0; dt < 4; ++dt) O[dt] = (f32x4){0.f, 0.f, 0.f, 0.f};
    __builtin_amdgcn_sched_barrier(0);
    float sk = 0.f;
    if (TYPE == 1) sk = X.tbl[SWA_SINK_OFF + hq];
    ATT_LOADV(VBl, VBh, 3);
    float l = 0.f;
#pragma unroll
    for (int t = 0; t < NREAL; ++t) {
#pragma unroll
        for (int j = 0; j < 4; ++j) { const float p = fast_exp2(S[t][j]); S[t][j] = p; l += p; }
    }
    l += __shfl_xor(l, 16); l += __shfl_xor(l, 32);
    if (TYPE == 1) l += fast_exp2(sk);
    __builtin_amdgcn_sched_barrier(0);
    const float inv = 1.0f / l;
    ATT_PV(VAl, VAh, 0);
    ATT_LOADV(VAl, VAh, 6);
    ATT_PV(VBl, VBh, 3);
    ATT_PV(VAl, VAh, 6);
#undef ATT_LOADK
#undef ATT_MMAK
#undef ATT_LOADV
#undef ATT_PV
#undef ATT_VPTR
#undef ATT_TOFF
    bf16_t* op = X.O + (size_t)((unsigned)(qtok0 + q) & X.omask) * 1024 + hq * 64 + 4 * kg;
#pragma unroll
    for (int dt = 0; dt < 4; ++dt) { u32x2 w; w.x = cvt_pk_bf16(O[dt][0] * inv, O[dt][1] * inv); w.y = cvt_pk_bf16(O[dt][2] * inv, O[dt][3] * inv); *(u32x2*)(op + 16 * dt) = w; }
}

template <int TYPE>
__device__ __forceinline__ void metaq_unit(const AttnCtx& X, const LAS float* t5s, const LAS float* sinks, int b, int hq, int lane) {
    const int q = lane & 15, kg = lane >> 4, hk = TYPE == 0 ? hq : (hq >> 2), nhk = X.kpitch >> 6, mtok0 = NREG;
    const size_t blk = (size_t)nhk * 512;
    const bf16_t* qp = X.Q + (size_t)(mtok0 + q) * 1024 + hq * 64 + 8 * kg;
    const bf16_t* kp = X.K + (size_t)(mtok0 >> 3) * blk + ((((size_t)(q >> 3) * nhk + hk) * 2) * 4 + kg) * 64 + (q & 7) * 8;
    const bf16_t* vp = X.VT + (size_t)(mtok0 >> 3) * blk + ((size_t)(kg >> 1) * nhk + hk) * 512 + ((kg & 1) * 16 + q) * 4;
    const bf16x8 q0 = *(const bf16x8*)qp, q1 = *(const bf16x8*)(qp + 32), k0 = *(const bf16x8*)kp, k1 = *(const bf16x8*)(kp + 256);
    s16x4 vl[4];
#pragma unroll
    for (int dt = 0; dt < 4; ++dt) vl[dt] = *(const s16x4*)(vp + dt * 128);
    f32x4 S;
#pragma unroll
    for (int j = 0; j < 4; ++j) {
        if (TYPE == 1) { const int rel = 4 * kg + j - q; S[j] = t5s[((rel > 0 ? 16 : 0) + t5_bucket_abs(rel < 0 ? -rel : rel)) * 16 + hq]; } else S[j] = -SM_SHIFT;
    }
    S = __builtin_amdgcn_mfma_f32_16x16x32_bf16(k0, q0, S, 0, 0, 0); S = __builtin_amdgcn_mfma_f32_16x16x32_bf16(k1, q1, S, 0, 0, 0);
    float l = 0.f;
#pragma unroll
    for (int j = 0; j < 4; ++j) { S[j] = fast_exp2(S[j]); l += S[j]; }
    l += __shfl_xor(l, 16); l += __shfl_xor(l, 32);
    if (TYPE == 1) l += fast_exp2(sinks[hq]);
    const float inv = 1.0f / l;
    u32x4 pw; pw.x = cvt_pk_bf16(S[0], S[1]); pw.y = cvt_pk_bf16(S[2], S[3]); pw.z = 0u; pw.w = 0u;
    const bf16x8 Pf = __builtin_bit_cast(bf16x8, pw);
    bf16_t* op = X.O + (size_t)((unsigned)(mtok0 + q) & X.omask) * 1024 + hq * 64 + 4 * kg;
#pragma unroll
    for (int dt = 0; dt < 4; ++dt) {
        const bf16x8 Vf = __builtin_shufflevector(vl[dt], (s16x4){0, 0, 0, 0}, 0, 1, 2, 3, 4, 5, 6, 7);
        const f32x4 o = __builtin_amdgcn_mfma_f32_16x16x32_bf16(Vf, Pf, (f32x4){0.f, 0.f, 0.f, 0.f}, 0, 0, 0);
        u32x2 w; w.x = cvt_pk_bf16(o[0] * inv, o[1] * inv); w.y = cvt_pk_bf16(o[2] * inv, o[3] * inv); *(u32x2*)(op + 16 * dt) = w;
    }
}

template <int TYPE>
__device__ __forceinline__ void attn_phase(Frame& F, const AttnCtx& X) {
    int lane_l = F.lane; asm volatile("" : "+v"(lane_l));
    if (F.G == 256) {
        const int xcd = F.bx & 7, cu = F.bx >> 3, w = F.wave;
        if (TYPE == 0) {
            for (int it = 0; it < 32; ++it) { const int p = xcd * 64 + 2 * it + (w >> 2); attn_unit<0>(X, p >> 4, p & 15, cu, w & 3, false, lane_l); }
        } else {
            for (int it = 0; it < 32; ++it) { const int bn = xcd * 16 + (it >> 1), qb = 4 * cu + 2 * (it & 1) + (w >> 2); attn_unit<1>(X, bn >> 2, (bn & 3) * 4 + (w & 3), qb, 0, false, lane_l); }
        }
    } else {
        const int UPC = (NREG + F.G - 1) / F.G;
        const int ubeg = F.bx * UPC, uend = (ubeg + UPC) < NREG ? (ubeg + UPC) : NREG;
        for (int u = ubeg + F.wave; u < uend; u += 8) {
            if (TYPE == 0) { const int cb = u & 3, r = (u >> 2) & 31, h = (u >> 7) & 15, b = u >> 11; attn_unit<0>(X, b, h, r, cb, false, lane_l); }
            else { const int g = u & 3, qb = (u >> 2) & 127, n = (u >> 9) & 3, b = u >> 11; attn_unit<1>(X, b, n * 4 + g, qb, 0, false, lane_l); }
        }
    }
    for (int u = F.bx * 8 + F.wave; u < 16; u += F.G * 8) metaq_unit<TYPE>(X, X.tbl, X.tbl, 0, u, lane_l);
}

__device__ __forceinline__ void dma16(const void* g, LAS void* l) { __builtin_amdgcn_global_load_lds((const unsigned*)g, (LAS unsigned*)l, 16, 0, 0); }
constexpr int NA_RING_ROWS = 12, NA_TBL_OFF = NA_RING_ROWS * 8192;
__device__ __forceinline__ void na_ring_item(Frame& F, const AttnCtx& X, int pair) {
    int lane = F.lane; asm volatile("" : "+v"(lane));
    const int w = F.wave, q = lane & 15, kg = lane >> 4, cb = w & 3, rsel = w >> 2, b = pair >> 4, hq = pair & 15;
    LAS unsigned char* lds = F.lds;
    const LAS float* tbl = (const LAS float*)(lds + NA_TBL_OFF);
    constexpr int nhk = 16; const size_t blk = (size_t)nhk * 512;
    const bf16_t* vglob = X.VT + ((size_t)(b * 256) * nhk + hq) * 512 + lane * 8;
    const int mtok0 = NREG;
    const bf16_t* kmet = X.K + (size_t)(mtok0 >> 3) * blk + ((((size_t)(q >> 3) * nhk + hq) * 2) * 4 + kg) * 64 + (q & 7) * 8;
    const bf16_t* vmet = X.VT + (size_t)(mtok0 >> 3) * blk + ((size_t)(kg >> 1) * nhk + hq) * 512 + ((kg & 1) * 16 + q) * 4;
#pragma unroll
    for (int r = 0; r < 8; ++r) dma16(vglob + (size_t)(8 * r + w) * blk, lds + r * 8192 + w * 1024);
    int loaded_hi = 8;
    const int ks = (16 * cb - 8) < 0 ? 0 : ((16 * cb - 8) > 32 ? 32 : (16 * cb - 8));
    const int qc = 16 * cb + q; int wsq = qc - 8; wsq = wsq < 0 ? 0 : (wsq > 48 ? 48 : wsq);
    const int colbase = ks + 4 * kg;
    bool okm[2][4];
#pragma unroll
    for (int hf = 0; hf < 2; ++hf)
#pragma unroll
        for (int j = 0; j < 4; ++j) okm[hf][j] = (unsigned)(colbase + 16 * hf + j - wsq) < 16u;
    const int kfl = ((((q >> 3) * nhk + hq) * 2) * 4 + kg) * 64 + (q & 7) * 8;
    const int vfl = ((ks >> 3) + (kg >> 1)) * 1024 + ((kg & 1) * 16 + q) * 8;
    bf16x8 Qn[2];
    { const bf16_t* qp = X.Q + (size_t)(b * SEQ + rsel * 64 + 16 * cb + q) * 1024 + hq * 64 + 8 * kg; Qn[0] = *(const bf16x8*)qp; Qn[1] = *(const bf16x8*)(qp + 32); }
    __builtin_amdgcn_s_waitcnt(0x0F70); asm volatile("" ::: "memory"); __builtin_amdgcn_s_barrier(); asm volatile("" ::: "memory");
    for (int s = 0; s < 16; ++s) {
        const int r = 2 * s + rsel;
        bf16x8 Qf[2]; Qf[0] = Qn[0]; Qf[1] = Qn[1];
        if (s + 1 < 16) {
            int nh = 2 * s + 3 - 4; nh = nh < 0 ? 0 : (nh > 24 ? 24 : nh); nh += 8;
#pragma unroll
            for (int k = 0; k < 2; ++k) { const int rr = loaded_hi + k; if (rr < nh) { const int slot = rr >= 24 ? rr - 24 : (rr >= 12 ? rr - 12 : rr); dma16(vglob + (size_t)(8 * rr + w) * blk, lds + slot * 8192 + w * 1024); } }
            loaded_hi = nh > loaded_hi ? nh : loaded_hi;
            const bf16_t* qp = X.Q + (size_t)(b * SEQ + (r + 2) * 64 + 16 * cb + q) * 1024 + hq * 64 + 8 * kg; Qn[0] = *(const bf16x8*)qp; Qn[1] = *(const bf16x8*)(qp + 32);
        }
        int rs = r - 4; rs = rs < 0 ? 0 : (rs > 24 ? 24 : rs);
        const int wtok0 = b * SEQ + rs * 64 + ks;
        const bf16_t* kwin = X.K + (size_t)(wtok0 >> 3) * blk + kfl;
        const LAS float* bt = tbl + hq * NA_TBL_HEAD + (rs - r + 7) * NA_TBL_ROW + (colbase - qc + 15 + 16);
        f32x4 S[17];
        bf16x8 KA[6][2], KB[6][2];
#define NR_LOADK(buf, t0) do { _Pragma("unroll") for (int t = 0; t < 6; ++t) if ((t0) + t < 17) { const bf16_t* kp = ((t0) + t == 16) ? kmet : kwin + (size_t)(8 * (((t0) + t) >> 1) + 2 * (((t0) + t) & 1)) * blk; buf[t][0] = *(const bf16x8*)kp; buf[t][1] = *(const bf16x8*)(kp + 256); } } while (0)
#define NR_MMAK(buf, t0) do { _Pragma("unroll") for (int t = 0; t < 6; ++t) if ((t0) + t < 17) { \
        f32x4 s_ = __builtin_amdgcn_mfma_f32_16x16x32_bf16(buf[t][0], Qf[0], S[(t0) + t], 0, 0, 0); S[(t0) + t] = __builtin_amdgcn_mfma_f32_16x16x32_bf16(buf[t][1], Qf[1], s_, 0, 0, 0); } } while (0)
        NR_LOADK(KA, 0); NR_LOADK(KB, 6);
        s16x4 vm[4];
#pragma unroll
        for (int dt = 0; dt < 4; ++dt) vm[dt] = *(const s16x4*)(vmet + dt * 128);
#pragma unroll
        for (int t = 0; t < 16; ++t)
#pragma unroll
            for (int j = 0; j < 4; ++j) S[t][j] = bt[(t >> 1) * NA_TBL_ROW + 16 * (t & 1) + j];
#pragma unroll
        for (int t = 0; t < 16; ++t)
#pragma unroll
            for (int j = 0; j < 4; ++j) S[t][j] = okm[t & 1][j] ? S[t][j] : NEGBIG;
        S[16] = (f32x4){-SM_SHIFT, -SM_SHIFT, -SM_SHIFT, -SM_SHIFT};
        NR_MMAK(KA, 0);
        NR_LOADK(KA, 12);
        NR_MMAK(KB, 6);
        NR_MMAK(KA, 12);
#undef NR_LOADK
#undef NR_MMAK
        bf16x8 Vp0[4], Vp1[4];
#define NA_LOADV(buf, st_) do { if ((st_) < 8) { int rr_ = rs + (st_); const int sl_ = rr_ >= 24 ? rr_ - 24 : (rr_ >= 12 ? rr_ - 12 : rr_); const LAS unsigned char* vp_ = lds + sl_ * 8192 + vfl; \
            _Pragma("unroll") for (int dt = 0; dt < 4; ++dt) { const s16x4 vl_ = *(const LAS s16x4*)(vp_ + 256 * dt), vh_ = *(const LAS s16x4*)(vp_ + 2048 + 256 * dt); buf[dt] = __builtin_shufflevector(vl_, vh_, 0, 1, 2, 3, 4, 5, 6, 7); asm volatile("" ::: "memory"); } } \
          else { _Pragma("unroll") for (int dt = 0; dt < 4; ++dt) buf[dt] = __builtin_shufflevector(vm[dt], (s16x4){0, 0, 0, 0}, 0, 1, 2, 3, 4, 5, 6, 7); } } while (0)
        NA_LOADV(Vp0, 0); NA_LOADV(Vp1, 1);
        __builtin_amdgcn_sched_barrier(0);
        float l = 0.f;
#pragma unroll
        for (int t = 0; t < 17; ++t)
#pragma unroll
            for (int j = 0; j < 4; ++j) { const float p = fast_exp2(S[t][j]); S[t][j] = p; l += p; }
        l += __shfl_xor(l, 16); l += __shfl_xor(l, 32);
        const float inv = 1.0f / l;
        __builtin_amdgcn_sched_barrier(0);
        f32x4 O[4];
#pragma unroll
        for (int dt = 0; dt < 4; ++dt) O[dt] = (f32x4){0.f, 0.f, 0.f, 0.f};
#pragma unroll
        for (int st = 0; st < 9; ++st) {
            const f32x4 pa = S[2 * st]; f32x4 pb = {0.f, 0.f, 0.f, 0.f}; if (st < 8) pb = S[2 * st + 1];
            u32x4 pw; pw.x = cvt_pk_bf16(pa[0], pa[1]); pw.y = cvt_pk_bf16(pa[2], pa[3]); pw.z = cvt_pk_bf16(pb[0], pb[1]); pw.w = cvt_pk_bf16(pb[2], pb[3]);
            const bf16x8 Pf = __builtin_bit_cast(bf16x8, pw);
            if ((st & 1) == 0) {
#pragma unroll
                for (int dt = 0; dt < 4; ++dt) O[dt] = __builtin_amdgcn_mfma_f32_16x16x32_bf16(Vp0[dt], Pf, O[dt], 0, 0, 0);
                __builtin_amdgcn_sched_barrier(0);
                if (st + 2 < 9) NA_LOADV(Vp0, st + 2);
            } else {
#pragma unroll
                for (int dt = 0; dt < 4; ++dt) O[dt] = __builtin_amdgcn_mfma_f32_16x16x32_bf16(Vp1[dt], Pf, O[dt], 0, 0, 0);
                __builtin_amdgcn_sched_barrier(0);
                if (st + 2 < 9) NA_LOADV(Vp1, st + 2);
            }
        }
#undef NA_LOADV
        bf16_t* op = X.O + (size_t)((unsigned)(b * SEQ + r * 64 + 16 * cb + q) & X.omask) * 1024 + hq * 64 + 4 * (kg & ~1) + 16 * (kg & 1);
#pragma unroll
        for (int dp = 0; dp < 2; ++dp) {
            const unsigned a0 = cvt_pk_bf16(O[2 * dp][0] * inv, O[2 * dp][1] * inv), a1 = cvt_pk_bf16(O[2 * dp][2] * inv, O[2 * dp][3] * inv);
            const unsigned b0 = cvt_pk_bf16(O[2 * dp + 1][0] * inv, O[2 * dp + 1][1] * inv), b1 = cvt_pk_bf16(O[2 * dp + 1][2] * inv, O[2 * dp + 1][3] * inv);
            const auto r0 = __builtin_amdgcn_permlane16_swap(a0, b0, false, false); const auto r1 = __builtin_amdgcn_permlane16_swap(a1, b1, false, false);
            u32x4 wv; wv.x = r0[0]; wv.y = r1[0]; wv.z = r0[1]; wv.w = r1[1];
            *(u32x4*)(op + 32 * dp) = wv; }
        __builtin_amdgcn_s_waitcnt(0x0F72); asm volatile("" ::: "memory"); __builtin_amdgcn_s_barrier(); asm volatile("" ::: "memory");
    }
    __builtin_amdgcn_s_waitcnt(0x0F70); asm volatile("" ::: "memory");
}

constexpr int SX_T5 = 0, SX_SINK = 2048, SX_TBL = 2176, SX_MK = 11392, SX_MV = 13440, SWA_VRING = 65536;
__device__ __forceinline__ void swa_ring_item(Frame& F, const AttnCtx& X, int item) {
    int lane = F.lane; asm volatile("" : "+v"(lane));
    const int w = F.wave, q = lane & 15, kg = lane >> 4;
    const int bn = item >> 1, hf = item & 1, b = bn >> 2, n = bn & 3, g = w & 3, qsel = w >> 2, hq = n * 4 + g;
    LAS unsigned char* lds = F.lds;
    const LAS float* xt5 = (const LAS float*)(lds + ATT_X_OFF + SX_T5);
    const LAS float* xtb = (const LAS float*)(lds + ATT_X_OFF + SX_TBL) + g * SWA_TBL_HEAD;
    const float sk = ((const LAS float*)(lds + ATT_X_OFF + SX_SINK))[hq];
    const bf16_t* kglob = X.K + ((size_t)(b * 256) * 4 + n) * 512 + lane * 8;
    const bf16_t* vglob = X.VT + ((size_t)(b * 256) * 4 + n) * 512 + lane * 8;
    if (w < 4) { const size_t mb = ((size_t)(NREG >> 3) + (w & 1)) * 4 + n; dma16((w < 2 ? X.K : X.VT) + mb * 512 + lane * 8, lds + ATT_X_OFF + (w < 2 ? SX_MK : SX_MV) + (w & 1) * 1024); }
    const int qbase = 64 * hf;
    int q0f = 16 * qbase; int lo = q0f - 128; lo = lo < 0 ? 0 : (lo > SEQ - 272 ? SEQ - 272 : lo);
    int hi0 = q0f + 16 - 128; hi0 = hi0 < 0 ? 0 : (hi0 > SEQ - 272 ? SEQ - 272 : hi0); hi0 += 272;
    for (int B = (lo >> 3) + w; B < (hi0 >> 3); B += 8) { dma16(kglob + (size_t)B * 2048, lds + (B & 63) * 1024); dma16(vglob + (size_t)B * 2048, lds + SWA_VRING + (B & 63) * 1024); }
    int loaded_hi = hi0;
    bf16x8 Qn[2];
    { const bf16_t* qp = X.Q + (size_t)(b * SEQ + 16 * (qbase + qsel) + q) * 1024 + hq * 64 + 8 * kg; Qn[0] = *(const bf16x8*)qp; Qn[1] = *(const bf16x8*)(qp + 32); }
    const int kfrag = (q >> 3) * 1024 + kg * 128 + (q & 7) * 16;
    const int vfrag = (kg >> 1) * 1024 + ((kg & 1) * 16 + q) * 8;
    __builtin_amdgcn_s_waitcnt(0x0F70); asm volatile("" ::: "memory"); __builtin_amdgcn_s_barrier(); asm volatile("" ::: "memory");
    for (int s = 0; s < 32; ++s) {
        const int qblk = qbase + 2 * s + qsel, q0 = 16 * qblk;
        bf16x8 Qf[2]; Qf[0] = Qn[0]; Qf[1] = Qn[1];
        if (s + 1 < 32) {
            int nh = 16 * (qbase + 2 * s + 3) - 128; nh = nh < 0 ? 0 : (nh > SEQ - 272 ? SEQ - 272 : nh); nh += 272;
            const int B = (loaded_hi >> 3) + (w & 3);
            if (B < (nh >> 3)) { if (w < 4) dma16(kglob + (size_t)B * 2048, lds + (B & 63) * 1024); else dma16(vglob + (size_t)B * 2048, lds + SWA_VRING + (B & 63) * 1024); }
            loaded_hi = nh > loaded_hi ? nh : loaded_hi;
            const bf16_t* qp = X.Q + (size_t)(b * SEQ + q0 + 32 + q) * 1024 + hq * 64 + 8 * kg; Qn[0] = *(const bf16x8*)qp; Qn[1] = *(const bf16x8*)(qp + 32);
        }
        int jb = q0 - 128; jb = jb < 0 ? 0 : (jb > SEQ - 272 ? SEQ - 272 : jb);
        const int relbase = jb + 4 * kg - q0 - q;
        const int jblk = jb >> 3;
        f32x4 S[18];
        {
            const LAS float* bt = xtb + relbase + 288;
#pragma unroll
            for (int t = 0; t < 17; ++t)
#pragma unroll
                for (int j = 0; j < 4; ++j) S[t][j] = bt[16 * t + j];
#pragma unroll
            for (int j = 0; j < 4; ++j) S[17][j] = xt5[t5_bucket_abs(16 + q0 + q - (4 * kg + j)) * 16 + hq];
            if (jb == q0 - 128) {
#pragma unroll
                for (int j = 0; j < 4; ++j) { S[0][j] = (relbase + j >= -128) ? S[0][j] : NEGBIG; S[16][j] = (relbase + 256 + j <= 128) ? S[16][j] : NEGBIG; }
            } else {
                int r0 = relbase + 128; asm volatile("" : "+v"(r0));
#pragma unroll
                for (int t = 0; t < 17; ++t)
#pragma unroll
                    for (int j = 0; j < 4; ++j) S[t][j] = ((unsigned)(r0 + (16 * t + j)) <= 256u) ? S[t][j] : NEGBIG;
            }
        }
#pragma unroll
        for (int t0 = 0; t0 < 18; t0 += 6) {
            bf16x8 Kf[6][2];
#pragma unroll
            for (int t = 0; t < 6; ++t) {
                const LAS unsigned char* kp = (t0 + t == 17) ? lds + ATT_X_OFF + SX_MK + kfrag : lds + (((jblk + 2 * (t0 + t) + (q >> 3)) & 63) * 1024) + (kfrag & 1023);
                Kf[t][0] = *(const LAS bf16x8*)kp; Kf[t][1] = *(const LAS bf16x8*)(kp + 512);
            }
#pragma unroll
            for (int t = 0; t < 6; ++t) { f32x4 s_ = __builtin_amdgcn_mfma_f32_16x16x32_bf16(Kf[t][0], Qf[0], S[t0 + t], 0, 0, 0); S[t0 + t] = __builtin_amdgcn_mfma_f32_16x16x32_bf16(Kf[t][1], Qf[1], s_, 0, 0, 0); }
        }
        bf16x8 Vp0[4], Vp1[4];
#define SW_LOADV(buf, st_) do { const LAS unsigned char* va_ = lds + SWA_VRING + (((jblk + 4 * (st_) + (kg >> 1)) & 63) * 1024) + (vfrag & 1023); \
            const LAS unsigned char* vb_ = ((st_) == 8) ? lds + ATT_X_OFF + SX_MV + vfrag : lds + SWA_VRING + (((jblk + 4 * (st_) + 2 + (kg >> 1)) & 63) * 1024) + (vfrag & 1023); \
            _Pragma("unroll") for (int dt = 0; dt < 4; ++dt) { const s16x4 vl_ = *(const LAS s16x4*)(va_ + 256 * dt), vh_ = *(const LAS s16x4*)(vb_ + 256 * dt); buf[dt] = __builtin_shufflevector(vl_, vh_, 0, 1, 2, 3, 4, 5, 6, 7); asm volatile("" ::: "memory"); } } while (0)
        SW_LOADV(Vp0, 0); SW_LOADV(Vp1, 1);
        __builtin_amdgcn_sched_barrier(0);
        float l = 0.f;
#pragma unroll
        for (int t = 0; t < 18; ++t)
#pragma unroll
            for (int j = 0; j < 4; ++j) { const float p = fast_exp2(S[t][j]); S[t][j] = p; l += p; }
        l += __shfl_xor(l, 16); l += __shfl_xor(l, 32);
        l += fast_exp2(sk);
        __builtin_amdgcn_sched_barrier(0);
        const float inv = 1.0f / l;
        f32x4 O[4];
#pragma unroll
        for (int dt = 0; dt < 4; ++dt) O[dt] = (f32x4){0.f, 0.f, 0.f, 0.f};
#pragma unroll
        for (int st = 0; st < 9; ++st) {
            const f32x4 pa = S[2 * st], pb = S[2 * st + 1];
            u32x4 pw; pw.x = cvt_pk_bf16(pa[0], pa[1]); pw.y = cvt_pk_bf16(pa[2], pa[3]); pw.z = cvt_pk_bf16(pb[0], pb[1]); pw.w = cvt_pk_bf16(pb[2], pb[3]);
            const bf16x8 Pf = __builtin_bit_cast(bf16x8, pw);
            if ((st & 1) == 0) {
#pragma unroll
                for (int dt = 0; dt < 4; ++dt) O[dt] = __builtin_amdgcn_mfma_f32_16x16x32_bf16(Vp0[dt], Pf, O[dt], 0, 0, 0);
                __builtin_amdgcn_sched_barrier(0);
                if (st + 2 < 9) SW_LOADV(Vp0, st + 2);
            } else {
#pragma unroll
                for (int dt = 0; dt < 4; ++dt) O[dt] = __builtin_amdgcn_mfma_f32_16x16x32_bf16(Vp1[dt], Pf, O[dt], 0, 0, 0);
                __builtin_amdgcn_sched_barrier(0);
                if (st + 2 < 9) SW_LOADV(Vp1, st + 2);
            }
        }
#undef SW_LOADV
        bf16_t* op = X.O + (size_t)((unsigned)(b * SEQ + q0 + q) & X.omask) * 1024 + hq * 64 + 4 * (kg & ~1) + 16 * (kg & 1);
#pragma unroll
        for (int dp = 0; dp < 2; ++dp) {
            const unsigned a0 = cvt_pk_bf16(O[2 * dp][0] * inv, O[2 * dp][1] * inv), a1 = cvt_pk_bf16(O[2 * dp][2] * inv, O[2 * dp][3] * inv);
            const unsigned b0 = cvt_pk_bf16(O[2 * dp + 1][0] * inv, O[2 * dp + 1][1] * inv), b1 = cvt_pk_bf16(O[2 * dp + 1][2] * inv, O[2 * dp + 1][3] * inv);
            const auto r0 = __builtin_amdgcn_permlane16_swap(a0, b0, false, false); const auto r1 = __builtin_amdgcn_permlane16_swap(a1, b1, false, false);
            u32x4 wv; wv.x = r0[0]; wv.y = r1[0]; wv.z = r0[1]; wv.w = r1[1];
            *(u32x4*)(op + 32 * dp) = wv; }
        __builtin_amdgcn_s_waitcnt(0x0F72); asm volatile("" ::: "memory"); __builtin_amdgcn_s_barrier(); asm volatile("" ::: "memory");
    }
    asm volatile("s_waitcnt vmcnt(0)" ::: "memory");
}

__device__ __forceinline__ void router_phase(Frame& F, const float* wr, const float* gain, const u64* ssq, int moe_idx, bool dummy) {
    LAS u32x4* Wl = (LAS u32x4*)F.lds;
    for (int idx = F.tid; idx < 32 * 64; idx += 512) {
        const int st = idx >> 6, ln = idx & 63, n = ln & 15, kg = ln >> 4, e = 2 * (n >> 2) + (n & 1), part = (n >> 1) & 1;
        float v[8];
#pragma unroll
        for (int c = 0; c < 8; ++c) { const int k = 64 * (st >> 1) + 16 * kg + 8 * (st & 1) + c; const float w = wr[(size_t)k * 8 + e] * gain[k];
            const float hi = __uint_as_float(cvt_pk_bf16(w, 0.f) << 16); v[c] = part ? w - hi : hi; }
        u32x4 o; o.x = cvt_pk_bf16(v[0], v[1]); o.y = cvt_pk_bf16(v[2], v[3]); o.z = cvt_pk_bf16(v[4], v[5]); o.w = cvt_pk_bf16(v[6], v[7]);
        Wl[idx] = o;
    }
    __syncthreads();
    unsigned* cnt = F.ctl + CW_CNT + (dummy ? 2 : moe_idx) * 8 * 64;
    unsigned char* tb_ = dummy ? F.ws + WS_R : F.ws + WS_TAB;
    unsigned* rowtok = (unsigned*)(tb_); float* rowssq = (float*)(tb_ + TAB_BYTES);
    unsigned* rowslot = (unsigned*)(tb_ + 2 * TAB_BYTES); float* rowgate = (float*)(tb_ + 3 * TAB_BYTES);
    const int gw = F.bx * 8 + F.wave, NGW = F.G * 8;
    constexpr int RT = 48;
    int lane_ = F.lane; asm volatile("" : "+v"(lane_));
    const int tok = lane_ & 15, q = lane_ >> 4;
    constexpr int NT = (M + RT - 1) / RT;
    LAS unsigned* wcnt = (LAS unsigned*)(F.lds + 32768);
    (void)gw;
    for (int t0 = 0; t0 < NT; t0 += NGW) {
        const int task = t0 + F.wave * F.G + F.bx; const bool has = task < NT;
        int me1 = 0, me2 = 0; float mg1 = 0.f, mg2 = 0.f, mss = 0.f;
        if (has) for (int j = 0; j < 3; ++j) {
            int mm = task * RT + 16 * j + tok; mm = mm < M ? mm : M - 1;
            const bf16_t* xr = F.hb + (size_t)mm * D + 16 * q;
            bf16x8 xa[16][2];
#pragma unroll
            for (int i = 0; i < 16; ++i) { xa[i][0] = *(const bf16x8*)(xr + 64 * i); xa[i][1] = *(const bf16x8*)(xr + 64 * i + 8); }
            const float ssv = ssq_val(ssq[mm]);
            f32x4 acc0 = {0.f, 0.f, 0.f, 0.f}, acc1 = {0.f, 0.f, 0.f, 0.f};
#pragma unroll
            for (int i = 0; i < 16; ++i) {
                const bf16x8 w0 = __builtin_bit_cast(bf16x8, Wl[(2 * i) * 64 + lane_]), w1 = __builtin_bit_cast(bf16x8, Wl[(2 * i + 1) * 64 + lane_]);
                acc0 = __builtin_amdgcn_mfma_f32_16x16x32_bf16(w0, xa[i][0], acc0, 0, 0, 0);
                acc1 = __builtin_amdgcn_mfma_f32_16x16x32_bf16(w1, xa[i][1], acc1, 0, 0, 0); }
            const f32x4 acc = acc0 + acc1;
            const float l0 = acc[0] + acc[2], l1 = acc[1] + acc[3];
            float cv[8]; int ce[8];
            cv[0] = l0; cv[1] = l1; ce[0] = 2 * q; ce[1] = 2 * q + 1;
#pragma unroll
            for (int d = 1; d < 4; ++d) { cv[2 * d] = __shfl_xor(l0, 16 * d); cv[2 * d + 1] = __shfl_xor(l1, 16 * d); ce[2 * d] = 2 * (q ^ d); ce[2 * d + 1] = 2 * (q ^ d) + 1; }
            int e1 = ce[0]; float v1 = cv[0];
#pragma unroll
            for (int c = 1; c < 8; ++c) if (cv[c] > v1 || (cv[c] == v1 && ce[c] < e1)) { v1 = cv[c]; e1 = ce[c]; }
            int e2 = -1; float v2 = -3.0e38f;
#pragma unroll
            for (int c = 0; c < 8; ++c) if (ce[c] != e1 && (cv[c] > v2 || (cv[c] == v2 && ce[c] < e2))) { v2 = cv[c]; e2 = ce[c]; }
            if (e2 < 0) e2 = e1 ^ 1;
            const float rstd = 1.0f / sqrtf(ssv * (1.0f / 1024.0f) + EPS);
            const float ex = __expf((v2 - v1) * rstd); const float g1 = 1.0f / (1.0f + ex), g2 = ex * g1;
            if (q == j) { me1 = e1; me2 = e2; mg1 = g1; mg2 = g2; mss = ssv; }
        }
        const bool act = has && F.lane < RT && task * RT + F.lane < M;
        int rank1 = 0, rank2 = 0, mycnt = 0, n1e2 = 0;
        const unsigned long long lt = (1ull << F.lane) - 1ull;
#pragma unroll
        for (int e = 0; e < 8; ++e) {
            const unsigned long long m1 = __ballot(act && me1 == e), m2 = __ballot(act && me2 == e);
            const int c1 = __popcll(m1), c2 = __popcll(m2);
            if (me1 == e) rank1 = __popcll(m1 & lt);
            if (me2 == e) { rank2 = __popcll(m2 & lt); n1e2 = c1; }
            if (F.lane == e) mycnt = c1 + c2;
        }
        unsigned basev = 0;
        if (F.lane < 8) wcnt[F.wave * 8 + F.lane] = (unsigned)mycnt;
        __syncthreads();
        if (F.wave == 0 && F.lane < 8) { unsigned tot = 0;
#pragma unroll
            for (int w = 0; w < 8; ++w) tot += wcnt[w * 8 + F.lane];
            wcnt[64 + F.lane] = tot ? __hip_atomic_fetch_add(cnt + F.lane * 64, tot, RLX_AGENT) : 0u; }
        __syncthreads();
        if (F.lane < 8) { basev = wcnt[64 + F.lane]; for (int w = 0; w < F.wave; ++w) basev += wcnt[w * 8 + F.lane]; }
        __syncthreads();
        const unsigned b1 = __shfl(basev, me1), b2 = __shfl(basev, me2);
        if (act) {
            const int m = task * RT + F.lane;
            const size_t p1 = (size_t)me1 * M + b1 + rank1, p2 = (size_t)me2 * M + b2 + n1e2 + rank2;
            rowtok[p1] = m; rowssq[p1] = mss; rowslot[p1] = 2 * m; rowgate[p1] = mg1;
            rowtok[p2] = m; rowssq[p2] = mss; rowslot[p2] = 2 * m + 1; rowgate[p2] = mg2;
        }
    }
}
__device__ __forceinline__ void combine_phase(Frame& F, const bf16_t* ys, u64* ssq_next, bool last, bool dummy) {
    const int gw = F.bx * 8 + F.wave, NGW = F.G * 8, mend = last ? NREG : M;
    u32x4 nh[2], na[2], nc[2];
    if (gw < mend) { const u32x4* hr = (const u32x4*)(F.hb + (size_t)gw * D) + F.lane; const u32x4* y0 = (const u32x4*)(ys + (size_t)(2 * gw) * D) + F.lane; const u32x4* y1 = (const u32x4*)(ys + (size_t)(2 * gw + 1) * D) + F.lane;
#pragma unroll
        for (int j = 0; j < 2; ++j) { nh[j] = hr[64 * j]; na[j] = y0[64 * j]; nc[j] = y1[64 * j]; } }
    for (int m = gw; m < mend; m += NGW) {
        u32x4 ch[2], ca[2], cc2[2];
#pragma unroll
        for (int j = 0; j < 2; ++j) { ch[j] = nh[j]; ca[j] = na[j]; cc2[j] = nc[j]; }
        const int mn = m + NGW;
        if (mn < mend) { const u32x4* hr = (const u32x4*)(F.hb + (size_t)mn * D) + F.lane; const u32x4* y0 = (const u32x4*)(ys + (size_t)(2 * mn) * D) + F.lane; const u32x4* y1 = (const u32x4*)(ys + (size_t)(2 * mn + 1) * D) + F.lane;
#pragma unroll
            for (int j = 0; j < 2; ++j) { nh[j] = hr[64 * j]; na[j] = y0[64 * j]; nc[j] = y1[64 * j]; } }
        float v[2][8]; float s = 0.f;
#pragma unroll
        for (int j = 0; j < 2; ++j) { const u32x4 h4 = ch[j], a = ca[j], c = cc2[j];
            const unsigned hh[4] = {h4.x, h4.y, h4.z, h4.w}, aa[4] = {a.x, a.y, a.z, a.w}, cc[4] = {c.x, c.y, c.z, c.w};
#pragma unroll
            for (int i = 0; i < 4; ++i) { v[j][2 * i] = __uint_as_float(hh[i] << 16) + (__uint_as_float(aa[i] << 16) + __uint_as_float(cc[i] << 16));
                v[j][2 * i + 1] = __uint_as_float(hh[i] & 0xffff0000u) + (__uint_as_float(aa[i] & 0xffff0000u) + __uint_as_float(cc[i] & 0xffff0000u)); }
#pragma unroll
            for (int i = 0; i < 8; ++i) s += v[j][i] * v[j][i]; }
        if (last) {
            f32x4* o = (f32x4*)((dummy ? (float*)(F.ws + WS_R) + (size_t)(m & 0x7FFF) * D : F.out + (size_t)m * D)) + 2 * F.lane;
#pragma unroll
            for (int j = 0; j < 2; ++j) { o[128 * j] = (f32x4){v[j][0], v[j][1], v[j][2], v[j][3]}; o[128 * j + 1] = (f32x4){v[j][4], v[j][5], v[j][6], v[j][7]}; }
        } else {
            s = wave_sum(s);
            u32x4* o8 = (u32x4*)(dummy ? (bf16_t*)(F.ws + WS_R) + (size_t)(m & 0x7FFF) * D : F.hb + (size_t)m * D) + F.lane;
#pragma unroll
            for (int j = 0; j < 2; ++j) { u32x4 w; w.x = cvt_pk_bf16(v[j][0], v[j][1]); w.y = cvt_pk_bf16(v[j][2], v[j][3]); w.z = cvt_pk_bf16(v[j][4], v[j][5]); w.w = cvt_pk_bf16(v[j][6], v[j][7]); o8[64 * j] = w; }
            if (F.lane == 0) ssq_next[m] = ssq_fix(s);
        }
    }
}

__device__ __forceinline__ bool thin_gemm(Frame& F, f32x4 (&acc)[4], const bf16_t* ap, const bf16_t* const (&bp)[4], int K, int lane) {
#pragma unroll
    for (int t = 0; t < 4; ++t) acc[t] = (f32x4){0.f, 0.f, 0.f, 0.f};
    const int ksl = K / 8, kb = F.wave * ksl;
#pragma unroll 2
    for (int k0 = kb; k0 < kb + ksl; k0 += 64) {
        bf16x8 af[2], bf[2][4];
#pragma unroll
        for (int st = 0; st < 2; ++st) { af[st] = *(const bf16x8*)(ap + k0 + 32 * st);
#pragma unroll
            for (int t = 0; t < 4; ++t) bf[st][t] = *(const bf16x8*)(bp[t] + k0 + 32 * st); }
#pragma unroll
        for (int st = 0; st < 2; ++st)
#pragma unroll
            for (int t = 0; t < 4; ++t) acc[t] = __builtin_amdgcn_mfma_f32_16x16x32_bf16(bf[st][t], af[st], acc[t], 0, 0, 0);
    }
    LAS f32x4* part = (LAS f32x4*)F.lds;
#pragma unroll
    for (int t = 0; t < 4; ++t) part[(F.wave * 4 + t) * 64 + lane] = acc[t];
    __syncthreads();
    if (F.wave == 0) {
#pragma unroll
        for (int w = 1; w < 8; ++w)
#pragma unroll
            for (int t = 0; t < 4; ++t) acc[t] = acc[t] + part[(w * 4 + t) * 64 + lane];
    }
    return F.wave == 0;
}
__device__ __forceinline__ void thin_qkv(Frame& F, const bf16_t* W, const u64* ssq, const float* gq, const float* gk, bf16_t* Q, bf16_t* Kb, bf16_t* Vb, int nhk, int QT) {
    for (int task = F.bx; task < 16 + 2 * nhk; task += F.G) {
    int lane = F.lane; asm volatile("" : "+v"(lane));
    const int tk = lane & 15, kg = lane >> 4, tok = NREG + tk;
    const int kind = task < 16 ? 0 : (task < 16 + nhk ? 1 : 2), hh = kind == 0 ? task : (kind == 1 ? task - 16 : task - 16 - nhk);
    const bf16_t* bp[4];
#pragma unroll
    for (int t = 0; t < 4; ++t) { const int d = 16 * t + tk;
        const int row = kind == 0 ? (hh >> 2) * 256 + qk_perm(64 * (hh & 3) + d) : (kind == 1 ? (4 + (hh >> 2)) * 256 + qk_perm(64 * (hh & 3) + d) : QT * 256 + hh * 64 + d);
        bp[t] = W + (size_t)row * 1024 + 8 * kg; }
    f32x4 acc[4];
    if (thin_gemm(F, acc, F.hb + (size_t)tok * D + 8 * kg, bp, 1024, lane)) {
        const float rstd = fast_rsqrt(ssq_val(ssq[tok]) * (1.0f / 1024.0f) + EPS);
        if (kind < 2) {
            float ss = 0.f;
#pragma unroll
            for (int t = 0; t < 4; ++t) { acc[t] = acc[t] * rstd; ss += acc[t][0] * acc[t][0] + acc[t][1] * acc[t][1] + acc[t][2] * acc[t][2] + acc[t][3] * acc[t][3]; }
            ss += __shfl_xor(ss, 16); ss += __shfl_xor(ss, 32);
            const float hn = fast_rsqrt(ss * (1.0f / 64.0f) + EPS) * (kind == 0 ? 0.125f * LOG2E : 1.0f);
            const float* gp = kind == 0 ? gq : gk;
#pragma unroll
            for (int t = 0; t < 4; ++t) { const int d0 = 16 * t + 4 * kg; const f32x4 g = *(const f32x4*)(gp + d0); const f32x4 v = acc[t] * g * hn;
                u32x2 w; w.x = cvt_pk_bf16(v[0], v[1]); w.y = cvt_pk_bf16(v[2], v[3]);
                if (kind == 0) *(u32x2*)(Q + (size_t)tok * 1024 + hh * 64 + d0) = w;
                else *(u32x2*)(Kb + (((((size_t)(tok >> 3) * nhk + hh) * 2 + (d0 >> 5)) * 4 + ((d0 >> 3) & 3)) * 64) + (tok & 7) * 8 + (d0 & 7)) = w; }
        } else {
#pragma unroll
            for (int t = 0; t < 4; ++t)
#pragma unroll
                for (int r = 0; r < 4; ++r) { const int d = 16 * t + 4 * kg + r; const unsigned pk = cvt_pk_bf16(acc[t][r] * rstd, 0.f);
                    Vb[((size_t)(tok >> 3) * nhk + hh) * 512 + (((d >> 4) * 2 + ((tok >> 2) & 1)) * 16 + (d & 15)) * 4 + (tok & 3)] = (bf16_t)(pk & 0xffffu); }
        }
    }
    __syncthreads();
    }
}
__device__ __forceinline__ void thin_res(Frame& F, const bf16_t* A, int pitchA, int K, const bf16_t* W, u64* ssq_out, unsigned char* hb8) {
    for (int task = F.bx; task < 16; task += F.G) {
    int lane = F.lane; asm volatile("" : "+v"(lane));
    const int tk = lane & 15, kg = lane >> 4, tok = NREG + tk, c0 = 64 * task;
    const bf16_t* bp[4];
#pragma unroll
    for (int t = 0; t < 4; ++t) bp[t] = W + (size_t)dst_row(5, c0 + 16 * t + tk) * K + 8 * kg;
    f32x4 acc[4];
    if (thin_gemm(F, acc, A + (size_t)tk * pitchA + 8 * kg, bp, K, lane)) {
        float ss = 0.f;
#pragma unroll
        for (int t = 0; t < 4; ++t) { bf16_t* hp = F.hb + (size_t)tok * D + c0 + 16 * t + 4 * kg; const u32x2 b = *(const u32x2*)hp;
            const float o0 = __uint_as_float(b.x << 16) + acc[t][0], o1 = __uint_as_float(b.x & 0xffff0000u) + acc[t][1], o2 = __uint_as_float(b.y << 16) + acc[t][2], o3 = __uint_as_float(b.y & 0xffff0000u) + acc[t][3];
            u32x2 w; w.x = cvt_pk_bf16(o0, o1); w.y = cvt_pk_bf16(o2, o3); *(u32x2*)hp = w; ss += o0 * o0 + o1 * o1 + o2 * o2 + o3 * o3;
            if (hb8) { int p0 = 0; p0 = __builtin_amdgcn_cvt_pk_fp8_f32(o0, o1, p0, false); p0 = __builtin_amdgcn_cvt_pk_fp8_f32(o2, o3, p0, true); *(unsigned*)(hb8 + (size_t)tok * D + c0 + 16 * t + 4 * kg) = (unsigned)p0; } }
        ss += __shfl_xor(ss, 16); ss += __shfl_xor(ss, 32);
        if (kg == 0) __hip_atomic_fetch_add(ssq_out + tok, ssq_fix(ss), RLX_AGENT);
    }
    __syncthreads();
    }
}
__device__ __forceinline__ void thin_gu(Frame& F, const bf16_t* W, const u64* ssq, bf16_t* hid) {
    for (int task = F.bx; task < FF / 32; task += F.G) {
    int lane = F.lane; asm volatile("" : "+v"(lane));
    const int tk = lane & 15, kg = lane >> 4, tok = NREG + tk, j0 = 32 * task;
    const bf16_t* bp[4];
#pragma unroll
    for (int t = 0; t < 4; ++t) bp[t] = W + (size_t)dst_row(t < 2 ? 3 : 4, j0 + 16 * (t & 1) + tk) * 1024 + 8 * kg;
    f32x4 acc[4];
    if (thin_gemm(F, acc, F.hb + (size_t)tok * D + 8 * kg, bp, 1024, lane)) {
        const float rstd = fast_rsqrt(ssq_val(ssq[tok]) * (1.0f / 1024.0f) + EPS);
#pragma unroll
        for (int t = 0; t < 2; ++t) { float o[4];
#pragma unroll
            for (int r = 0; r < 4; ++r) o[r] = silu_f(acc[t][r] * rstd) * (acc[t + 2][r] * rstd);
            u32x2 w; w.x = cvt_pk_bf16(o[0], o[1]); w.y = cvt_pk_bf16(o[2], o[3]); *(u32x2*)(hid + (size_t)tok * FF + j0 + 16 * t + 4 * kg) = w; }
    }
    __syncthreads();
    }
}

__device__ __forceinline__ void thin_gu8(Frame& F, const unsigned char* W, const u64* ssq, bf16_t* hid) {
    for (int task = F.bx; task < FF / 32; task += F.G) {
    int lane = F.lane; asm volatile("" : "+v"(lane));
    const int tk = lane & 15, kg = lane >> 4, tok = NREG + tk, j0 = 32 * task;
    const unsigned char* ap = F.ws + WS_HB8 + (size_t)tok * D + F.wave * 128 + 32 * kg;
    const bf16x8 a0 = *(const bf16x8*)ap, a1 = *(const bf16x8*)(ap + 16);
    f32x4 acc[4];
#pragma unroll
    for (int t = 0; t < 4; ++t) { const unsigned char* bp = W + (size_t)dst_row(t < 2 ? 3 : 4, j0 + 16 * (t & 1) + tk) * 1024 + F.wave * 128 + 32 * kg;
        const bf16x8 b0 = *(const bf16x8*)bp, b1 = *(const bf16x8*)(bp + 16);
        acc[t] = __builtin_amdgcn_mfma_scale_f32_16x16x128_f8f6f4(pg8::cat8(b0, b1), pg8::cat8(a0, a1), (f32x4){0.f, 0.f, 0.f, 0.f}, 0, 0, 0, 0, 0, 0); }
    LAS f32x4* part = (LAS f32x4*)F.lds;
#pragma unroll
    for (int t = 0; t < 4; ++t) part[(F.wave * 4 + t) * 64 + lane] = acc[t];
    __syncthreads();
    if (F.wave == 0) {
#pragma unroll
        for (int w = 1; w < 8; ++w)
#pragma unroll
            for (int t = 0; t < 4; ++t) acc[t] = acc[t] + part[(w * 4 + t) * 64 + lane];
        const float rstd = fast_rsqrt(ssq_val(ssq[tok]) * (1.0f / 1024.0f) + EPS) * W8_INV;
#pragma unroll
        for (int t = 0; t < 2; ++t) { float o[4];
#pragma unroll
            for (int r = 0; r < 4; ++r) o[r] = silu_f(acc[t][r] * rstd) * (acc[t + 2][r] * rstd) * HID8_SCALE;
            int q = 0; q = __builtin_amdgcn_cvt_pk_fp8_f32(o[0], o[1], q, false); q = __builtin_amdgcn_cvt_pk_fp8_f32(o[2], o[3], q, true);
            *(unsigned*)((unsigned char*)hid + (size_t)tok * FF + j0 + 16 * t + 4 * kg) = (unsigned)q; }
    }
    __syncthreads();
    }
}
__device__ __forceinline__ void thin_res8(Frame& F, const unsigned char* A, const unsigned char* W, u64* ssq_out) {
    for (int task = F.bx; task < 16; task += F.G) {
    int lane = F.lane; asm volatile("" : "+v"(lane));
    const int tk = lane & 15, kg = lane >> 4, tok = NREG + tk, c0 = 64 * task;
    f32x4 acc[4];
#pragma unroll
    for (int t = 0; t < 4; ++t) acc[t] = (f32x4){0.f, 0.f, 0.f, 0.f};
    if (F.wave < 7) {
        const unsigned char* ap = A + (size_t)tk * FF + F.wave * 512 + 32 * kg;
#pragma unroll
        for (int i = 0; i < 4; ++i) {
            const bf16x8 a0 = *(const bf16x8*)(ap + 128 * i), a1 = *(const bf16x8*)(ap + 128 * i + 16);
#pragma unroll
            for (int t = 0; t < 4; ++t) { const unsigned char* bp = W + (size_t)dst_row(5, c0 + 16 * t + tk) * FF + F.wave * 512 + 128 * i + 32 * kg;
                const bf16x8 b0 = *(const bf16x8*)bp, b1 = *(const bf16x8*)(bp + 16);
                acc[t] = __builtin_amdgcn_mfma_scale_f32_16x16x128_f8f6f4(pg8::cat8(b0, b1), pg8::cat8(a0, a1), acc[t], 0, 0, 0, 0, 0, 0); }
        }
    }
    LAS f32x4* part = (LAS f32x4*)F.lds;
#pragma unroll
    for (int t = 0; t < 4; ++t) part[(F.wave * 4 + t) * 64 + lane] = acc[t];
    __syncthreads();
    if (F.wave == 0) {
#pragma unroll
        for (int w = 1; w < 8; ++w)
#pragma unroll
            for (int t = 0; t < 4; ++t) acc[t] = acc[t] + part[(w * 4 + t) * 64 + lane];
        float ss = 0.f;
#pragma unroll
        for (int t = 0; t < 4; ++t) { bf16_t* hp = F.hb + (size_t)tok * D + c0 + 16 * t + 4 * kg; const u32x2 b = *(const u32x2*)hp; const f32x4 a = acc[t] * (W8_INV * HID8_INV);
            const float o0 = __uint_as_float(b.x << 16) + a[0], o1 = __uint_as_float(b.x & 0xffff0000u) + a[1], o2 = __uint_as_float(b.y << 16) + a[2], o3 = __uint_as_float(b.y & 0xffff0000u) + a[3];
            u32x2 w; w.x = cvt_pk_bf16(o0, o1); w.y = cvt_pk_bf16(o2, o3); *(u32x2*)hp = w; ss += o0 * o0 + o1 * o1 + o2 * o2 + o3 * o3; }
        ss += __shfl_xor(ss, 16); ss += __shfl_xor(ss, 32);
        if (kg == 0) __hip_atomic_fetch_add(ssq_out + tok, ssq_fix(ss), RLX_AGENT);
    }
    __syncthreads();
    }
}

constexpr int PH_PER_PAIR = 10 + 2 * MOE_NCH, N_PHASES = 1 + 2 * PH_PER_PAIR;
typedef const __attribute__((address_space(4))) Args* KArgs;
__device__ __forceinline__ KArgs kargs() { KArgs p = (KArgs)__builtin_amdgcn_kernarg_segment_ptr(); asm volatile("" : "+s"(p)); return p; }
__device__ __forceinline__ void make_frame(Frame& F, KArgs ap) {
    extern __shared__ __attribute__((aligned(16))) unsigned char lds_raw[];
    { LAS unsigned char* lp = (LAS unsigned char*)lds_raw; asm volatile("" : "+s"(lp)); F.lds = lp; }
    F.tab = F.lds + TAB_OFF;
    int t = threadIdx.x; asm volatile("" : "+v"(t));
    F.tid = t; F.lane = t & 63; F.wave = __builtin_amdgcn_readfirstlane(t >> 6);
    { int g_ = gridDim.x, b_ = blockIdx.x; asm volatile("" : "+s"(g_), "+s"(b_)); F.G = g_; F.bx = b_; }
    unsigned char* ws = ap->ws;
    F.ws = ws; F.out = ap->out; F.hb = (bf16_t*)(ws + WS_HB); F.ctl = (unsigned*)(ws + WS_CTL);
}
__device__ __forceinline__ void grid_seam() {
    KArgs ap = kargs();
    extern __shared__ __attribute__((aligned(16))) unsigned char lds_raw[];
    XcdBarrier b; b.bar = (unsigned*)(ap->ws + WS_CTL) + CW_BAR; b.x = xb_xcc_id(); b.st = (volatile LAS unsigned*)((LAS unsigned char*)lds_raw + MISC_OFF) + 8;
    xcd_barrier(b);
}
#ifndef SITE_MASK
#define SITE_MASK 0xFFFF
#endif
#define SITE(b) ((SITE_MASK >> (b)) & 1)

__device__ __forceinline__ void site_na_qkv(int pr) {
    KArgs ap = kargs(); Frame F; make_frame(F, ap);
    const int lb = pr ? I_L2 : I_L0; const unsigned char* wb = F.ws + WS_W + (size_t)pr * WPAIR; unsigned char* R = F.ws + WS_R;
    LAS float* gainsL = (LAS float*)(F.lds + GAIN_OFF);
    if (F.tid < 64) { gainsL[F.tid] = ap->in[lb + 2][F.tid] * (0.125f * LOG2E); gainsL[64 + F.tid] = ap->in[lb + 3][F.tid]; }
    __syncthreads();
    QkvPolicy P; P.nt = 16; P.pitchA = 2048; P.pitchB = 2048; P.G = F.G; P.c = F.bx; P.nN = 12; P.QT = 8; P.hb = (const char*)F.hb; P.W = (const char*)(wb + WNA_QKV);
    P.ssq = ssq_buf(F, 4 * pr + 0); P.Q = (bf16_t*)(R + R_Q); P.K = (bf16_t*)(R + R_K); P.VT = (bf16_t*)(R + R_VT_NA); P.kpitch = 1024; P.nQ = 4; P.gains = gainsL;
    thin_qkv(F, (const bf16_t*)(wb + WNA_QKV), ssq_buf(F, 4 * pr + 0), ap->in[lb + 2], ap->in[lb + 3], P.Q, P.K, P.VT, 16, 8);
    pg8::gemm_phase(F.lds, F.tab, P);
}
__device__ __forceinline__ void site_na_attn(int pr, bool dummy) {
    KArgs ap = kargs(); Frame F; make_frame(F, ap);
    const int lb = pr ? I_L2 : I_L0; unsigned char* R = F.ws + WS_R;
    LAS float* tbl = (LAS float*)(F.lds + NA_TBL_OFF); const float* rpb = ap->in[lb + 4];
    for (int i = F.tid; i < 16 * NA_TBL_HEAD; i += 512) { const int c = (i & 63) - 16, hd = i >> 6; tbl[i] = (c >= 0 && c < 31) ? rpb[hd * 31 + c] * LOG2E - SM_SHIFT : 0.f; }
    __syncthreads();
    AttnCtx X; X.Q = (const bf16_t*)(R + R_Q); X.K = (const bf16_t*)(R + R_K); X.VT = (const bf16_t*)(R + R_VT_NA); X.O = dummy ? (bf16_t*)(R + 3 * HB_BYTES) : (bf16_t*)(R + R_Q); X.omask = dummy ? 0x7FFFu : 0xFFFFFFFFu; X.kpitch = 1024; X.tbl = tbl;
    { int lane_l = F.lane; asm volatile("" : "+v"(lane_l));
      for (int u = F.bx * 8 + F.wave; u < 16; u += F.G * 8) metaq_unit<0>(X, tbl, tbl, 0, u, lane_l); }
    for (int pair = F.bx; pair < 512; pair += F.G) na_ring_item(F, X, pair);
    __syncthreads();
}
__device__ __forceinline__ void site_wo(int pr, int swa) {
    KArgs ap = kargs(); Frame F; make_frame(F, ap);
    const unsigned char* wb = F.ws + WS_W + (size_t)pr * WPAIR; unsigned char* R = F.ws + WS_R;
    ResPolicy<> P; P.nt = 16; P.pitchA = 2048; P.pitchB = 2048; P.G = F.G; P.c = F.bx; P.A = (const char*)(R + R_Q); P.W = (const char*)(wb + (swa ? WSW_O : WNA_O));
    const bool dummy = ap->dummy != 0;
    P.hb = F.hb; P.ssq_out = ssq_buf(F, dummy ? 8 : 4 * pr + (swa ? 3 : 1)); P.dmy = dummy ? (bf16_t*)(F.ws + WS_END) : nullptr;
    P.hb8 = ((swa || pr >= DENSE8_FROM) && !dummy) ? F.ws + WS_HB8 : nullptr;
    if (!dummy) thin_res(F, (const bf16_t*)(R + R_Q) + (size_t)NREG * 1024, 1024, 1024, (const bf16_t*)P.W, P.ssq_out, P.hb8);
    pg8::gemm_phase(F.lds, F.tab, P);
}
__device__ __forceinline__ void site_dense_gu(int pr) {
    KArgs ap = kargs(); Frame F; make_frame(F, ap);
    const unsigned char* wb = F.ws + WS_W + (size_t)pr * WPAIR; unsigned char* R = F.ws + WS_R;
    if (pr >= DENSE8_FROM) {
        GuPolicy<false, true> P; P.nt = 8; P.pitchA = 1024; P.pitchB = 1024; P.G = F.G; P.c = F.bx; P.hb = (const char*)(F.ws + WS_HB8); P.W = (const char*)(wb + WNA_GU); P.ssq = ssq_buf(F, 4 * pr + 1); P.hid = (bf16_t*)R;
        P.rowtok = nullptr; P.p0 = 0; P.p1 = 0; P.ptab = nullptr;
        thin_gu8(F, wb + WNA_GU, ssq_buf(F, 4 * pr + 1), (bf16_t*)R);
        pg8::gemm_phase(F.lds, F.tab, P);
    } else {
    GuPolicy<false> P; P.nt = 16; P.pitchA = 2048; P.pitchB = 2048; P.G = F.G; P.c = F.bx; P.hb = (const char*)F.hb; P.W = (const char*)(wb + WNA_GU); P.ssq = ssq_buf(F, 4 * pr + 1); P.hid = (bf16_t*)R;
    P.rowtok = nullptr; P.p0 = 0; P.p1 = 0; P.ptab = nullptr;
    thin_gu(F, (const bf16_t*)(wb + WNA_GU), ssq_buf(F, 4 * pr + 1), (bf16_t*)R);
    pg8::gemm_phase(F.lds, F.tab, P);
    }
}
__device__ __forceinline__ void site_dense_down(int pr) {
    KArgs ap = kargs(); Frame F; make_frame(F, ap);
    const unsigned char* wb = F.ws + WS_W + (size_t)pr * WPAIR; unsigned char* R = F.ws + WS_R;
    const bool dummy = ap->dummy != 0;
    if (pr >= DENSE8_FROM) {
        ResPolicy<true> P; P.nt = 28; P.pitchA = 3584; P.pitchB = 3584; P.G = F.G; P.c = F.bx; P.A = (const char*)R; P.W = (const char*)(wb + WNA_D);
        P.hb = F.hb; P.ssq_out = ssq_buf(F, dummy ? 8 : 4 * pr + 2); P.dmy = dummy ? (bf16_t*)(F.ws + WS_END) : nullptr;
        P.hb8 = nullptr;
        if (!dummy) thin_res8(F, (const unsigned char*)R + (size_t)NREG * FF, (const unsigned char*)P.W, P.ssq_out);
        pg8::gemm_phase(F.lds, F.tab, P);
    } else {
    ResPolicy<> P; P.nt = 56; P.pitchA = 7168; P.pitchB = 7168; P.G = F.G; P.c = F.bx; P.A = (const char*)R; P.W = (const char*)(wb + WNA_D);
    P.hb = F.hb; P.ssq_out = ssq_buf(F, dummy ? 8 : 4 * pr + 2); P.dmy = dummy ? (bf16_t*)(F.ws + WS_END) : nullptr;
    P.hb8 = nullptr;
    if (!dummy) thin_res(F, (const bf16_t*)R + (size_t)NREG * FF, FF, FF, (const bf16_t*)P.W, P.ssq_out, nullptr);
    pg8::gemm_phase(F.lds, F.tab, P);
    }
}
__device__ __forceinline__ void site_swa_qkv(int pr) {
    KArgs ap = kargs(); Frame F; make_frame(F, ap);
    const int lb = pr ? I_L3 : I_L1; const unsigned char* wb = F.ws + WS_W + (size_t)pr * WPAIR; unsigned char* R = F.ws + WS_R;
    LAS float* gainsL = (LAS float*)(F.lds + GAIN_OFF);
    if (F.tid < 64) { gainsL[F.tid] = ap->in[lb + 2][F.tid] * (0.125f * LOG2E); gainsL[64 + F.tid] = ap->in[lb + 3][F.tid]; }
    __syncthreads();
    QkvPolicy P; P.nt = 16; P.pitchA = 2048; P.pitchB = 2048; P.G = F.G; P.c = F.bx; P.nN = 6; P.QT = 5; P.hb = (const char*)F.hb; P.W = (const char*)(wb + WSW_QKV);
    P.ssq = ssq_buf(F, 4 * pr + 2); P.Q = (bf16_t*)(R + R_Q); P.K = (bf16_t*)(R + R_K); P.VT = (bf16_t*)(R + R_VT_SWA); P.kpitch = 256; P.nQ = 4; P.gains = gainsL;
    thin_qkv(F, (const bf16_t*)(wb + WSW_QKV), ssq_buf(F, 4 * pr + 2), ap->in[lb + 2], ap->in[lb + 3], P.Q, P.K, P.VT, 4, 5);
    pg8::gemm_phase(F.lds, F.tab, P);
}
__device__ __forceinline__ void site_swa_attn(int pr, bool dummy) {
    KArgs ap = kargs(); Frame F; make_frame(F, ap);
    const int lb = pr ? I_L3 : I_L1; unsigned char* R = F.ws + WS_R;
    const float* t5 = ap->in[I_T5]; const float* sink = ap->in[lb + 4];
    AttnCtx X; X.Q = (const bf16_t*)(R + R_Q); X.K = (const bf16_t*)(R + R_K); X.VT = (const bf16_t*)(R + R_VT_SWA); X.O = dummy ? (bf16_t*)(R + 3 * HB_BYTES) : (bf16_t*)(R + R_Q); X.omask = dummy ? 0x7FFFu : 0xFFFFFFFFu; X.kpitch = 256;
    {
        LAS float* xt = (LAS float*)(F.lds + ATT_X_OFF);
        xt[SX_T5 / 4 + F.tid] = t5[F.tid] * LOG2E - SM_SHIFT;
        if (F.tid < 16) xt[SX_SINK / 4 + F.tid] = sink[F.tid] * LOG2E - SM_SHIFT;
        __syncthreads();
        X.tbl = (const LAS float*)(F.lds + ATT_X_OFF) - SWA_T5_OFF;
        { int lane_l = F.lane; asm volatile("" : "+v"(lane_l));
          for (int u = F.bx * 8 + F.wave; u < 16; u += F.G * 8) attn_unit<1>(X, 0, u, 0, 0, true, lane_l); }
        for (int item = F.bx; item < 256; item += F.G) {
            const int n = (item >> 1) & 3;
            __syncthreads();
            for (int i = F.tid; i < 4 * SWA_TBL_HEAD; i += 512) { const int gg = i / SWA_TBL_HEAD, rel = i % SWA_TBL_HEAD - 288; const int bkt = (rel > 0 ? 16 : 0) + t5_bucket_abs(rel < 0 ? -rel : rel); xt[SX_TBL / 4 + i] = t5[bkt * 16 + n * 4 + gg] * LOG2E - SM_SHIFT; }
            __syncthreads();
            swa_ring_item(F, X, item);
        }
    }
    __syncthreads();
}
__device__ __forceinline__ void site_router(int pr) {
    KArgs ap = kargs(); Frame F; make_frame(F, ap);
    const int lb = pr ? I_L3 : I_L1;
    router_phase(F, ap->in[lb + 7], ap->in[lb + 6], ssq_buf(F, 4 * pr + 3), pr, ap->dummy != 0);
}
__device__ __forceinline__ int moe_tables(Frame& F, int pr) {
    volatile LAS int* pt = (volatile LAS int*)(F.lds + MISC_OFF + 128);
    if (F.tid == 0) { int acc = 0; pt[0] = 0;
        for (int e = 0; e < NE; ++e) { const int c = (int)__hip_atomic_load(F.ctl + CW_CNT + pr * 8 * 64 + e * 64, RLX_AGENT); pt[9 + e] = c; acc += (c + 255) / 256; pt[e + 1] = acc; } }
    __syncthreads();
    return pt[NE];
}
__device__ __forceinline__ void site_moe_gu(int pr, int ch) {
    KArgs ap = kargs(); Frame F; make_frame(F, ap);
    const int PT = moe_tables(F, pr); const int P0 = ch * MOE_CH, P1 = (ch == MOE_NCH - 1 || (P0 + MOE_CH) >= PT) ? PT : (P0 + MOE_CH);
    if (P0 < P1) {
        const unsigned char* wb = F.ws + WS_W + (size_t)pr * WPAIR; unsigned char* R = F.ws + WS_R;
        GuPolicy<true> P; P.nt = 8; P.pitchA = 1024; P.pitchB = 1024; P.G = F.G; P.c = F.bx; P.hb = (const char*)(F.ws + WS_HB8); P.W = (const char*)(wb + WSW_GU); P.ssq = (const void*)(F.ws + WS_TAB + TAB_BYTES); P.hid = (bf16_t*)R;
        P.rowtok = (const unsigned*)(F.ws + WS_TAB); P.p0 = P0; P.p1 = P1; P.ptab = (const LAS int*)(F.lds + MISC_OFF + 128);
        pg8::gemm_phase(F.lds, F.tab, P);
    }
    __syncthreads();
}
__device__ __forceinline__ void site_moe_down(int pr, int ch) {
    KArgs ap = kargs(); Frame F; make_frame(F, ap);
    const int PT = moe_tables(F, pr); const int P0 = ch * MOE_CH, P1 = (ch == MOE_NCH - 1 || (P0 + MOE_CH) >= PT) ? PT : (P0 + MOE_CH);
    if (P0 < P1) {
        const unsigned char* wb = F.ws + WS_W + (size_t)pr * WPAIR; unsigned char* R = F.ws + WS_R;
        MoeDownPolicy P; P.nt = 28; P.pitchA = 3584; P.pitchB = 3584; P.G = F.G; P.c = F.bx; P.hid = (const char*)R; P.W = (const char*)(wb + WSW_D);
        P.rowslot = (const unsigned*)(F.ws + WS_TAB + 2 * TAB_BYTES); P.rowgate = (const float*)(F.ws + WS_TAB + 3 * TAB_BYTES); P.ys = (bf16_t*)(R + R_YS); P.p0 = P0; P.p1 = P1; P.ptab = (const LAS int*)(F.lds + MISC_OFF + 128);
        pg8::gemm_phase(F.lds, F.tab, P);
    }
    __syncthreads();
}
__device__ __forceinline__ void site_combine(int pr) {
    KArgs ap = kargs(); Frame F; make_frame(F, ap);
    const bool dummy = ap->dummy != 0;
    combine_phase(F, (const bf16_t*)(F.ws + WS_R + R_YS), ssq_buf(F, dummy ? 3 : (pr ? 0 : 4)), pr == 1, dummy);
}

__global__ void __launch_bounds__(512, 2) fwd_kernel(Args args) {
    extern __shared__ __attribute__((aligned(16))) unsigned char lds_raw[];
    {
        volatile LAS unsigned* MISC = (volatile LAS unsigned*)((LAS unsigned char*)lds_raw + MISC_OFF);
        if (threadIdx.x < 64) MISC[threadIdx.x] = 0u;
        __syncthreads();
    }
    const int lo = args.ph_lo, hi = args.ph_hi;
    if (hi - lo > 1) { KArgs ap = kargs(); (void)xcd_barrier_post((unsigned*)(ap->ws + WS_CTL) + CW_BAR, (volatile LAS unsigned*)((LAS unsigned char*)lds_raw + MISC_OFF) + 8); }
#define IN(k) (lo <= (k) && (k) < hi)
#if PROBE_A || PROBE_B
#define STAMP(k) do { if (blockIdx.x == 0 && threadIdx.x == 0) { KArgs ap_ = kargs(); ((u64*)(ap_->ws + WS_CTL + 49152))[(k)] = __builtin_amdgcn_s_memrealtime(); } } while (0)
#else
#define STAMP(k) do { } while (0)
#endif
#define SEAM(k) do { if (IN(k) && IN((k) + 1)) grid_seam(); STAMP((k) + 1); } while (0)
    STAMP(0);
    if ((REP_MASK & 1) && IN(0)) { KArgs ap = kargs(); Frame F; make_frame(F, ap); prologue(F, ap); grid_seam(); }
    if (SITE(0) && IN(0)) { KArgs ap = kargs(); Frame F; make_frame(F, ap); prologue(F, ap); }
    SEAM(0);
    for (int pr = 0; pr < 2; ++pr) {
        const int pb = 1 + pr * PH_PER_PAIR;
        if (((REP_MASK >> 1) & 1) && IN(pb + 0)) { site_na_qkv(pr); grid_seam(); }
        if (SITE(1) && IN(pb + 0)) site_na_qkv(pr);
        SEAM(pb + 0);
        if (((REP_MASK >> 2) & 1) && IN(pb + 1)) { site_na_attn(pr, true); grid_seam(); }
        if (SITE(2) && IN(pb + 1)) site_na_attn(pr, kargs()->dummy != 0);
        SEAM(pb + 1);
        if (SITE(3) && IN(pb + 2)) site_wo(pr, 0);
        SEAM(pb + 2);
        if (((REP_MASK >> 4) & 1) && IN(pb + 3)) { site_dense_gu(pr); grid_seam(); }
        if (SITE(4) && IN(pb + 3)) site_dense_gu(pr);
        SEAM(pb + 3);
        if (SITE(5) && IN(pb + 4)) site_dense_down(pr);
        SEAM(pb + 4);
        if (SITE(6) && IN(pb + 5)) site_swa_qkv(pr);
        SEAM(pb + 5);
        if (((REP_MASK >> 7) & 1) && IN(pb + 6)) { site_swa_attn(pr, true); grid_seam(); }
        if (SITE(7) && IN(pb + 6)) site_swa_attn(pr, kargs()->dummy != 0);
        SEAM(pb + 6);
        if (SITE(8) && IN(pb + 7)) site_wo(pr, 1);
        SEAM(pb + 7);
        if (SITE(9) && IN(pb + 8)) site_router(pr);
        SEAM(pb + 8);
        for (int ch = 0; ch < MOE_NCH; ++ch) {
            if (SITE(10) && IN(pb + 9 + 2 * ch)) site_moe_gu(pr, ch);
            SEAM(pb + 9 + 2 * ch);
            if (SITE(11) && IN(pb + 10 + 2 * ch)) site_moe_down(pr, ch);
            SEAM(pb + 10 + 2 * ch);
        }
        if (SITE(12) && IN(pb + 9 + 2 * MOE_NCH)) site_combine(pr);
        SEAM(pb + 9 + 2 * MOE_NCH);
    }
#if PROBE_A || PROBE_B
    {
        grid_seam();
        KArgs ap = kargs(); const u64* ts = (const u64*)(ap->ws + WS_CTL + 49152);
        u64 ta = 0, tb = 0;
        for (int k = 0; k < N_PHASES; ++k) { const u64 d = __hip_atomic_load(ts + k + 1, RLX_AGENT) - __hip_atomic_load(ts + k, RLX_AGENT); if ((PROBE_A >> k) & 1ull) ta += d; if ((PROBE_B >> k) & 1ull) tb += d; }
        const float sc = 1.0f + (float)ta * 1e-5f;
        float* o = ap->out;
        for (size_t i = (size_t)blockIdx.x * 512 + threadIdx.x; i < (size_t)NREG * D; i += (size_t)gridDim.x * 512) o[i] *= sc;
        if (PROBE_B) { grid_seam(); if (blockIdx.x == 0 && threadIdx.x == 0) o[0] = (float)tb * 0.01f; }
    }
#endif
#undef IN
#undef SEAM
}

extern "C" void kernel_launch(void* const* d_in, const int* in_sizes, int n_in, void* d_out, int out_size, void* d_ws, size_t ws_size, hipStream_t stream) {
    static int grid = 0;
    if (grid == 0) {
        if (n_in != 45 || out_size != NREG * D || ws_size < WS_END) { fprintf(stderr, "kernel_launch: unexpected shapes (n_in %d out %d ws %zu need %zu)\n", n_in, out_size, ws_size, (size_t)WS_END); grid = -1; return; }
        int dev = 0, cus = 0, per_cu = 0;
        if (hipGetDevice(&dev) != hipSuccess || hipDeviceGetAttribute(&cus, hipDeviceAttributeMultiprocessorCount, dev) != hipSuccess) { grid = -1; return; }
        if (hipFuncSetAttribute((const void*)fwd_kernel, hipFuncAttributeMaxDynamicSharedMemorySize, LDS_BYTES) != hipSuccess) { fprintf(stderr, "kernel_launch: hipFuncSetAttribute failed\n"); grid = -1; return; }
        if (hipOccupancyMaxActiveBlocksPerMultiprocessor(&per_cu, (const void*)fwd_kernel, 512, LDS_BYTES) != hipSuccess || per_cu < 1) fprintf(stderr, "kernel_launch: occupancy query says %d\n", per_cu);
        (void)hipGetLastError();
        grid = cus;
    }
    if (grid < 0) return;
    (void)hipMemsetAsync((char*)d_ws + WS_CTL, 0, CTL_BYTES, stream);
    Args a{};
    for (int i = 0; i < 45; ++i) a.in[i] = (const float*)d_in[i];
    a.out = (float*)d_out; a.ws = (unsigned char*)d_ws;
#if MK_MULTI
    for (int p = 0; p < N_PHASES && p <= MK_STOP; ++p) { a.ph_lo = p; a.ph_hi = p + 1;
        if (p == DUP_PHASE) { a.dummy = 1; hipLaunchKernelGGL(fwd_kernel, dim3(grid), dim3(512), LDS_BYTES, stream, a); a.dummy = 0; }
        hipLaunchKernelGGL(fwd_kernel, dim3(grid), dim3(512), LDS_BYTES, stream, a); }
#else
    a.ph_lo = 0; a.ph_hi = N_PHASES;
    hipLaunchKernelGGL(fwd_kernel, dim3(grid), dim3(512), LDS_BYTES, stream, a);
#endif
}
```
